# Optimizing an MI355X kernel written in HIP

```python
import jax, jax.numpy as jnp
from jax import lax
import numpy as np

D_MODEL = 1024
BATCH = 16
SEQ = 256
DEPTH = 2
DEC_BATCH = 4
DEC_SEQ = 2048
PAST_LEN = 256

GRID_W = 64
N_HEADS = 8
KV_HEADS = 2
HEAD_DIM = 64
Q_GROUP = N_HEADS // KV_HEADS
ATTN_WIDTH = N_HEADS * HEAD_DIM
KV_WIDTH = KV_HEADS * HEAD_DIM
WINDOW = 128
BLOCK = 128
AXIS_ROT = HEAD_DIM // 2
ROPE_BASE = 10000.0
LRU_WIDTH = 512
LRU_BLOCKS = 8
LRU_BW = LRU_WIDTH // LRU_BLOCKS
LRU_C = 8.0
CONV_W = 4
CONV_LEFT = 2
FOURIER_WIDTH = 512
FOURIER_GROUPS = 4
FOURIER_GW = FOURIER_WIDTH // FOURIER_GROUPS
D_FF = 2816
N_BRANCH = 3
N_SUB = 3
EPS = 1e-6
NEG = -1e30
IN_WIDTH = ATTN_WIDTH + 2 * KV_WIDTH + 2 * LRU_WIDTH + FOURIER_WIDTH
SPLITS = [ATTN_WIDTH,
          ATTN_WIDTH + KV_WIDTH,
          ATTN_WIDTH + 2 * KV_WIDTH,
          ATTN_WIDTH + 2 * KV_WIDTH + LRU_WIDTH,
          ATTN_WIDTH + 2 * KV_WIDTH + 2 * LRU_WIDTH]

kernel_name = "hybrid_diffusion_prefix_step"

f32 = jnp.float32


def rmsnorm(x, g):
    xf = x.astype(f32)
    y = xf * lax.rsqrt(jnp.mean(xf * xf, axis=-1, keepdims=True) + EPS)
    return (y * g.astype(f32)).astype(x.dtype)


def swiglu(h, wg, wu, wd):
    return (jax.nn.silu(h @ wg) * (h @ wu)) @ wd


def axial_rope_tables(n_tokens):
    rows = n_tokens // GRID_W
    row = jnp.repeat(jnp.arange(rows), GRID_W).astype(f32)
    col = jnp.tile(jnp.arange(GRID_W), rows).astype(f32)
    inv = ROPE_BASE ** (-jnp.arange(0, AXIS_ROT, 2, dtype=f32) / AXIS_ROT)
    ang = jnp.stack([row[:, None] * inv, col[:, None] * inv], axis=1)
    return jnp.cos(ang), jnp.sin(ang)


def apply_rope(x, cos, sin):
    B, L, H, _ = x.shape
    xr = x.astype(f32).reshape(B, L, H, 2, 2, AXIS_ROT // 2)
    x1, x2 = xr[..., 0, :], xr[..., 1, :]
    c, s = cos[:, None], sin[:, None]
    out = jnp.stack([x1 * c - x2 * s, x1 * s + x2 * c], axis=-2)
    return out.reshape(B, L, H, HEAD_DIM).astype(x.dtype)


def sink_attend(q, k, v, bias, sink):
    s = jnp.einsum('bqhgd,bkhd->bhgqk', q.astype(f32), k.astype(f32)) * (HEAD_DIM ** -0.5)
    if bias is not None:
        s = s + bias
    sk = sink.astype(f32)[None, :, :, None, None]
    m = jnp.maximum(jnp.max(s, axis=-1, keepdims=True), sk)
    p = jnp.exp(s - m)
    denom = jnp.sum(p, axis=-1, keepdims=True) + jnp.exp(sk - m)
    o = jnp.einsum('bhgqk,bkhd->bqhgd', p / denom, v.astype(f32))
    return o.astype(q.dtype)


def context_attention(q, k, v, sink):
    B, L = q.shape[:2]
    nb = L // BLOCK
    qb = q.reshape(B, nb, BLOCK, KV_HEADS, Q_GROUP, HEAD_DIM).swapaxes(0, 1)
    ob = lax.map(lambda qi: sink_attend(qi, k, v, None, sink), qb)
    return ob.swapaxes(0, 1).reshape(B, L, ATTN_WIDTH)


def latent_attention(q, k, v, k_ctx, v_ctx, sink):
    B, L = q.shape[:2]
    nb = L // BLOCK
    pad = ((0, 0), (BLOCK, BLOCK), (0, 0), (0, 0))
    kp, vp = jnp.pad(k, pad), jnp.pad(v, pad)
    qb = q.reshape(B, nb, BLOCK, KV_HEADS, Q_GROUP, HEAD_DIM).swapaxes(0, 1)
    a_idx = jnp.arange(BLOCK)[:, None]
    b_idx = jnp.arange(3 * BLOCK)[None, :]
    band_ok = jnp.abs(b_idx - BLOCK - a_idx) <= WINDOW
    ctx_bias = jnp.zeros((BLOCK, k_ctx.shape[1]), f32)

    def one_block(args):
        qi, n = args
        start = n * BLOCK
        kb = lax.dynamic_slice_in_dim(kp, start, 3 * BLOCK, axis=1)
        vb = lax.dynamic_slice_in_dim(vp, start, 3 * BLOCK, axis=1)
        ppos = start + b_idx
        ok = band_ok & (ppos >= BLOCK) & (ppos < L + BLOCK)
        bias = jnp.concatenate([jnp.where(ok, 0.0, NEG).astype(f32), ctx_bias], axis=1)
        keys = jnp.concatenate([kb, k_ctx.astype(kb.dtype)], axis=1)
        vals = jnp.concatenate([vb, v_ctx.astype(vb.dtype)], axis=1)
        return sink_attend(qi, keys, vals, bias, sink)

    ob = lax.map(one_block, (qb, jnp.arange(nb)))
    return ob.swapaxes(0, 1).reshape(B, L, ATTN_WIDTH)


def short_conv(x, w, bias):
    L = x.shape[1]
    xp = jnp.pad(x, ((0, 0), (CONV_LEFT, CONV_W - 1 - CONV_LEFT), (0, 0)))
    out = bias
    for j in range(CONV_W):
        out = out + xp[:, j:j + L] * w[j]
    return out


def block_diag(x, w):
    B, L, _ = x.shape
    y = jnp.einsum('blnc,ncd->blnd', x.reshape(B, L, LRU_BLOCKS, LRU_BW), w.astype(f32))
    return y.reshape(B, L, LRU_WIDTH)


def rglru_coeffs(x, wa, ba, wi, bi, lam):
    xf = x.astype(f32)
    r = jax.nn.sigmoid(block_diag(xf, wa) + ba.astype(f32))
    i = jax.nn.sigmoid(block_diag(xf, wi) + bi.astype(f32))
    log_a = -LRU_C * r * jax.nn.softplus(-lam.astype(f32))
    a = jnp.exp(log_a)
    b = jnp.sqrt(-jnp.expm1(2.0 * log_a)) * (i * xf)
    return a, b


def linear_scan(a, b, h0, reverse):
    edge = -1 if reverse else 0
    b = b.at[:, edge].add(a[:, edge] * h0)

    def combine(e1, e2):
        a1, b1 = e1
        a2, b2 = e2
        return a1 * a2, a2 * b1 + b2

    _, h = lax.associative_scan(combine, (a, b), reverse=reverse, axis=1)
    return h


def bidir_rglru(x, wa, ba, wi, bi, lam, h0):
    af, bf = rglru_coeffs(x, wa[0], ba[0], wi[0], bi[0], lam[0])
    h_fwd = linear_scan(af, bf, h0[:, 0].astype(f32), False)
    ab, bb = rglru_coeffs(x, wa[1], ba[1], wi[1], bi[1], lam[1])
    h_bwd = linear_scan(ab, bb, h0[:, 1].astype(f32), True)
    return h_fwd, h_bwd


def fourier_mix(x):
    B, L, _ = x.shape
    xf = x.astype(f32).reshape(B, L, FOURIER_GROUPS, FOURIER_GW)
    y = jnp.fft.fft2(xf, axes=(1, 3), norm="ortho").real
    return y.reshape(B, L, FOURIER_WIDTH).astype(x.dtype)


def token_mixer(h, P, rope, ctx):
    B, L, _ = h.shape
    q, k, v, xr, yr, xf = jnp.split(h @ P["w_in"], SPLITS, axis=-1)
    q = q.reshape(B, L, N_HEADS, HEAD_DIM)
    k = k.reshape(B, L, KV_HEADS, HEAD_DIM)
    v = v.reshape(B, L, KV_HEADS, HEAD_DIM)
    sink = P["attn_sink"].reshape(KV_HEADS, Q_GROUP)
    xc = short_conv(xr, P["conv_w"], P["conv_b"])
    if ctx is None:
        attn = context_attention(q, k, v, sink)
        h0 = jnp.zeros((B, 2, LRU_WIDTH), f32)
    else:
        k_ctx, v_ctx, h0 = ctx
        cos, sin = rope
        q = apply_rope(q, cos, sin)
        k = apply_rope(k, cos, sin)
        attn = latent_attention(q, k, v, k_ctx, v_ctx, sink)
    h_fwd, h_bwd = bidir_rglru(xc, P["lru_wa"], P["lru_ba"], P["lru_wi"], P["lru_bi"], P["lru_lambda"], h0)
    rec = ((h_fwd + h_bwd) * jax.nn.gelu(yr.astype(f32))).astype(h.dtype)
    four = fourier_mix(xf)
    g = jax.nn.sigmoid(h @ P["w_branch_gate"] + P["b_branch_gate"])
    ga, gr, gf = jnp.split(g, N_BRANCH, axis=-1)
    merged = (ga * (attn @ P["w_attn_out"]) + gr * (rec @ P["w_lru_out"])
              + gf * (four @ P["w_fourier_out"]))
    out = merged @ P["w_o"]
    if ctx is None:
        return out, (k, v, jnp.stack([h_fwd[:, -1], h_bwd[:, 0]], axis=1))
    return out, None


def trunk_layer(x, cond, P, rope, ctx):
    M = cond.shape[0]
    mod = (jax.nn.silu(cond) @ P["w_ada"] + P["b_ada"]).reshape(M, 1, N_SUB, 3, D_MODEL)

    def modnorm(z, i):
        return rmsnorm(z, P["norm_w"][i]) * (1.0 + mod[:, :, i, 1]) + mod[:, :, i, 0]

    x = x + 0.5 * mod[:, :, 0, 2] * swiglu(modnorm(x, 0), P["ffn1_wg"], P["ffn1_wu"], P["ffn1_wd"])
    mix, ctx_out = token_mixer(modnorm(x, 1), P, rope, ctx)
    x = x + mod[:, :, 1, 2] * mix
    x = x + 0.5 * mod[:, :, 2, 2] * swiglu(modnorm(x, 2), P["ffn2_wg"], P["ffn2_wu"], P["ffn2_wd"])
    return x, ctx_out


def setup_inputs(seed: int = 0) -> dict:
    key = jax.random.key(seed)
    keys = iter(jax.random.split(key, 48))

    def nrm(shape, scale):
        return jax.random.normal(next(keys), shape, f32) * scale

    D = D_MODEL
    lo, hi = 0.9 ** (1.0 / LRU_C), 0.999 ** (1.0 / LRU_C)
    a0 = jax.random.uniform(next(keys), (DEPTH, 2, LRU_WIDTH), f32, minval=lo, maxval=hi)
    return {
        "x_prompt": nrm((BATCH, SEQ, D), 1.0),
        "x_sample": nrm((DEC_BATCH, DEC_SEQ, D), 1.0),
        "c": nrm((DEC_BATCH, D), 1.0),
        "cache_k": nrm((DEC_BATCH, DEPTH, PAST_LEN, KV_HEADS, HEAD_DIM), 1.0),
        "cache_v": nrm((DEC_BATCH, DEPTH, PAST_LEN, KV_HEADS, HEAD_DIM), 1.0),
        "state_lru": nrm((DEC_BATCH, DEPTH, 2, LRU_WIDTH), 0.5),
        "c_ctx": nrm((D,), 1.0),
        "w_ada": nrm((DEPTH, D, N_SUB * 3 * D), 0.5 * D ** -0.5),
        "b_ada": nrm((DEPTH, N_SUB * 3 * D), 0.01),
        "norm_w": 1.0 + nrm((DEPTH, N_SUB, D), 0.01),
        "final_norm_w": 1.0 + nrm((D,), 0.01),
        "ffn1_wg": nrm((DEPTH, D, D_FF), D ** -0.5),
        "ffn1_wu": nrm((DEPTH, D, D_FF), D ** -0.5),
        "ffn1_wd": nrm((DEPTH, D_FF, D), D_FF ** -0.5),
        "ffn2_wg": nrm((DEPTH, D, D_FF), D ** -0.5),
        "ffn2_wu": nrm((DEPTH, D, D_FF), D ** -0.5),
        "ffn2_wd": nrm((DEPTH, D_FF, D), D_FF ** -0.5),
        "w_in": nrm((DEPTH, D, IN_WIDTH), D ** -0.5),
        "w_branch_gate": nrm((DEPTH, D, N_BRANCH * D), D ** -0.5),
        "b_branch_gate": nrm((DEPTH, N_BRANCH * D), 0.01),
        "attn_sink": nrm((DEPTH, N_HEADS), 0.5),
        "w_attn_out": nrm((DEPTH, ATTN_WIDTH, D), ATTN_WIDTH ** -0.5),
        "conv_w": nrm((DEPTH, CONV_W, LRU_WIDTH), CONV_W ** -0.5),
        "conv_b": nrm((DEPTH, LRU_WIDTH), 0.01),
        "lru_wa": nrm((DEPTH, 2, LRU_BLOCKS, LRU_BW, LRU_BW), LRU_BW ** -0.5),
        "lru_ba": nrm((DEPTH, 2, LRU_WIDTH), 0.01),
        "lru_wi": nrm((DEPTH, 2, LRU_BLOCKS, LRU_BW, LRU_BW), LRU_BW ** -0.5),
        "lru_bi": nrm((DEPTH, 2, LRU_WIDTH), 0.01),
        "lru_lambda": jnp.log(a0) - jnp.log1p(-a0),
        "w_lru_out": nrm((DEPTH, LRU_WIDTH, D), LRU_WIDTH ** -0.5),
        "w_fourier_out": nrm((DEPTH, FOURIER_WIDTH, D), FOURIER_WIDTH ** -0.5),
        "w_o": nrm((DEPTH, D, D), D ** -0.5),
    }


def reference(x_prompt, x_sample, c, cache_k, cache_v, state_lru, c_ctx,
              w_ada, b_ada, norm_w, final_norm_w,
              ffn1_wg, ffn1_wu, ffn1_wd, ffn2_wg, ffn2_wu, ffn2_wd,
              w_in, w_branch_gate, b_branch_gate, attn_sink, w_attn_out,
              conv_w, conv_b, lru_wa, lru_ba, lru_wi, lru_bi, lru_lambda,
              w_lru_out, w_fourier_out, w_o):
    rope = axial_rope_tables(x_sample.shape[1])
    cond_ctx = c_ctx[None, :]
    xp, xs = x_prompt, x_sample
    ks, vs, ss = [], [], []
    for l in range(DEPTH):
        P = dict(w_ada=w_ada[l], b_ada=b_ada[l], norm_w=norm_w[l],
                 ffn1_wg=ffn1_wg[l], ffn1_wu=ffn1_wu[l], ffn1_wd=ffn1_wd[l],
                 ffn2_wg=ffn2_wg[l], ffn2_wu=ffn2_wu[l], ffn2_wd=ffn2_wd[l],
                 w_in=w_in[l], w_branch_gate=w_branch_gate[l], b_branch_gate=b_branch_gate[l],
                 attn_sink=attn_sink[l], w_attn_out=w_attn_out[l],
                 conv_w=conv_w[l], conv_b=conv_b[l],
                 lru_wa=lru_wa[l], lru_ba=lru_ba[l], lru_wi=lru_wi[l], lru_bi=lru_bi[l],
                 lru_lambda=lru_lambda[l], w_lru_out=w_lru_out[l],
                 w_fourier_out=w_fourier_out[l], w_o=w_o[l])
        xp, (k_l, v_l, s_l) = trunk_layer(xp, cond_ctx, P, None, None)
        ks.append(k_l)
        vs.append(v_l)
        ss.append(s_l)
        xs, _ = trunk_layer(xs, c, P, rope, (cache_k[:, l], cache_v[:, l], state_lru[:, l]))
    y_prompt = rmsnorm(xp, final_norm_w)
    y_sample = rmsnorm(xs, final_norm_w)
    new_cache_k = jnp.stack(ks, axis=1)
    new_cache_v = jnp.stack(vs, axis=1)
    new_state_lru = jnp.stack(ss, axis=1)
    return (y_prompt, y_sample, new_cache_k, new_cache_v, new_state_lru)
```

```cpp
#include <hip/hip_runtime.h>
#include <hip/hip_cooperative_groups.h>
#include <cstdint>
#include <cstdio>

#ifndef N_LAUNCH_MODE
#define N_LAUNCH_MODE 0
#endif

#define LAS __attribute__((address_space(3)))
typedef unsigned short bf16_t;
typedef short bf16x8 __attribute__((ext_vector_type(8)));
typedef float f32x4 __attribute__((ext_vector_type(4)));
typedef float f32x2 __attribute__((ext_vector_type(2)));
typedef unsigned u32x4 __attribute__((ext_vector_type(4)));
typedef unsigned u32x2 __attribute__((ext_vector_type(2)));

constexpr int D = 1024, MP = 4096, MS = 8192, M = MP + MS, DFF = 2816, DEPTH = 2;
constexpr int LC = 256, LS = 2048;
constexpr int NB_C = 16, NB_S = 4;
constexpr int NIN = 2304 + 3072;
constexpr int NMOD = 9216;
constexpr float EPS = 1e-6f;
constexpr float LOG2E = 1.4426950408889634f;
constexpr float QSCALE = 0.125f * LOG2E;

constexpr size_t MiB = 1u << 20;
constexpr size_t SZ_WGU = (size_t)2 * DFF * D * 2, SZ_WD = (size_t)D * DFF * 2, SZ_WIN = (size_t)NIN * D * 2;
constexpr size_t SZ_WA = (size_t)D * 512 * 2, SZ_W1K = (size_t)D * D * 2;
constexpr size_t WL_GU1 = 0, WL_D1 = WL_GU1 + SZ_WGU, WL_GU2 = WL_D1 + SZ_WD, WL_D2 = WL_GU2 + SZ_WGU, WL_IN = WL_D2 + SZ_WD,
                 WL_A = WL_IN + SZ_WIN, WL_L2 = WL_A + SZ_WA, WL_F2 = WL_L2 + SZ_W1K, WL_O = WL_F2 + SZ_W1K, WL_SIZE = WL_O + SZ_W1K;
constexpr size_t WS_CTL = 0;
constexpr size_t WS_MISC = 1 * MiB;
constexpr size_t OFF_MOD = WS_MISC;
constexpr size_t OFF_ROPE = OFF_MOD + (size_t)2 * 5 * NMOD * 4;
constexpr size_t OFF_CK = OFF_ROPE + 2 * 1024 * 4;
constexpr size_t OFF_CVT = OFF_CK + (size_t)4 * 2 * 256 * 128 * 2;
constexpr size_t WS_DFTC = 3 * MiB;
constexpr size_t WS_DFTL = 4 * MiB;
constexpr size_t WS_W = 20 * MiB;
constexpr size_t WS_ACT = WS_W + 2 * WL_SIZE;
constexpr size_t A_G = 0;
constexpr size_t A_XN = 72 * MiB;
constexpr size_t A_XR = 96 * MiB;
constexpr size_t A_GY = 120 * MiB;
constexpr size_t A_XFT = 132 * MiB;
constexpr size_t A_Q = 144 * MiB;
constexpr size_t A_K = 156 * MiB;
constexpr size_t A_VT = 159 * MiB;
constexpr size_t A_Z = 162 * MiB;
constexpr size_t A_END = 186 * MiB;
constexpr size_t WS_END = WS_ACT + A_END;

constexpr int OUT_YS = MP * D, OUT_CK = M * D, OUT_CV = OUT_CK + 16 * 2 * 256 * 128, OUT_ST = OUT_CV + 16 * 2 * 256 * 128;

constexpr int NTHREADS = 512, NWAVES = 8;
constexpr int LDS_BYTES = 147456;

__device__ __forceinline__ unsigned cvt_pk_bf16(float lo, float hi) { unsigned r; asm volatile("v_cvt_pk_bf16_f32 %0, %1, %2" : "=v"(r) : "v"(lo), "v"(hi)); return r; }
__device__ __forceinline__ bf16_t f2bf(float f) { return (bf16_t)(cvt_pk_bf16(f, 0.f) & 0xffffu); }
__device__ __forceinline__ float bf2f(unsigned h) { return __uint_as_float(h << 16); }
__device__ __forceinline__ float bflo(unsigned w) { return __uint_as_float(w << 16); }
__device__ __forceinline__ float bfhi(unsigned w) { return __uint_as_float(w & 0xffff0000u); }
__device__ __forceinline__ float sigmoidf_(float x) { return 1.0f / (1.0f + __expf(-x)); }
__device__ __forceinline__ float siluf_(float x) { return x / (1.0f + __expf(-x)); }
__device__ __forceinline__ float gelu_tanh(float x) { const float u = 0.7978845608028654f * (x + 0.044715f * x * x * x); return x / (1.0f + __expf(-2.0f * u)); }
__device__ __forceinline__ float wave_sum(float v) {
#pragma unroll
    for (int o = 1; o < 64; o <<= 1) v += __shfl_xor(v, o);
    return v;
}
__device__ __forceinline__ int cond_of_row(int r) { return r < MP ? 4 : ((r - MP) >> 11); }

struct Args {
    const float* in[32];
    float* out;
    unsigned char* ws;
    int ph_lo, ph_hi;
};

struct Ctx {
    float* out; unsigned char* ws; LAS unsigned char* lds;
    int tid, lane, wave, bid, G;
};
__device__ __forceinline__ unsigned char* wl_ptr(const Ctx& C, int l, size_t off) { return C.ws + WS_W + (size_t)l * WL_SIZE + off; }
__device__ __forceinline__ unsigned char* act_ptr(const Ctx& C, size_t off) { return C.ws + WS_ACT + off; }
__device__ __forceinline__ const float* mod_ptr(const Ctx& C, int l, int c, int sub, int which) { return (const float*)(C.ws + OFF_MOD) + ((size_t)(l * 5 + c) * NMOD + (sub * 3 + which) * D); }

__device__ __forceinline__ void p0_transpose_item(const float* W, int ldw, bf16_t* WT, int ldt, int drow0, int dcol0, int k0, int n0, LAS float* scr, int lane) {
#pragma unroll 8
    for (int i = 0; i < 32; ++i) { const int kk = 2 * i + (lane >> 5); scr[kk * 33 + (lane & 31)] = W[(size_t)(k0 + kk) * ldw + n0 + (lane & 31)]; }
    asm volatile("s_waitcnt lgkmcnt(0)" ::: "memory");
    const int c = lane & 7;
#pragma unroll
    for (int j = 0; j < 4; ++j) { const int n = (lane >> 3) + 8 * j; const LAS float* s = scr + (8 * c) * 33 + n;
        u32x4 o; o.x = cvt_pk_bf16(s[0 * 33], s[1 * 33]); o.y = cvt_pk_bf16(s[2 * 33], s[3 * 33]); o.z = cvt_pk_bf16(s[4 * 33], s[5 * 33]); o.w = cvt_pk_bf16(s[6 * 33], s[7 * 33]);
        *(u32x4*)(WT + (size_t)(drow0 + n) * ldt + dcol0 + k0 + 8 * c) = o; }
    asm volatile("s_waitcnt lgkmcnt(0)" ::: "memory");
}

__device__ __forceinline__ void p0_prologue(const Args& args, const Ctx& C) {
    LAS float* SC = (LAS float*)C.lds;
    LAS float* TAB = (LAS float*)(C.lds + 20480);
    LAS float* SCR = (LAS float*)(C.lds + 32768);
    const float* c_in = args.in[2]; const float* cctx = args.in[6];
    for (int i = C.tid; i < 5 * 1024; i += NTHREADS) { const float v = (i < 4096) ? c_in[i] : cctx[i - 4096]; SC[i] = siluf_(v); }
    for (int i = C.tid; i < 2048; i += NTHREADS) TAB[i] = cospif((float)i * (1.0f / 1024.0f));
    __syncthreads();
    for (int it = C.bid; it < 288 + 128; it += C.G) {
        if (it < 288) {
            const int l = it / 144, j0 = (it % 144) * 64;
            const float* W = args.in[7] + (size_t)l * D * NMOD + j0 + C.lane;
            float a0 = 0.f, a1 = 0.f, a2 = 0.f, a3 = 0.f, a4 = 0.f;
            const int kb = C.wave * 128;
#pragma unroll 8
            for (int k = 0; k < 128; ++k) { const float w = W[(size_t)(kb + k) * NMOD];
                a0 += SC[kb + k] * w; a1 += SC[1024 + kb + k] * w; a2 += SC[2048 + kb + k] * w; a3 += SC[3072 + kb + k] * w; a4 += SC[4096 + kb + k] * w; }
            SCR[(C.wave * 5 + 0) * 64 + C.lane] = a0; SCR[(C.wave * 5 + 1) * 64 + C.lane] = a1; SCR[(C.wave * 5 + 2) * 64 + C.lane] = a2;
            SCR[(C.wave * 5 + 3) * 64 + C.lane] = a3; SCR[(C.wave * 5 + 4) * 64 + C.lane] = a4;
            __syncthreads();
            if (C.tid < 320) { const int c = C.tid >> 6, j = C.tid & 63; float s = args.in[8][(size_t)l * NMOD + j0 + j];
#pragma unroll
                for (int w = 0; w < 8; ++w) s += SCR[(w * 5 + c) * 64 + j];
                ((float*)(C.ws + OFF_MOD))[(size_t)(l * 5 + c) * NMOD + j0 + j] = s; }
            __syncthreads();
        } else {
            const int r = it - 288, l = r >> 6, g = (r >> 4) & 3, n0 = (r & 15) * 64;
            const float* Wf = args.in[30] + (size_t)l * 512 * D + (size_t)(g * 128) * D + n0;
            for (int i = C.tid; i < 128 * 64; i += NTHREADS) SCR[i] = Wf[(size_t)(i >> 6) * D + (i & 63)];
            __syncthreads();
            const int n = C.tid & 63, cw = C.tid >> 6;
            bf16_t* dst = (bf16_t*)wl_ptr(C, l, WL_F2) + (size_t)(n0 + n) * D + g * 128;
            const float s = 0.08838834764831845f;
            for (int j = 0; j < 16; ++j) { const int c = cw + 8 * j; float ac = 0.f, as = 0.f;
#pragma unroll 8
                for (int q = 0; q < 128; ++q) { const int idx = ((q * c) & 127) * 16; const float w = SCR[q * 64 + n];
                    ac += TAB[idx] * w; as += TAB[(idx - 512) & 2047] * w; }
                dst[c] = f2bf(ac * s); dst[512 + c] = f2bf(-as * s); }
            __syncthreads();
        }
    }
    __syncthreads();
    {
        LAS float* scr = SCR + C.wave * (64 * 33);
        const int gw = C.bid * NWAVES + C.wave, NGW = C.G * NWAVES;
        constexpr int I_G = 16 * 88, I_D = 44 * 32, I_IN = 16 * 72, I_BG = 16 * 96, I_A = 8 * 32, I_L = 8 * 32, I_O = 16 * 32;
        constexpr int PER_LAYER = 4 * I_G + 2 * I_D + I_IN + I_BG + I_A + I_L + I_O;
        for (int it = gw; it < 2 * PER_LAYER; it += NGW) {
            const int l = it / PER_LAYER; int r = it % PER_LAYER;
            if (r < I_G) { const int kb = r / 88, n0 = (r % 88) * 32; p0_transpose_item(args.in[11] + (size_t)l * D * DFF, DFF, (bf16_t*)wl_ptr(C, l, WL_GU1), D, 256 * (n0 >> 7) + (n0 & 127), 0, kb * 64, n0, scr, C.lane); continue; } r -= I_G;
            if (r < I_G) { const int kb = r / 88, n0 = (r % 88) * 32; p0_transpose_item(args.in[12] + (size_t)l * D * DFF, DFF, (bf16_t*)wl_ptr(C, l, WL_GU1), D, 256 * (n0 >> 7) + 128 + (n0 & 127), 0, kb * 64, n0, scr, C.lane); continue; } r -= I_G;
            if (r < I_D) { const int kb = r / 32, nb = r % 32; p0_transpose_item(args.in[13] + (size_t)l * DFF * D, D, (bf16_t*)wl_ptr(C, l, WL_D1), DFF, nb * 32, 0, kb * 64, nb * 32, scr, C.lane); continue; } r -= I_D;
            if (r < I_G) { const int kb = r / 88, n0 = (r % 88) * 32; p0_transpose_item(args.in[14] + (size_t)l * D * DFF, DFF, (bf16_t*)wl_ptr(C, l, WL_GU2), D, 256 * (n0 >> 7) + (n0 & 127), 0, kb * 64, n0, scr, C.lane); continue; } r -= I_G;
            if (r < I_G) { const int kb = r / 88, n0 = (r % 88) * 32; p0_transpose_item(args.in[15] + (size_t)l * D * DFF, DFF, (bf16_t*)wl_ptr(C, l, WL_GU2), D, 256 * (n0 >> 7) + 128 + (n0 & 127), 0, kb * 64, n0, scr, C.lane); continue; } r -= I_G;
            if (r < I_D) { const int kb = r / 32, nb = r % 32; p0_transpose_item(args.in[16] + (size_t)l * DFF * D, D, (bf16_t*)wl_ptr(C, l, WL_D2), DFF, nb * 32, 0, kb * 64, nb * 32, scr, C.lane); continue; } r -= I_D;
            if (r < I_IN) { const int kb = r / 72, nb = r % 72; p0_transpose_item(args.in[17] + (size_t)l * D * 2304, 2304, (bf16_t*)wl_ptr(C, l, WL_IN), D, nb * 32, 0, kb * 64, nb * 32, scr, C.lane); continue; } r -= I_IN;
            if (r < I_BG) { const int kb = r / 96, nb = r % 96; p0_transpose_item(args.in[18] + (size_t)l * D * 3072, 3072, (bf16_t*)wl_ptr(C, l, WL_IN), D, 2304 + nb * 32, 0, kb * 64, nb * 32, scr, C.lane); continue; } r -= I_BG;
            if (r < I_A) { const int kb = r / 32, nb = r % 32; p0_transpose_item(args.in[21] + (size_t)l * 512 * D, D, (bf16_t*)wl_ptr(C, l, WL_A), 512, nb * 32, 0, kb * 64, nb * 32, scr, C.lane); continue; } r -= I_A;
            if (r < I_L) { const int kb = r / 32, nb = r % 32;
                p0_transpose_item(args.in[29] + (size_t)l * 512 * D, D, (bf16_t*)wl_ptr(C, l, WL_L2), D, nb * 32, 0, kb * 64, nb * 32, scr, C.lane);
                p0_transpose_item(args.in[29] + (size_t)l * 512 * D, D, (bf16_t*)wl_ptr(C, l, WL_L2), D, nb * 32, 512, kb * 64, nb * 32, scr, C.lane); continue; } r -= I_L;
            { const int kb = r / 32, nb = r % 32; p0_transpose_item(args.in[31] + (size_t)l * D * D, D, (bf16_t*)wl_ptr(C, l, WL_O), D, nb * 32, 0, kb * 64, nb * 32, scr, C.lane); }
        }
    }
    const int gt = C.bid * NTHREADS + C.tid, NGT = C.G * NTHREADS;
    for (int i = gt; i < M * D / 4; i += NGT) { const f32x4 v = (i < MP * D / 4) ? ((const f32x4*)args.in[0])[i] : ((const f32x4*)args.in[1])[i - MP * D / 4]; ((f32x4*)C.out)[i] = v; }
    for (int i = gt; i < 4096 * 256; i += NGT) { const int pr = i >> 8, t0 = (i & 255) * 8, p = pr & 2047, sh = (pr >= 2048) ? 512 : 0; const float s = 0.022097086912079608f;
        float v[8];
#pragma unroll
        for (int j = 0; j < 8; ++j) v[j] = TAB[((p * (t0 + j)) - sh) & 2047] * s;
        u32x4 o; o.x = cvt_pk_bf16(v[0], v[1]); o.y = cvt_pk_bf16(v[2], v[3]); o.z = cvt_pk_bf16(v[4], v[5]); o.w = cvt_pk_bf16(v[6], v[7]);
        *(u32x4*)((bf16_t*)(C.ws + WS_DFTL) + (size_t)pr * 2048 + t0) = o; }
    for (int i = gt; i < 512 * 32; i += NGT) { const int pr = i >> 5, t0 = (i & 31) * 8, p = pr & 255, sh = (pr >= 256) ? 512 : 0; const float s = 0.0625f;
        float v[8];
#pragma unroll
        for (int j = 0; j < 8; ++j) v[j] = TAB[((p * (t0 + j) * 8) - sh) & 2047] * s;
        u32x4 o; o.x = cvt_pk_bf16(v[0], v[1]); o.y = cvt_pk_bf16(v[2], v[3]); o.z = cvt_pk_bf16(v[4], v[5]); o.w = cvt_pk_bf16(v[6], v[7]);
        *(u32x4*)((bf16_t*)(C.ws + WS_DFTC) + (size_t)pr * 256 + t0) = o; }
    for (int i = gt; i < 1024; i += NGT) { const int pos = i >> 4, f = i & 15; const float inv = exp2f(-(float)f * (13.287712379549449f / 16.0f)); const float ang = (float)pos * inv; const float af = (float)((double)ang * 0.3183098861837907);
        ((float*)(C.ws + OFF_ROPE))[i] = cospif(af); ((float*)(C.ws + OFF_ROPE))[1024 + i] = sinpif(af); }
    for (int i = gt; i < 4 * 2 * 256 * 128; i += NGT) { ((bf16_t*)(C.ws + OFF_CK))[i] = f2bf(args.in[3][i]);
        const int d = i & 63, kvh = (i >> 6) & 1, t = (i >> 7) & 255, bl = i >> 15;
        ((bf16_t*)(C.ws + OFF_CVT))[((size_t)(bl * 2 + kvh) * 64 + d) * 256 + t] = f2bf(args.in[4][i]); }
}

__device__ __forceinline__ void modnorm_phase(const Args& args, const Ctx& C, int l, int sub) {
    const int gw = C.bid * NWAVES + C.wave, NGW = C.G * NWAVES;
    const float* nw = args.in[9] + (size_t)(l * 3 + sub) * D;
    bf16_t* XN = (bf16_t*)act_ptr(C, A_XN);
    for (int r = gw; r < M; r += NGW) {
        const int c = cond_of_row(r);
        const float* sh = mod_ptr(C, l, c, sub, 0); const float* sc = mod_ptr(C, l, c, sub, 1);
        const f32x4* xr = (const f32x4*)(C.out + (size_t)r * D) + C.lane;
        f32x4 v[4]; float s = 0.f;
#pragma unroll
        for (int j = 0; j < 4; ++j) { v[j] = xr[64 * j]; s += (v[j].x * v[j].x + v[j].y * v[j].y) + (v[j].z * v[j].z + v[j].w * v[j].w); }
        const float rstd = rsqrtf(wave_sum(s) * (1.0f / D) + EPS);
        u32x2* o = (u32x2*)(XN + (size_t)r * D) + C.lane;
#pragma unroll
        for (int j = 0; j < 4; ++j) { const int col = 4 * C.lane + 256 * j; const f32x4 w = *(const f32x4*)(nw + col), a = *(const f32x4*)(sc + col), b = *(const f32x4*)(sh + col);
            f32x4 y = v[j] * rstd * w * (a + 1.0f) + b; u32x2 p; p.x = cvt_pk_bf16(y.x, y.y); p.y = cvt_pk_bf16(y.z, y.w); o[64 * j] = p; }
    }
}
__device__ __forceinline__ void finalnorm_phase(const Args& args, const Ctx& C) {
    const int gw = C.bid * NWAVES + C.wave, NGW = C.G * NWAVES;
    const float* nw = args.in[10];
    for (int r = gw; r < M; r += NGW) {
        f32x4* xr = (f32x4*)(C.out + (size_t)r * D) + C.lane;
        f32x4 v[4]; float s = 0.f;
#pragma unroll
        for (int j = 0; j < 4; ++j) { v[j] = xr[64 * j]; s += (v[j].x * v[j].x + v[j].y * v[j].y) + (v[j].z * v[j].z + v[j].w * v[j].w); }
        const float rstd = rsqrtf(wave_sum(s) * (1.0f / D) + EPS);
#pragma unroll
        for (int j = 0; j < 4; ++j) { const f32x4 w = *(const f32x4*)(nw + 4 * C.lane + 256 * j); xr[64 * j] = v[j] * rstd * w; }
    }
}

struct Unit { int pm, pn, z; const bf16_t* A; const bf16_t* B; };

struct StaticOrder {
    int nM, nN, nwg, G, c; const bf16_t* A; const bf16_t* B; int lda, ldb;
    __device__ void init(int Mr, int N, int G_, int c_, const bf16_t* A_, int lda_, const bf16_t* B_, int ldb_) { nM = Mr / 256; nN = N / 256; nwg = nM * nN; G = G_; c = c_; A = A_; B = B_; lda = lda_; ldb = ldb_; }
    __device__ bool next(int i, Unit& u) const {
        const long L = (long)i * G + c; if (L >= nwg) return false;
        int wgid = (int)L; { const int q = nwg / 8, r = nwg % 8, xcd = wgid % 8, off = wgid / 8; wgid = (xcd < r ? xcd * (q + 1) : r * (q + 1) + (xcd - r) * q) + off; }
        const int nig = 8 * nN, gid = wgid / nig, fm = gid * 8, gsz = (nM - fm) < 8 ? (nM - fm) : 8;
        u.pm = fm + ((wgid % nig) % gsz); u.pn = (wgid % nig) / gsz; u.z = 0;
        u.A = A + (size_t)u.pm * 256 * lda; u.B = B + (size_t)u.pn * 256 * ldb; return true;
    }
};
struct DftOrder {
    int nseq, nPm, L, G, c; const bf16_t* A; const bf16_t* XFT;
    __device__ bool next(int i, Unit& u) const {
        const int idx = i * G + c; if (idx >= nseq * nPm * 2) return false;
        u.z = idx / (nPm * 2); const int r = idx % (nPm * 2); u.pm = r >> 1; u.pn = r & 1;
        u.A = A + (size_t)u.pm * 256 * L; u.B = XFT + ((size_t)u.z * 512 + u.pn * 256) * L; return true;
    }
};

template <class Epi, class Sched>
__device__ __forceinline__ void gemm_simple(const Ctx& C, const Sched& S, const Epi& E, int lda, int ldb, int K) {
    const int wr = C.wave >> 2, wc = C.wave & 3, fr = C.lane & 15, fq = C.lane >> 4;
    Unit u;
    for (int ui = 0; S.next(ui, u); ++ui) {
        f32x4 acc[2][2][4][2];
#pragma unroll
        for (int a = 0; a < 2; ++a)
#pragma unroll
            for (int b = 0; b < 2; ++b)
#pragma unroll
                for (int m = 0; m < 4; ++m)
#pragma unroll
                    for (int n = 0; n < 2; ++n) acc[a][b][m][n] = (f32x4){0.f, 0.f, 0.f, 0.f};
        const bf16_t* pa = u.A + (size_t)(wr * 64 + fr) * lda + fq * 8;
        const bf16_t* pb = u.B + (size_t)(wc * 32 + fr) * ldb + fq * 8;
        for (int k0 = 0; k0 < K; k0 += 32) {
            bf16x8 At[2][4], Bt[2][2];
#pragma unroll
            for (int a = 0; a < 2; ++a)
#pragma unroll
                for (int m = 0; m < 4; ++m) At[a][m] = *(const bf16x8*)(pa + (size_t)(a * 128 + m * 16) * lda + k0);
#pragma unroll
            for (int b = 0; b < 2; ++b)
#pragma unroll
                for (int n = 0; n < 2; ++n) Bt[b][n] = *(const bf16x8*)(pb + (size_t)(b * 128 + n * 16) * ldb + k0);
#pragma unroll
            for (int a = 0; a < 2; ++a)
#pragma unroll
                for (int b = 0; b < 2; ++b)
#pragma unroll
                    for (int m = 0; m < 4; ++m)
#pragma unroll
                        for (int n = 0; n < 2; ++n) acc[a][b][m][n] = __builtin_amdgcn_mfma_f32_16x16x32_bf16(Bt[b][n], At[a][m], acc[a][b][m][n], 0, 0, 0);
        }
        E(acc, u, wr, wc, fr, fq);
    }
}

#define EPI_LOOP_AM for (int ai = 0; ai < 2; ++ai) _Pragma("unroll") for (int m = 0; m < 4; ++m)
struct EpiGU {
    bf16_t* H;
    __device__ __forceinline__ void operator()(const f32x4 (&acc)[2][2][4][2], const Unit& u, int wr, int wc, int fr, int fq) const {
#pragma unroll
        EPI_LOOP_AM { const int row = u.pm * 256 + ai * 128 + wr * 64 + m * 16 + fr;
#pragma unroll
            for (int n = 0; n < 2; ++n) { const f32x4 g = acc[ai][0][m][n], up = acc[ai][1][m][n];
                u32x2 p; p.x = cvt_pk_bf16(siluf_(g.x) * up.x, siluf_(g.y) * up.y); p.y = cvt_pk_bf16(siluf_(g.z) * up.z, siluf_(g.w) * up.w);
                *(u32x2*)(H + (size_t)row * DFF + u.pn * 128 + wc * 32 + n * 16 + fq * 4) = p; } }
    }
};
struct EpiRes {
    float* X; const float* modbase; int l, sub; float coef;
    __device__ __forceinline__ void operator()(const f32x4 (&acc)[2][2][4][2], const Unit& u, int wr, int wc, int fr, int fq) const {
        const int c = cond_of_row(u.pm * 256);
        const float* gate = modbase + ((size_t)(l * 5 + c) * NMOD + (sub * 3 + 2) * D);
#pragma unroll
        for (int bj = 0; bj < 2; ++bj)
#pragma unroll
            for (int n = 0; n < 2; ++n) { const int col = u.pn * 256 + bj * 128 + wc * 32 + n * 16 + fq * 4; const f32x4 g = *(const f32x4*)(gate + col) * coef;
#pragma unroll
                EPI_LOOP_AM { const int row = u.pm * 256 + ai * 128 + wr * 64 + m * 16 + fr; f32x4* p = (f32x4*)(X + (size_t)row * D + col); *p = *p + g * acc[ai][bj][m][n]; } }
    }
};
struct EpiIn {
    bf16_t *Q, *Kb, *VT, *GY, *XFT, *G; float* XR; float* out; const float* rope; const float* bgate; int l;
    __device__ __forceinline__ void operator()(const f32x4 (&acc)[2][2][4][2], const Unit& u, int wr, int wc, int fr, int fq) const {
        const int row0 = u.pm * 256 + wr * 64 + fr; const bool latent = u.pm >= 16;
        if (u.pn <= 2) {
#pragma unroll
            for (int bj = 0; bj < 2; ++bj) {
                if (u.pn == 2 && bj == 1) {
#pragma unroll
                    EPI_LOOP_AM { const int row = row0 + ai * 128 + m * 16; int seqoff, L, t;
                        if (latent) { const int b = (row - MP) >> 11; t = (row - MP) & 2047; L = LS; seqoff = 16 * 128 * LC + b * 128 * LS; } else { const int b = row >> 8; t = row & 255; L = LC; seqoff = b * 128 * LC; }
#pragma unroll
                        for (int n = 0; n < 2; ++n) { const f32x4 v = acc[ai][1][m][n]; const int d128 = wc * 32 + n * 16 + fq * 4;
                            bf16_t* p = VT + seqoff + (size_t)d128 * L + t; p[0] = f2bf(v.x); p[L] = f2bf(v.y); p[2 * L] = f2bf(v.z); p[3 * L] = f2bf(v.w);
                            if (!latent) *(f32x4*)(out + OUT_CV + ((size_t)((row >> 8) * 2 + l) * 256 + t) * 128 + d128) = v; } }
                } else {
                    const bool isk = (u.pn == 2); const int axis = wc & 1;
#pragma unroll
                    EPI_LOOP_AM { const int row = row0 + ai * 128 + m * 16; f32x4 x1 = acc[ai][bj][m][0], x2 = acc[ai][bj][m][1];
                        if (isk && !latent) { float* o = out + OUT_CK + ((size_t)((row >> 8) * 2 + l) * 256 + (row & 255)) * 128 + wc * 32 + fq * 4; *(f32x4*)o = x1; *(f32x4*)(o + 16) = x2; }
                        if (latent) { const int t = (row - MP) & 2047, pos = axis ? (t & 63) : (t >> 6);
                            const f32x4 cs = *(const f32x4*)(rope + pos * 16 + fq * 4), sn = *(const f32x4*)(rope + 1024 + pos * 16 + fq * 4);
                            const f32x4 o1 = x1 * cs - x2 * sn, o2 = x1 * sn + x2 * cs; x1 = o1; x2 = o2; }
                        if (!isk) { x1 = x1 * QSCALE; x2 = x2 * QSCALE; }
                        bf16_t* o = isk ? (Kb + (size_t)row * 128 + wc * 32 + fq * 4) : (Q + (size_t)row * 512 + u.pn * 256 + bj * 128 + wc * 32 + fq * 4);
                        u32x2 p; p.x = cvt_pk_bf16(x1.x, x1.y); p.y = cvt_pk_bf16(x1.z, x1.w); *(u32x2*)o = p;
                        p.x = cvt_pk_bf16(x2.x, x2.y); p.y = cvt_pk_bf16(x2.z, x2.w); *(u32x2*)(o + 16) = p; }
                }
            }
        } else if (u.pn <= 4) {
#pragma unroll
            EPI_LOOP_AM { const int row = row0 + ai * 128 + m * 16;
#pragma unroll
                for (int bj = 0; bj < 2; ++bj)
#pragma unroll
                    for (int n = 0; n < 2; ++n) *(f32x4*)(XR + (size_t)row * 512 + (u.pn - 3) * 256 + bj * 128 + wc * 32 + n * 16 + fq * 4) = acc[ai][bj][m][n]; }
        } else if (u.pn <= 6) {
#pragma unroll
            EPI_LOOP_AM { const int row = row0 + ai * 128 + m * 16;
#pragma unroll
                for (int bj = 0; bj < 2; ++bj)
#pragma unroll
                    for (int n = 0; n < 2; ++n) { const f32x4 v = acc[ai][bj][m][n]; u32x2 p; p.x = cvt_pk_bf16(gelu_tanh(v.x), gelu_tanh(v.y)); p.y = cvt_pk_bf16(gelu_tanh(v.z), gelu_tanh(v.w));
                        *(u32x2*)(GY + (size_t)row * 512 + (u.pn - 5) * 256 + bj * 128 + wc * 32 + n * 16 + fq * 4) = p; } }
        } else if (u.pn <= 8) {
#pragma unroll
            EPI_LOOP_AM { const int row = row0 + ai * 128 + m * 16; size_t seqoff; int L, t;
                if (latent) { const int b = (row - MP) >> 11; t = (row - MP) & 2047; L = LS; seqoff = (size_t)16 * 512 * LC + (size_t)b * 512 * LS; } else { const int b = row >> 8; t = row & 255; L = LC; seqoff = (size_t)b * 512 * LC; }
#pragma unroll
                for (int bj = 0; bj < 2; ++bj)
#pragma unroll
                    for (int n = 0; n < 2; ++n) { const f32x4 v = acc[ai][bj][m][n]; bf16_t* p = XFT + seqoff + (size_t)((u.pn - 7) * 256 + bj * 128 + wc * 32 + n * 16 + fq * 4) * L + t;
                        p[0] = f2bf(v.x); p[L] = f2bf(v.y); p[2 * L] = f2bf(v.z); p[3 * L] = f2bf(v.w); } }
        } else {
#pragma unroll
            for (int bj = 0; bj < 2; ++bj)
#pragma unroll
                for (int n = 0; n < 2; ++n) { const int col = (u.pn - 9) * 256 + bj * 128 + wc * 32 + n * 16 + fq * 4; const f32x4 b = *(const f32x4*)(bgate + col);
#pragma unroll
                    EPI_LOOP_AM { const int row = row0 + ai * 128 + m * 16; const f32x4 v = acc[ai][bj][m][n] + b;
                        u32x2 p; p.x = cvt_pk_bf16(sigmoidf_(v.x), sigmoidf_(v.y)); p.y = cvt_pk_bf16(sigmoidf_(v.z), sigmoidf_(v.w)); *(u32x2*)(G + (size_t)row * 3072 + col) = p; } }
        }
    }
};
template <int MODE> struct EpiBranch {
    bf16_t* MG; const bf16_t* G; int br;
    __device__ __forceinline__ void operator()(const f32x4 (&acc)[2][2][4][2], const Unit& u, int wr, int wc, int fr, int fq) const {
#pragma unroll
        EPI_LOOP_AM { const int row = u.pm * 256 + ai * 128 + wr * 64 + m * 16 + fr;
#pragma unroll
            for (int bj = 0; bj < 2; ++bj)
#pragma unroll
                for (int n = 0; n < 2; ++n) { const int col = u.pn * 256 + bj * 128 + wc * 32 + n * 16 + fq * 4;
                    const u32x2 g = *(const u32x2*)(G + (size_t)row * 3072 + br * 1024 + col); f32x4 v = acc[ai][bj][m][n];
                    v.x *= bflo(g.x); v.y *= bfhi(g.x); v.z *= bflo(g.y); v.w *= bfhi(g.y);
                    u32x2* p = (u32x2*)(MG + (size_t)row * D + col);
                    if (MODE == 1) { const u32x2 o = *p; v.x += bflo(o.x); v.y += bfhi(o.x); v.z += bflo(o.y); v.w += bfhi(o.y); }
                    u32x2 w; w.x = cvt_pk_bf16(v.x, v.y); w.y = cvt_pk_bf16(v.z, v.w); *p = w; } }
    }
};
struct EpiDft {
    bf16_t* Z; int L, rowbase0;
    __device__ __forceinline__ void operator()(const f32x4 (&acc)[2][2][4][2], const Unit& u, int wr, int wc, int fr, int fq) const {
        const int pp = u.pm * 256, soff = (pp >= L) ? 512 : 0, p0 = (pp >= L) ? pp - L : pp;
#pragma unroll
        EPI_LOOP_AM { const int row = rowbase0 + u.z * L + p0 + ai * 128 + wr * 64 + m * 16 + fr;
#pragma unroll
            for (int bj = 0; bj < 2; ++bj)
#pragma unroll
                for (int n = 0; n < 2; ++n) { const f32x4 v = acc[ai][bj][m][n]; u32x2 w; w.x = cvt_pk_bf16(v.x, v.y); w.y = cvt_pk_bf16(v.z, v.w);
                    *(u32x2*)(Z + (size_t)row * D + soff + u.pn * 256 + bj * 128 + wc * 32 + n * 16 + fq * 4) = w; } }
    }
};

__device__ __forceinline__ void attn_naive_phase(const Args& args, const Ctx& C, int l) {
    bf16_t* Q = (bf16_t*)act_ptr(C, A_Q); const bf16_t* Kb = (const bf16_t*)act_ptr(C, A_K); const bf16_t* VT = (const bf16_t*)act_ptr(C, A_VT);
    const bf16_t* CK = (const bf16_t*)(C.ws + OFF_CK); const bf16_t* CVT = (const bf16_t*)(C.ws + OFF_CVT);
    const int gw = C.bid * NWAVES + C.wave, NGW = C.G * NWAVES;
    for (int it = gw; it < (M / 64) * 8; it += NGW) {
        const int h = it & 7, row = (it >> 3) * 64 + C.lane, kvh = h >> 2;
        float q[64], o[64];
        { const u32x4* qp = (const u32x4*)(Q + (size_t)row * 512 + h * 64);
#pragma unroll
          for (int j = 0; j < 8; ++j) { const u32x4 w = qp[j]; q[8 * j] = bflo(w.x); q[8 * j + 1] = bfhi(w.x); q[8 * j + 2] = bflo(w.y); q[8 * j + 3] = bfhi(w.y); q[8 * j + 4] = bflo(w.z); q[8 * j + 5] = bfhi(w.z); q[8 * j + 6] = bflo(w.w); q[8 * j + 7] = bfhi(w.w); } }
#pragma unroll
        for (int d = 0; d < 64; ++d) o[d] = 0.f;
        float mx = args.in[20][l * 8 + h] * LOG2E, lsum = 1.0f;
        const bool latent = row >= MP;
        const int b = latent ? ((row - MP) >> 11) : (row >> 8), t = latent ? ((row - MP) & 2047) : (row & 255);
        for (int seg = 0; seg < (latent ? 2 : 1); ++seg) {
            const int nk = (seg == 1 || !latent) ? 256 : 257;
            for (int jj = 0; jj < nk; ++jj) {
                int j; bool ok = true; const bf16_t* kp; const bf16_t* vp; int L;
                if (seg == 1) { j = jj; kp = CK + ((size_t)(b * 2 + l) * 256 + j) * 128 + kvh * 64; vp = CVT + ((size_t)((b * 2 + l) * 2 + kvh) * 64) * 256 + j; L = 256; }
                else if (!latent) { j = jj; kp = Kb + ((size_t)(b * 256 + j)) * 128 + kvh * 64; vp = VT + (size_t)b * 128 * LC + (size_t)(kvh * 64) * LC + j; L = LC; }
                else { j = t - 128 + jj; ok = (j >= 0 && j < LS); const int jc = ok ? j : t; kp = Kb + ((size_t)(MP + b * LS + jc)) * 128 + kvh * 64; vp = VT + (size_t)16 * 128 * LC + (size_t)b * 128 * LS + (size_t)(kvh * 64) * LS + jc; L = LS; }
                float s = 0.f;
#pragma unroll
                for (int jq = 0; jq < 8; ++jq) { const u32x4 w = ((const u32x4*)kp)[jq];
                    s += q[8 * jq] * bflo(w.x) + q[8 * jq + 1] * bfhi(w.x) + q[8 * jq + 2] * bflo(w.y) + q[8 * jq + 3] * bfhi(w.y) + q[8 * jq + 4] * bflo(w.z) + q[8 * jq + 5] * bfhi(w.z) + q[8 * jq + 6] * bflo(w.w) + q[8 * jq + 7] * bfhi(w.w); }
                if (!ok) s = -1e30f;
                const float mn = fmaxf(mx, s), alpha = exp2f(mx - mn), p = exp2f(s - mn);
                lsum = lsum * alpha + p; mx = mn;
#pragma unroll
                for (int d = 0; d < 64; ++d) o[d] = o[d] * alpha + p * bf2f(vp[(size_t)d * L]);
            }
        }
        const float inv = 1.0f / lsum;
        u32x4* op = (u32x4*)(Q + (size_t)row * 512 + h * 64);
#pragma unroll
        for (int j = 0; j < 8; ++j) { u32x4 w; w.x = cvt_pk_bf16(o[8 * j] * inv, o[8 * j + 1] * inv); w.y = cvt_pk_bf16(o[8 * j + 2] * inv, o[8 * j + 3] * inv); w.z = cvt_pk_bf16(o[8 * j + 4] * inv, o[8 * j + 5] * inv); w.w = cvt_pk_bf16(o[8 * j + 6] * inv, o[8 * j + 7] * inv); op[j] = w; }
    }
}

__device__ __forceinline__ void lru_naive_phase(const Args& args, const Ctx& C, int l) {
    const float* XR = (const float*)act_ptr(C, A_XR); const bf16_t* GY = (const bf16_t*)act_ptr(C, A_GY); bf16_t* REC = (bf16_t*)act_ptr(C, A_XN);
    const int gw = C.bid * NWAVES + C.wave, NGW = C.G * NWAVES;
    for (int it = gw; it < 20 * 8 * 2; it += NGW) {
        const int dir = it & 1, nb = (it >> 1) & 7, sq = it >> 4;
        const bool latent = sq < 4; const int b = latent ? sq : sq - 4, L = latent ? LS : LC, rowbase = latent ? MP + b * LS : b * LC;
        const int ch = nb * 64 + C.lane;
        float wa[64], wi[64];
        { const float* pa = args.in[24] + ((size_t)((l * 2 + dir) * 8 + nb) * 64) * 64 + C.lane; const float* pi = args.in[26] + ((size_t)((l * 2 + dir) * 8 + nb) * 64) * 64 + C.lane;
#pragma unroll
          for (int k = 0; k < 64; ++k) { wa[k] = pa[k * 64]; wi[k] = pi[k * 64]; } }
        const float ba = args.in[25][(l * 2 + dir) * 512 + ch], bi = args.in[27][(l * 2 + dir) * 512 + ch], lam = args.in[28][(l * 2 + dir) * 512 + ch];
        const float sp = log1pf(__expf(-lam));
        const float cw0 = args.in[22][(l * 4 + 0) * 512 + ch], cw1 = args.in[22][(l * 4 + 1) * 512 + ch], cw2 = args.in[22][(l * 4 + 2) * 512 + ch], cw3 = args.in[22][(l * 4 + 3) * 512 + ch], cb = args.in[23][l * 512 + ch];
        float h = latent ? args.in[5][((size_t)(b * 2 + l) * 2 + dir) * 512 + ch] : 0.f;
        for (int s = 0; s < L; ++s) {
            const int t = dir ? (L - 1 - s) : s;
            const float* xp = XR + (size_t)(rowbase + t) * 512 + ch;
            const float xm2 = (t >= 2) ? xp[-2 * 512] : 0.f, xm1 = (t >= 1) ? xp[-512] : 0.f, x0 = xp[0], xp1 = (t + 1 < L) ? xp[512] : 0.f;
            const float xc = cb + cw0 * xm2 + cw1 * xm1 + cw2 * x0 + cw3 * xp1;
            float ra = ba, ri = bi;
#pragma unroll
            for (int k = 0; k < 64; ++k) { const float xk = __shfl(xc, k); ra += xk * wa[k]; ri += xk * wi[k]; }
            const float r = sigmoidf_(ra), ig = sigmoidf_(ri);
            const float log_a = -8.0f * r * sp, a = __expf(log_a), bb = sqrtf(fmaxf(-expm1f(2.0f * log_a), 0.f)) * (ig * xc);
            h = a * h + bb;
            REC[(size_t)(rowbase + t) * D + dir * 512 + ch] = f2bf(h * bf2f(GY[(size_t)(rowbase + t) * 512 + ch]));
        }
        if (!latent) C.out[OUT_ST + ((size_t)(b * 2 + l) * 2 + dir) * 512 + ch] = h;
    }
}

constexpr int N_PHASES = 28;
enum { K_P0 = 1, K_NORM = 2, K_GU = 4, K_RES = 8, K_IN = 16, K_ATTN = 32, K_LRU = 64, K_DFT = 128, K_BR = 256, K_ALL = 511 };
__host__ __device__ constexpr int kind_of_phase(int ph) {
    if (ph == 0) return K_P0;
    if (ph == N_PHASES - 1) return K_NORM;
    const int s = (ph - 1) % 13;
    return (s == 0 || s == 3 || s == 10) ? K_NORM : (s == 1 || s == 11) ? K_GU : (s == 2 || s == 12 || s == 9) ? K_RES : (s == 4) ? K_IN : (s == 5) ? K_ATTN : (s == 6) ? K_LRU : (s == 7) ? K_DFT : K_BR;
}
__host__ __device__ constexpr bool sync_after_phase(int ph) { const int s = (ph - 1) % 13; return !(ph >= 1 && ph < N_PHASES - 1 && (s == 5 || s == 6)); }

template <int KM>
__device__ __forceinline__ void run_phase(const Args& args, const Ctx& C, int ph) {
    if (ph == 0) { if constexpr ((KM & K_P0) != 0) p0_prologue(args, C); return; }
    if (ph == N_PHASES - 1) { if constexpr ((KM & K_NORM) != 0) finalnorm_phase(args, C); return; }
    const int l = (ph - 1) / 13, s = (ph - 1) % 13;
    const float* MODB = (const float*)(C.ws + OFF_MOD);
    if (s == 0 || s == 3 || s == 10) { if constexpr ((KM & K_NORM) != 0) modnorm_phase(args, C, l, s == 0 ? 0 : (s == 3 ? 1 : 2)); }
    else if (s == 1 || s == 11) { if constexpr ((KM & K_GU) != 0) { StaticOrder S; S.init(M, 2 * DFF, C.G, C.bid, (const bf16_t*)act_ptr(C, A_XN), D, (const bf16_t*)wl_ptr(C, l, s == 1 ? WL_GU1 : WL_GU2), D);
        EpiGU E{(bf16_t*)act_ptr(C, A_G)}; gemm_simple(C, S, E, D, D, D); } }
    else if (s == 2 || s == 12) { if constexpr ((KM & K_RES) != 0) { StaticOrder S; S.init(M, D, C.G, C.bid, (const bf16_t*)act_ptr(C, A_G), DFF, (const bf16_t*)wl_ptr(C, l, s == 2 ? WL_D1 : WL_D2), DFF);
        EpiRes E{C.out, MODB, l, s == 2 ? 0 : 2, 0.5f}; gemm_simple(C, S, E, DFF, DFF, DFF); } }
    else if (s == 4) { if constexpr ((KM & K_IN) != 0) { StaticOrder S; S.init(M, NIN, C.G, C.bid, (const bf16_t*)act_ptr(C, A_XN), D, (const bf16_t*)wl_ptr(C, l, WL_IN), D);
        EpiIn E{(bf16_t*)act_ptr(C, A_Q), (bf16_t*)act_ptr(C, A_K), (bf16_t*)act_ptr(C, A_VT), (bf16_t*)act_ptr(C, A_GY), (bf16_t*)act_ptr(C, A_XFT), (bf16_t*)act_ptr(C, A_G),
                (float*)act_ptr(C, A_XR), C.out, (const float*)(C.ws + OFF_ROPE), args.in[19] + (size_t)l * 3072, l};
        gemm_simple(C, S, E, D, D, D); } }
    else if (s == 5) { if constexpr ((KM & K_ATTN) != 0) attn_naive_phase(args, C, l); }
    else if (s == 6) { if constexpr ((KM & K_LRU) != 0) lru_naive_phase(args, C, l); }
    else if (s == 7) { if constexpr ((KM & K_DFT) != 0) {
        { DftOrder S{4, 16, LS, C.G, C.bid, (const bf16_t*)(C.ws + WS_DFTL), (const bf16_t*)act_ptr(C, A_XFT) + (size_t)16 * 512 * LC}; EpiDft E{(bf16_t*)act_ptr(C, A_Z), LS, MP}; gemm_simple(C, S, E, LS, LS, LS); }
        { DftOrder S{16, 2, LC, C.G, C.bid, (const bf16_t*)(C.ws + WS_DFTC), (const bf16_t*)act_ptr(C, A_XFT)}; EpiDft E{(bf16_t*)act_ptr(C, A_Z), LC, 0}; gemm_simple(C, S, E, LC, LC, LC); } } }
    else if (s == 8) { if constexpr ((KM & K_BR) != 0) {
        bf16_t* MG = (bf16_t*)act_ptr(C, A_XR); const bf16_t* G = (const bf16_t*)act_ptr(C, A_G);
        { StaticOrder S; S.init(M, D, C.G, C.bid, (const bf16_t*)act_ptr(C, A_Q), 512, (const bf16_t*)wl_ptr(C, l, WL_A), 512); EpiBranch<0> E{MG, G, 0}; gemm_simple(C, S, E, 512, 512, 512); }
        { StaticOrder S; S.init(M, D, C.G, C.bid, (const bf16_t*)act_ptr(C, A_XN), D, (const bf16_t*)wl_ptr(C, l, WL_L2), D); EpiBranch<1> E{MG, G, 1}; gemm_simple(C, S, E, D, D, D); }
        { StaticOrder S; S.init(M, D, C.G, C.bid, (const bf16_t*)act_ptr(C, A_Z), D, (const bf16_t*)wl_ptr(C, l, WL_F2), D); EpiBranch<1> E{MG, G, 2}; gemm_simple(C, S, E, D, D, D); } } }
    else if (s == 9) { if constexpr ((KM & K_RES) != 0) { StaticOrder S; S.init(M, D, C.G, C.bid, (const bf16_t*)act_ptr(C, A_XR), D, (const bf16_t*)wl_ptr(C, l, WL_O), D);
        EpiRes E{C.out, MODB, l, 1, 1.0f}; gemm_simple(C, S, E, D, D, D); } }
}

template <int KM>
__global__ void __launch_bounds__(NTHREADS, 2) fwd_kernel(Args args) {
    extern __shared__ __attribute__((aligned(16))) unsigned char lds_raw[];
    Ctx C; C.out = args.out; C.ws = args.ws; C.lds = (LAS unsigned char*)lds_raw;
    C.tid = threadIdx.x; C.lane = C.tid & 63; C.wave = __builtin_amdgcn_readfirstlane(C.tid >> 6); C.bid = blockIdx.x; C.G = gridDim.x;
    const int lo = args.ph_lo, hi = args.ph_hi;
    for (int ph = lo; ph < hi; ++ph) {
        run_phase<KM>(args, C, ph);
        if constexpr (KM == K_ALL) { if (ph + 1 < hi && sync_after_phase(ph)) cooperative_groups::this_grid().sync(); }
    }
}

template <int KM> static void launch_kind(const Args& a, hipStream_t stream) {
    static bool attr = false;
    if (!attr) { if (hipFuncSetAttribute((const void*)fwd_kernel<KM>, hipFuncAttributeMaxDynamicSharedMemorySize, LDS_BYTES) != hipSuccess) fprintf(stderr, "hipFuncSetAttribute failed\n"); attr = true; }
    hipLaunchKernelGGL(fwd_kernel<KM>, dim3(256), dim3(NTHREADS), LDS_BYTES, stream, a);
}
extern "C" void kernel_launch(void* const* d_in, const int* in_sizes, int n_in, void* d_out, int out_size, void* d_ws, size_t ws_size, hipStream_t stream) {
    if (n_in != 32 || ws_size < WS_END) { fprintf(stderr, "kernel_launch: n_in %d ws %zu (need %zu)\n", n_in, ws_size, (size_t)WS_END); return; }
    Args a{};
    for (int i = 0; i < 32; ++i) a.in[i] = (const float*)d_in[i];
    a.out = (float*)d_out; a.ws = (unsigned char*)d_ws;
#if N_LAUNCH_MODE == 1
    static bool attr = false;
    if (!attr) { if (hipFuncSetAttribute((const void*)fwd_kernel<K_ALL>, hipFuncAttributeMaxDynamicSharedMemorySize, LDS_BYTES) != hipSuccess) fprintf(stderr, "hipFuncSetAttribute failed\n"); attr = true; }
    a.ph_lo = 0; a.ph_hi = N_PHASES;
    void* kargs[] = {&a};
    hipError_t e = hipLaunchCooperativeKernel((const void*)fwd_kernel<K_ALL>, dim3(256), dim3(NTHREADS), kargs, LDS_BYTES, stream);
    if (e != hipSuccess) fprintf(stderr, "cooperative launch failed: %s\n", hipGetErrorString(e));
#else
    for (int p = 0; p < N_PHASES; ++p) { a.ph_lo = p; a.ph_hi = p + 1;
        switch (kind_of_phase(p)) {
            case K_P0: launch_kind<K_P0>(a, stream); break; case K_NORM: launch_kind<K_NORM>(a, stream); break; case K_GU: launch_kind<K_GU>(a, stream); break;
            case K_RES: launch_kind<K_RES>(a, stream); break; case K_IN: launch_kind<K_IN>(a, stream); break; case K_ATTN: launch_kind<K_ATTN>(a, stream); break;
            case K_LRU: launch_kind<K_LRU>(a, stream); break; case K_DFT: launch_kind<K_DFT>(a, stream); break; default: launch_kind<K_BR>(a, stream); break; } }
#endif
}
```

```cpp
#include <hip/hip_runtime.h>
#include <hip/hip_cooperative_groups.h>
#include <cstdint>
#include <cstdio>

#ifndef N_LAUNCH_MODE
#define N_LAUNCH_MODE 1
#endif

#define LAS __attribute__((address_space(3)))
typedef unsigned short bf16_t;
typedef short bf16x8 __attribute__((ext_vector_type(8)));
typedef float f32x4 __attribute__((ext_vector_type(4)));
typedef float f32x2 __attribute__((ext_vector_type(2)));
typedef unsigned u32x4 __attribute__((ext_vector_type(4)));
typedef unsigned u32x2 __attribute__((ext_vector_type(2)));

constexpr int D = 1024, MP = 4096, MS = 8192, M = MP + MS, DFF = 2816, DEPTH = 2;
constexpr int LC = 256, LS = 2048;
constexpr int NB_C = 16, NB_S = 4;
constexpr int NIN = 2304 + 3072;
constexpr int NMOD = 9216;
constexpr float EPS = 1e-6f;
constexpr float LOG2E = 1.4426950408889634f;
constexpr float QSCALE = 0.125f * LOG2E;

constexpr size_t MiB = 1u << 20;
constexpr size_t SZ_WGU = (size_t)2 * DFF * D * 2, SZ_WD = (size_t)D * DFF * 2, SZ_WIN = (size_t)NIN * D * 2;
constexpr size_t SZ_WA = (size_t)D * 512 * 2, SZ_W1K = (size_t)D * D * 2;
constexpr size_t WL_GU1 = 0, WL_D1 = WL_GU1 + SZ_WGU, WL_GU2 = WL_D1 + SZ_WD, WL_D2 = WL_GU2 + SZ_WGU, WL_IN = WL_D2 + SZ_WD,
                 WL_A = WL_IN + SZ_WIN, WL_L2 = WL_A + SZ_WA, WL_F2 = WL_L2 + SZ_W1K, WL_O = WL_F2 + SZ_W1K, WL_SIZE = WL_O + SZ_W1K;
constexpr size_t WS_CTL = 0;
constexpr size_t WS_MISC = 1 * MiB;
constexpr size_t OFF_MOD = WS_MISC;
constexpr size_t OFF_ROPE = OFF_MOD + (size_t)2 * 5 * NMOD * 4;
constexpr size_t OFF_CK = OFF_ROPE + 2 * 1024 * 4;
constexpr size_t OFF_CVT = OFF_CK + (size_t)4 * 2 * 256 * 128 * 2;
constexpr size_t WS_DFTC = 3 * MiB;
constexpr size_t WS_DFTL = 4 * MiB;
constexpr size_t WS_W = 20 * MiB;
constexpr size_t WS_ACT = WS_W + 2 * WL_SIZE;
constexpr size_t A_G = 0;
constexpr size_t A_XN = 72 * MiB;
constexpr size_t A_XR = 96 * MiB;
constexpr size_t A_GY = 120 * MiB;
constexpr size_t A_XFT = 132 * MiB;
constexpr size_t A_Q = 144 * MiB;
constexpr size_t A_K = 156 * MiB;
constexpr size_t A_VT = 159 * MiB;
constexpr size_t A_Z = 162 * MiB;
constexpr size_t A_END = 186 * MiB;
constexpr size_t WS_END = WS_ACT + A_END;

constexpr int OUT_YS = MP * D, OUT_CK = M * D, OUT_CV = OUT_CK + 16 * 2 * 256 * 128, OUT_ST = OUT_CV + 16 * 2 * 256 * 128;

constexpr int NTHREADS = 512, NWAVES = 8;
constexpr int LDS_BYTES = 147456;

__device__ __forceinline__ unsigned cvt_pk_bf16(float lo, float hi) { unsigned r; asm volatile("v_cvt_pk_bf16_f32 %0, %1, %2" : "=v"(r) : "v"(lo), "v"(hi)); return r; }
__device__ __forceinline__ bf16_t f2bf(float f) { return (bf16_t)(cvt_pk_bf16(f, 0.f) & 0xffffu); }
__device__ __forceinline__ float bf2f(unsigned h) { return __uint_as_float(h << 16); }
__device__ __forceinline__ float bflo(unsigned w) { return __uint_as_float(w << 16); }
__device__ __forceinline__ float bfhi(unsigned w) { return __uint_as_float(w & 0xffff0000u); }
__device__ __forceinline__ float sigmoidf_(float x) { return 1.0f / (1.0f + __expf(-x)); }
__device__ __forceinline__ float siluf_(float x) { return x / (1.0f + __expf(-x)); }
__device__ __forceinline__ float gelu_tanh(float x) { const float u = 0.7978845608028654f * (x + 0.044715f * x * x * x); return x / (1.0f + __expf(-2.0f * u)); }
__device__ __forceinline__ float wave_sum(float v) {
#pragma unroll
    for (int o = 1; o < 64; o <<= 1) v += __shfl_xor(v, o);
    return v;
}
__device__ __forceinline__ int cond_of_row(int r) { return r < MP ? 4 : ((r - MP) >> 11); }

struct Args {
    const float* in[32];
    float* out;
    unsigned char* ws;
    int ph_lo, ph_hi;
};

typedef const __attribute__((address_space(4))) Args* ArgsP;
struct Ctx {
    float* out; unsigned char* ws; LAS unsigned char* lds;
    int tid, lane, wave, bid, G;
};
__device__ __forceinline__ unsigned char* wl_ptr(const Ctx& C, int l, size_t off) { return C.ws + WS_W + (size_t)l * WL_SIZE + off; }
__device__ __forceinline__ unsigned char* act_ptr(const Ctx& C, size_t off) { return C.ws + WS_ACT + off; }
__device__ __forceinline__ const float* mod_ptr(const Ctx& C, int l, int c, int sub, int which) { return (const float*)(C.ws + OFF_MOD) + ((size_t)(l * 5 + c) * NMOD + (sub * 3 + which) * D); }

__device__ __forceinline__ void p0_transpose_item(const float* W, int ldw, bf16_t* WT, int ldt, int drow0, int dcol0, int k0, int n0, LAS float* scr, int lane) {
#pragma unroll 8
    for (int i = 0; i < 32; ++i) { const int kk = 2 * i + (lane >> 5); scr[kk * 33 + (lane & 31)] = W[(size_t)(k0 + kk) * ldw + n0 + (lane & 31)]; }
    asm volatile("s_waitcnt lgkmcnt(0)" ::: "memory");
    const int c = lane & 7;
#pragma unroll
    for (int j = 0; j < 4; ++j) { const int n = (lane >> 3) + 8 * j; const LAS float* s = scr + (8 * c) * 33 + n;
        u32x4 o; o.x = cvt_pk_bf16(s[0 * 33], s[1 * 33]); o.y = cvt_pk_bf16(s[2 * 33], s[3 * 33]); o.z = cvt_pk_bf16(s[4 * 33], s[5 * 33]); o.w = cvt_pk_bf16(s[6 * 33], s[7 * 33]);
        *(u32x4*)(WT + (size_t)(drow0 + n) * ldt + dcol0 + k0 + 8 * c) = o; }
    asm volatile("s_waitcnt lgkmcnt(0)" ::: "memory");
}

__device__ __forceinline__ void p0_prologue(ArgsP args, const Ctx& C) {
    LAS float* SC = (LAS float*)C.lds;
    LAS float* TAB = (LAS float*)(C.lds + 20480);
    LAS float* SCR = (LAS float*)(C.lds + 32768);
    const float* c_in = args->in[2]; const float* cctx = args->in[6];
    for (int i = C.tid; i < 5 * 1024; i += NTHREADS) { const float v = (i < 4096) ? c_in[i] : cctx[i - 4096]; SC[i] = siluf_(v); }
    for (int i = C.tid; i < 2048; i += NTHREADS) TAB[i] = cospif((float)i * (1.0f / 1024.0f));
    __syncthreads();
    for (int it = C.bid; it < 288 + 128; it += C.G) {
        if (it < 288) {
            const int l = it / 144, j0 = (it % 144) * 64;
            const float* W = args->in[7] + (size_t)l * D * NMOD + j0 + C.lane;
            float a0 = 0.f, a1 = 0.f, a2 = 0.f, a3 = 0.f, a4 = 0.f;
            const int kb = C.wave * 128;
#pragma unroll 8
            for (int k = 0; k < 128; ++k) { const float w = W[(size_t)(kb + k) * NMOD];
                a0 += SC[kb + k] * w; a1 += SC[1024 + kb + k] * w; a2 += SC[2048 + kb + k] * w; a3 += SC[3072 + kb + k] * w; a4 += SC[4096 + kb + k] * w; }
            SCR[(C.wave * 5 + 0) * 64 + C.lane] = a0; SCR[(C.wave * 5 + 1) * 64 + C.lane] = a1; SCR[(C.wave * 5 + 2) * 64 + C.lane] = a2;
            SCR[(C.wave * 5 + 3) * 64 + C.lane] = a3; SCR[(C.wave * 5 + 4) * 64 + C.lane] = a4;
            __syncthreads();
            if (C.tid < 320) { const int c = C.tid >> 6, j = C.tid & 63; float s = args->in[8][(size_t)l * NMOD + j0 + j];
#pragma unroll
                for (int w = 0; w < 8; ++w) s += SCR[(w * 5 + c) * 64 + j];
                ((float*)(C.ws + OFF_MOD))[(size_t)(l * 5 + c) * NMOD + j0 + j] = s; }
            __syncthreads();
        } else {
            const int r = it - 288, l = r >> 6, g = (r >> 4) & 3, n0 = (r & 15) * 64;
            const float* Wf = args->in[30] + (size_t)l * 512 * D + (size_t)(g * 128) * D + n0;
            for (int i = C.tid; i < 128 * 64; i += NTHREADS) SCR[i] = Wf[(size_t)(i >> 6) * D + (i & 63)];
            __syncthreads();
            const int n = C.tid & 63, cw = C.tid >> 6;
            bf16_t* dst = (bf16_t*)wl_ptr(C, l, WL_F2) + (size_t)(n0 + n) * D + g * 128;
            const float s = 0.08838834764831845f;
            for (int j = 0; j < 16; ++j) { const int c = cw + 8 * j; float ac = 0.f, as = 0.f;
#pragma unroll 8
                for (int q = 0; q < 128; ++q) { const int idx = ((q * c) & 127) * 16; const float w = SCR[q * 64 + n];
                    ac += TAB[idx] * w; as += TAB[(idx - 512) & 2047] * w; }
                dst[c] = f2bf(ac * s); dst[512 + c] = f2bf(-as * s); }
            __syncthreads();
        }
    }
    __syncthreads();
    {
        LAS float* scr = SCR + C.wave * (64 * 33);
        const int gw = C.bid * NWAVES + C.wave, NGW = C.G * NWAVES;
        constexpr int I_G = 16 * 88, I_D = 44 * 32, I_IN = 16 * 72, I_BG = 16 * 96, I_A = 8 * 32, I_L = 8 * 32, I_O = 16 * 32;
        constexpr int PER_LAYER = 4 * I_G + 2 * I_D + I_IN + I_BG + I_A + I_L + I_O;
        for (int it = gw; it < 2 * PER_LAYER; it += NGW) {
            const int l = it / PER_LAYER; int r = it % PER_LAYER;
            if (r < I_G) { const int kb = r / 88, n0 = (r % 88) * 32; p0_transpose_item(args->in[11] + (size_t)l * D * DFF, DFF, (bf16_t*)wl_ptr(C, l, WL_GU1), D, 256 * (n0 >> 7) + (n0 & 127), 0, kb * 64, n0, scr, C.lane); continue; } r -= I_G;
            if (r < I_G) { const int kb = r / 88, n0 = (r % 88) * 32; p0_transpose_item(args->in[12] + (size_t)l * D * DFF, DFF, (bf16_t*)wl_ptr(C, l, WL_GU1), D, 256 * (n0 >> 7) + 128 + (n0 & 127), 0, kb * 64, n0, scr, C.lane); continue; } r -= I_G;
            if (r < I_D) { const int kb = r / 32, nb = r % 32; p0_transpose_item(args->in[13] + (size_t)l * DFF * D, D, (bf16_t*)wl_ptr(C, l, WL_D1), DFF, nb * 32, 0, kb * 64, nb * 32, scr, C.lane); continue; } r -= I_D;
            if (r < I_G) { const int kb = r / 88, n0 = (r % 88) * 32; p0_transpose_item(args->in[14] + (size_t)l * D * DFF, DFF, (bf16_t*)wl_ptr(C, l, WL_GU2), D, 256 * (n0 >> 7) + (n0 & 127), 0, kb * 64, n0, scr, C.lane); continue; } r -= I_G;
            if (r < I_G) { const int kb = r / 88, n0 = (r % 88) * 32; p0_transpose_item(args->in[15] + (size_t)l * D * DFF, DFF, (bf16_t*)wl_ptr(C, l, WL_GU2), D, 256 * (n0 >> 7) + 128 + (n0 & 127), 0, kb * 64, n0, scr, C.lane); continue; } r -= I_G;
            if (r < I_D) { const int kb = r / 32, nb = r % 32; p0_transpose_item(args->in[16] + (size_t)l * DFF * D, D, (bf16_t*)wl_ptr(C, l, WL_D2), DFF, nb * 32, 0, kb * 64, nb * 32, scr, C.lane); continue; } r -= I_D;
            if (r < I_IN) { const int kb = r / 72, nb = r % 72; p0_transpose_item(args->in[17] + (size_t)l * D * 2304, 2304, (bf16_t*)wl_ptr(C, l, WL_IN), D, nb * 32, 0, kb * 64, nb * 32, scr, C.lane); continue; } r -= I_IN;
            if (r < I_BG) { const int kb = r / 96, nb = r % 96; p0_transpose_item(args->in[18] + (size_t)l * D * 3072, 3072, (bf16_t*)wl_ptr(C, l, WL_IN), D, 2304 + nb * 32, 0, kb * 64, nb * 32, scr, C.lane); continue; } r -= I_BG;
            if (r < I_A) { const int kb = r / 32, nb = r % 32; p0_transpose_item(args->in[21] + (size_t)l * 512 * D, D, (bf16_t*)wl_ptr(C, l, WL_A), 512, nb * 32, 0, kb * 64, nb * 32, scr, C.lane); continue; } r -= I_A;
            if (r < I_L) { const int kb = r / 32, nb = r % 32;
                p0_transpose_item(args->in[29] + (size_t)l * 512 * D, D, (bf16_t*)wl_ptr(C, l, WL_L2), D, nb * 32, 0, kb * 64, nb * 32, scr, C.lane);
                p0_transpose_item(args->in[29] + (size_t)l * 512 * D, D, (bf16_t*)wl_ptr(C, l, WL_L2), D, nb * 32, 512, kb * 64, nb * 32, scr, C.lane); continue; } r -= I_L;
            { const int kb = r / 32, nb = r % 32; p0_transpose_item(args->in[31] + (size_t)l * D * D, D, (bf16_t*)wl_ptr(C, l, WL_O), D, nb * 32, 0, kb * 64, nb * 32, scr, C.lane); }
        }
    }
    const int gt = C.bid * NTHREADS + C.tid, NGT = C.G * NTHREADS;
    for (int i = gt; i < M * D / 4; i += NGT) { const f32x4 v = (i < MP * D / 4) ? ((const f32x4*)args->in[0])[i] : ((const f32x4*)args->in[1])[i - MP * D / 4]; ((f32x4*)C.out)[i] = v; }
    for (int i = gt; i < 4096 * 256; i += NGT) { const int pr = i >> 8, t0 = (i & 255) * 8, p = pr & 2047, sh = (pr >= 2048) ? 512 : 0; const float s = 0.022097086912079608f;
        float v[8];
#pragma unroll
        for (int j = 0; j < 8; ++j) v[j] = TAB[((p * (t0 + j)) - sh) & 2047] * s;
        u32x4 o; o.x = cvt_pk_bf16(v[0], v[1]); o.y = cvt_pk_bf16(v[2], v[3]); o.z = cvt_pk_bf16(v[4], v[5]); o.w = cvt_pk_bf16(v[6], v[7]);
        *(u32x4*)((bf16_t*)(C.ws + WS_DFTL) + (size_t)pr * 2048 + t0) = o; }
    for (int i = gt; i < 512 * 32; i += NGT) { const int pr = i >> 5, t0 = (i & 31) * 8, p = pr & 255, sh = (pr >= 256) ? 512 : 0; const float s = 0.0625f;
        float v[8];
#pragma unroll
        for (int j = 0; j < 8; ++j) v[j] = TAB[((p * (t0 + j) * 8) - sh) & 2047] * s;
        u32x4 o; o.x = cvt_pk_bf16(v[0], v[1]); o.y = cvt_pk_bf16(v[2], v[3]); o.z = cvt_pk_bf16(v[4], v[5]); o.w = cvt_pk_bf16(v[6], v[7]);
        *(u32x4*)((bf16_t*)(C.ws + WS_DFTC) + (size_t)pr * 256 + t0) = o; }
    for (int i = gt; i < 1024; i += NGT) { const int pos = i >> 4, f = i & 15; const float inv = exp2f(-(float)f * (13.287712379549449f / 16.0f)); const float ang = (float)pos * inv; const float af = (float)((double)ang * 0.3183098861837907);
        ((float*)(C.ws + OFF_ROPE))[i] = cospif(af); ((float*)(C.ws + OFF_ROPE))[1024 + i] = sinpif(af); }
    for (int i = gt; i < 4 * 2 * 256 * 128; i += NGT) { ((bf16_t*)(C.ws + OFF_CK))[i] = f2bf(args->in[3][i]);
        const int d = i & 63, kvh = (i >> 6) & 1, t = (i >> 7) & 255, bl = i >> 15;
        ((bf16_t*)(C.ws + OFF_CVT))[((size_t)(bl * 2 + kvh) * 64 + d) * 256 + t] = f2bf(args->in[4][i]); }
}

__device__ __forceinline__ void modnorm_phase(ArgsP args, const Ctx& C, int l, int sub) {
    const int gw = C.bid * NWAVES + C.wave, NGW = C.G * NWAVES;
    const float* nw = args->in[9] + (size_t)(l * 3 + sub) * D;
    bf16_t* XN = (bf16_t*)act_ptr(C, A_XN);
    for (int r = gw; r < M; r += NGW) {
        const int c = cond_of_row(r);
        const float* sh = mod_ptr(C, l, c, sub, 0); const float* sc = mod_ptr(C, l, c, sub, 1);
        const f32x4* xr = (const f32x4*)(C.out + (size_t)r * D) + C.lane;
        f32x4 v[4]; float s = 0.f;
#pragma unroll
        for (int j = 0; j < 4; ++j) { v[j] = xr[64 * j]; s += (v[j].x * v[j].x + v[j].y * v[j].y) + (v[j].z * v[j].z + v[j].w * v[j].w); }
        const float rstd = rsqrtf(wave_sum(s) * (1.0f / D) + EPS);
        u32x2* o = (u32x2*)(XN + (size_t)r * D) + C.lane;
#pragma unroll
        for (int j = 0; j < 4; ++j) { const int col = 4 * C.lane + 256 * j; const f32x4 w = *(const f32x4*)(nw + col), a = *(const f32x4*)(sc + col), b = *(const f32x4*)(sh + col);
            f32x4 y = v[j] * rstd * w * (a + 1.0f) + b; u32x2 p; p.x = cvt_pk_bf16(y.x, y.y); p.y = cvt_pk_bf16(y.z, y.w); o[64 * j] = p; }
    }
}
__device__ __forceinline__ void finalnorm_phase(ArgsP args, const Ctx& C) {
    const int gw = C.bid * NWAVES + C.wave, NGW = C.G * NWAVES;
    const float* nw = args->in[10];
    for (int r = gw; r < M; r += NGW) {
        f32x4* xr = (f32x4*)(C.out + (size_t)r * D) + C.lane;
        f32x4 v[4]; float s = 0.f;
#pragma unroll
        for (int j = 0; j < 4; ++j) { v[j] = xr[64 * j]; s += (v[j].x * v[j].x + v[j].y * v[j].y) + (v[j].z * v[j].z + v[j].w * v[j].w); }
        const float rstd = rsqrtf(wave_sum(s) * (1.0f / D) + EPS);
#pragma unroll
        for (int j = 0; j < 4; ++j) { const f32x4 w = *(const f32x4*)(nw + 4 * C.lane + 256 * j); xr[64 * j] = v[j] * rstd * w; }
    }
}

struct Unit { int pm, pn, z; const bf16_t* A; const bf16_t* B; };

struct StaticOrder {
    int nM, nN, nwg, G, c; const bf16_t* A; const bf16_t* B; int lda, ldb;
    __device__ void init(int Mr, int N, int G_, int c_, const bf16_t* A_, int lda_, const bf16_t* B_, int ldb_) { nM = Mr / 256; nN = N / 256; nwg = nM * nN; G = G_; c = c_; A = A_; B = B_; lda = lda_; ldb = ldb_; }
    __device__ bool next(int i, Unit& u) const {
        const long L = (long)i * G + c; if (L >= nwg) return false;
        int wgid = (int)L; { const int q = nwg / 8, r = nwg % 8, xcd = wgid % 8, off = wgid / 8; wgid = (xcd < r ? xcd * (q + 1) : r * (q + 1) + (xcd - r) * q) + off; }
        const int nig = 8 * nN, gid = wgid / nig, fm = gid * 8, gsz = (nM - fm) < 8 ? (nM - fm) : 8;
        u.pm = fm + ((wgid % nig) % gsz); u.pn = (wgid % nig) / gsz; u.z = 0;
        u.A = A + (size_t)u.pm * 256 * lda; u.B = B + (size_t)u.pn * 256 * ldb; return true;
    }
};
struct DftOrder {
    int nseq, nPm, L, G, c; const bf16_t* A; const bf16_t* XFT;
    __device__ bool next(int i, Unit& u) const {
        const int idx = i * G + c; if (idx >= nseq * nPm * 2) return false;
        u.z = idx / (nPm * 2); const int r = idx % (nPm * 2); u.pm = r >> 1; u.pn = r & 1;
        u.A = A + (size_t)u.pm * 256 * L; u.B = XFT + ((size_t)u.z * 512 + u.pn * 256) * L; return true;
    }
};

template <class Epi, class Sched>
__device__ __forceinline__ void gemm_simple(const Ctx& C, const Sched& S, const Epi& E, int lda, int ldb, int K) {
    const int wr = C.wave >> 2, wc = C.wave & 3, fr = C.lane & 15, fq = C.lane >> 4;
    Unit u;
    for (int ui = 0; S.next(ui, u); ++ui) {
        f32x4 acc[2][2][4][2];
#pragma unroll
        for (int a = 0; a < 2; ++a)
#pragma unroll
            for (int b = 0; b < 2; ++b)
#pragma unroll
                for (int m = 0; m < 4; ++m)
#pragma unroll
                    for (int n = 0; n < 2; ++n) acc[a][b][m][n] = (f32x4){0.f, 0.f, 0.f, 0.f};
        const bf16_t* pa = u.A + (size_t)(wr * 64 + fr) * lda + fq * 8;
        const bf16_t* pb = u.B + (size_t)(wc * 32 + fr) * ldb + fq * 8;
        for (int k0 = 0; k0 < K; k0 += 32) {
            bf16x8 At[2][4], Bt[2][2];
#pragma unroll
            for (int a = 0; a < 2; ++a)
#pragma unroll
                for (int m = 0; m < 4; ++m) At[a][m] = *(const bf16x8*)(pa + (size_t)(a * 128 + m * 16) * lda + k0);
#pragma unroll
            for (int b = 0; b < 2; ++b)
#pragma unroll
                for (int n = 0; n < 2; ++n) Bt[b][n] = *(const bf16x8*)(pb + (size_t)(b * 128 + n * 16) * ldb + k0);
#pragma unroll
            for (int a = 0; a < 2; ++a)
#pragma unroll
                for (int b = 0; b < 2; ++b)
#pragma unroll
                    for (int m = 0; m < 4; ++m)
#pragma unroll
                        for (int n = 0; n < 2; ++n) acc[a][b][m][n] = __builtin_amdgcn_mfma_f32_16x16x32_bf16(Bt[b][n], At[a][m], acc[a][b][m][n], 0, 0, 0);
        }
        E(acc, u, wr, wc, fr, fq);
    }
}

#define EPI_LOOP_AM for (int ai = 0; ai < 2; ++ai) _Pragma("unroll") for (int m = 0; m < 4; ++m)
struct EpiGU {
    bf16_t* H;
    __device__ __forceinline__ void operator()(const f32x4 (&acc)[2][2][4][2], const Unit& u, int wr, int wc, int fr, int fq) const {
#pragma unroll
        EPI_LOOP_AM { const int row = u.pm * 256 + ai * 128 + wr * 64 + m * 16 + fr;
#pragma unroll
            for (int n = 0; n < 2; ++n) { const f32x4 g = acc[ai][0][m][n], up = acc[ai][1][m][n];
                u32x2 p; p.x = cvt_pk_bf16(siluf_(g.x) * up.x, siluf_(g.y) * up.y); p.y = cvt_pk_bf16(siluf_(g.z) * up.z, siluf_(g.w) * up.w);
                *(u32x2*)(H + (size_t)row * DFF + u.pn * 128 + wc * 32 + n * 16 + fq * 4) = p; } }
    }
};
struct EpiRes {
    float* X; const float* modbase; int l, sub; float coef;
    __device__ __forceinline__ void operator()(const f32x4 (&acc)[2][2][4][2], const Unit& u, int wr, int wc, int fr, int fq) const {
        const int c = cond_of_row(u.pm * 256);
        const float* gate = modbase + ((size_t)(l * 5 + c) * NMOD + (sub * 3 + 2) * D);
#pragma unroll
        for (int bj = 0; bj < 2; ++bj)
#pragma unroll
            for (int n = 0; n < 2; ++n) { const int col = u.pn * 256 + bj * 128 + wc * 32 + n * 16 + fq * 4; const f32x4 g = *(const f32x4*)(gate + col) * coef;
#pragma unroll
                EPI_LOOP_AM { const int row = u.pm * 256 + ai * 128 + wr * 64 + m * 16 + fr; f32x4* p = (f32x4*)(X + (size_t)row * D + col); *p = *p + g * acc[ai][bj][m][n]; } }
    }
};
struct EpiIn {
    bf16_t *Q, *Kb, *VT, *GY, *XFT, *G; float* XR; float* out; const float* rope; const float* bgate; int l;
    __device__ __forceinline__ void operator()(const f32x4 (&acc)[2][2][4][2], const Unit& u, int wr, int wc, int fr, int fq) const {
        const int row0 = u.pm * 256 + wr * 64 + fr; const bool latent = u.pm >= 16;
        if (u.pn <= 2) {
#pragma unroll
            for (int bj = 0; bj < 2; ++bj) {
                if (u.pn == 2 && bj == 1) {
#pragma unroll
                    EPI_LOOP_AM { const int row = row0 + ai * 128 + m * 16; int seqoff, L, t;
                        if (latent) { const int b = (row - MP) >> 11; t = (row - MP) & 2047; L = LS; seqoff = 16 * 128 * LC + b * 128 * LS; } else { const int b = row >> 8; t = row & 255; L = LC; seqoff = b * 128 * LC; }
#pragma unroll
                        for (int n = 0; n < 2; ++n) { const f32x4 v = acc[ai][1][m][n]; const int d128 = wc * 32 + n * 16 + fq * 4;
                            bf16_t* p = VT + seqoff + (size_t)d128 * L + t; p[0] = f2bf(v.x); p[L] = f2bf(v.y); p[2 * L] = f2bf(v.z); p[3 * L] = f2bf(v.w);
                            if (!latent) *(f32x4*)(out + OUT_CV + ((size_t)((row >> 8) * 2 + l) * 256 + t) * 128 + d128) = v; } }
                } else {
                    const bool isk = (u.pn == 2); const int axis = wc & 1;
#pragma unroll
                    EPI_LOOP_AM { const int row = row0 + ai * 128 + m * 16; f32x4 x1 = acc[ai][bj][m][0], x2 = acc[ai][bj][m][1];
                        if (isk && !latent) { float* o = out + OUT_CK + ((size_t)((row >> 8) * 2 + l) * 256 + (row & 255)) * 128 + wc * 32 + fq * 4; *(f32x4*)o = x1; *(f32x4*)(o + 16) = x2; }
                        if (latent) { const int t = (row - MP) & 2047, pos = axis ? (t & 63) : (t >> 6);
                            const f32x4 cs = *(const f32x4*)(rope + pos * 16 + fq * 4), sn = *(const f32x4*)(rope + 1024 + pos * 16 + fq * 4);
                            const f32x4 o1 = x1 * cs - x2 * sn, o2 = x1 * sn + x2 * cs; x1 = o1; x2 = o2; }
                        if (!isk) { x1 = x1 * QSCALE; x2 = x2 * QSCALE; }
                        bf16_t* o = isk ? (Kb + (size_t)row * 128 + wc * 32 + fq * 4) : (Q + (size_t)row * 512 + u.pn * 256 + bj * 128 + wc * 32 + fq * 4);
                        u32x2 p; p.x = cvt_pk_bf16(x1.x, x1.y); p.y = cvt_pk_bf16(x1.z, x1.w); *(u32x2*)o = p;
                        p.x = cvt_pk_bf16(x2.x, x2.y); p.y = cvt_pk_bf16(x2.z, x2.w); *(u32x2*)(o + 16) = p; }
                }
            }
        } else if (u.pn <= 4) {
#pragma unroll
            EPI_LOOP_AM { const int row = row0 + ai * 128 + m * 16;
#pragma unroll
                for (int bj = 0; bj < 2; ++bj)
#pragma unroll
                    for (int n = 0; n < 2; ++n) *(f32x4*)(XR + (size_t)row * 512 + (u.pn - 3) * 256 + bj * 128 + wc * 32 + n * 16 + fq * 4) = acc[ai][bj][m][n]; }
        } else if (u.pn <= 6) {
#pragma unroll
            EPI_LOOP_AM { const int row = row0 + ai * 128 + m * 16;
#pragma unroll
                for (int bj = 0; bj < 2; ++bj)
#pragma unroll
                    for (int n = 0; n < 2; ++n) { const f32x4 v = acc[ai][bj][m][n]; u32x2 p; p.x = cvt_pk_bf16(gelu_tanh(v.x), gelu_tanh(v.y)); p.y = cvt_pk_bf16(gelu_tanh(v.z), gelu_tanh(v.w));
                        *(u32x2*)(GY + (size_t)row * 512 + (u.pn - 5) * 256 + bj * 128 + wc * 32 + n * 16 + fq * 4) = p; } }
        } else if (u.pn <= 8) {
#pragma unroll
            EPI_LOOP_AM { const int row = row0 + ai * 128 + m * 16; size_t seqoff; int L, t;
                if (latent) { const int b = (row - MP) >> 11; t = (row - MP) & 2047; L = LS; seqoff = (size_t)16 * 512 * LC + (size_t)b * 512 * LS; } else { const int b = row >> 8; t = row & 255; L = LC; seqoff = (size_t)b * 512 * LC; }
#pragma unroll
                for (int bj = 0; bj < 2; ++bj)
#pragma unroll
                    for (int n = 0; n < 2; ++n) { const f32x4 v = acc[ai][bj][m][n]; bf16_t* p = XFT + seqoff + (size_t)((u.pn - 7) * 256 + bj * 128 + wc * 32 + n * 16 + fq * 4) * L + t;
                        p[0] = f2bf(v.x); p[L] = f2bf(v.y); p[2 * L] = f2bf(v.z); p[3 * L] = f2bf(v.w); } }
        } else {
#pragma unroll
            for (int bj = 0; bj < 2; ++bj)
#pragma unroll
                for (int n = 0; n < 2; ++n) { const int col = (u.pn - 9) * 256 + bj * 128 + wc * 32 + n * 16 + fq * 4; const f32x4 b = *(const f32x4*)(bgate + col);
#pragma unroll
                    EPI_LOOP_AM { const int row = row0 + ai * 128 + m * 16; const f32x4 v = acc[ai][bj][m][n] + b;
                        u32x2 p; p.x = cvt_pk_bf16(sigmoidf_(v.x), sigmoidf_(v.y)); p.y = cvt_pk_bf16(sigmoidf_(v.z), sigmoidf_(v.w)); *(u32x2*)(G + (size_t)row * 3072 + col) = p; } }
        }
    }
};
template <int MODE> struct EpiBranch {
    bf16_t* MG; const bf16_t* G; int br;
    __device__ __forceinline__ void operator()(const f32x4 (&acc)[2][2][4][2], const Unit& u, int wr, int wc, int fr, int fq) const {
#pragma unroll
        EPI_LOOP_AM { const int row = u.pm * 256 + ai * 128 + wr * 64 + m * 16 + fr;
#pragma unroll
            for (int bj = 0; bj < 2; ++bj)
#pragma unroll
                for (int n = 0; n < 2; ++n) { const int col = u.pn * 256 + bj * 128 + wc * 32 + n * 16 + fq * 4;
                    const u32x2 g = *(const u32x2*)(G + (size_t)row * 3072 + br * 1024 + col); f32x4 v = acc[ai][bj][m][n];
                    v.x *= bflo(g.x); v.y *= bfhi(g.x); v.z *= bflo(g.y); v.w *= bfhi(g.y);
                    u32x2* p = (u32x2*)(MG + (size_t)row * D + col);
                    if (MODE == 1) { const u32x2 o = *p; v.x += bflo(o.x); v.y += bfhi(o.x); v.z += bflo(o.y); v.w += bfhi(o.y); }
                    u32x2 w; w.x = cvt_pk_bf16(v.x, v.y); w.y = cvt_pk_bf16(v.z, v.w); *p = w; } }
    }
};
struct EpiDft {
    bf16_t* Z; int L, rowbase0;
    __device__ __forceinline__ void operator()(const f32x4 (&acc)[2][2][4][2], const Unit& u, int wr, int wc, int fr, int fq) const {
        const int pp = u.pm * 256, soff = (pp >= L) ? 512 : 0, p0 = (pp >= L) ? pp - L : pp;
#pragma unroll
        EPI_LOOP_AM { const int row = rowbase0 + u.z * L + p0 + ai * 128 + wr * 64 + m * 16 + fr;
#pragma unroll
            for (int bj = 0; bj < 2; ++bj)
#pragma unroll
                for (int n = 0; n < 2; ++n) { const f32x4 v = acc[ai][bj][m][n]; u32x2 w; w.x = cvt_pk_bf16(v.x, v.y); w.y = cvt_pk_bf16(v.z, v.w);
                    *(u32x2*)(Z + (size_t)row * D + soff + u.pn * 256 + bj * 128 + wc * 32 + n * 16 + fq * 4) = w; } }
    }
};

__device__ __forceinline__ void attn_naive_phase(ArgsP args, const Ctx& C, int l) {
    bf16_t* Q = (bf16_t*)act_ptr(C, A_Q); const bf16_t* Kb = (const bf16_t*)act_ptr(C, A_K); const bf16_t* VT = (const bf16_t*)act_ptr(C, A_VT);
    const bf16_t* CK = (const bf16_t*)(C.ws + OFF_CK); const bf16_t* CVT = (const bf16_t*)(C.ws + OFF_CVT);
    const int gw = C.bid * NWAVES + C.wave, NGW = C.G * NWAVES;
    for (int it = gw; it < (M / 64) * 8; it += NGW) {
        const int h = it & 7, row = (it >> 3) * 64 + C.lane, kvh = h >> 2;
        float q[64], o[64];
        { const u32x4* qp = (const u32x4*)(Q + (size_t)row * 512 + h * 64);
#pragma unroll
          for (int j = 0; j < 8; ++j) { const u32x4 w = qp[j]; q[8 * j] = bflo(w.x); q[8 * j + 1] = bfhi(w.x); q[8 * j + 2] = bflo(w.y); q[8 * j + 3] = bfhi(w.y); q[8 * j + 4] = bflo(w.z); q[8 * j + 5] = bfhi(w.z); q[8 * j + 6] = bflo(w.w); q[8 * j + 7] = bfhi(w.w); } }
#pragma unroll
        for (int d = 0; d < 64; ++d) o[d] = 0.f;
        float mx = args->in[20][l * 8 + h] * LOG2E, lsum = 1.0f;
        const bool latent = row >= MP;
        const int b = latent ? ((row - MP) >> 11) : (row >> 8), t = latent ? ((row - MP) & 2047) : (row & 255);
        for (int seg = 0; seg < (latent ? 2 : 1); ++seg) {
            const int nk = (seg == 1 || !latent) ? 256 : 257;
            for (int jj = 0; jj < nk; ++jj) {
                int j; bool ok = true; const bf16_t* kp; const bf16_t* vp; int L;
                if (seg == 1) { j = jj; kp = CK + ((size_t)(b * 2 + l) * 256 + j) * 128 + kvh * 64; vp = CVT + ((size_t)((b * 2 + l) * 2 + kvh) * 64) * 256 + j; L = 256; }
                else if (!latent) { j = jj; kp = Kb + ((size_t)(b * 256 + j)) * 128 + kvh * 64; vp = VT + (size_t)b * 128 * LC + (size_t)(kvh * 64) * LC + j; L = LC; }
                else { j = t - 128 + jj; ok = (j >= 0 && j < LS); const int jc = ok ? j : t; kp = Kb + ((size_t)(MP + b * LS + jc)) * 128 + kvh * 64; vp = VT + (size_t)16 * 128 * LC + (size_t)b * 128 * LS + (size_t)(kvh * 64) * LS + jc; L = LS; }
                float s = 0.f;
#pragma unroll
                for (int jq = 0; jq < 8; ++jq) { const u32x4 w = ((const u32x4*)kp)[jq];
                    s += q[8 * jq] * bflo(w.x) + q[8 * jq + 1] * bfhi(w.x) + q[8 * jq + 2] * bflo(w.y) + q[8 * jq + 3] * bfhi(w.y) + q[8 * jq + 4] * bflo(w.z) + q[8 * jq + 5] * bfhi(w.z) + q[8 * jq + 6] * bflo(w.w) + q[8 * jq + 7] * bfhi(w.w); }
                if (!ok) s = -1e30f;
                const float mn = fmaxf(mx, s), alpha = exp2f(mx - mn), p = exp2f(s - mn);
                lsum = lsum * alpha + p; mx = mn;
#pragma unroll
                for (int d = 0; d < 64; ++d) o[d] = o[d] * alpha + p * bf2f(vp[(size_t)d * L]);
            }
        }
        const float inv = 1.0f / lsum;
        u32x4* op = (u32x4*)(Q + (size_t)row * 512 + h * 64);
#pragma unroll
        for (int j = 0; j < 8; ++j) { u32x4 w; w.x = cvt_pk_bf16(o[8 * j] * inv, o[8 * j + 1] * inv); w.y = cvt_pk_bf16(o[8 * j + 2] * inv, o[8 * j + 3] * inv); w.z = cvt_pk_bf16(o[8 * j + 4] * inv, o[8 * j + 5] * inv); w.w = cvt_pk_bf16(o[8 * j + 6] * inv, o[8 * j + 7] * inv); op[j] = w; }
    }
}

__device__ __forceinline__ void lru_naive_phase(ArgsP args, const Ctx& C, int l) {
    const float* XR = (const float*)act_ptr(C, A_XR); const bf16_t* GY = (const bf16_t*)act_ptr(C, A_GY); bf16_t* REC = (bf16_t*)act_ptr(C, A_XN);
    const int gw = C.bid * NWAVES + C.wave, NGW = C.G * NWAVES;
    for (int it = gw; it < 20 * 8 * 2; it += NGW) {
        const int dir = it & 1, nb = (it >> 1) & 7, sq = it >> 4;
        const bool latent = sq < 4; const int b = latent ? sq : sq - 4, L = latent ? LS : LC, rowbase = latent ? MP + b * LS : b * LC;
        const int ch = nb * 64 + C.lane;
        float wa[64], wi[64];
        { const float* pa = args->in[24] + ((size_t)((l * 2 + dir) * 8 + nb) * 64) * 64 + C.lane; const float* pi = args->in[26] + ((size_t)((l * 2 + dir) * 8 + nb) * 64) * 64 + C.lane;
#pragma unroll
          for (int k = 0; k < 64; ++k) { wa[k] = pa[k * 64]; wi[k] = pi[k * 64]; } }
        const float ba = args->in[25][(l * 2 + dir) * 512 + ch], bi = args->in[27][(l * 2 + dir) * 512 + ch], lam = args->in[28][(l * 2 + dir) * 512 + ch];
        const float sp = log1pf(__expf(-lam));
        const float cw0 = args->in[22][(l * 4 + 0) * 512 + ch], cw1 = args->in[22][(l * 4 + 1) * 512 + ch], cw2 = args->in[22][(l * 4 + 2) * 512 + ch], cw3 = args->in[22][(l * 4 + 3) * 512 + ch], cb = args->in[23][l * 512 + ch];
        float h = latent ? args->in[5][((size_t)(b * 2 + l) * 2 + dir) * 512 + ch] : 0.f;
        for (int s = 0; s < L; ++s) {
            const int t = dir ? (L - 1 - s) : s;
            const float* xp = XR + (size_t)(rowbase + t) * 512 + ch;
            const float xm2 = (t >= 2) ? xp[-2 * 512] : 0.f, xm1 = (t >= 1) ? xp[-512] : 0.f, x0 = xp[0], xp1 = (t + 1 < L) ? xp[512] : 0.f;
            const float xc = cb + cw0 * xm2 + cw1 * xm1 + cw2 * x0 + cw3 * xp1;
            float ra = ba, ri = bi;
#pragma unroll
            for (int k = 0; k < 64; ++k) { const float xk = __shfl(xc, k); ra += xk * wa[k]; ri += xk * wi[k]; }
            const float r = sigmoidf_(ra), ig = sigmoidf_(ri);
            const float log_a = -8.0f * r * sp, a = __expf(log_a), bb = sqrtf(fmaxf(-expm1f(2.0f * log_a), 0.f)) * (ig * xc);
            h = a * h + bb;
            REC[(size_t)(rowbase + t) * D + dir * 512 + ch] = f2bf(h * bf2f(GY[(size_t)(rowbase + t) * 512 + ch]));
        }
        if (!latent) C.out[OUT_ST + ((size_t)(b * 2 + l) * 2 + dir) * 512 + ch] = h;
    }
}

constexpr int N_PHASES = 28;
enum { K_P0 = 1, K_NORM = 2, K_GU = 4, K_RES = 8, K_IN = 16, K_ATTN = 32, K_LRU = 64, K_DFT = 128, K_BR = 256, K_ALL = 511 };
__host__ __device__ constexpr int kind_of_phase(int ph) {
    if (ph == 0) return K_P0;
    if (ph == N_PHASES - 1) return K_NORM;
    const int s = (ph - 1) % 13;
    return (s == 0 || s == 3 || s == 10) ? K_NORM : (s == 1 || s == 11) ? K_GU : (s == 2 || s == 12 || s == 9) ? K_RES : (s == 4) ? K_IN : (s == 5) ? K_ATTN : (s == 6) ? K_LRU : (s == 7) ? K_DFT : K_BR;
}
__host__ __device__ constexpr bool sync_after_phase(int ph) { const int s = (ph - 1) % 13; return !(ph >= 1 && ph < N_PHASES - 1 && (s == 5 || s == 6)); }

template <int KM>
__device__ __forceinline__ void run_phase(ArgsP args, const Ctx& C, int ph) {
    if (ph == 0) { if constexpr ((KM & K_P0) != 0) p0_prologue(args, C); return; }
    if (ph == N_PHASES - 1) { if constexpr ((KM & K_NORM) != 0) finalnorm_phase(args, C); return; }
    const int l = (ph - 1) / 13, s = (ph - 1) % 13;
    const float* MODB = (const float*)(C.ws + OFF_MOD);
    if (s == 0 || s == 3 || s == 10) { if constexpr ((KM & K_NORM) != 0) modnorm_phase(args, C, l, s == 0 ? 0 : (s == 3 ? 1 : 2)); }
    else if (s == 1 || s == 11) { if constexpr ((KM & K_GU) != 0) { StaticOrder S; S.init(M, 2 * DFF, C.G, C.bid, (const bf16_t*)act_ptr(C, A_XN), D, (const bf16_t*)wl_ptr(C, l, s == 1 ? WL_GU1 : WL_GU2), D);
        EpiGU E{(bf16_t*)act_ptr(C, A_G)}; gemm_simple(C, S, E, D, D, D); } }
    else if (s == 2 || s == 12) { if constexpr ((KM & K_RES) != 0) { StaticOrder S; S.init(M, D, C.G, C.bid, (const bf16_t*)act_ptr(C, A_G), DFF, (const bf16_t*)wl_ptr(C, l, s == 2 ? WL_D1 : WL_D2), DFF);
        EpiRes E{C.out, MODB, l, s == 2 ? 0 : 2, 0.5f}; gemm_simple(C, S, E, DFF, DFF, DFF); } }
    else if (s == 4) { if constexpr ((KM & K_IN) != 0) { StaticOrder S; S.init(M, NIN, C.G, C.bid, (const bf16_t*)act_ptr(C, A_XN), D, (const bf16_t*)wl_ptr(C, l, WL_IN), D);
        EpiIn E{(bf16_t*)act_ptr(C, A_Q), (bf16_t*)act_ptr(C, A_K), (bf16_t*)act_ptr(C, A_VT), (bf16_t*)act_ptr(C, A_GY), (bf16_t*)act_ptr(C, A_XFT), (bf16_t*)act_ptr(C, A_G),
                (float*)act_ptr(C, A_XR), C.out, (const float*)(C.ws + OFF_ROPE), args->in[19] + (size_t)l * 3072, l};
        gemm_simple(C, S, E, D, D, D); } }
    else if (s == 5) { if constexpr ((KM & K_ATTN) != 0) attn_naive_phase(args, C, l); }
    else if (s == 6) { if constexpr ((KM & K_LRU) != 0) lru_naive_phase(args, C, l); }
    else if (s == 7) { if constexpr ((KM & K_DFT) != 0) {
        { DftOrder S{4, 16, LS, C.G, C.bid, (const bf16_t*)(C.ws + WS_DFTL), (const bf16_t*)act_ptr(C, A_XFT) + (size_t)16 * 512 * LC}; EpiDft E{(bf16_t*)act_ptr(C, A_Z), LS, MP}; gemm_simple(C, S, E, LS, LS, LS); }
        { DftOrder S{16, 2, LC, C.G, C.bid, (const bf16_t*)(C.ws + WS_DFTC), (const bf16_t*)act_ptr(C, A_XFT)}; EpiDft E{(bf16_t*)act_ptr(C, A_Z), LC, 0}; gemm_simple(C, S, E, LC, LC, LC); } } }
    else if (s == 8) { if constexpr ((KM & K_BR) != 0) {
        bf16_t* MG = (bf16_t*)act_ptr(C, A_XR); const bf16_t* G = (const bf16_t*)act_ptr(C, A_G);
        { StaticOrder S; S.init(M, D, C.G, C.bid, (const bf16_t*)act_ptr(C, A_Q), 512, (const bf16_t*)wl_ptr(C, l, WL_A), 512); EpiBranch<0> E{MG, G, 0}; gemm_simple(C, S, E, 512, 512, 512); }
        { StaticOrder S; S.init(M, D, C.G, C.bid, (const bf16_t*)act_ptr(C, A_XN), D, (const bf16_t*)wl_ptr(C, l, WL_L2), D); EpiBranch<1> E{MG, G, 1}; gemm_simple(C, S, E, D, D, D); }
        { StaticOrder S; S.init(M, D, C.G, C.bid, (const bf16_t*)act_ptr(C, A_Z), D, (const bf16_t*)wl_ptr(C, l, WL_F2), D); EpiBranch<1> E{MG, G, 2}; gemm_simple(C, S, E, D, D, D); } } }
    else if (s == 9) { if constexpr ((KM & K_RES) != 0) { StaticOrder S; S.init(M, D, C.G, C.bid, (const bf16_t*)act_ptr(C, A_XR), D, (const bf16_t*)wl_ptr(C, l, WL_O), D);
        EpiRes E{C.out, MODB, l, 1, 1.0f}; gemm_simple(C, S, E, D, D, D); } }
}

template <int KM>
__global__ void __launch_bounds__(NTHREADS, 2) fwd_kernel(Args args_byval) {
    extern __shared__ __attribute__((aligned(16))) unsigned char lds_raw[];
    ArgsP args0 = (ArgsP)__builtin_amdgcn_kernarg_segment_ptr();
    const int lo = args0->ph_lo, hi = args0->ph_hi;
    for (int ph = lo; ph < hi; ++ph) {
        ArgsP args = args0; asm volatile("" : "+s"(args));
        int tid = threadIdx.x; asm volatile("" : "+v"(tid));
        int bid = blockIdx.x; asm volatile("" : "+s"(bid));
        Ctx C; C.out = args->out; C.ws = args->ws; C.lds = (LAS unsigned char*)lds_raw;
        C.tid = tid; C.lane = tid & 63; C.wave = __builtin_amdgcn_readfirstlane(tid >> 6); C.bid = bid; C.G = gridDim.x;
        run_phase<KM>(args, C, ph);
        if constexpr (KM == K_ALL) { if (ph + 1 < hi && sync_after_phase(ph)) cooperative_groups::this_grid().sync(); }
    }
}

template <int KM> static void launch_kind(const Args& a, hipStream_t stream) {
    static bool attr = false;
    if (!attr) { if (hipFuncSetAttribute((const void*)fwd_kernel<KM>, hipFuncAttributeMaxDynamicSharedMemorySize, LDS_BYTES) != hipSuccess) fprintf(stderr, "hipFuncSetAttribute failed\n"); attr = true; }
    hipLaunchKernelGGL(fwd_kernel<KM>, dim3(256), dim3(NTHREADS), LDS_BYTES, stream, a);
}
extern "C" void kernel_launch(void* const* d_in, const int* in_sizes, int n_in, void* d_out, int out_size, void* d_ws, size_t ws_size, hipStream_t stream) {
    if (n_in != 32 || ws_size < WS_END) { fprintf(stderr, "kernel_launch: n_in %d ws %zu (need %zu)\n", n_in, ws_size, (size_t)WS_END); return; }
    Args a{};
    for (int i = 0; i < 32; ++i) a.in[i] = (const float*)d_in[i];
    a.out = (float*)d_out; a.ws = (unsigned char*)d_ws;
#if N_LAUNCH_MODE == 1
    static bool attr = false;
    if (!attr) { if (hipFuncSetAttribute((const void*)fwd_kernel<K_ALL>, hipFuncAttributeMaxDynamicSharedMemorySize, LDS_BYTES) != hipSuccess) fprintf(stderr, "hipFuncSetAttribute failed\n"); attr = true; }
    a.ph_lo = 0; a.ph_hi = N_PHASES;
    void* kargs[] = {&a};
    hipError_t e = hipLaunchCooperativeKernel((const void*)fwd_kernel<K_ALL>, dim3(256), dim3(NTHREADS), kargs, LDS_BYTES, stream);
    if (e != hipSuccess) fprintf(stderr, "cooperative launch failed: %s\n", hipGetErrorString(e));
#else
    for (int p = 0; p < N_PHASES; ++p) { a.ph_lo = p; a.ph_hi = p + 1;
        switch (kind_of_phase(p)) {
            case K_P0: launch_kind<K_P0>(a, stream); break; case K_NORM: launch_kind<K_NORM>(a, stream); break; case K_GU: launch_kind<K_GU>(a, stream); break;
            case K_RES: launch_kind<K_RES>(a, stream); break; case K_IN: launch_kind<K_IN>(a, stream); break; case K_ATTN: launch_kind<K_ATTN>(a, stream); break;
            case K_LRU: launch_kind<K_LRU>(a, stream); break; case K_DFT: launch_kind<K_DFT>(a, stream); break; default: launch_kind<K_BR>(a, stream); break; } }
#endif
}
```

```cpp
#include <hip/hip_runtime.h>
#include <hip/hip_cooperative_groups.h>
#include <cstdint>
#include <cstdio>

#ifndef N_LAUNCH_MODE
#define N_LAUNCH_MODE 1
#endif

#define LAS __attribute__((address_space(3)))
typedef unsigned short bf16_t;
typedef short bf16x8 __attribute__((ext_vector_type(8)));
typedef float f32x4 __attribute__((ext_vector_type(4)));
typedef float f32x2 __attribute__((ext_vector_type(2)));
typedef unsigned u32x4 __attribute__((ext_vector_type(4)));
typedef unsigned u32x2 __attribute__((ext_vector_type(2)));

constexpr int D = 1024, MP = 4096, MS = 8192, M = MP + MS, DFF = 2816, DEPTH = 2;
constexpr int LC = 256, LS = 2048;
constexpr int NB_C = 16, NB_S = 4;
constexpr int NIN = 2304 + 3072;
constexpr int NMOD = 9216;
constexpr float EPS = 1e-6f;
constexpr float LOG2E = 1.4426950408889634f;
constexpr float QSCALE = 0.125f * LOG2E;

constexpr size_t MiB = 1u << 20;
constexpr size_t SZ_WGU = (size_t)2 * DFF * D * 2, SZ_WD = (size_t)D * DFF * 2, SZ_WIN = (size_t)NIN * D * 2;
constexpr size_t SZ_WA = (size_t)D * 512 * 2, SZ_W1K = (size_t)D * D * 2;
constexpr size_t WL_GU1 = 0, WL_D1 = WL_GU1 + SZ_WGU, WL_GU2 = WL_D1 + SZ_WD, WL_D2 = WL_GU2 + SZ_WGU, WL_IN = WL_D2 + SZ_WD,
                 WL_A = WL_IN + SZ_WIN, WL_L2 = WL_A + SZ_WA, WL_F2 = WL_L2 + SZ_W1K, WL_O = WL_F2 + SZ_W1K, WL_SIZE = WL_O + SZ_W1K;
constexpr size_t WS_CTL = 0;
constexpr size_t WS_MISC = 1 * MiB;
constexpr size_t OFF_MOD = WS_MISC;
constexpr size_t OFF_ROPE = OFF_MOD + (size_t)2 * 5 * NMOD * 4;
constexpr size_t OFF_CK = OFF_ROPE + 2 * 1024 * 4;
constexpr size_t OFF_CVT = OFF_CK + (size_t)4 * 2 * 256 * 128 * 2;
constexpr size_t WS_DFTC = 3 * MiB;
constexpr size_t WS_DFTL = 4 * MiB;
constexpr size_t WS_W = 20 * MiB;
constexpr size_t WS_ACT = WS_W + 2 * WL_SIZE;
constexpr size_t A_G = 0;
constexpr size_t A_XN = 72 * MiB;
constexpr size_t A_XR = 96 * MiB;
constexpr size_t A_GY = 120 * MiB;
constexpr size_t A_XFT = 132 * MiB;
constexpr size_t A_Q = 144 * MiB;
constexpr size_t A_K = 156 * MiB;
constexpr size_t A_VT = 159 * MiB;
constexpr size_t A_Z = 162 * MiB;
constexpr size_t A_END = 186 * MiB;
constexpr size_t WS_END = WS_ACT + A_END;

constexpr int OUT_YS = MP * D, OUT_CK = M * D, OUT_CV = OUT_CK + 16 * 2 * 256 * 128, OUT_ST = OUT_CV + 16 * 2 * 256 * 128;

constexpr int NTHREADS = 512, NWAVES = 8;
constexpr int LDS_BYTES = 147456;

__device__ __forceinline__ unsigned cvt_pk_bf16(float lo, float hi) { unsigned r; asm volatile("v_cvt_pk_bf16_f32 %0, %1, %2" : "=v"(r) : "v"(lo), "v"(hi)); return r; }
__device__ __forceinline__ bf16_t f2bf(float f) { return (bf16_t)(cvt_pk_bf16(f, 0.f) & 0xffffu); }
__device__ __forceinline__ float bf2f(unsigned h) { return __uint_as_float(h << 16); }
__device__ __forceinline__ float bflo(unsigned w) { return __uint_as_float(w << 16); }
__device__ __forceinline__ float bfhi(unsigned w) { return __uint_as_float(w & 0xffff0000u); }
__device__ __forceinline__ float sigmoidf_(float x) { return 1.0f / (1.0f + __expf(-x)); }
__device__ __forceinline__ float siluf_(float x) { return x / (1.0f + __expf(-x)); }
__device__ __forceinline__ float gelu_tanh(float x) { const float u = 0.7978845608028654f * (x + 0.044715f * x * x * x); return x / (1.0f + __expf(-2.0f * u)); }
__device__ __forceinline__ float wave_sum(float v) {
#pragma unroll
    for (int o = 1; o < 64; o <<= 1) v += __shfl_xor(v, o);
    return v;
}
__device__ __forceinline__ int cond_of_row(int r) { return r < MP ? 4 : ((r - MP) >> 11); }

struct Args {
    const float* in[32];
    float* out;
    unsigned char* ws;
    int ph_lo, ph_hi;
};

typedef const __attribute__((address_space(4))) Args* ArgsP;
struct Ctx {
    float* out; unsigned char* ws; LAS unsigned char* lds;
    int tid, lane, wave, bid, G;
};
__device__ __forceinline__ unsigned char* wl_ptr(const Ctx& C, int l, size_t off) { return C.ws + WS_W + (size_t)l * WL_SIZE + off; }
__device__ __forceinline__ unsigned char* act_ptr(const Ctx& C, size_t off) { return C.ws + WS_ACT + off; }
__device__ __forceinline__ const float* mod_ptr(const Ctx& C, int l, int c, int sub, int which) { return (const float*)(C.ws + OFF_MOD) + ((size_t)(l * 5 + c) * NMOD + (sub * 3 + which) * D); }

__device__ __forceinline__ void p0_transpose_item(const float* W, int ldw, bf16_t* WT, int ldt, int drow0, int dcol0, int k0, int n0, LAS float* scr, int lane) {
#pragma unroll 8
    for (int i = 0; i < 32; ++i) { const int kk = 2 * i + (lane >> 5); scr[kk * 33 + (lane & 31)] = W[(size_t)(k0 + kk) * ldw + n0 + (lane & 31)]; }
    asm volatile("s_waitcnt lgkmcnt(0)" ::: "memory");
    const int c = lane & 7;
#pragma unroll
    for (int j = 0; j < 4; ++j) { const int n = (lane >> 3) + 8 * j; const LAS float* s = scr + (8 * c) * 33 + n;
        u32x4 o; o.x = cvt_pk_bf16(s[0 * 33], s[1 * 33]); o.y = cvt_pk_bf16(s[2 * 33], s[3 * 33]); o.z = cvt_pk_bf16(s[4 * 33], s[5 * 33]); o.w = cvt_pk_bf16(s[6 * 33], s[7 * 33]);
        *(u32x4*)(WT + (size_t)(drow0 + n) * ldt + dcol0 + k0 + 8 * c) = o; }
    asm volatile("s_waitcnt lgkmcnt(0)" ::: "memory");
}

__device__ __forceinline__ void p0_prologue(ArgsP args, const Ctx& C) {
    LAS float* SC = (LAS float*)C.lds;
    LAS float* TAB = (LAS float*)(C.lds + 20480);
    LAS float* SCR = (LAS float*)(C.lds + 32768);
    const float* c_in = args->in[2]; const float* cctx = args->in[6];
    for (int i = C.tid; i < 5 * 1024; i += NTHREADS) { const float v = (i < 4096) ? c_in[i] : cctx[i - 4096]; SC[i] = siluf_(v); }
    for (int i = C.tid; i < 2048; i += NTHREADS) TAB[i] = cospif((float)i * (1.0f / 1024.0f));
    __syncthreads();
    for (int it = C.bid; it < 288 + 128; it += C.G) {
        if (it < 288) {
            const int l = it / 144, j0 = (it % 144) * 64;
            const float* W = args->in[7] + (size_t)l * D * NMOD + j0 + C.lane;
            float a0 = 0.f, a1 = 0.f, a2 = 0.f, a3 = 0.f, a4 = 0.f;
            const int kb = C.wave * 128;
#pragma unroll 8
            for (int k = 0; k < 128; ++k) { const float w = W[(size_t)(kb + k) * NMOD];
                a0 += SC[kb + k] * w; a1 += SC[1024 + kb + k] * w; a2 += SC[2048 + kb + k] * w; a3 += SC[3072 + kb + k] * w; a4 += SC[4096 + kb + k] * w; }
            SCR[(C.wave * 5 + 0) * 64 + C.lane] = a0; SCR[(C.wave * 5 + 1) * 64 + C.lane] = a1; SCR[(C.wave * 5 + 2) * 64 + C.lane] = a2;
            SCR[(C.wave * 5 + 3) * 64 + C.lane] = a3; SCR[(C.wave * 5 + 4) * 64 + C.lane] = a4;
            __syncthreads();
            if (C.tid < 320) { const int c = C.tid >> 6, j = C.tid & 63; float s = args->in[8][(size_t)l * NMOD + j0 + j];
#pragma unroll
                for (int w = 0; w < 8; ++w) s += SCR[(w * 5 + c) * 64 + j];
                ((float*)(C.ws + OFF_MOD))[(size_t)(l * 5 + c) * NMOD + j0 + j] = s; }
            __syncthreads();
        } else {
            const int r = it - 288, l = r >> 6, g = (r >> 4) & 3, n0 = (r & 15) * 64;
            const float* Wf = args->in[30] + (size_t)l * 512 * D + (size_t)(g * 128) * D + n0;
            for (int i = C.tid; i < 128 * 64; i += NTHREADS) SCR[i] = Wf[(size_t)(i >> 6) * D + (i & 63)];
            __syncthreads();
            const int n = C.tid & 63, cw = C.tid >> 6;
            bf16_t* dst = (bf16_t*)wl_ptr(C, l, WL_F2) + (size_t)(n0 + n) * D + g * 128;
            const float s = 0.08838834764831845f;
            for (int j = 0; j < 16; ++j) { const int c = cw + 8 * j; float ac = 0.f, as = 0.f;
#pragma unroll 8
                for (int q = 0; q < 128; ++q) { const int idx = ((q * c) & 127) * 16; const float w = SCR[q * 64 + n];
                    ac += TAB[idx] * w; as += TAB[(idx - 512) & 2047] * w; }
                dst[c] = f2bf(ac * s); dst[512 + c] = f2bf(-as * s); }
            __syncthreads();
        }
    }
    __syncthreads();
    {
        LAS float* scr = SCR + C.wave * (64 * 33);
        const int gw = C.bid * NWAVES + C.wave, NGW = C.G * NWAVES;
        constexpr int I_G = 16 * 88, I_D = 44 * 32, I_IN = 16 * 72, I_BG = 16 * 96, I_A = 8 * 32, I_L = 8 * 32, I_O = 16 * 32;
        constexpr int PER_LAYER = 4 * I_G + 2 * I_D + I_IN + I_BG + I_A + I_L + I_O;
        for (int it = gw; it < 2 * PER_LAYER; it += NGW) {
            const int l = it / PER_LAYER; int r = it % PER_LAYER;
            if (r < I_G) { const int kb = r / 88, n0 = (r % 88) * 32; p0_transpose_item(args->in[11] + (size_t)l * D * DFF, DFF, (bf16_t*)wl_ptr(C, l, WL_GU1), D, 256 * (n0 >> 7) + (n0 & 127), 0, kb * 64, n0, scr, C.lane); continue; } r -= I_G;
            if (r < I_G) { const int kb = r / 88, n0 = (r % 88) * 32; p0_transpose_item(args->in[12] + (size_t)l * D * DFF, DFF, (bf16_t*)wl_ptr(C, l, WL_GU1), D, 256 * (n0 >> 7) + 128 + (n0 & 127), 0, kb * 64, n0, scr, C.lane); continue; } r -= I_G;
            if (r < I_D) { const int kb = r / 32, nb = r % 32; p0_transpose_item(args->in[13] + (size_t)l * DFF * D, D, (bf16_t*)wl_ptr(C, l, WL_D1), DFF, nb * 32, 0, kb * 64, nb * 32, scr, C.lane); continue; } r -= I_D;
            if (r < I_G) { const int kb = r / 88, n0 = (r % 88) * 32; p0_transpose_item(args->in[14] + (size_t)l * D * DFF, DFF, (bf16_t*)wl_ptr(C, l, WL_GU2), D, 256 * (n0 >> 7) + (n0 & 127), 0, kb * 64, n0, scr, C.lane); continue; } r -= I_G;
            if (r < I_G) { const int kb = r / 88, n0 = (r % 88) * 32; p0_transpose_item(args->in[15] + (size_t)l * D * DFF, DFF, (bf16_t*)wl_ptr(C, l, WL_GU2), D, 256 * (n0 >> 7) + 128 + (n0 & 127), 0, kb * 64, n0, scr, C.lane); continue; } r -= I_G;
            if (r < I_D) { const int kb = r / 32, nb = r % 32; p0_transpose_item(args->in[16] + (size_t)l * DFF * D, D, (bf16_t*)wl_ptr(C, l, WL_D2), DFF, nb * 32, 0, kb * 64, nb * 32, scr, C.lane); continue; } r -= I_D;
            if (r < I_IN) { const int kb = r / 72, nb = r % 72; p0_transpose_item(args->in[17] + (size_t)l * D * 2304, 2304, (bf16_t*)wl_ptr(C, l, WL_IN), D, nb * 32, 0, kb * 64, nb * 32, scr, C.lane); continue; } r -= I_IN;
            if (r < I_BG) { const int kb = r / 96, nb = r % 96; p0_transpose_item(args->in[18] + (size_t)l * D * 3072, 3072, (bf16_t*)wl_ptr(C, l, WL_IN), D, 2304 + nb * 32, 0, kb * 64, nb * 32, scr, C.lane); continue; } r -= I_BG;
            if (r < I_A) { const int kb = r / 32, nb = r % 32; p0_transpose_item(args->in[21] + (size_t)l * 512 * D, D, (bf16_t*)wl_ptr(C, l, WL_A), 512, nb * 32, 0, kb * 64, nb * 32, scr, C.lane); continue; } r -= I_A;
            if (r < I_L) { const int kb = r / 32, nb = r % 32;
                p0_transpose_item(args->in[29] + (size_t)l * 512 * D, D, (bf16_t*)wl_ptr(C, l, WL_L2), D, nb * 32, 0, kb * 64, nb * 32, scr, C.lane);
                p0_transpose_item(args->in[29] + (size_t)l * 512 * D, D, (bf16_t*)wl_ptr(C, l, WL_L2), D, nb * 32, 512, kb * 64, nb * 32, scr, C.lane); continue; } r -= I_L;
            { const int kb = r / 32, nb = r % 32; p0_transpose_item(args->in[31] + (size_t)l * D * D, D, (bf16_t*)wl_ptr(C, l, WL_O), D, nb * 32, 0, kb * 64, nb * 32, scr, C.lane); }
        }
    }
    const int gt = C.bid * NTHREADS + C.tid, NGT = C.G * NTHREADS;
    for (int i = gt; i < M * D / 4; i += NGT) { const f32x4 v = (i < MP * D / 4) ? ((const f32x4*)args->in[0])[i] : ((const f32x4*)args->in[1])[i - MP * D / 4]; ((f32x4*)C.out)[i] = v; }
    for (int i = gt; i < 4096 * 256; i += NGT) { const int pr = i >> 8, t0 = (i & 255) * 8, p = pr & 2047, sh = (pr >= 2048) ? 512 : 0; const float s = 0.022097086912079608f;
        float v[8];
#pragma unroll
        for (int j = 0; j < 8; ++j) v[j] = TAB[((p * (t0 + j)) - sh) & 2047] * s;
        u32x4 o; o.x = cvt_pk_bf16(v[0], v[1]); o.y = cvt_pk_bf16(v[2], v[3]); o.z = cvt_pk_bf16(v[4], v[5]); o.w = cvt_pk_bf16(v[6], v[7]);
        *(u32x4*)((bf16_t*)(C.ws + WS_DFTL) + (size_t)pr * 2048 + t0) = o; }
    for (int i = gt; i < 512 * 32; i += NGT) { const int pr = i >> 5, t0 = (i & 31) * 8, p = pr & 255, sh = (pr >= 256) ? 512 : 0; const float s = 0.0625f;
        float v[8];
#pragma unroll
        for (int j = 0; j < 8; ++j) v[j] = TAB[((p * (t0 + j) * 8) - sh) & 2047] * s;
        u32x4 o; o.x = cvt_pk_bf16(v[0], v[1]); o.y = cvt_pk_bf16(v[2], v[3]); o.z = cvt_pk_bf16(v[4], v[5]); o.w = cvt_pk_bf16(v[6], v[7]);
        *(u32x4*)((bf16_t*)(C.ws + WS_DFTC) + (size_t)pr * 256 + t0) = o; }
    for (int i = gt; i < 1024; i += NGT) { const int pos = i >> 4, f = i & 15; const float inv = exp2f(-(float)f * (13.287712379549449f / 16.0f)); const float ang = (float)pos * inv; const float af = (float)((double)ang * 0.3183098861837907);
        ((float*)(C.ws + OFF_ROPE))[i] = cospif(af); ((float*)(C.ws + OFF_ROPE))[1024 + i] = sinpif(af); }
    for (int i = gt; i < 4 * 2 * 256 * 128; i += NGT) { ((bf16_t*)(C.ws + OFF_CK))[i] = f2bf(args->in[3][i]);
        const int d = i & 63, kvh = (i >> 6) & 1, t = (i >> 7) & 255, bl = i >> 15;
        ((bf16_t*)(C.ws + OFF_CVT))[((size_t)(bl * 2 + kvh) * 64 + d) * 256 + t] = f2bf(args->in[4][i]); }
}

__device__ __forceinline__ void modnorm_phase(ArgsP args, const Ctx& C, int l, int sub) {
    const int gw = C.bid * NWAVES + C.wave, NGW = C.G * NWAVES;
    const float* nw = args->in[9] + (size_t)(l * 3 + sub) * D;
    bf16_t* XN = (bf16_t*)act_ptr(C, A_XN);
    for (int r = gw; r < M; r += NGW) {
        const int c = cond_of_row(r);
        const float* sh = mod_ptr(C, l, c, sub, 0); const float* sc = mod_ptr(C, l, c, sub, 1);
        const f32x4* xr = (const f32x4*)(C.out + (size_t)r * D) + C.lane;
        f32x4 v[4]; float s = 0.f;
#pragma unroll
        for (int j = 0; j < 4; ++j) { v[j] = xr[64 * j]; s += (v[j].x * v[j].x + v[j].y * v[j].y) + (v[j].z * v[j].z + v[j].w * v[j].w); }
        const float rstd = rsqrtf(wave_sum(s) * (1.0f / D) + EPS);
        u32x2* o = (u32x2*)(XN + (size_t)r * D) + C.lane;
#pragma unroll
        for (int j = 0; j < 4; ++j) { const int col = 4 * C.lane + 256 * j; const f32x4 w = *(const f32x4*)(nw + col), a = *(const f32x4*)(sc + col), b = *(const f32x4*)(sh + col);
            f32x4 y = v[j] * rstd * w * (a + 1.0f) + b; u32x2 p; p.x = cvt_pk_bf16(y.x, y.y); p.y = cvt_pk_bf16(y.z, y.w); o[64 * j] = p; }
    }
}
__device__ __forceinline__ void finalnorm_phase(ArgsP args, const Ctx& C) {
    const int gw = C.bid * NWAVES + C.wave, NGW = C.G * NWAVES;
    const float* nw = args->in[10];
    for (int r = gw; r < M; r += NGW) {
        f32x4* xr = (f32x4*)(C.out + (size_t)r * D) + C.lane;
        f32x4 v[4]; float s = 0.f;
#pragma unroll
        for (int j = 0; j < 4; ++j) { v[j] = xr[64 * j]; s += (v[j].x * v[j].x + v[j].y * v[j].y) + (v[j].z * v[j].z + v[j].w * v[j].w); }
        const float rstd = rsqrtf(wave_sum(s) * (1.0f / D) + EPS);
#pragma unroll
        for (int j = 0; j < 4; ++j) { const f32x4 w = *(const f32x4*)(nw + 4 * C.lane + 256 * j); xr[64 * j] = v[j] * rstd * w; }
    }
}

struct Unit { int pm, pn, z; const bf16_t* A; const bf16_t* B; };

struct StaticOrder {
    int nM, nN, nwg, G, c; const bf16_t* A; const bf16_t* B; int lda, ldb;
    __device__ void init(int Mr, int N, int G_, int c_, const bf16_t* A_, int lda_, const bf16_t* B_, int ldb_) { nM = Mr / 256; nN = N / 256; nwg = nM * nN; G = G_; c = c_; A = A_; B = B_; lda = lda_; ldb = ldb_; }
    __device__ bool next(int i, Unit& u) const {
        const long L = (long)i * G + c; if (L >= nwg) return false;
        int wgid = (int)L; { const int q = nwg / 8, r = nwg % 8, xcd = wgid % 8, off = wgid / 8; wgid = (xcd < r ? xcd * (q + 1) : r * (q + 1) + (xcd - r) * q) + off; }
        const int nig = 8 * nN, gid = wgid / nig, fm = gid * 8, gsz = (nM - fm) < 8 ? (nM - fm) : 8;
        u.pm = fm + ((wgid % nig) % gsz); u.pn = (wgid % nig) / gsz; u.z = 0;
        u.A = A + (size_t)u.pm * 256 * lda; u.B = B + (size_t)u.pn * 256 * ldb; return true;
    }
};
struct DftOrder {
    int nseq, nPm, L, G, c; const bf16_t* A; const bf16_t* XFT;
    __device__ bool next(int i, Unit& u) const {
        const int idx = i * G + c; if (idx >= nseq * nPm * 2) return false;
        u.z = idx / (nPm * 2); const int r = idx % (nPm * 2); u.pm = r >> 1; u.pn = r & 1;
        u.A = A + (size_t)u.pm * 256 * L; u.B = XFT + ((size_t)u.z * 512 + u.pn * 256) * L; return true;
    }
};

template <class Epi, class Sched>
__device__ __forceinline__ void gemm_simple(const Ctx& C, const Sched& S, const Epi& E, int lda, int ldb, int K) {
    const int wr = C.wave >> 2, wc = C.wave & 3, fr = C.lane & 15, fq = C.lane >> 4;
    Unit u;
    for (int ui = 0; S.next(ui, u); ++ui) {
        f32x4 acc[2][2][4][2];
#pragma unroll
        for (int a = 0; a < 2; ++a)
#pragma unroll
            for (int b = 0; b < 2; ++b)
#pragma unroll
                for (int m = 0; m < 4; ++m)
#pragma unroll
                    for (int n = 0; n < 2; ++n) acc[a][b][m][n] = (f32x4){0.f, 0.f, 0.f, 0.f};
        const bf16_t* pa = u.A + (size_t)(wr * 64 + fr) * lda + fq * 8;
        const bf16_t* pb = u.B + (size_t)(wc * 32 + fr) * ldb + fq * 8;
        for (int k0 = 0; k0 < K; k0 += 32) {
            bf16x8 At[2][4], Bt[2][2];
#pragma unroll
            for (int a = 0; a < 2; ++a)
#pragma unroll
                for (int m = 0; m < 4; ++m) At[a][m] = *(const bf16x8*)(pa + (size_t)(a * 128 + m * 16) * lda + k0);
#pragma unroll
            for (int b = 0; b < 2; ++b)
#pragma unroll
                for (int n = 0; n < 2; ++n) Bt[b][n] = *(const bf16x8*)(pb + (size_t)(b * 128 + n * 16) * ldb + k0);
#pragma unroll
            for (int a = 0; a < 2; ++a)
#pragma unroll
                for (int b = 0; b < 2; ++b)
#pragma unroll
                    for (int m = 0; m < 4; ++m)
#pragma unroll
                        for (int n = 0; n < 2; ++n) acc[a][b][m][n] = __builtin_amdgcn_mfma_f32_16x16x32_bf16(Bt[b][n], At[a][m], acc[a][b][m][n], 0, 0, 0);
        }
        E(acc, u, wr, wc, fr, fq);
    }
}

namespace pg8 {
#define PG8_LAS __attribute__((address_space(3)))
constexpr int BM = 256, BK = 64, HALF = 128, HTB = HALF * BK * 2  , STAGE_BYTES = 8 * HTB, NXCD = 8, WGM = 8;

__host__ __device__ __forceinline__ int lds_byte(int r, int c) { const int st = (r >> 4) * 2 + (c >> 5), rr = r & 15, cc = c & 31, ob = rr * 64 + cc * 2; return st * 1024 + (ob ^ (((ob >> 9) & 1) << 5)); }
__host__ __device__ __forceinline__ void stage_rc(int b, int& R, int& C) { const int st = b / 1024, sb = b % 1024, swz = sb ^ (((sb >> 9) & 1) << 5); R = (st >> 1) * 16 + swz / 64; C = (st & 1) * 32 + (swz % 64) / 2; }
__host__ __device__ __forceinline__ int perm32(int rho) { const int n = rho >> 4, i = rho & 15; return 8 * (i >> 2) + 4 * n + (i & 3); }
template <class Epi, class Sched, bool ALIGN_EPI = true, bool SP2 = true>
__device__ __forceinline__ void gemm_phase(PG8_LAS unsigned char* lds, const int tid, const Sched& S, const Epi& E, const int lda, const int ldb, const int K) {
    const int wid = __builtin_amdgcn_readfirstlane(tid >> 6), lane = tid & 63, wr = wid >> 2, wc = wid & 3, fr = lane & 15, fq = lane >> 4;
    const int nt = K / BK;
    unsigned voffA[2], voffB[2];
#pragma unroll
    for (int i = 0; i < 2; ++i) { int R, C; stage_rc(tid * 16 + i * 8192, R, C); const int Rb = Epi::PERM ? ((R & ~31) + perm32(R & 31)) : R;
        voffA[i] = (unsigned)(R * lda + C) * 2u; voffB[i] = (unsigned)(Rb * ldb + C) * 2u; }
    const size_t kstep = (size_t)(BK * 2);
    const size_t hstepA = (size_t)HALF * lda * 2, hstepB = (size_t)HALF * ldb * 2;
    const unsigned ldsw = (unsigned)wid * 1024u;
    const int aoff = lds_byte(wr * 64 + fr, fq * 8), boff = lds_byte(wc * 32 + fr, fq * 8);
#define PG8_SA(b, h) (((b) * 2 + (h)) * HTB)
#define PG8_SB(b, h) ((4 + (b) * 2 + (h)) * HTB)
#define PG8_STAGE(bufoff, gbase, voff) do { _Pragma("unroll") for (int _i = 0; _i < 2; ++_i) \
        __builtin_amdgcn_global_load_lds((const unsigned*)((const char*)(gbase) + (voff)[_i]), (PG8_LAS unsigned*)(lds + (bufoff) + ldsw + _i * 8192), 16, 0, 0); } while (0)
#define PG8_LDA(dst, b, h) do { _Pragma("unroll") for (int m = 0; m < 4; ++m) _Pragma("unroll") for (int k = 0; k < 2; ++k) dst[m][k] = *(const PG8_LAS bf16x8*)(lds + PG8_SA(b, h) + aoff + m * 2048 + k * 1024); } while (0)
#define PG8_LDB(dst, b, h) do { _Pragma("unroll") for (int n = 0; n < 2; ++n) _Pragma("unroll") for (int k = 0; k < 2; ++k) dst[n][k] = *(const PG8_LAS bf16x8*)(lds + PG8_SB(b, h) + boff + n * 2048 + k * 1024); } while (0)
#define PG8_MMA(ai, bj, At, Bt) do { __builtin_amdgcn_s_setprio(1); _Pragma("unroll") for (int m = 0; m < 4; ++m) _Pragma("unroll") for (int n = 0; n < 2; ++n) _Pragma("unroll") for (int k = 0; k < 2; ++k) \
        acc[ai][bj][m][n] = __builtin_amdgcn_mfma_f32_16x16x32_bf16(Bt[n][k], At[m][k], acc[ai][bj][m][n], 0, 0, 0); __builtin_amdgcn_s_setprio(0); } while (0)
#define PG8_WAIT_V(n) asm volatile("s_waitcnt vmcnt(" #n ")" ::: "memory")
#define PG8_WAIT_L(n) asm volatile("s_waitcnt lgkmcnt(" #n ")" ::: "memory")
#define PG8_BAR __builtin_amdgcn_s_barrier()
#define PG8_SCHED __builtin_amdgcn_sched_barrier(0)
    Unit cur, nxt; int ui = 0;
    if (!S.next(0, cur)) return;
    f32x4 acc[2][2][4][2];
#pragma unroll
    for (int a = 0; a < 2; ++a)
#pragma unroll
        for (int b = 0; b < 2; ++b)
#pragma unroll
            for (int m = 0; m < 4; ++m)
#pragma unroll
                for (int n = 0; n < 2; ++n) acc[a][b][m][n] = (f32x4){0.f, 0.f, 0.f, 0.f};
    bf16x8 At[4][2], B0[2][2], B1[2][2];
    const char* cA = (const char*)cur.A; const char* cB = (const char*)cur.B;
    if constexpr (SP2) {
        PG8_STAGE(PG8_SB(0, 0), cB, voffB); PG8_STAGE(PG8_SB(0, 1), cB + hstepB, voffB); PG8_STAGE(PG8_SA(0, 0), cA, voffA); PG8_STAGE(PG8_SA(0, 1), cA + hstepA, voffA);
        if (wr == 1) PG8_BAR;
        PG8_WAIT_V(2); PG8_BAR;
        PG8_STAGE(PG8_SB(1, 0), cB + kstep, voffB); PG8_STAGE(PG8_SA(1, 0), cA + kstep, voffA); PG8_STAGE(PG8_SB(1, 1), cB + hstepB + kstep, voffB);
        PG8_WAIT_V(6); PG8_BAR;
    } else {
        PG8_STAGE(PG8_SB(0, 0), cB, voffB); PG8_STAGE(PG8_SA(0, 0), cA, voffA); PG8_STAGE(PG8_SB(0, 1), cB + hstepB, voffB); PG8_STAGE(PG8_SA(0, 1), cA + hstepA, voffA);
        if (wr == 1) PG8_BAR;
        PG8_WAIT_V(4); PG8_BAR;
        PG8_STAGE(PG8_SB(1, 0), cB + kstep, voffB); PG8_STAGE(PG8_SA(1, 0), cA + kstep, voffA); PG8_STAGE(PG8_SB(1, 1), cB + hstepB + kstep, voffB);
        PG8_WAIT_V(6); PG8_BAR;
    }
    for (;;) {
        const bool has_next = S.next(ui + 1, nxt);
        const char* nA = has_next ? (const char*)nxt.A : cA; const char* nB = has_next ? (const char*)nxt.B : cB;
        for (int t = 0; t < nt; t += 2) {
            const bool last = (t == nt - 2);
            const char* a1 = cA + (size_t)(t + 1) * kstep;
            const char* a2 = last ? nA : cA + (size_t)(t + 2) * kstep; const char* b2 = last ? nB : cB + (size_t)(t + 2) * kstep;
            const char* a3 = a2 + kstep; const char* b3 = b2 + kstep;
            if constexpr (SP2) {
            PG8_LDB(B0, 0, 0); PG8_LDB(B1, 0, 1); PG8_SCHED; PG8_LDA(At, 0, 0); PG8_STAGE(PG8_SA(1, 1), a1 + hstepA, voffA);
            PG8_WAIT_V(8); PG8_WAIT_L(0); PG8_BAR; PG8_MMA(0, 0, At, B0); PG8_MMA(0, 1, At, B1); PG8_BAR; PG8_SCHED;
            PG8_LDA(At, 0, 1); PG8_STAGE(PG8_SB(0, 0), b2, voffB); PG8_STAGE(PG8_SB(0, 1), b2 + hstepB, voffB); PG8_STAGE(PG8_SA(0, 0), a2, voffA);
            PG8_WAIT_V(8); PG8_WAIT_L(0); PG8_BAR; PG8_MMA(1, 0, At, B0); PG8_MMA(1, 1, At, B1); PG8_BAR; PG8_SCHED;
            PG8_LDB(B0, 1, 0); PG8_LDB(B1, 1, 1); PG8_SCHED; PG8_LDA(At, 1, 0); PG8_STAGE(PG8_SA(0, 1), a2 + hstepA, voffA);
            PG8_WAIT_V(8); PG8_WAIT_L(0); PG8_BAR; PG8_MMA(0, 0, At, B0); PG8_MMA(0, 1, At, B1); PG8_BAR; PG8_SCHED;
            PG8_LDA(At, 1, 1); PG8_STAGE(PG8_SB(1, 0), b3, voffB); PG8_STAGE(PG8_SB(1, 1), b3 + hstepB, voffB); PG8_STAGE(PG8_SA(1, 0), a3, voffA);
            PG8_WAIT_V(8); PG8_WAIT_L(0); PG8_BAR; PG8_MMA(1, 0, At, B0); PG8_MMA(1, 1, At, B1); PG8_BAR; PG8_SCHED;
            } else {
            PG8_LDB(B0, 0, 0); PG8_SCHED; PG8_LDA(At, 0, 0); PG8_STAGE(PG8_SA(1, 1), a1 + hstepA, voffA);
            PG8_WAIT_L(8); PG8_BAR; PG8_WAIT_L(0); PG8_MMA(0, 0, At, B0); PG8_BAR; PG8_SCHED;
            PG8_LDB(B1, 0, 1); PG8_STAGE(PG8_SB(0, 0), b2, voffB);
            PG8_BAR; PG8_WAIT_L(0); PG8_MMA(0, 1, At, B1); PG8_BAR;
            PG8_LDA(At, 0, 1); PG8_STAGE(PG8_SA(0, 0), a2, voffA);
            PG8_BAR; PG8_WAIT_L(0); PG8_MMA(1, 0, At, B0); PG8_BAR; PG8_SCHED;
            PG8_STAGE(PG8_SB(0, 1), b2 + hstepB, voffB);
            PG8_WAIT_V(6); PG8_BAR; PG8_MMA(1, 1, At, B1); PG8_BAR;
            PG8_LDB(B0, 1, 0); PG8_SCHED; PG8_LDA(At, 1, 0); PG8_STAGE(PG8_SA(0, 1), a2 + hstepA, voffA);
            PG8_WAIT_L(8); PG8_BAR; PG8_WAIT_L(0); PG8_MMA(0, 0, At, B0); PG8_BAR; PG8_SCHED;
            PG8_LDB(B1, 1, 1); PG8_STAGE(PG8_SB(1, 0), b3, voffB);
            PG8_BAR; PG8_WAIT_L(0); PG8_MMA(0, 1, At, B1); PG8_BAR;
            PG8_LDA(At, 1, 1); PG8_STAGE(PG8_SA(1, 0), a3, voffA);
            PG8_BAR; PG8_WAIT_L(0); PG8_MMA(1, 0, At, B0); PG8_BAR; PG8_SCHED;
            PG8_STAGE(PG8_SB(1, 1), b3 + hstepB, voffB);
            PG8_WAIT_V(6); PG8_BAR; PG8_MMA(1, 1, At, B1); PG8_BAR;
            }
        }
        if constexpr (ALIGN_EPI) { if (wr == 0) PG8_BAR; }
        if constexpr (!Epi::AFTER_DRAIN) { E(acc, cur, wr, wc, fr, fq); }
        if (!has_next) break;
#pragma unroll
        for (int a = 0; a < 2; ++a)
#pragma unroll
            for (int b = 0; b < 2; ++b)
#pragma unroll
                for (int m = 0; m < 4; ++m)
#pragma unroll
                    for (int n = 0; n < 2; ++n) acc[a][b][m][n] = (f32x4){0.f, 0.f, 0.f, 0.f};
        cur = nxt; cA = nA; cB = nB; ++ui;
        if constexpr (ALIGN_EPI) { if (wr == 1) PG8_BAR; }
    }
    PG8_WAIT_V(0);
    if constexpr (!ALIGN_EPI) { if (wr == 0) PG8_BAR; }
    PG8_BAR;
    if constexpr (Epi::AFTER_DRAIN) { E.fused(acc, cur, wr, wc, fr, fq, lds, wid, lane); }
#undef PG8_SA
#undef PG8_SB
#undef PG8_STAGE
#undef PG8_LDA
#undef PG8_LDB
#undef PG8_MMA
#undef PG8_WAIT_V
#undef PG8_WAIT_L
#undef PG8_BAR
#undef PG8_SCHED
}
}

#ifndef USE_PG8
#define USE_PG8 1
#endif
#if USE_PG8
#define GEMM(C, S, E, lda, ldb, K) pg8::gemm_phase(C.lds, C.tid, S, E, lda, ldb, K)
#else
#define GEMM(C, S, E, lda, ldb, K) GEMM(C, S, E, lda, ldb, K)
#endif

#define EPI_LOOP_AM for (int ai = 0; ai < 2; ++ai) _Pragma("unroll") for (int m = 0; m < 4; ++m)
struct EpiGU {
    static constexpr bool PERM = false, AFTER_DRAIN = false;
    bf16_t* H;
    __device__ __forceinline__ void operator()(const f32x4 (&acc)[2][2][4][2], const Unit& u, int wr, int wc, int fr, int fq) const {
#pragma unroll
        EPI_LOOP_AM { const int row = u.pm * 256 + ai * 128 + wr * 64 + m * 16 + fr;
#pragma unroll
            for (int n = 0; n < 2; ++n) { const f32x4 g = acc[ai][0][m][n], up = acc[ai][1][m][n];
                u32x2 p; p.x = cvt_pk_bf16(siluf_(g.x) * up.x, siluf_(g.y) * up.y); p.y = cvt_pk_bf16(siluf_(g.z) * up.z, siluf_(g.w) * up.w);
                *(u32x2*)(H + (size_t)row * DFF + u.pn * 128 + wc * 32 + n * 16 + fq * 4) = p; } }
    }
};
struct EpiRes {
    static constexpr bool PERM = false, AFTER_DRAIN = false;
    float* X; const float* modbase; int l, sub; float coef;
    __device__ __forceinline__ void operator()(const f32x4 (&acc)[2][2][4][2], const Unit& u, int wr, int wc, int fr, int fq) const {
        const int c = cond_of_row(u.pm * 256);
        const float* gate = modbase + ((size_t)(l * 5 + c) * NMOD + (sub * 3 + 2) * D) + u.pn * 256 + wc * 32 + fq * 4;
        f32x4 g[2][2];
#pragma unroll
        for (int bj = 0; bj < 2; ++bj)
#pragma unroll
            for (int n = 0; n < 2; ++n) g[bj][n] = *(const f32x4*)(gate + bj * 128 + n * 16) * coef;
#pragma unroll
        EPI_LOOP_AM { float* xrow = X + (size_t)(u.pm * 256 + ai * 128 + wr * 64 + m * 16 + fr) * D + u.pn * 256 + wc * 32 + fq * 4;
#pragma unroll
            for (int bj = 0; bj < 2; ++bj)
#pragma unroll
                for (int n = 0; n < 2; ++n) { f32x4* p = (f32x4*)(xrow + bj * 128 + n * 16); *p = *p + g[bj][n] * acc[ai][bj][m][n]; }
            asm volatile("" ::: "memory"); }
    }
};
struct EpiIn {
    static constexpr bool PERM = false, AFTER_DRAIN = false;
    bf16_t *Q, *Kb, *VT, *GY, *XFT, *G; float* XR; float* out; const float* rope; const float* bgate; int l;
    __device__ __forceinline__ void operator()(const f32x4 (&acc)[2][2][4][2], const Unit& u, int wr, int wc, int fr, int fq) const {
        const int row0 = u.pm * 256 + wr * 64 + fr; const bool latent = u.pm >= 16;
        if (u.pn <= 2) {
#pragma unroll
            for (int bj = 0; bj < 2; ++bj) {
                if (u.pn == 2 && bj == 1) {
#pragma unroll
                    EPI_LOOP_AM { const int row = row0 + ai * 128 + m * 16; int seqoff, L, t;
                        if (latent) { const int b = (row - MP) >> 11; t = (row - MP) & 2047; L = LS; seqoff = 16 * 128 * LC + b * 128 * LS; } else { const int b = row >> 8; t = row & 255; L = LC; seqoff = b * 128 * LC; }
#pragma unroll
                        for (int n = 0; n < 2; ++n) { const f32x4 v = acc[ai][1][m][n]; const int d128 = wc * 32 + n * 16 + fq * 4;
                            bf16_t* p = VT + seqoff + (size_t)d128 * L + t; p[0] = f2bf(v.x); p[L] = f2bf(v.y); p[2 * L] = f2bf(v.z); p[3 * L] = f2bf(v.w);
                            if (!latent) *(f32x4*)(out + OUT_CV + ((size_t)((row >> 8) * 2 + l) * 256 + t) * 128 + d128) = v; } }
                } else {
                    const bool isk = (u.pn == 2); const int axis = wc & 1;
#pragma unroll
                    EPI_LOOP_AM { const int row = row0 + ai * 128 + m * 16; f32x4 x1 = acc[ai][bj][m][0], x2 = acc[ai][bj][m][1];
                        if (isk && !latent) { float* o = out + OUT_CK + ((size_t)((row >> 8) * 2 + l) * 256 + (row & 255)) * 128 + wc * 32 + fq * 4; *(f32x4*)o = x1; *(f32x4*)(o + 16) = x2; }
                        if (latent) { const int t = (row - MP) & 2047, pos = axis ? (t & 63) : (t >> 6);
                            const f32x4 cs = *(const f32x4*)(rope + pos * 16 + fq * 4), sn = *(const f32x4*)(rope + 1024 + pos * 16 + fq * 4);
                            const f32x4 o1 = x1 * cs - x2 * sn, o2 = x1 * sn + x2 * cs; x1 = o1; x2 = o2; }
                        if (!isk) { x1 = x1 * QSCALE; x2 = x2 * QSCALE; }
                        bf16_t* o = isk ? (Kb + (size_t)row * 128 + wc * 32 + fq * 4) : (Q + (size_t)row * 512 + u.pn * 256 + bj * 128 + wc * 32 + fq * 4);
                        u32x2 p; p.x = cvt_pk_bf16(x1.x, x1.y); p.y = cvt_pk_bf16(x1.z, x1.w); *(u32x2*)o = p;
                        p.x = cvt_pk_bf16(x2.x, x2.y); p.y = cvt_pk_bf16(x2.z, x2.w); *(u32x2*)(o + 16) = p; }
                }
            }
        } else if (u.pn <= 4) {
#pragma unroll
            EPI_LOOP_AM { const int row = row0 + ai * 128 + m * 16;
#pragma unroll
                for (int bj = 0; bj < 2; ++bj)
#pragma unroll
                    for (int n = 0; n < 2; ++n) *(f32x4*)(XR + (size_t)row * 512 + (u.pn - 3) * 256 + bj * 128 + wc * 32 + n * 16 + fq * 4) = acc[ai][bj][m][n]; }
        } else if (u.pn <= 6) {
#pragma unroll
            EPI_LOOP_AM { const int row = row0 + ai * 128 + m * 16;
#pragma unroll
                for (int bj = 0; bj < 2; ++bj)
#pragma unroll
                    for (int n = 0; n < 2; ++n) { const f32x4 v = acc[ai][bj][m][n]; u32x2 p; p.x = cvt_pk_bf16(gelu_tanh(v.x), gelu_tanh(v.y)); p.y = cvt_pk_bf16(gelu_tanh(v.z), gelu_tanh(v.w));
                        *(u32x2*)(GY + (size_t)row * 512 + (u.pn - 5) * 256 + bj * 128 + wc * 32 + n * 16 + fq * 4) = p; } }
        } else if (u.pn <= 8) {
#pragma unroll
            EPI_LOOP_AM { const int row = row0 + ai * 128 + m * 16; size_t seqoff; int L, t;
                if (latent) { const int b = (row - MP) >> 11; t = (row - MP) & 2047; L = LS; seqoff = (size_t)16 * 512 * LC + (size_t)b * 512 * LS; } else { const int b = row >> 8; t = row & 255; L = LC; seqoff = (size_t)b * 512 * LC; }
#pragma unroll
                for (int bj = 0; bj < 2; ++bj)
#pragma unroll
                    for (int n = 0; n < 2; ++n) { const f32x4 v = acc[ai][bj][m][n]; bf16_t* p = XFT + seqoff + (size_t)((u.pn - 7) * 256 + bj * 128 + wc * 32 + n * 16 + fq * 4) * L + t;
                        p[0] = f2bf(v.x); p[L] = f2bf(v.y); p[2 * L] = f2bf(v.z); p[3 * L] = f2bf(v.w); } }
        } else {
#pragma unroll
            for (int bj = 0; bj < 2; ++bj)
#pragma unroll
                for (int n = 0; n < 2; ++n) { const int col = (u.pn - 9) * 256 + bj * 128 + wc * 32 + n * 16 + fq * 4; const f32x4 b = *(const f32x4*)(bgate + col);
#pragma unroll
                    EPI_LOOP_AM { const int row = row0 + ai * 128 + m * 16; const f32x4 v = acc[ai][bj][m][n] + b;
                        u32x2 p; p.x = cvt_pk_bf16(sigmoidf_(v.x), sigmoidf_(v.y)); p.y = cvt_pk_bf16(sigmoidf_(v.z), sigmoidf_(v.w)); *(u32x2*)(G + (size_t)row * 3072 + col) = p; } }
        }
    }
};
template <int MODE> struct EpiBranch {
    static constexpr bool PERM = false, AFTER_DRAIN = false;
    bf16_t* MG; const bf16_t* G; int br;
    __device__ __forceinline__ void operator()(const f32x4 (&acc)[2][2][4][2], const Unit& u, int wr, int wc, int fr, int fq) const {
#pragma unroll
        EPI_LOOP_AM { const int row = u.pm * 256 + ai * 128 + wr * 64 + m * 16 + fr;
#pragma unroll
            for (int bj = 0; bj < 2; ++bj)
#pragma unroll
                for (int n = 0; n < 2; ++n) { const int col = u.pn * 256 + bj * 128 + wc * 32 + n * 16 + fq * 4;
                    const u32x2 g = *(const u32x2*)(G + (size_t)row * 3072 + br * 1024 + col); f32x4 v = acc[ai][bj][m][n];
                    v.x *= bflo(g.x); v.y *= bfhi(g.x); v.z *= bflo(g.y); v.w *= bfhi(g.y);
                    u32x2* p = (u32x2*)(MG + (size_t)row * D + col);
                    if (MODE == 1) { const u32x2 o = *p; v.x += bflo(o.x); v.y += bfhi(o.x); v.z += bflo(o.y); v.w += bfhi(o.y); }
                    u32x2 w; w.x = cvt_pk_bf16(v.x, v.y); w.y = cvt_pk_bf16(v.z, v.w); *p = w; }
            asm volatile("" ::: "memory"); }
    }
};
struct EpiDft {
    static constexpr bool PERM = false, AFTER_DRAIN = false;
    bf16_t* Z; int L, rowbase0;
    __device__ __forceinline__ void operator()(const f32x4 (&acc)[2][2][4][2], const Unit& u, int wr, int wc, int fr, int fq) const {
        const int pp = u.pm * 256, soff = (pp >= L) ? 512 : 0, p0 = (pp >= L) ? pp - L : pp;
#pragma unroll
        EPI_LOOP_AM { const int row = rowbase0 + u.z * L + p0 + ai * 128 + wr * 64 + m * 16 + fr;
#pragma unroll
            for (int bj = 0; bj < 2; ++bj)
#pragma unroll
                for (int n = 0; n < 2; ++n) { const f32x4 v = acc[ai][bj][m][n]; u32x2 w; w.x = cvt_pk_bf16(v.x, v.y); w.y = cvt_pk_bf16(v.z, v.w);
                    *(u32x2*)(Z + (size_t)row * D + soff + u.pn * 256 + bj * 128 + wc * 32 + n * 16 + fq * 4) = w; } }
    }
};

__device__ __forceinline__ void attn_naive_phase(ArgsP args, const Ctx& C, int l) {
    bf16_t* Q = (bf16_t*)act_ptr(C, A_Q); const bf16_t* Kb = (const bf16_t*)act_ptr(C, A_K); const bf16_t* VT = (const bf16_t*)act_ptr(C, A_VT);
    const bf16_t* CK = (const bf16_t*)(C.ws + OFF_CK); const bf16_t* CVT = (const bf16_t*)(C.ws + OFF_CVT);
    const int gw = C.bid * NWAVES + C.wave, NGW = C.G * NWAVES;
    for (int it = gw; it < (M / 64) * 8; it += NGW) {
        const int h = it & 7, row = (it >> 3) * 64 + C.lane, kvh = h >> 2;
        float q[64], o[64];
        { const u32x4* qp = (const u32x4*)(Q + (size_t)row * 512 + h * 64);
#pragma unroll
          for (int j = 0; j < 8; ++j) { const u32x4 w = qp[j]; q[8 * j] = bflo(w.x); q[8 * j + 1] = bfhi(w.x); q[8 * j + 2] = bflo(w.y); q[8 * j + 3] = bfhi(w.y); q[8 * j + 4] = bflo(w.z); q[8 * j + 5] = bfhi(w.z); q[8 * j + 6] = bflo(w.w); q[8 * j + 7] = bfhi(w.w); } }
#pragma unroll
        for (int d = 0; d < 64; ++d) o[d] = 0.f;
        float mx = args->in[20][l * 8 + h] * LOG2E, lsum = 1.0f;
        const bool latent = row >= MP;
        const int b = latent ? ((row - MP) >> 11) : (row >> 8), t = latent ? ((row - MP) & 2047) : (row & 255);
        for (int seg = 0; seg < (latent ? 2 : 1); ++seg) {
            const int nk = (seg == 1 || !latent) ? 256 : 257;
            for (int jj = 0; jj < nk; ++jj) {
                int j; bool ok = true; const bf16_t* kp; const bf16_t* vp; int L;
                if (seg == 1) { j = jj; kp = CK + ((size_t)(b * 2 + l) * 256 + j) * 128 + kvh * 64; vp = CVT + ((size_t)((b * 2 + l) * 2 + kvh) * 64) * 256 + j; L = 256; }
                else if (!latent) { j = jj; kp = Kb + ((size_t)(b * 256 + j)) * 128 + kvh * 64; vp = VT + (size_t)b * 128 * LC + (size_t)(kvh * 64) * LC + j; L = LC; }
                else { j = t - 128 + jj; ok = (j >= 0 && j < LS); const int jc = ok ? j : t; kp = Kb + ((size_t)(MP + b * LS + jc)) * 128 + kvh * 64; vp = VT + (size_t)16 * 128 * LC + (size_t)b * 128 * LS + (size_t)(kvh * 64) * LS + jc; L = LS; }
                float s = 0.f;
#pragma unroll
                for (int jq = 0; jq < 8; ++jq) { const u32x4 w = ((const u32x4*)kp)[jq];
                    s += q[8 * jq] * bflo(w.x) + q[8 * jq + 1] * bfhi(w.x) + q[8 * jq + 2] * bflo(w.y) + q[8 * jq + 3] * bfhi(w.y) + q[8 * jq + 4] * bflo(w.z) + q[8 * jq + 5] * bfhi(w.z) + q[8 * jq + 6] * bflo(w.w) + q[8 * jq + 7] * bfhi(w.w); }
                if (!ok) s = -1e30f;
                const float mn = fmaxf(mx, s), alpha = exp2f(mx - mn), p = exp2f(s - mn);
                lsum = lsum * alpha + p; mx = mn;
#pragma unroll
                for (int d = 0; d < 64; ++d) o[d] = o[d] * alpha + p * bf2f(vp[(size_t)d * L]);
            }
        }
        const float inv = 1.0f / lsum;
        u32x4* op = (u32x4*)(Q + (size_t)row * 512 + h * 64);
#pragma unroll
        for (int j = 0; j < 8; ++j) { u32x4 w; w.x = cvt_pk_bf16(o[8 * j] * inv, o[8 * j + 1] * inv); w.y = cvt_pk_bf16(o[8 * j + 2] * inv, o[8 * j + 3] * inv); w.z = cvt_pk_bf16(o[8 * j + 4] * inv, o[8 * j + 5] * inv); w.w = cvt_pk_bf16(o[8 * j + 6] * inv, o[8 * j + 7] * inv); op[j] = w; }
    }
}

__device__ __forceinline__ void lru_naive_phase(ArgsP args, const Ctx& C, int l) {
    const float* XR = (const float*)act_ptr(C, A_XR); const bf16_t* GY = (const bf16_t*)act_ptr(C, A_GY); bf16_t* REC = (bf16_t*)act_ptr(C, A_XN);
    const int gw = C.bid * NWAVES + C.wave, NGW = C.G * NWAVES;
    for (int it = gw; it < 20 * 8 * 2; it += NGW) {
        const int dir = it & 1, nb = (it >> 1) & 7, sq = it >> 4;
        const bool latent = sq < 4; const int b = latent ? sq : sq - 4, L = latent ? LS : LC, rowbase = latent ? MP + b * LS : b * LC;
        const int ch = nb * 64 + C.lane;
        float wa[64], wi[64];
        { const float* pa = args->in[24] + ((size_t)((l * 2 + dir) * 8 + nb) * 64) * 64 + C.lane; const float* pi = args->in[26] + ((size_t)((l * 2 + dir) * 8 + nb) * 64) * 64 + C.lane;
#pragma unroll
          for (int k = 0; k < 64; ++k) { wa[k] = pa[k * 64]; wi[k] = pi[k * 64]; } }
        const float ba = args->in[25][(l * 2 + dir) * 512 + ch], bi = args->in[27][(l * 2 + dir) * 512 + ch], lam = args->in[28][(l * 2 + dir) * 512 + ch];
        const float sp = log1pf(__expf(-lam));
        const float cw0 = args->in[22][(l * 4 + 0) * 512 + ch], cw1 = args->in[22][(l * 4 + 1) * 512 + ch], cw2 = args->in[22][(l * 4 + 2) * 512 + ch], cw3 = args->in[22][(l * 4 + 3) * 512 + ch], cb = args->in[23][l * 512 + ch];
        float h = latent ? args->in[5][((size_t)(b * 2 + l) * 2 + dir) * 512 + ch] : 0.f;
        for (int s = 0; s < L; ++s) {
            const int t = dir ? (L - 1 - s) : s;
            const float* xp = XR + (size_t)(rowbase + t) * 512 + ch;
            const float xm2 = (t >= 2) ? xp[-2 * 512] : 0.f, xm1 = (t >= 1) ? xp[-512] : 0.f, x0 = xp[0], xp1 = (t + 1 < L) ? xp[512] : 0.f;
            const float xc = cb + cw0 * xm2 + cw1 * xm1 + cw2 * x0 + cw3 * xp1;
            float ra = ba, ri = bi;
#pragma unroll
            for (int k = 0; k < 64; ++k) { const float xk = __shfl(xc, k); ra += xk * wa[k]; ri += xk * wi[k]; }
            const float r = sigmoidf_(ra), ig = sigmoidf_(ri);
            const float log_a = -8.0f * r * sp, a = __expf(log_a), bb = sqrtf(fmaxf(-expm1f(2.0f * log_a), 0.f)) * (ig * xc);
            h = a * h + bb;
            REC[(size_t)(rowbase + t) * D + dir * 512 + ch] = f2bf(h * bf2f(GY[(size_t)(rowbase + t) * 512 + ch]));
        }
        if (!latent) C.out[OUT_ST + ((size_t)(b * 2 + l) * 2 + dir) * 512 + ch] = h;
    }
}

constexpr int N_PHASES = 28;
enum { K_P0 = 1, K_NORM = 2, K_GU = 4, K_RES = 8, K_IN = 16, K_ATTN = 32, K_LRU = 64, K_DFT = 128, K_BR = 256, K_ALL = 511 };
__host__ __device__ constexpr int kind_of_phase(int ph) {
    if (ph == 0) return K_P0;
    if (ph == N_PHASES - 1) return K_NORM;
    const int s = (ph - 1) % 13;
    return (s == 0 || s == 3 || s == 10) ? K_NORM : (s == 1 || s == 11) ? K_GU : (s == 2 || s == 12 || s == 9) ? K_RES : (s == 4) ? K_IN : (s == 5) ? K_ATTN : (s == 6) ? K_LRU : (s == 7) ? K_DFT : K_BR;
}
__host__ __device__ constexpr bool sync_after_phase(int ph) { const int s = (ph - 1) % 13; return !(ph >= 1 && ph < N_PHASES - 1 && (s == 5 || s == 6)); }

template <int KM>
__device__ __forceinline__ void run_phase(ArgsP args, const Ctx& C, int ph) {
    if (ph == 0) { if constexpr ((KM & K_P0) != 0) p0_prologue(args, C); return; }
    if (ph == N_PHASES - 1) { if constexpr ((KM & K_NORM) != 0) finalnorm_phase(args, C); return; }
    const int l = (ph - 1) / 13, s = (ph - 1) % 13;
    const float* MODB = (const float*)(C.ws + OFF_MOD);
    if (s == 0 || s == 3 || s == 10) { if constexpr ((KM & K_NORM) != 0) modnorm_phase(args, C, l, s == 0 ? 0 : (s == 3 ? 1 : 2)); }
    else if (s == 1 || s == 11) { if constexpr ((KM & K_GU) != 0) { StaticOrder S; S.init(M, 2 * DFF, C.G, C.bid, (const bf16_t*)act_ptr(C, A_XN), D, (const bf16_t*)wl_ptr(C, l, s == 1 ? WL_GU1 : WL_GU2), D);
        EpiGU E{(bf16_t*)act_ptr(C, A_G)}; GEMM(C, S, E, D, D, D); } }
    else if (s == 2 || s == 12) { if constexpr ((KM & K_RES) != 0) { StaticOrder S; S.init(M, D, C.G, C.bid, (const bf16_t*)act_ptr(C, A_G), DFF, (const bf16_t*)wl_ptr(C, l, s == 2 ? WL_D1 : WL_D2), DFF);
        EpiRes E{C.out, MODB, l, s == 2 ? 0 : 2, 0.5f}; GEMM(C, S, E, DFF, DFF, DFF); } }
    else if (s == 4) { if constexpr ((KM & K_IN) != 0) { StaticOrder S; S.init(M, NIN, C.G, C.bid, (const bf16_t*)act_ptr(C, A_XN), D, (const bf16_t*)wl_ptr(C, l, WL_IN), D);
        EpiIn E{(bf16_t*)act_ptr(C, A_Q), (bf16_t*)act_ptr(C, A_K), (bf16_t*)act_ptr(C, A_VT), (bf16_t*)act_ptr(C, A_GY), (bf16_t*)act_ptr(C, A_XFT), (bf16_t*)act_ptr(C, A_G),
                (float*)act_ptr(C, A_XR), C.out, (const float*)(C.ws + OFF_ROPE), args->in[19] + (size_t)l * 3072, l};
        GEMM(C, S, E, D, D, D); } }
    else if (s == 5) { if constexpr ((KM & K_ATTN) != 0) attn_naive_phase(args, C, l); }
    else if (s == 6) { if constexpr ((KM & K_LRU) != 0) lru_naive_phase(args, C, l); }
    else if (s == 7) { if constexpr ((KM & K_DFT) != 0) {
        { DftOrder S{4, 16, LS, C.G, C.bid, (const bf16_t*)(C.ws + WS_DFTL), (const bf16_t*)act_ptr(C, A_XFT) + (size_t)16 * 512 * LC}; EpiDft E{(bf16_t*)act_ptr(C, A_Z), LS, MP}; GEMM(C, S, E, LS, LS, LS); }
        { DftOrder S{16, 2, LC, C.G, C.bid, (const bf16_t*)(C.ws + WS_DFTC), (const bf16_t*)act_ptr(C, A_XFT)}; EpiDft E{(bf16_t*)act_ptr(C, A_Z), LC, 0}; GEMM(C, S, E, LC, LC, LC); } } }
    else if (s == 8) { if constexpr ((KM & K_BR) != 0) {
        bf16_t* MG = (bf16_t*)act_ptr(C, A_XR); const bf16_t* G = (const bf16_t*)act_ptr(C, A_G);
        { StaticOrder S; S.init(M, D, C.G, C.bid, (const bf16_t*)act_ptr(C, A_Q), 512, (const bf16_t*)wl_ptr(C, l, WL_A), 512); EpiBranch<0> E{MG, G, 0}; GEMM(C, S, E, 512, 512, 512); }
        { StaticOrder S; S.init(M, D, C.G, C.bid, (const bf16_t*)act_ptr(C, A_XN), D, (const bf16_t*)wl_ptr(C, l, WL_L2), D); EpiBranch<1> E{MG, G, 1}; GEMM(C, S, E, D, D, D); }
        { StaticOrder S; S.init(M, D, C.G, C.bid, (const bf16_t*)act_ptr(C, A_Z), D, (const bf16_t*)wl_ptr(C, l, WL_F2), D); EpiBranch<1> E{MG, G, 2}; GEMM(C, S, E, D, D, D); } } }
    else if (s == 9) { if constexpr ((KM & K_RES) != 0) { StaticOrder S; S.init(M, D, C.G, C.bid, (const bf16_t*)act_ptr(C, A_XR), D, (const bf16_t*)wl_ptr(C, l, WL_O), D);
        EpiRes E{C.out, MODB, l, 1, 1.0f}; GEMM(C, S, E, D, D, D); } }
}

template <int KM>
__global__ void __launch_bounds__(NTHREADS, 2) fwd_kernel(Args args_byval) {
    extern __shared__ __attribute__((aligned(16))) unsigned char lds_raw[];
    ArgsP args0 = (ArgsP)__builtin_amdgcn_kernarg_segment_ptr();
    const int lo = args0->ph_lo, hi = args0->ph_hi;
    for (int ph = lo; ph < hi; ++ph) {
        ArgsP args = args0; asm volatile("" : "+s"(args));
        int tid = threadIdx.x; asm volatile("" : "+v"(tid));
        int bid = blockIdx.x; asm volatile("" : "+s"(bid));
        Ctx C; C.out = args->out; C.ws = args->ws; C.lds = (LAS unsigned char*)lds_raw;
        C.tid = tid; C.lane = tid & 63; C.wave = __builtin_amdgcn_readfirstlane(tid >> 6); C.bid = bid; C.G = gridDim.x;
        run_phase<KM>(args, C, ph);
        if constexpr (KM == K_ALL) { if (ph + 1 < hi && sync_after_phase(ph)) cooperative_groups::this_grid().sync(); }
    }
}

template <int KM> static void launch_kind(const Args& a, hipStream_t stream) {
    static bool attr = false;
    if (!attr) { if (hipFuncSetAttribute((const void*)fwd_kernel<KM>, hipFuncAttributeMaxDynamicSharedMemorySize, LDS_BYTES) != hipSuccess) fprintf(stderr, "hipFuncSetAttribute failed\n"); attr = true; }
    hipLaunchKernelGGL(fwd_kernel<KM>, dim3(256), dim3(NTHREADS), LDS_BYTES, stream, a);
}
extern "C" void kernel_launch(void* const* d_in, const int* in_sizes, int n_in, void* d_out, int out_size, void* d_ws, size_t ws_size, hipStream_t stream) {
    if (n_in != 32 || ws_size < WS_END) { fprintf(stderr, "kernel_launch: n_in %d ws %zu (need %zu)\n", n_in, ws_size, (size_t)WS_END); return; }
    Args a{};
    for (int i = 0; i < 32; ++i) a.in[i] = (const float*)d_in[i];
    a.out = (float*)d_out; a.ws = (unsigned char*)d_ws;
#if N_LAUNCH_MODE == 1
    static bool attr = false;
    if (!attr) { if (hipFuncSetAttribute((const void*)fwd_kernel<K_ALL>, hipFuncAttributeMaxDynamicSharedMemorySize, LDS_BYTES) != hipSuccess) fprintf(stderr, "hipFuncSetAttribute failed\n"); attr = true; }
    a.ph_lo = 0; a.ph_hi = N_PHASES;
    void* kargs[] = {&a};
    hipError_t e = hipLaunchCooperativeKernel((const void*)fwd_kernel<K_ALL>, dim3(256), dim3(NTHREADS), kargs, LDS_BYTES, stream);
    if (e != hipSuccess) fprintf(stderr, "cooperative launch failed: %s\n", hipGetErrorString(e));
#else
    for (int p = 0; p < N_PHASES; ++p) { a.ph_lo = p; a.ph_hi = p + 1;
        switch (kind_of_phase(p)) {
            case K_P0: launch_kind<K_P0>(a, stream); break; case K_NORM: launch_kind<K_NORM>(a, stream); break; case K_GU: launch_kind<K_GU>(a, stream); break;
            case K_RES: launch_kind<K_RES>(a, stream); break; case K_IN: launch_kind<K_IN>(a, stream); break; case K_ATTN: launch_kind<K_ATTN>(a, stream); break;
            case K_LRU: launch_kind<K_LRU>(a, stream); break; case K_DFT: launch_kind<K_DFT>(a, stream); break; default: launch_kind<K_BR>(a, stream); break; } }
#endif
}
```

```cpp
#include <hip/hip_runtime.h>
#include <hip/hip_cooperative_groups.h>
#include <cstdint>
#include <cstdio>

#ifndef N_LAUNCH_MODE
#define N_LAUNCH_MODE 1
#endif

#define LAS __attribute__((address_space(3)))
typedef unsigned short bf16_t;
typedef short bf16x8 __attribute__((ext_vector_type(8)));
typedef float f32x4 __attribute__((ext_vector_type(4)));
typedef float f32x2 __attribute__((ext_vector_type(2)));
typedef unsigned u32x4 __attribute__((ext_vector_type(4)));
typedef unsigned u32x2 __attribute__((ext_vector_type(2)));

constexpr int D = 1024, MP = 4096, MS = 8192, M = MP + MS, DFF = 2816, DEPTH = 2;
constexpr int LC = 256, LS = 2048;
constexpr int NB_C = 16, NB_S = 4;
constexpr int NIN = 2304 + 3072;
constexpr int NMOD = 9216;
constexpr float EPS = 1e-6f;
constexpr float LOG2E = 1.4426950408889634f;
constexpr float QSCALE = 0.125f * LOG2E;

constexpr size_t MiB = 1u << 20;
constexpr size_t SZ_WGU = (size_t)2 * DFF * D * 2, SZ_WD = (size_t)D * DFF * 2, SZ_WIN = (size_t)NIN * D * 2;
constexpr size_t SZ_WA = (size_t)D * 512 * 2, SZ_W1K = (size_t)D * D * 2;
constexpr size_t WL_GU1 = 0, WL_D1 = WL_GU1 + SZ_WGU, WL_GU2 = WL_D1 + SZ_WD, WL_D2 = WL_GU2 + SZ_WGU, WL_IN = WL_D2 + SZ_WD,
                 WL_A = WL_IN + SZ_WIN, WL_L2 = WL_A + SZ_WA, WL_F2 = WL_L2 + SZ_W1K, WL_O = WL_F2 + SZ_W1K, WL_SIZE = WL_O + SZ_W1K;
constexpr size_t WS_CTL = 0;
constexpr size_t WS_MISC = 1 * MiB;
constexpr size_t OFF_MOD = WS_MISC;
constexpr size_t OFF_ROPE = OFF_MOD + (size_t)2 * 5 * NMOD * 4;
constexpr size_t OFF_CK = OFF_ROPE + 2 * 1024 * 4;
constexpr size_t OFF_CVT = OFF_CK + (size_t)4 * 2 * 256 * 128 * 2;
constexpr size_t WS_DFTC = 3 * MiB;
constexpr size_t WS_DFTL = 4 * MiB;
constexpr size_t WS_W = 20 * MiB;
constexpr size_t WS_ACT = WS_W + 2 * WL_SIZE;
constexpr size_t A_G = 0;
constexpr size_t A_XN = 72 * MiB;
constexpr size_t A_XR = 96 * MiB;
constexpr size_t A_GY = 120 * MiB;
constexpr size_t A_XFT = 132 * MiB;
constexpr size_t A_Q = 144 * MiB;
constexpr size_t A_K = 156 * MiB;
constexpr size_t A_VT = 159 * MiB;
constexpr size_t A_Z = 162 * MiB;
constexpr size_t A_END = 186 * MiB;
constexpr size_t WS_END = WS_ACT + A_END;

constexpr int OUT_YS = MP * D, OUT_CK = M * D, OUT_CV = OUT_CK + 16 * 2 * 256 * 128, OUT_ST = OUT_CV + 16 * 2 * 256 * 128;

constexpr int NTHREADS = 512, NWAVES = 8;
constexpr int LDS_BYTES = 147456;

typedef __bf16 bf16x2_t __attribute__((ext_vector_type(2)));
__device__ __forceinline__ unsigned cvt_pk_bf16(float lo, float hi) { f32x2 v = {lo, hi}; bf16x2_t b = __builtin_convertvector(v, bf16x2_t); return __builtin_bit_cast(unsigned, b); }
__device__ __forceinline__ bf16_t f2bf(float f) { return (bf16_t)(cvt_pk_bf16(f, 0.f) & 0xffffu); }
__device__ __forceinline__ float bf2f(unsigned h) { return __uint_as_float(h << 16); }
__device__ __forceinline__ float bflo(unsigned w) { return __uint_as_float(w << 16); }
__device__ __forceinline__ float bfhi(unsigned w) { return __uint_as_float(w & 0xffff0000u); }
__device__ __forceinline__ float sigmoidf_(float x) { return 1.0f / (1.0f + __expf(-x)); }
__device__ __forceinline__ float siluf_(float x) { return x / (1.0f + __expf(-x)); }
__device__ __forceinline__ float gelu_tanh(float x) { const float u = 0.7978845608028654f * (x + 0.044715f * x * x * x); return x / (1.0f + __expf(-2.0f * u)); }
__device__ __forceinline__ float wave_sum(float v) {
#pragma unroll
    for (int o = 1; o < 64; o <<= 1) v += __shfl_xor(v, o);
    return v;
}
__device__ __forceinline__ int cond_of_row(int r) { return r < MP ? 4 : ((r - MP) >> 11); }

struct Args {
    const float* in[32];
    float* out;
    unsigned char* ws;
    int ph_lo, ph_hi;
};

typedef const __attribute__((address_space(4))) Args* ArgsP;
struct Ctx {
    float* out; unsigned char* ws; LAS unsigned char* lds;
    int tid, lane, wave, bid, G;
};
__device__ __forceinline__ unsigned char* wl_ptr(const Ctx& C, int l, size_t off) { return C.ws + WS_W + (size_t)l * WL_SIZE + off; }
__device__ __forceinline__ unsigned char* act_ptr(const Ctx& C, size_t off) { return C.ws + WS_ACT + off; }
__device__ __forceinline__ const float* mod_ptr(const Ctx& C, int l, int c, int sub, int which) { return (const float*)(C.ws + OFF_MOD) + ((size_t)(l * 5 + c) * NMOD + (sub * 3 + which) * D); }

__device__ __forceinline__ void p0_transpose_item(const float* W, int ldw, bf16_t* WT, int ldt, int drow0, int dcol0, int k0, int n0, LAS float* scr, int lane) {
#pragma unroll 8
    for (int i = 0; i < 32; ++i) { const int kk = 2 * i + (lane >> 5); scr[kk * 33 + (lane & 31)] = W[(size_t)(k0 + kk) * ldw + n0 + (lane & 31)]; }
    asm volatile("s_waitcnt lgkmcnt(0)" ::: "memory");
    const int c = lane & 7;
#pragma unroll
    for (int j = 0; j < 4; ++j) { const int n = (lane >> 3) + 8 * j; const LAS float* s = scr + (8 * c) * 33 + n;
        u32x4 o; o.x = cvt_pk_bf16(s[0 * 33], s[1 * 33]); o.y = cvt_pk_bf16(s[2 * 33], s[3 * 33]); o.z = cvt_pk_bf16(s[4 * 33], s[5 * 33]); o.w = cvt_pk_bf16(s[6 * 33], s[7 * 33]);
        *(u32x4*)(WT + (size_t)(drow0 + n) * ldt + dcol0 + k0 + 8 * c) = o; }
    asm volatile("s_waitcnt lgkmcnt(0)" ::: "memory");
}

__device__ __forceinline__ void p0_prologue(ArgsP args, const Ctx& C) {
    LAS float* SC = (LAS float*)C.lds;
    LAS float* TAB = (LAS float*)(C.lds + 20480);
    LAS float* SCR = (LAS float*)(C.lds + 32768);
    const float* c_in = args->in[2]; const float* cctx = args->in[6];
    for (int i = C.tid; i < 5 * 1024; i += NTHREADS) { const float v = (i < 4096) ? c_in[i] : cctx[i - 4096]; SC[i] = siluf_(v); }
    for (int i = C.tid; i < 2048; i += NTHREADS) TAB[i] = cospif((float)i * (1.0f / 1024.0f));
    __syncthreads();
    for (int it = C.bid; it < 288 + 128; it += C.G) {
        if (it < 288) {
            const int l = it / 144, j0 = (it % 144) * 64;
            const float* W = args->in[7] + (size_t)l * D * NMOD + j0 + C.lane;
            float a0 = 0.f, a1 = 0.f, a2 = 0.f, a3 = 0.f, a4 = 0.f;
            const int kb = C.wave * 128;
#pragma unroll 8
            for (int k = 0; k < 128; ++k) { const float w = W[(size_t)(kb + k) * NMOD];
                a0 += SC[kb + k] * w; a1 += SC[1024 + kb + k] * w; a2 += SC[2048 + kb + k] * w; a3 += SC[3072 + kb + k] * w; a4 += SC[4096 + kb + k] * w; }
            SCR[(C.wave * 5 + 0) * 64 + C.lane] = a0; SCR[(C.wave * 5 + 1) * 64 + C.lane] = a1; SCR[(C.wave * 5 + 2) * 64 + C.lane] = a2;
            SCR[(C.wave * 5 + 3) * 64 + C.lane] = a3; SCR[(C.wave * 5 + 4) * 64 + C.lane] = a4;
            __syncthreads();
            if (C.tid < 320) { const int c = C.tid >> 6, j = C.tid & 63; float s = args->in[8][(size_t)l * NMOD + j0 + j];
#pragma unroll
                for (int w = 0; w < 8; ++w) s += SCR[(w * 5 + c) * 64 + j];
                ((float*)(C.ws + OFF_MOD))[(size_t)(l * 5 + c) * NMOD + j0 + j] = s; }
            __syncthreads();
        } else {
            const int r = it - 288, l = r >> 6, g = (r >> 4) & 3, n0 = (r & 15) * 64;
            const float* Wf = args->in[30] + (size_t)l * 512 * D + (size_t)(g * 128) * D + n0;
            for (int i = C.tid; i < 128 * 64; i += NTHREADS) SCR[i] = Wf[(size_t)(i >> 6) * D + (i & 63)];
            __syncthreads();
            const int n = C.tid & 63, cw = C.tid >> 6;
            bf16_t* dst = (bf16_t*)wl_ptr(C, l, WL_F2) + (size_t)(n0 + n) * D + g * 128;
            const float s = 0.08838834764831845f;
            for (int j = 0; j < 16; ++j) { const int c = cw + 8 * j; float ac = 0.f, as = 0.f;
#pragma unroll 8
                for (int q = 0; q < 128; ++q) { const int idx = ((q * c) & 127) * 16; const float w = SCR[q * 64 + n];
                    ac += TAB[idx] * w; as += TAB[(idx - 512) & 2047] * w; }
                dst[c] = f2bf(ac * s); dst[512 + c] = f2bf(-as * s); }
            __syncthreads();
        }
    }
    __syncthreads();
    {
        LAS float* scr = SCR + C.wave * (64 * 33);
        const int gw = C.bid * NWAVES + C.wave, NGW = C.G * NWAVES;
        constexpr int I_G = 16 * 88, I_D = 44 * 32, I_IN = 16 * 72, I_BG = 16 * 96, I_A = 8 * 32, I_L = 8 * 32, I_O = 16 * 32;
        constexpr int PER_LAYER = 4 * I_G + 2 * I_D + I_IN + I_BG + I_A + I_L + I_O;
        for (int it = gw; it < 2 * PER_LAYER; it += NGW) {
            const int l = it / PER_LAYER; int r = it % PER_LAYER;
            if (r < I_G) { const int kb = r / 88, n0 = (r % 88) * 32; p0_transpose_item(args->in[11] + (size_t)l * D * DFF, DFF, (bf16_t*)wl_ptr(C, l, WL_GU1), D, 256 * (n0 >> 7) + (n0 & 127), 0, kb * 64, n0, scr, C.lane); continue; } r -= I_G;
            if (r < I_G) { const int kb = r / 88, n0 = (r % 88) * 32; p0_transpose_item(args->in[12] + (size_t)l * D * DFF, DFF, (bf16_t*)wl_ptr(C, l, WL_GU1), D, 256 * (n0 >> 7) + 128 + (n0 & 127), 0, kb * 64, n0, scr, C.lane); continue; } r -= I_G;
            if (r < I_D) { const int kb = r / 32, nb = r % 32; p0_transpose_item(args->in[13] + (size_t)l * DFF * D, D, (bf16_t*)wl_ptr(C, l, WL_D1), DFF, nb * 32, 0, kb * 64, nb * 32, scr, C.lane); continue; } r -= I_D;
            if (r < I_G) { const int kb = r / 88, n0 = (r % 88) * 32; p0_transpose_item(args->in[14] + (size_t)l * D * DFF, DFF, (bf16_t*)wl_ptr(C, l, WL_GU2), D, 256 * (n0 >> 7) + (n0 & 127), 0, kb * 64, n0, scr, C.lane); continue; } r -= I_G;
            if (r < I_G) { const int kb = r / 88, n0 = (r % 88) * 32; p0_transpose_item(args->in[15] + (size_t)l * D * DFF, DFF, (bf16_t*)wl_ptr(C, l, WL_GU2), D, 256 * (n0 >> 7) + 128 + (n0 & 127), 0, kb * 64, n0, scr, C.lane); continue; } r -= I_G;
            if (r < I_D) { const int kb = r / 32, nb = r % 32; p0_transpose_item(args->in[16] + (size_t)l * DFF * D, D, (bf16_t*)wl_ptr(C, l, WL_D2), DFF, nb * 32, 0, kb * 64, nb * 32, scr, C.lane); continue; } r -= I_D;
            if (r < I_IN) { const int kb = r / 72, nb = r % 72; p0_transpose_item(args->in[17] + (size_t)l * D * 2304, 2304, (bf16_t*)wl_ptr(C, l, WL_IN), D, nb * 32, 0, kb * 64, nb * 32, scr, C.lane); continue; } r -= I_IN;
            if (r < I_BG) { const int kb = r / 96, nb = r % 96; p0_transpose_item(args->in[18] + (size_t)l * D * 3072, 3072, (bf16_t*)wl_ptr(C, l, WL_IN), D, 2304 + nb * 32, 0, kb * 64, nb * 32, scr, C.lane); continue; } r -= I_BG;
            if (r < I_A) { const int kb = r / 32, nb = r % 32; p0_transpose_item(args->in[21] + (size_t)l * 512 * D, D, (bf16_t*)wl_ptr(C, l, WL_A), 512, nb * 32, 0, kb * 64, nb * 32, scr, C.lane); continue; } r -= I_A;
            if (r < I_L) { const int kb = r / 32, nb = r % 32;
                p0_transpose_item(args->in[29] + (size_t)l * 512 * D, D, (bf16_t*)wl_ptr(C, l, WL_L2), D, nb * 32, 0, kb * 64, nb * 32, scr, C.lane);
                p0_transpose_item(args->in[29] + (size_t)l * 512 * D, D, (bf16_t*)wl_ptr(C, l, WL_L2), D, nb * 32, 512, kb * 64, nb * 32, scr, C.lane); continue; } r -= I_L;
            { const int kb = r / 32, nb = r % 32; p0_transpose_item(args->in[31] + (size_t)l * D * D, D, (bf16_t*)wl_ptr(C, l, WL_O), D, nb * 32, 0, kb * 64, nb * 32, scr, C.lane); }
        }
    }
    const int gt = C.bid * NTHREADS + C.tid, NGT = C.G * NTHREADS;
    for (int i = gt; i < M * D / 4; i += NGT) { const f32x4 v = (i < MP * D / 4) ? ((const f32x4*)args->in[0])[i] : ((const f32x4*)args->in[1])[i - MP * D / 4]; ((f32x4*)C.out)[i] = v; }
    for (int i = gt; i < 4096 * 256; i += NGT) { const int pr = i >> 8, t0 = (i & 255) * 8, p = pr & 2047, sh = (pr >= 2048) ? 512 : 0; const float s = 0.022097086912079608f;
        float v[8];
#pragma unroll
        for (int j = 0; j < 8; ++j) v[j] = TAB[((p * (t0 + j)) - sh) & 2047] * s;
        u32x4 o; o.x = cvt_pk_bf16(v[0], v[1]); o.y = cvt_pk_bf16(v[2], v[3]); o.z = cvt_pk_bf16(v[4], v[5]); o.w = cvt_pk_bf16(v[6], v[7]);
        *(u32x4*)((bf16_t*)(C.ws + WS_DFTL) + (size_t)pr * 2048 + t0) = o; }
    for (int i = gt; i < 512 * 32; i += NGT) { const int pr = i >> 5, t0 = (i & 31) * 8, p = pr & 255, sh = (pr >= 256) ? 512 : 0; const float s = 0.0625f;
        float v[8];
#pragma unroll
        for (int j = 0; j < 8; ++j) v[j] = TAB[((p * (t0 + j) * 8) - sh) & 2047] * s;
        u32x4 o; o.x = cvt_pk_bf16(v[0], v[1]); o.y = cvt_pk_bf16(v[2], v[3]); o.z = cvt_pk_bf16(v[4], v[5]); o.w = cvt_pk_bf16(v[6], v[7]);
        *(u32x4*)((bf16_t*)(C.ws + WS_DFTC) + (size_t)pr * 256 + t0) = o; }
    for (int i = gt; i < 1024; i += NGT) { const int pos = i >> 4, f = i & 15; const float inv = exp2f(-(float)f * (13.287712379549449f / 16.0f)); const float ang = (float)pos * inv; const float af = (float)((double)ang * 0.3183098861837907);
        ((float*)(C.ws + OFF_ROPE))[i] = cospif(af); ((float*)(C.ws + OFF_ROPE))[1024 + i] = sinpif(af); }
    for (int i = gt; i < 4 * 2 * 256 * 128; i += NGT) { ((bf16_t*)(C.ws + OFF_CK))[i] = f2bf(args->in[3][i]);
        const int d = i & 63, kvh = (i >> 6) & 1, t = (i >> 7) & 255, bl = i >> 15;
        ((bf16_t*)(C.ws + OFF_CVT))[((size_t)(bl * 2 + kvh) * 64 + d) * 256 + t] = f2bf(args->in[4][i]); }
}

__device__ __forceinline__ void modnorm_phase(ArgsP args, const Ctx& C, int l, int sub) {
    const int gw = C.bid * NWAVES + C.wave, NGW = C.G * NWAVES;
    const float* nw = args->in[9] + (size_t)(l * 3 + sub) * D;
    bf16_t* XN = (bf16_t*)act_ptr(C, A_XN);
    for (int r = gw; r < M; r += NGW) {
        const int c = cond_of_row(r);
        const float* sh = mod_ptr(C, l, c, sub, 0); const float* sc = mod_ptr(C, l, c, sub, 1);
        const f32x4* xr = (const f32x4*)(C.out + (size_t)r * D) + C.lane;
        f32x4 v[4]; float s = 0.f;
#pragma unroll
        for (int j = 0; j < 4; ++j) { v[j] = xr[64 * j]; s += (v[j].x * v[j].x + v[j].y * v[j].y) + (v[j].z * v[j].z + v[j].w * v[j].w); }
        const float rstd = rsqrtf(wave_sum(s) * (1.0f / D) + EPS);
        u32x2* o = (u32x2*)(XN + (size_t)r * D) + C.lane;
#pragma unroll
        for (int j = 0; j < 4; ++j) { const int col = 4 * C.lane + 256 * j; const f32x4 w = *(const f32x4*)(nw + col), a = *(const f32x4*)(sc + col), b = *(const f32x4*)(sh + col);
            f32x4 y = v[j] * rstd * w * (a + 1.0f) + b; u32x2 p; p.x = cvt_pk_bf16(y.x, y.y); p.y = cvt_pk_bf16(y.z, y.w); o[64 * j] = p; }
    }
}
__device__ __forceinline__ void finalnorm_phase(ArgsP args, const Ctx& C) {
    const int gw = C.bid * NWAVES + C.wave, NGW = C.G * NWAVES;
    const float* nw = args->in[10];
    for (int r = gw; r < M; r += NGW) {
        f32x4* xr = (f32x4*)(C.out + (size_t)r * D) + C.lane;
        f32x4 v[4]; float s = 0.f;
#pragma unroll
        for (int j = 0; j < 4; ++j) { v[j] = xr[64 * j]; s += (v[j].x * v[j].x + v[j].y * v[j].y) + (v[j].z * v[j].z + v[j].w * v[j].w); }
        const float rstd = rsqrtf(wave_sum(s) * (1.0f / D) + EPS);
#pragma unroll
        for (int j = 0; j < 4; ++j) { const f32x4 w = *(const f32x4*)(nw + 4 * C.lane + 256 * j); xr[64 * j] = v[j] * rstd * w; }
    }
}

struct Unit { int pm, pn, z; const bf16_t* A; const bf16_t* B; };

struct StaticOrder {
    int nM, nN, nwg, G, c; const bf16_t* A; const bf16_t* B; int lda, ldb;
    __device__ void init(int Mr, int N, int G_, int c_, const bf16_t* A_, int lda_, const bf16_t* B_, int ldb_) { nM = Mr / 256; nN = N / 256; nwg = nM * nN; G = G_; c = c_; A = A_; B = B_; lda = lda_; ldb = ldb_; }
    __device__ bool next(int i, Unit& u) const {
        const long L = (long)i * G + c; if (L >= nwg) return false;
        int wgid = (int)L; { const int q = nwg / 8, r = nwg % 8, xcd = wgid % 8, off = wgid / 8; wgid = (xcd < r ? xcd * (q + 1) : r * (q + 1) + (xcd - r) * q) + off; }
        const int nig = 8 * nN, gid = wgid / nig, fm = gid * 8, gsz = (nM - fm) < 8 ? (nM - fm) : 8;
        u.pm = fm + ((wgid % nig) % gsz); u.pn = (wgid % nig) / gsz; u.z = 0;
        u.A = A + (size_t)u.pm * 256 * lda; u.B = B + (size_t)u.pn * 256 * ldb; return true;
    }
};
struct DftOrder {
    int nseq, nPm, L, G, c; const bf16_t* A; const bf16_t* XFT;
    __device__ bool next(int i, Unit& u) const {
        const int idx = i * G + c; if (idx >= nseq * nPm * 2) return false;
        u.z = idx / (nPm * 2); const int r = idx % (nPm * 2); u.pm = r >> 1; u.pn = r & 1;
        u.A = A + (size_t)u.pm * 256 * L; u.B = XFT + ((size_t)u.z * 512 + u.pn * 256) * L; return true;
    }
};

template <class Epi, class Sched>
__device__ __forceinline__ void gemm_simple(const Ctx& C, const Sched& S, const Epi& E, int lda, int ldb, int K) {
    const int wr = C.wave >> 2, wc = C.wave & 3, fr = C.lane & 15, fq = C.lane >> 4;
    Unit u;
    for (int ui = 0; S.next(ui, u); ++ui) {
        f32x4 acc[2][2][4][2];
#pragma unroll
        for (int a = 0; a < 2; ++a)
#pragma unroll
            for (int b = 0; b < 2; ++b)
#pragma unroll
                for (int m = 0; m < 4; ++m)
#pragma unroll
                    for (int n = 0; n < 2; ++n) acc[a][b][m][n] = (f32x4){0.f, 0.f, 0.f, 0.f};
        const bf16_t* pa = u.A + (size_t)(wr * 64 + fr) * lda + fq * 8;
        const bf16_t* pb = u.B + (size_t)(wc * 32 + fr) * ldb + fq * 8;
        for (int k0 = 0; k0 < K; k0 += 32) {
            bf16x8 At[2][4], Bt[2][2];
#pragma unroll
            for (int a = 0; a < 2; ++a)
#pragma unroll
                for (int m = 0; m < 4; ++m) At[a][m] = *(const bf16x8*)(pa + (size_t)(a * 128 + m * 16) * lda + k0);
#pragma unroll
            for (int b = 0; b < 2; ++b)
#pragma unroll
                for (int n = 0; n < 2; ++n) Bt[b][n] = *(const bf16x8*)(pb + (size_t)(b * 128 + n * 16) * ldb + k0);
#pragma unroll
            for (int a = 0; a < 2; ++a)
#pragma unroll
                for (int b = 0; b < 2; ++b)
#pragma unroll
                    for (int m = 0; m < 4; ++m)
#pragma unroll
                        for (int n = 0; n < 2; ++n) acc[a][b][m][n] = __builtin_amdgcn_mfma_f32_16x16x32_bf16(Bt[b][n], At[a][m], acc[a][b][m][n], 0, 0, 0);
        }
        E(acc, u, wr, wc, fr, fq);
    }
}

namespace pg8 {
#define PG8_LAS __attribute__((address_space(3)))
constexpr int BM = 256, BK = 64, HALF = 128, HTB = HALF * BK * 2  , STAGE_BYTES = 8 * HTB, NXCD = 8, WGM = 8;

__host__ __device__ __forceinline__ int lds_byte(int r, int c) { const int st = (r >> 4) * 2 + (c >> 5), rr = r & 15, cc = c & 31, ob = rr * 64 + cc * 2; return st * 1024 + (ob ^ (((ob >> 9) & 1) << 5)); }
__host__ __device__ __forceinline__ void stage_rc(int b, int& R, int& C) { const int st = b / 1024, sb = b % 1024, swz = sb ^ (((sb >> 9) & 1) << 5); R = (st >> 1) * 16 + swz / 64; C = (st & 1) * 32 + (swz % 64) / 2; }
__host__ __device__ __forceinline__ int perm32(int rho) { const int n = rho >> 4, i = rho & 15; return 8 * (i >> 2) + 4 * n + (i & 3); }
template <class Epi, class Sched, bool ALIGN_EPI = true, bool SP2 = true>
__device__ __forceinline__ void gemm_phase(PG8_LAS unsigned char* lds, const int tid, const Sched& S, const Epi& E, const int lda, const int ldb, const int K) {
    const int wid = __builtin_amdgcn_readfirstlane(tid >> 6), lane = tid & 63, wr = wid >> 2, wc = wid & 3, fr = lane & 15, fq = lane >> 4;
    const int nt = K / BK;
    unsigned voffA[2], voffB[2];
#pragma unroll
    for (int i = 0; i < 2; ++i) { int R, C; stage_rc(tid * 16 + i * 8192, R, C); const int Rb = Epi::PERM ? ((R & ~31) + perm32(R & 31)) : R;
        voffA[i] = (unsigned)(R * lda + C) * 2u; voffB[i] = (unsigned)(Rb * ldb + C) * 2u; }
    const size_t kstep = (size_t)(BK * 2);
    const size_t hstepA = (size_t)HALF * lda * 2, hstepB = (size_t)HALF * ldb * 2;
    const unsigned ldsw = (unsigned)wid * 1024u;
    const int aoff = lds_byte(wr * 64 + fr, fq * 8), boff = lds_byte(wc * 32 + fr, fq * 8);
#define PG8_SA(b, h) (((b) * 2 + (h)) * HTB)
#define PG8_SB(b, h) ((4 + (b) * 2 + (h)) * HTB)
#define PG8_STAGE(bufoff, gbase, voff) do { _Pragma("unroll") for (int _i = 0; _i < 2; ++_i) \
        __builtin_amdgcn_global_load_lds((const unsigned*)((const char*)(gbase) + (voff)[_i]), (PG8_LAS unsigned*)(lds + (bufoff) + ldsw + _i * 8192), 16, 0, 0); } while (0)
#define PG8_LDA(dst, b, h) do { _Pragma("unroll") for (int m = 0; m < 4; ++m) _Pragma("unroll") for (int k = 0; k < 2; ++k) dst[m][k] = *(const PG8_LAS bf16x8*)(lds + PG8_SA(b, h) + aoff + m * 2048 + k * 1024); } while (0)
#define PG8_LDB(dst, b, h) do { _Pragma("unroll") for (int n = 0; n < 2; ++n) _Pragma("unroll") for (int k = 0; k < 2; ++k) dst[n][k] = *(const PG8_LAS bf16x8*)(lds + PG8_SB(b, h) + boff + n * 2048 + k * 1024); } while (0)
#define PG8_MMA(ai, bj, At, Bt) do { __builtin_amdgcn_s_setprio(1); _Pragma("unroll") for (int m = 0; m < 4; ++m) _Pragma("unroll") for (int n = 0; n < 2; ++n) _Pragma("unroll") for (int k = 0; k < 2; ++k) \
        acc[ai][bj][m][n] = __builtin_amdgcn_mfma_f32_16x16x32_bf16(Bt[n][k], At[m][k], acc[ai][bj][m][n], 0, 0, 0); __builtin_amdgcn_s_setprio(0); } while (0)
#define PG8_WAIT_V(n) asm volatile("s_waitcnt vmcnt(" #n ")" ::: "memory")
#define PG8_WAIT_L(n) asm volatile("s_waitcnt lgkmcnt(" #n ")" ::: "memory")
#define PG8_BAR __builtin_amdgcn_s_barrier()
#define PG8_SCHED __builtin_amdgcn_sched_barrier(0)
    Unit cur, nxt; int ui = 0;
    if (!S.next(0, cur)) return;
    f32x4 acc[2][2][4][2];
#pragma unroll
    for (int a = 0; a < 2; ++a)
#pragma unroll
        for (int b = 0; b < 2; ++b)
#pragma unroll
            for (int m = 0; m < 4; ++m)
#pragma unroll
                for (int n = 0; n < 2; ++n) acc[a][b][m][n] = (f32x4){0.f, 0.f, 0.f, 0.f};
    bf16x8 At[4][2], B0[2][2], B1[2][2];
    const char* cA = (const char*)cur.A; const char* cB = (const char*)cur.B;
    if constexpr (SP2) {
        PG8_STAGE(PG8_SB(0, 0), cB, voffB); PG8_STAGE(PG8_SB(0, 1), cB + hstepB, voffB); PG8_STAGE(PG8_SA(0, 0), cA, voffA); PG8_STAGE(PG8_SA(0, 1), cA + hstepA, voffA);
        if (wr == 1) PG8_BAR;
        PG8_WAIT_V(2); PG8_BAR;
        PG8_STAGE(PG8_SB(1, 0), cB + kstep, voffB); PG8_STAGE(PG8_SA(1, 0), cA + kstep, voffA); PG8_STAGE(PG8_SB(1, 1), cB + hstepB + kstep, voffB);
        PG8_WAIT_V(6); PG8_BAR;
    } else {
        PG8_STAGE(PG8_SB(0, 0), cB, voffB); PG8_STAGE(PG8_SA(0, 0), cA, voffA); PG8_STAGE(PG8_SB(0, 1), cB + hstepB, voffB); PG8_STAGE(PG8_SA(0, 1), cA + hstepA, voffA);
        if (wr == 1) PG8_BAR;
        PG8_WAIT_V(4); PG8_BAR;
        PG8_STAGE(PG8_SB(1, 0), cB + kstep, voffB); PG8_STAGE(PG8_SA(1, 0), cA + kstep, voffA); PG8_STAGE(PG8_SB(1, 1), cB + hstepB + kstep, voffB);
        PG8_WAIT_V(6); PG8_BAR;
    }
    for (;;) {
        const bool has_next = S.next(ui + 1, nxt);
        const char* nA = has_next ? (const char*)nxt.A : cA; const char* nB = has_next ? (const char*)nxt.B : cB;
        for (int t = 0; t < nt; t += 2) {
            const bool last = (t == nt - 2);
            const char* a1 = cA + (size_t)(t + 1) * kstep;
            const char* a2 = last ? nA : cA + (size_t)(t + 2) * kstep; const char* b2 = last ? nB : cB + (size_t)(t + 2) * kstep;
            const char* a3 = a2 + kstep; const char* b3 = b2 + kstep;
            if constexpr (SP2) {
            PG8_LDB(B0, 0, 0); PG8_LDB(B1, 0, 1); PG8_SCHED; PG8_LDA(At, 0, 0); PG8_STAGE(PG8_SA(1, 1), a1 + hstepA, voffA);
            PG8_WAIT_V(8); PG8_WAIT_L(0); PG8_BAR; PG8_MMA(0, 0, At, B0); PG8_MMA(0, 1, At, B1); PG8_BAR; PG8_SCHED;
            PG8_LDA(At, 0, 1); PG8_STAGE(PG8_SB(0, 0), b2, voffB); PG8_STAGE(PG8_SB(0, 1), b2 + hstepB, voffB); PG8_STAGE(PG8_SA(0, 0), a2, voffA);
            PG8_WAIT_V(8); PG8_WAIT_L(0); PG8_BAR; PG8_MMA(1, 0, At, B0); PG8_MMA(1, 1, At, B1); PG8_BAR; PG8_SCHED;
            PG8_LDB(B0, 1, 0); PG8_LDB(B1, 1, 1); PG8_SCHED; PG8_LDA(At, 1, 0); PG8_STAGE(PG8_SA(0, 1), a2 + hstepA, voffA);
            PG8_WAIT_V(8); PG8_WAIT_L(0); PG8_BAR; PG8_MMA(0, 0, At, B0); PG8_MMA(0, 1, At, B1); PG8_BAR; PG8_SCHED;
            PG8_LDA(At, 1, 1); PG8_STAGE(PG8_SB(1, 0), b3, voffB); PG8_STAGE(PG8_SB(1, 1), b3 + hstepB, voffB); PG8_STAGE(PG8_SA(1, 0), a3, voffA);
            PG8_WAIT_V(8); PG8_WAIT_L(0); PG8_BAR; PG8_MMA(1, 0, At, B0); PG8_MMA(1, 1, At, B1); PG8_BAR; PG8_SCHED;
            } else {
            PG8_LDB(B0, 0, 0); PG8_SCHED; PG8_LDA(At, 0, 0); PG8_STAGE(PG8_SA(1, 1), a1 + hstepA, voffA);
            PG8_WAIT_L(8); PG8_BAR; PG8_WAIT_L(0); PG8_MMA(0, 0, At, B0); PG8_BAR; PG8_SCHED;
            PG8_LDB(B1, 0, 1); PG8_STAGE(PG8_SB(0, 0), b2, voffB);
            PG8_BAR; PG8_WAIT_L(0); PG8_MMA(0, 1, At, B1); PG8_BAR;
            PG8_LDA(At, 0, 1); PG8_STAGE(PG8_SA(0, 0), a2, voffA);
            PG8_BAR; PG8_WAIT_L(0); PG8_MMA(1, 0, At, B0); PG8_BAR; PG8_SCHED;
            PG8_STAGE(PG8_SB(0, 1), b2 + hstepB, voffB);
            PG8_WAIT_V(6); PG8_BAR; PG8_MMA(1, 1, At, B1); PG8_BAR;
            PG8_LDB(B0, 1, 0); PG8_SCHED; PG8_LDA(At, 1, 0); PG8_STAGE(PG8_SA(0, 1), a2 + hstepA, voffA);
            PG8_WAIT_L(8); PG8_BAR; PG8_WAIT_L(0); PG8_MMA(0, 0, At, B0); PG8_BAR; PG8_SCHED;
            PG8_LDB(B1, 1, 1); PG8_STAGE(PG8_SB(1, 0), b3, voffB);
            PG8_BAR; PG8_WAIT_L(0); PG8_MMA(0, 1, At, B1); PG8_BAR;
            PG8_LDA(At, 1, 1); PG8_STAGE(PG8_SA(1, 0), a3, voffA);
            PG8_BAR; PG8_WAIT_L(0); PG8_MMA(1, 0, At, B0); PG8_BAR; PG8_SCHED;
            PG8_STAGE(PG8_SB(1, 1), b3 + hstepB, voffB);
            PG8_WAIT_V(6); PG8_BAR; PG8_MMA(1, 1, At, B1); PG8_BAR;
            }
        }
        if constexpr (ALIGN_EPI) { if (wr == 0) PG8_BAR; }
        if constexpr (!Epi::AFTER_DRAIN) { E(acc, cur, wr, wc, fr, fq); }
        if (!has_next) break;
#pragma unroll
        for (int a = 0; a < 2; ++a)
#pragma unroll
            for (int b = 0; b < 2; ++b)
#pragma unroll
                for (int m = 0; m < 4; ++m)
#pragma unroll
                    for (int n = 0; n < 2; ++n) acc[a][b][m][n] = (f32x4){0.f, 0.f, 0.f, 0.f};
        cur = nxt; cA = nA; cB = nB; ++ui;
        if constexpr (ALIGN_EPI) { if (wr == 1) PG8_BAR; }
    }
    PG8_WAIT_V(0);
    if constexpr (!ALIGN_EPI) { if (wr == 0) PG8_BAR; }
    PG8_BAR;
    if constexpr (Epi::AFTER_DRAIN) { E.fused(acc, cur, wr, wc, fr, fq, lds, wid, lane); }
#undef PG8_SA
#undef PG8_SB
#undef PG8_STAGE
#undef PG8_LDA
#undef PG8_LDB
#undef PG8_MMA
#undef PG8_WAIT_V
#undef PG8_WAIT_L
#undef PG8_BAR
#undef PG8_SCHED
}
}

#ifndef USE_NAIVE_ATTN
#define USE_NAIVE_ATTN 0
#endif
#ifndef USE_NAIVE_LRU
#define USE_NAIVE_LRU 0
#endif
#ifndef USE_PG8
#define USE_PG8 1
#endif
#if USE_PG8
#define GEMM(C, S, E, lda, ldb, K) pg8::gemm_phase(C.lds, C.tid, S, E, lda, ldb, K)
#else
#define GEMM(C, S, E, lda, ldb, K) GEMM(C, S, E, lda, ldb, K)
#endif

#define EPI_LOOP_AM for (int ai = 0; ai < 2; ++ai) _Pragma("unroll") for (int m = 0; m < 4; ++m)
struct EpiGU {
    static constexpr bool PERM = false, AFTER_DRAIN = false;
    bf16_t* H;
    __device__ __forceinline__ void operator()(const f32x4 (&acc)[2][2][4][2], const Unit& u, int wr, int wc, int fr, int fq) const {
#pragma unroll
        EPI_LOOP_AM { const int row = u.pm * 256 + ai * 128 + wr * 64 + m * 16 + fr;
#pragma unroll
            for (int n = 0; n < 2; ++n) { const f32x4 g = acc[ai][0][m][n], up = acc[ai][1][m][n];
                u32x2 p; p.x = cvt_pk_bf16(siluf_(g.x) * up.x, siluf_(g.y) * up.y); p.y = cvt_pk_bf16(siluf_(g.z) * up.z, siluf_(g.w) * up.w);
                *(u32x2*)(H + (size_t)row * DFF + u.pn * 128 + wc * 32 + n * 16 + fq * 4) = p; } }
    }
};
struct EpiRes {
    static constexpr bool PERM = false, AFTER_DRAIN = false;
    float* X; const float* modbase; int l, sub; float coef;
    __device__ __forceinline__ void operator()(const f32x4 (&acc)[2][2][4][2], const Unit& u, int wr, int wc, int fr, int fq) const {
        const int c = cond_of_row(u.pm * 256);
        const float* gate = modbase + ((size_t)(l * 5 + c) * NMOD + (sub * 3 + 2) * D) + u.pn * 256 + wc * 32 + fq * 4;
        f32x4 g[2][2];
#pragma unroll
        for (int bj = 0; bj < 2; ++bj)
#pragma unroll
            for (int n = 0; n < 2; ++n) g[bj][n] = *(const f32x4*)(gate + bj * 128 + n * 16) * coef;
#pragma unroll
        EPI_LOOP_AM { float* xrow = X + (size_t)(u.pm * 256 + ai * 128 + wr * 64 + m * 16 + fr) * D + u.pn * 256 + wc * 32 + fq * 4;
#pragma unroll
            for (int bj = 0; bj < 2; ++bj)
#pragma unroll
                for (int n = 0; n < 2; ++n) { f32x4* p = (f32x4*)(xrow + bj * 128 + n * 16); *p = *p + g[bj][n] * acc[ai][bj][m][n]; }
            asm volatile("" ::: "memory"); }
    }
};
struct EpiIn {
    static constexpr bool PERM = false, AFTER_DRAIN = false;
    bf16_t *Q, *Kb, *VT, *GY, *XFT, *G; float* XR; float* out; const float* rope; const float* bgate; int l;
    __device__ __forceinline__ void operator()(const f32x4 (&acc)[2][2][4][2], const Unit& u, int wr, int wc, int fr, int fq) const {
        const int row0 = u.pm * 256 + wr * 64 + fr; const bool latent = u.pm >= 16;
        if (u.pn <= 2) {
#pragma unroll
            for (int bj = 0; bj < 2; ++bj) {
                if (u.pn == 2 && bj == 1) {
#pragma unroll
                    EPI_LOOP_AM { const int row = row0 + ai * 128 + m * 16; int seqoff, L, t;
                        if (latent) { const int b = (row - MP) >> 11; t = (row - MP) & 2047; L = LS; seqoff = 16 * 128 * LC + b * 128 * LS; } else { const int b = row >> 8; t = row & 255; L = LC; seqoff = b * 128 * LC; }
#pragma unroll
                        for (int n = 0; n < 2; ++n) { const f32x4 v = acc[ai][1][m][n]; const int d128 = wc * 32 + n * 16 + fq * 4;
                            bf16_t* p = VT + seqoff + (size_t)d128 * L + t; p[0] = f2bf(v.x); p[L] = f2bf(v.y); p[2 * L] = f2bf(v.z); p[3 * L] = f2bf(v.w);
                            if (!latent) *(f32x4*)(out + OUT_CV + ((size_t)((row >> 8) * 2 + l) * 256 + t) * 128 + d128) = v; } }
                } else {
                    const bool isk = (u.pn == 2); const int axis = wc & 1;
#pragma unroll
                    EPI_LOOP_AM { const int row = row0 + ai * 128 + m * 16; f32x4 x1 = acc[ai][bj][m][0], x2 = acc[ai][bj][m][1];
                        if (isk && !latent) { float* o = out + OUT_CK + ((size_t)((row >> 8) * 2 + l) * 256 + (row & 255)) * 128 + wc * 32 + fq * 4; *(f32x4*)o = x1; *(f32x4*)(o + 16) = x2; }
                        if (latent) { const int t = (row - MP) & 2047, pos = axis ? (t & 63) : (t >> 6);
                            const f32x4 cs = *(const f32x4*)(rope + pos * 16 + fq * 4), sn = *(const f32x4*)(rope + 1024 + pos * 16 + fq * 4);
                            const f32x4 o1 = x1 * cs - x2 * sn, o2 = x1 * sn + x2 * cs; x1 = o1; x2 = o2; }
                        if (!isk) { x1 = x1 * QSCALE; x2 = x2 * QSCALE; }
                        bf16_t* o = isk ? (Kb + (size_t)row * 128 + wc * 32 + fq * 4) : (Q + (size_t)row * 512 + u.pn * 256 + bj * 128 + wc * 32 + fq * 4);
                        u32x2 p; p.x = cvt_pk_bf16(x1.x, x1.y); p.y = cvt_pk_bf16(x1.z, x1.w); *(u32x2*)o = p;
                        p.x = cvt_pk_bf16(x2.x, x2.y); p.y = cvt_pk_bf16(x2.z, x2.w); *(u32x2*)(o + 16) = p; }
                }
            }
        } else if (u.pn <= 4) {
#pragma unroll
            EPI_LOOP_AM { const int row = row0 + ai * 128 + m * 16;
#pragma unroll
                for (int bj = 0; bj < 2; ++bj)
#pragma unroll
                    for (int n = 0; n < 2; ++n) *(f32x4*)(XR + (size_t)row * 512 + (u.pn - 3) * 256 + bj * 128 + wc * 32 + n * 16 + fq * 4) = acc[ai][bj][m][n]; }
        } else if (u.pn <= 6) {
#pragma unroll
            EPI_LOOP_AM { const int row = row0 + ai * 128 + m * 16;
#pragma unroll
                for (int bj = 0; bj < 2; ++bj)
#pragma unroll
                    for (int n = 0; n < 2; ++n) { const f32x4 v = acc[ai][bj][m][n]; u32x2 p; p.x = cvt_pk_bf16(gelu_tanh(v.x), gelu_tanh(v.y)); p.y = cvt_pk_bf16(gelu_tanh(v.z), gelu_tanh(v.w));
                        *(u32x2*)(GY + (size_t)row * 512 + (u.pn - 5) * 256 + bj * 128 + wc * 32 + n * 16 + fq * 4) = p; } }
        } else if (u.pn <= 8) {
#pragma unroll
            EPI_LOOP_AM { const int row = row0 + ai * 128 + m * 16; size_t seqoff; int L, t;
                if (latent) { const int b = (row - MP) >> 11; t = (row - MP) & 2047; L = LS; seqoff = (size_t)16 * 512 * LC + (size_t)b * 512 * LS; } else { const int b = row >> 8; t = row & 255; L = LC; seqoff = (size_t)b * 512 * LC; }
#pragma unroll
                for (int bj = 0; bj < 2; ++bj)
#pragma unroll
                    for (int n = 0; n < 2; ++n) { const f32x4 v = acc[ai][bj][m][n]; bf16_t* p = XFT + seqoff + (size_t)((u.pn - 7) * 256 + bj * 128 + wc * 32 + n * 16 + fq * 4) * L + t;
                        p[0] = f2bf(v.x); p[L] = f2bf(v.y); p[2 * L] = f2bf(v.z); p[3 * L] = f2bf(v.w); } }
        } else {
#pragma unroll
            for (int bj = 0; bj < 2; ++bj)
#pragma unroll
                for (int n = 0; n < 2; ++n) { const int col = (u.pn - 9) * 256 + bj * 128 + wc * 32 + n * 16 + fq * 4; const f32x4 b = *(const f32x4*)(bgate + col);
#pragma unroll
                    EPI_LOOP_AM { const int row = row0 + ai * 128 + m * 16; const f32x4 v = acc[ai][bj][m][n] + b;
                        u32x2 p; p.x = cvt_pk_bf16(sigmoidf_(v.x), sigmoidf_(v.y)); p.y = cvt_pk_bf16(sigmoidf_(v.z), sigmoidf_(v.w)); *(u32x2*)(G + (size_t)row * 3072 + col) = p; } }
        }
    }
};
template <int MODE> struct EpiBranch {
    static constexpr bool PERM = false, AFTER_DRAIN = false;
    bf16_t* MG; const bf16_t* G; int br;
    __device__ __forceinline__ void operator()(const f32x4 (&acc)[2][2][4][2], const Unit& u, int wr, int wc, int fr, int fq) const {
#pragma unroll
        EPI_LOOP_AM { const int row = u.pm * 256 + ai * 128 + wr * 64 + m * 16 + fr;
#pragma unroll
            for (int bj = 0; bj < 2; ++bj)
#pragma unroll
                for (int n = 0; n < 2; ++n) { const int col = u.pn * 256 + bj * 128 + wc * 32 + n * 16 + fq * 4;
                    const u32x2 g = *(const u32x2*)(G + (size_t)row * 3072 + br * 1024 + col); f32x4 v = acc[ai][bj][m][n];
                    v.x *= bflo(g.x); v.y *= bfhi(g.x); v.z *= bflo(g.y); v.w *= bfhi(g.y);
                    u32x2* p = (u32x2*)(MG + (size_t)row * D + col);
                    if (MODE == 1) { const u32x2 o = *p; v.x += bflo(o.x); v.y += bfhi(o.x); v.z += bflo(o.y); v.w += bfhi(o.y); }
                    u32x2 w; w.x = cvt_pk_bf16(v.x, v.y); w.y = cvt_pk_bf16(v.z, v.w); *p = w; }
            asm volatile("" ::: "memory"); }
    }
};
struct EpiDft {
    static constexpr bool PERM = false, AFTER_DRAIN = false;
    bf16_t* Z; int L, rowbase0;
    __device__ __forceinline__ void operator()(const f32x4 (&acc)[2][2][4][2], const Unit& u, int wr, int wc, int fr, int fq) const {
        const int pp = u.pm * 256, soff = (pp >= L) ? 512 : 0, p0 = (pp >= L) ? pp - L : pp;
#pragma unroll
        EPI_LOOP_AM { const int row = rowbase0 + u.z * L + p0 + ai * 128 + wr * 64 + m * 16 + fr;
#pragma unroll
            for (int bj = 0; bj < 2; ++bj)
#pragma unroll
                for (int n = 0; n < 2; ++n) { const f32x4 v = acc[ai][bj][m][n]; u32x2 w; w.x = cvt_pk_bf16(v.x, v.y); w.y = cvt_pk_bf16(v.z, v.w);
                    *(u32x2*)(Z + (size_t)row * D + soff + u.pn * 256 + bj * 128 + wc * 32 + n * 16 + fq * 4) = w; } }
    }
};

__device__ __forceinline__ void attn_naive_phase(ArgsP args, const Ctx& C, int l) {
    bf16_t* Q = (bf16_t*)act_ptr(C, A_Q); const bf16_t* Kb = (const bf16_t*)act_ptr(C, A_K); const bf16_t* VT = (const bf16_t*)act_ptr(C, A_VT);
    const bf16_t* CK = (const bf16_t*)(C.ws + OFF_CK); const bf16_t* CVT = (const bf16_t*)(C.ws + OFF_CVT);
    const int gw = C.bid * NWAVES + C.wave, NGW = C.G * NWAVES;
    for (int it = gw; it < (M / 64) * 8; it += NGW) {
        const int h = it & 7, row = (it >> 3) * 64 + C.lane, kvh = h >> 2;
        float q[64], o[64];
        { const u32x4* qp = (const u32x4*)(Q + (size_t)row * 512 + h * 64);
#pragma unroll
          for (int j = 0; j < 8; ++j) { const u32x4 w = qp[j]; q[8 * j] = bflo(w.x); q[8 * j + 1] = bfhi(w.x); q[8 * j + 2] = bflo(w.y); q[8 * j + 3] = bfhi(w.y); q[8 * j + 4] = bflo(w.z); q[8 * j + 5] = bfhi(w.z); q[8 * j + 6] = bflo(w.w); q[8 * j + 7] = bfhi(w.w); } }
#pragma unroll
        for (int d = 0; d < 64; ++d) o[d] = 0.f;
        float mx = args->in[20][l * 8 + h] * LOG2E, lsum = 1.0f;
        const bool latent = row >= MP;
        const int b = latent ? ((row - MP) >> 11) : (row >> 8), t = latent ? ((row - MP) & 2047) : (row & 255);
        for (int seg = 0; seg < (latent ? 2 : 1); ++seg) {
            const int nk = (seg == 1 || !latent) ? 256 : 257;
            for (int jj = 0; jj < nk; ++jj) {
                int j; bool ok = true; const bf16_t* kp; const bf16_t* vp; int L;
                if (seg == 1) { j = jj; kp = CK + ((size_t)(b * 2 + l) * 256 + j) * 128 + kvh * 64; vp = CVT + ((size_t)((b * 2 + l) * 2 + kvh) * 64) * 256 + j; L = 256; }
                else if (!latent) { j = jj; kp = Kb + ((size_t)(b * 256 + j)) * 128 + kvh * 64; vp = VT + (size_t)b * 128 * LC + (size_t)(kvh * 64) * LC + j; L = LC; }
                else { j = t - 128 + jj; ok = (j >= 0 && j < LS); const int jc = ok ? j : t; kp = Kb + ((size_t)(MP + b * LS + jc)) * 128 + kvh * 64; vp = VT + (size_t)16 * 128 * LC + (size_t)b * 128 * LS + (size_t)(kvh * 64) * LS + jc; L = LS; }
                float s = 0.f;
#pragma unroll
                for (int jq = 0; jq < 8; ++jq) { const u32x4 w = ((const u32x4*)kp)[jq];
                    s += q[8 * jq] * bflo(w.x) + q[8 * jq + 1] * bfhi(w.x) + q[8 * jq + 2] * bflo(w.y) + q[8 * jq + 3] * bfhi(w.y) + q[8 * jq + 4] * bflo(w.z) + q[8 * jq + 5] * bfhi(w.z) + q[8 * jq + 6] * bflo(w.w) + q[8 * jq + 7] * bfhi(w.w); }
                if (!ok) s = -1e30f;
                const float mn = fmaxf(mx, s), alpha = exp2f(mx - mn), p = exp2f(s - mn);
                lsum = lsum * alpha + p; mx = mn;
#pragma unroll
                for (int d = 0; d < 64; ++d) o[d] = o[d] * alpha + p * bf2f(vp[(size_t)d * L]);
            }
        }
        const float inv = 1.0f / lsum;
        u32x4* op = (u32x4*)(Q + (size_t)row * 512 + h * 64);
#pragma unroll
        for (int j = 0; j < 8; ++j) { u32x4 w; w.x = cvt_pk_bf16(o[8 * j] * inv, o[8 * j + 1] * inv); w.y = cvt_pk_bf16(o[8 * j + 2] * inv, o[8 * j + 3] * inv); w.z = cvt_pk_bf16(o[8 * j + 4] * inv, o[8 * j + 5] * inv); w.w = cvt_pk_bf16(o[8 * j + 6] * inv, o[8 * j + 7] * inv); op[j] = w; }
    }
}

__device__ __forceinline__ void lru_naive_phase(ArgsP args, const Ctx& C, int l) {
    const float* XR = (const float*)act_ptr(C, A_XR); const bf16_t* GY = (const bf16_t*)act_ptr(C, A_GY); bf16_t* REC = (bf16_t*)act_ptr(C, A_XN);
    const int gw = C.bid * NWAVES + C.wave, NGW = C.G * NWAVES;
    for (int it = gw; it < 20 * 8 * 2; it += NGW) {
        const int dir = it & 1, nb = (it >> 1) & 7, sq = it >> 4;
        const bool latent = sq < 4; const int b = latent ? sq : sq - 4, L = latent ? LS : LC, rowbase = latent ? MP + b * LS : b * LC;
        const int ch = nb * 64 + C.lane;
        float wa[64], wi[64];
        { const float* pa = args->in[24] + ((size_t)((l * 2 + dir) * 8 + nb) * 64) * 64 + C.lane; const float* pi = args->in[26] + ((size_t)((l * 2 + dir) * 8 + nb) * 64) * 64 + C.lane;
#pragma unroll
          for (int k = 0; k < 64; ++k) { wa[k] = pa[k * 64]; wi[k] = pi[k * 64]; } }
        const float ba = args->in[25][(l * 2 + dir) * 512 + ch], bi = args->in[27][(l * 2 + dir) * 512 + ch], lam = args->in[28][(l * 2 + dir) * 512 + ch];
        const float sp = log1pf(__expf(-lam));
        const float cw0 = args->in[22][(l * 4 + 0) * 512 + ch], cw1 = args->in[22][(l * 4 + 1) * 512 + ch], cw2 = args->in[22][(l * 4 + 2) * 512 + ch], cw3 = args->in[22][(l * 4 + 3) * 512 + ch], cb = args->in[23][l * 512 + ch];
        float h = latent ? args->in[5][((size_t)(b * 2 + l) * 2 + dir) * 512 + ch] : 0.f;
        for (int s = 0; s < L; ++s) {
            const int t = dir ? (L - 1 - s) : s;
            const float* xp = XR + (size_t)(rowbase + t) * 512 + ch;
            const float xm2 = (t >= 2) ? xp[-2 * 512] : 0.f, xm1 = (t >= 1) ? xp[-512] : 0.f, x0 = xp[0], xp1 = (t + 1 < L) ? xp[512] : 0.f;
            const float xc = cb + cw0 * xm2 + cw1 * xm1 + cw2 * x0 + cw3 * xp1;
            float ra = ba, ri = bi;
#pragma unroll
            for (int k = 0; k < 64; ++k) { const float xk = __shfl(xc, k); ra += xk * wa[k]; ri += xk * wi[k]; }
            const float r = sigmoidf_(ra), ig = sigmoidf_(ri);
            const float log_a = -8.0f * r * sp, a = __expf(log_a), bb = sqrtf(fmaxf(-expm1f(2.0f * log_a), 0.f)) * (ig * xc);
            h = a * h + bb;
            REC[(size_t)(rowbase + t) * D + dir * 512 + ch] = f2bf(h * bf2f(GY[(size_t)(rowbase + t) * 512 + ch]));
        }
        if (!latent) C.out[OUT_ST + ((size_t)(b * 2 + l) * 2 + dir) * 512 + ch] = h;
    }
}


typedef float f32x16 __attribute__((ext_vector_type(16)));
typedef short s16x4 __attribute__((ext_vector_type(4)));
#define MFMA32(a, b, c) __builtin_amdgcn_mfma_f32_32x32x16_bf16((a), (b), (c), 0, 0, 0)
constexpr int AT_KSTR = 144, AT_VSTR = 136, AT_KBYTES = 64 * AT_KSTR, AT_VBYTES = 64 * AT_VSTR, AT_BUF = AT_KBYTES + AT_VBYTES;
struct AttnSrc { const bf16_t* kp; const bf16_t* vp; int vstride; int kbase; };
__device__ __forceinline__ AttnSrc attn_src(int t, bool latent, int nband, int lo, int b, int l, int kvh, const bf16_t* Kb, const bf16_t* VT, const bf16_t* CK, const bf16_t* CVT) {
    AttnSrc s;
    if (!latent) { s.kp = Kb + (size_t)(b * LC + 64 * t) * 128 + kvh * 64; s.vp = VT + (size_t)b * 128 * LC + (size_t)(kvh * 64) * LC + 64 * t; s.vstride = LC; s.kbase = 0; }
    else if (t < nband) { const int kb = lo + 64 * t; s.kp = Kb + (size_t)(MP + b * LS + kb) * 128 + kvh * 64; s.vp = VT + (size_t)16 * 128 * LC + (size_t)b * 128 * LS + (size_t)(kvh * 64) * LS + kb; s.vstride = LS; s.kbase = kb; }
    else { const int c = t - nband; s.kp = CK + (size_t)((b * 2 + l) * 256 + 64 * c) * 128 + kvh * 64; s.vp = CVT + (size_t)((b * 2 + l) * 2 + kvh) * 64 * 256 + 64 * c; s.vstride = 256; s.kbase = 0; }
    return s;
}
__device__ __forceinline__ void attn_phase(ArgsP args, const Ctx& C, int l) {
    bf16_t* Q = (bf16_t*)act_ptr(C, A_Q); const bf16_t* Kb = (const bf16_t*)act_ptr(C, A_K); const bf16_t* VT = (const bf16_t*)act_ptr(C, A_VT);
    const bf16_t* CK = (const bf16_t*)(C.ws + OFF_CK); const bf16_t* CVT = (const bf16_t*)(C.ws + OFF_CVT);
    const int q32 = C.lane & 31, half = C.lane >> 5, w = C.wave;
    const int srow = C.tid >> 3, schunk = C.tid & 7;
    for (int ui = C.bid; ui < 256 + 128; ui += C.G) {
        const bool latent = ui < 256;
        int b, h, qb; if (latent) { b = ui >> 6; h = (ui >> 3) & 7; qb = ui & 7; } else { const int r = ui - 256; b = r >> 3; h = r & 7; qb = 0; }
        const int kvh = h >> 2, rowbase = latent ? (MP + b * LS + qb * 256) : b * LC;
        int lo = 0, nband = 4, nt = 4;
        if (latent) { lo = 256 * qb - 128; if (lo < 0) lo = 0; int hi = 256 * qb + 384; if (hi > LS) hi = LS; nband = (hi - lo) >> 6; nt = nband + 4; }
        const int qw_lo = qb * 256 + 32 * w, qpos = qw_lo + q32;
        bf16x8 qf[4];
        { const bf16_t* qp = Q + (size_t)(rowbase + 32 * w + q32) * 512 + h * 64 + 8 * half;
#pragma unroll
          for (int ks = 0; ks < 4; ++ks) qf[ks] = *(const bf16x8*)(qp + 16 * ks); }
        f32x16 O0, O1;
#pragma unroll
        for (int r = 0; r < 16; ++r) { O0[r] = 0.f; O1[r] = 0.f; }
        float mrun = args->in[20][l * 8 + h] * LOG2E, lsum = half ? 0.f : 1.0f;
        { const AttnSrc s0 = attn_src(0, latent, nband, lo, b, l, kvh, Kb, VT, CK, CVT);
          const u32x4 kreg = *(const u32x4*)(s0.kp + (size_t)srow * 128 + schunk * 8), vreg = *(const u32x4*)(s0.vp + (size_t)srow * s0.vstride + schunk * 8);
          *(LAS u32x4*)(C.lds + srow * AT_KSTR + schunk * 16) = kreg;
          LAS u32x2* vd = (LAS u32x2*)(C.lds + AT_KBYTES + srow * AT_VSTR + schunk * 16); vd[0] = (u32x2){vreg.x, vreg.y}; vd[1] = (u32x2){vreg.z, vreg.w}; }
        __syncthreads();
        for (int t = 0; t < nt; ++t) {
            const int buf = t & 1;
            u32x4 kreg, vreg; const bool more = (t + 1 < nt);
            if (more) { const AttnSrc s1 = attn_src(t + 1, latent, nband, lo, b, l, kvh, Kb, VT, CK, CVT);
                kreg = *(const u32x4*)(s1.kp + (size_t)srow * 128 + schunk * 8); vreg = *(const u32x4*)(s1.vp + (size_t)srow * s1.vstride + schunk * 8); }
            bool skip = false, domask = false;
            if (latent && t < nband) { const int kb = lo + 64 * t; skip = (kb > qw_lo + 31 + 128) || (kb + 63 < qw_lo - 128); domask = !((kb + 63 - qw_lo <= 128) && (qw_lo + 31 - kb <= 128)); }
            if (!skip) {
                const LAS unsigned char* kbp = C.lds + buf * AT_BUF; const LAS unsigned char* vbp = kbp + AT_KBYTES;
                f32x16 S0, S1;
#pragma unroll
                for (int r = 0; r < 16; ++r) { S0[r] = 0.f; S1[r] = 0.f; }
#pragma unroll
                for (int ks = 0; ks < 4; ++ks) { const bf16x8 k0 = *(const LAS bf16x8*)(kbp + q32 * AT_KSTR + ks * 32 + half * 16), k1 = *(const LAS bf16x8*)(kbp + (32 + q32) * AT_KSTR + ks * 32 + half * 16);
                    S0 = MFMA32(k0, qf[ks], S0); S1 = MFMA32(k1, qf[ks], S1); }
                if (domask) { const int kb = lo + 64 * t;
#pragma unroll
                    for (int r = 0; r < 16; ++r) { const int d0 = kb + (r & 3) + 8 * (r >> 2) + 4 * half - qpos, d1 = d0 + 32;
                        S0[r] = (d0 > 128 || d0 < -128) ? -1e30f : S0[r]; S1[r] = (d1 > 128 || d1 < -128) ? -1e30f : S1[r]; } }
                float mx = fmaxf(S0[0], S1[0]);
#pragma unroll
                for (int r = 1; r < 16; ++r) mx = fmaxf(mx, fmaxf(S0[r], S1[r]));
                mx = fmaxf(mx, __shfl_xor(mx, 32));
                const float mnew = fmaxf(mrun, mx), alpha = __builtin_amdgcn_exp2f(mrun - mnew); mrun = mnew;
                float ps = 0.f;
#pragma unroll
                for (int r = 0; r < 16; ++r) { S0[r] = __builtin_amdgcn_exp2f(S0[r] - mnew); S1[r] = __builtin_amdgcn_exp2f(S1[r] - mnew); ps += S0[r] + S1[r]; }
                lsum = lsum * alpha + ps;
#pragma unroll
                for (int r = 0; r < 16; ++r) { O0[r] *= alpha; O1[r] *= alpha; }
                bf16x8 pf[4];
#pragma unroll
                for (int s2 = 0; s2 < 2; ++s2) { u32x4 a, c2;
                    a.x = cvt_pk_bf16(S0[8 * s2 + 0], S0[8 * s2 + 1]); a.y = cvt_pk_bf16(S0[8 * s2 + 2], S0[8 * s2 + 3]); a.z = cvt_pk_bf16(S0[8 * s2 + 4], S0[8 * s2 + 5]); a.w = cvt_pk_bf16(S0[8 * s2 + 6], S0[8 * s2 + 7]);
                    c2.x = cvt_pk_bf16(S1[8 * s2 + 0], S1[8 * s2 + 1]); c2.y = cvt_pk_bf16(S1[8 * s2 + 2], S1[8 * s2 + 3]); c2.z = cvt_pk_bf16(S1[8 * s2 + 4], S1[8 * s2 + 5]); c2.w = cvt_pk_bf16(S1[8 * s2 + 6], S1[8 * s2 + 7]);
                    pf[s2] = __builtin_bit_cast(bf16x8, a); pf[2 + s2] = __builtin_bit_cast(bf16x8, c2); }
#pragma unroll
                for (int s4 = 0; s4 < 4; ++s4) {
                    const LAS unsigned char* v0p = vbp + q32 * AT_VSTR + s4 * 32 + half * 8; const LAS unsigned char* v1p = v0p + 32 * AT_VSTR;
                    const s16x4 a0 = *(const LAS s16x4*)v0p, a1 = *(const LAS s16x4*)(v0p + 16), b0 = *(const LAS s16x4*)v1p, b1 = *(const LAS s16x4*)(v1p + 16);
                    const bf16x8 vf0 = __builtin_shufflevector(a0, a1, 0, 1, 2, 3, 4, 5, 6, 7), vf1 = __builtin_shufflevector(b0, b1, 0, 1, 2, 3, 4, 5, 6, 7);
                    O0 = MFMA32(vf0, pf[s4], O0); O1 = MFMA32(vf1, pf[s4], O1); }
            }
            if (more) { *(LAS u32x4*)(C.lds + (buf ^ 1) * AT_BUF + srow * AT_KSTR + schunk * 16) = kreg;
                LAS u32x2* vd = (LAS u32x2*)(C.lds + (buf ^ 1) * AT_BUF + AT_KBYTES + srow * AT_VSTR + schunk * 16); vd[0] = (u32x2){vreg.x, vreg.y}; vd[1] = (u32x2){vreg.z, vreg.w}; }
            __syncthreads();
        }
        const float inv = 1.0f / (lsum + __shfl_xor(lsum, 32));
        bf16_t* op = Q + (size_t)(rowbase + 32 * w + q32) * 512 + h * 64 + 4 * half;
#pragma unroll
        for (int g = 0; g < 4; ++g) { u32x2 o; o.x = cvt_pk_bf16(O0[4 * g] * inv, O0[4 * g + 1] * inv); o.y = cvt_pk_bf16(O0[4 * g + 2] * inv, O0[4 * g + 3] * inv); *(u32x2*)(op + 8 * g) = o;
            o.x = cvt_pk_bf16(O1[4 * g] * inv, O1[4 * g + 1] * inv); o.y = cvt_pk_bf16(O1[4 * g + 2] * inv, O1[4 * g + 3] * inv); *(u32x2*)(op + 32 + 8 * g) = o; }
    }
}

constexpr int LR_XCB = 0, LR_WT = 18432, LR_BX = 36864, LR_AA = LR_BX + 128 * 272, LR_PH = LR_AA + 128 * 272, LR_CAR = LR_PH + 4096, LR_CONST = LR_CAR + 512, LR_END = LR_CONST + 768;
static_assert(LR_END <= 131072, "lru LDS map");
__device__ __forceinline__ void lru_phase(ArgsP args, const Ctx& C, int l) {
    const float* XR = (const float*)act_ptr(C, A_XR); const bf16_t* GY = (const bf16_t*)act_ptr(C, A_GY); bf16_t* REC = (bf16_t*)act_ptr(C, A_XN);
    LAS bf16_t* XCB = (LAS bf16_t*)(C.lds + LR_XCB); LAS bf16_t* WT = (LAS bf16_t*)(C.lds + LR_WT);
    LAS float* BX = (LAS float*)(C.lds + LR_BX); LAS float* AA = (LAS float*)(C.lds + LR_AA); LAS float* PH = (LAS float*)(C.lds + LR_PH);
    LAS float* CAR = (LAS float*)(C.lds + LR_CAR); LAS float* CST = (LAS float*)(C.lds + LR_CONST);
    const int ch = C.tid & 63, sub = C.wave, fr = C.lane & 15, fq = C.lane >> 4;
    for (int it = C.bid; it < 320; it += C.G) {
        const int dir = it & 1, nb = (it >> 1) & 7, sq = it >> 4;
        const bool latent = sq < 4; const int b = latent ? sq : sq - 4, L = latent ? LS : LC, rowbase = latent ? MP + b * LS : b * LC;
        __syncthreads();
        { const float* pa = args->in[24] + ((size_t)((l * 2 + dir) * 8 + nb) * 64) * 64; const float* pi = args->in[26] + ((size_t)((l * 2 + dir) * 8 + nb) * 64) * 64;
          for (int i = C.tid; i < 4096; i += NTHREADS) { const int k = i >> 6, n = i & 63; WT[n * 72 + k] = f2bf(pa[i]); WT[(64 + n) * 72 + k] = f2bf(pi[i]); } }
        if (C.tid < 64) { const int cg = (l * 2 + dir) * 512 + nb * 64 + C.tid; CST[C.tid] = args->in[25][cg]; CST[64 + C.tid] = args->in[27][cg]; CST[128 + C.tid] = -8.0f * log1pf(__expf(-args->in[28][cg]));
            CAR[C.tid] = latent ? args->in[5][((size_t)(b * 2 + l) * 2 + dir) * 512 + nb * 64 + C.tid] : 0.f; }
        const int cgl = nb * 64 + ch;
        const float cw0 = args->in[22][(l * 4 + 0) * 512 + cgl], cw1 = args->in[22][(l * 4 + 1) * 512 + cgl], cw2 = args->in[22][(l * 4 + 2) * 512 + cgl], cw3 = args->in[22][(l * 4 + 3) * 512 + cgl], cb = args->in[23][l * 512 + cgl];
        const int nch = L >> 7;
        float hfin = 0.f;
        for (int c = 0; c < nch; ++c) {
            const int t0 = dir ? (L - 128 * (c + 1)) : 128 * c;
            { const float* xp = XR + (size_t)(rowbase + t0) * 512 + cgl;
#pragma unroll 4
              for (int i = 0; i < 16; ++i) { const int e = sub + 8 * i, t = t0 + e; const float* x = xp + (size_t)e * 512;
                  const float xm2 = (t >= 2) ? x[-1024] : 0.f, xm1 = (t >= 1) ? x[-512] : 0.f, x0 = x[0], xp1 = (t + 1 < L) ? x[512] : 0.f;
                  const float xc = cb + cw0 * xm2 + cw1 * xm1 + cw2 * x0 + cw3 * xp1;
                  BX[e * 68 + ch] = xc; XCB[e * 72 + ch] = f2bf(xc); } }
            __syncthreads();
            { f32x4 acc[8];
#pragma unroll
              for (int nt = 0; nt < 8; ++nt) acc[nt] = (f32x4){0.f, 0.f, 0.f, 0.f};
              const int e = 16 * sub + fr;
#pragma unroll
              for (int kk = 0; kk < 2; ++kk) { const bf16x8 xf = *(const LAS bf16x8*)(XCB + e * 72 + 8 * fq + 32 * kk);
#pragma unroll
                  for (int nt = 0; nt < 8; ++nt) { const bf16x8 wf = *(const LAS bf16x8*)(WT + (16 * nt + fr) * 72 + 8 * fq + 32 * kk); acc[nt] = __builtin_amdgcn_mfma_f32_16x16x32_bf16(wf, xf, acc[nt], 0, 0, 0); } }
#pragma unroll
              for (int nt = 0; nt < 4; ++nt) { const int c0 = 16 * nt + 4 * fq; const f32x4 ba = *(const LAS f32x4*)(CST + c0), bi = *(const LAS f32x4*)(CST + 64 + c0), sp = *(const LAS f32x4*)(CST + 128 + c0);
                  const f32x4 xcv = *(const LAS f32x4*)(BX + e * 68 + c0); f32x4 av, bv;
#pragma unroll
                  for (int i = 0; i < 4; ++i) { const float r = sigmoidf_(acc[nt][i] + ba[i]), ig = sigmoidf_(acc[nt + 4][i] + bi[i]); const float la = r * sp[i], a = __expf(la), y = 2.0f * la;
                      const float om = (y > -0.05f) ? -y * (1.0f + 0.5f * y * (1.0f + (1.0f / 3.0f) * y * (1.0f + 0.25f * y))) : (1.0f - a * a);
                      av[i] = a; bv[i] = sqrtf(fmaxf(om, 0.f)) * (ig * xcv[i]); }
                  *(LAS f32x4*)(AA + e * 68 + c0) = av; *(LAS f32x4*)(BX + e * 68 + c0) = bv; } }
            __syncthreads();
            float av[16], bv[16], gy[16];
            { float P = 1.f, H = 0.f;
#pragma unroll
              for (int j = 0; j < 16; ++j) { const int sl = 16 * sub + j, e = dir ? 127 - sl : sl; av[j] = AA[e * 68 + ch]; bv[j] = BX[e * 68 + ch];
                  gy[j] = bf2f(GY[(size_t)(rowbase + t0 + e) * 512 + cgl]); H = av[j] * H + bv[j]; P *= av[j]; }
              PH[sub * 64 + ch] = P; PH[512 + sub * 64 + ch] = H; }
            __syncthreads();
            float h = CAR[(c & 1) * 64 + ch];
            for (int s2 = 0; s2 < sub; ++s2) h = PH[s2 * 64 + ch] * h + PH[512 + s2 * 64 + ch];
#pragma unroll
            for (int j = 0; j < 16; ++j) { const int sl = 16 * sub + j, e = dir ? 127 - sl : sl; h = av[j] * h + bv[j];
                REC[(size_t)(rowbase + t0 + e) * D + dir * 512 + cgl] = f2bf(h * gy[j]); }
            if (sub == 7) { CAR[((c + 1) & 1) * 64 + ch] = h; hfin = h; }
        }
        if (!latent && sub == 7) C.out[OUT_ST + ((size_t)(b * 2 + l) * 2 + dir) * 512 + cgl] = hfin;
    }
}

constexpr int N_PHASES = 28;
enum { K_P0 = 1, K_NORM = 2, K_GU = 4, K_RES = 8, K_IN = 16, K_ATTN = 32, K_LRU = 64, K_DFT = 128, K_BR = 256, K_ALL = 511 };
__host__ __device__ constexpr int kind_of_phase(int ph) {
    if (ph == 0) return K_P0;
    if (ph == N_PHASES - 1) return K_NORM;
    const int s = (ph - 1) % 13;
    return (s == 0 || s == 3 || s == 10) ? K_NORM : (s == 1 || s == 11) ? K_GU : (s == 2 || s == 12 || s == 9) ? K_RES : (s == 4) ? K_IN : (s == 5) ? K_ATTN : (s == 6) ? K_LRU : (s == 7) ? K_DFT : K_BR;
}
__host__ __device__ constexpr bool sync_after_phase(int ph) { const int s = (ph - 1) % 13; return !(ph >= 1 && ph < N_PHASES - 1 && (s == 5 || s == 6)); }

template <int KM>
__device__ __forceinline__ void run_phase(ArgsP args, const Ctx& C, int ph) {
    if (ph == 0) { if constexpr ((KM & K_P0) != 0) p0_prologue(args, C); return; }
    if (ph == N_PHASES - 1) { if constexpr ((KM & K_NORM) != 0) finalnorm_phase(args, C); return; }
    const int l = (ph - 1) / 13, s = (ph - 1) % 13;
    const float* MODB = (const float*)(C.ws + OFF_MOD);
    if (s == 0 || s == 3 || s == 10) { if constexpr ((KM & K_NORM) != 0) modnorm_phase(args, C, l, s == 0 ? 0 : (s == 3 ? 1 : 2)); }
    else if (s == 1 || s == 11) { if constexpr ((KM & K_GU) != 0) { StaticOrder S; S.init(M, 2 * DFF, C.G, C.bid, (const bf16_t*)act_ptr(C, A_XN), D, (const bf16_t*)wl_ptr(C, l, s == 1 ? WL_GU1 : WL_GU2), D);
        EpiGU E{(bf16_t*)act_ptr(C, A_G)}; GEMM(C, S, E, D, D, D); } }
    else if (s == 2 || s == 12) { if constexpr ((KM & K_RES) != 0) { StaticOrder S; S.init(M, D, C.G, C.bid, (const bf16_t*)act_ptr(C, A_G), DFF, (const bf16_t*)wl_ptr(C, l, s == 2 ? WL_D1 : WL_D2), DFF);
        EpiRes E{C.out, MODB, l, s == 2 ? 0 : 2, 0.5f}; GEMM(C, S, E, DFF, DFF, DFF); } }
    else if (s == 4) { if constexpr ((KM & K_IN) != 0) { StaticOrder S; S.init(M, NIN, C.G, C.bid, (const bf16_t*)act_ptr(C, A_XN), D, (const bf16_t*)wl_ptr(C, l, WL_IN), D);
        EpiIn E{(bf16_t*)act_ptr(C, A_Q), (bf16_t*)act_ptr(C, A_K), (bf16_t*)act_ptr(C, A_VT), (bf16_t*)act_ptr(C, A_GY), (bf16_t*)act_ptr(C, A_XFT), (bf16_t*)act_ptr(C, A_G),
                (float*)act_ptr(C, A_XR), C.out, (const float*)(C.ws + OFF_ROPE), args->in[19] + (size_t)l * 3072, l};
        GEMM(C, S, E, D, D, D); } }
    else if (s == 5) { if constexpr ((KM & K_ATTN) != 0) { if (USE_NAIVE_ATTN) attn_naive_phase(args, C, l); else attn_phase(args, C, l); } }
    else if (s == 6) { if constexpr ((KM & K_LRU) != 0) { if (USE_NAIVE_LRU) lru_naive_phase(args, C, l); else lru_phase(args, C, l); } }
    else if (s == 7) { if constexpr ((KM & K_DFT) != 0) {
        { DftOrder S{4, 16, LS, C.G, C.bid, (const bf16_t*)(C.ws + WS_DFTL), (const bf16_t*)act_ptr(C, A_XFT) + (size_t)16 * 512 * LC}; EpiDft E{(bf16_t*)act_ptr(C, A_Z), LS, MP}; GEMM(C, S, E, LS, LS, LS); }
        { DftOrder S{16, 2, LC, C.G, C.bid, (const bf16_t*)(C.ws + WS_DFTC), (const bf16_t*)act_ptr(C, A_XFT)}; EpiDft E{(bf16_t*)act_ptr(C, A_Z), LC, 0}; GEMM(C, S, E, LC, LC, LC); } } }
    else if (s == 8) { if constexpr ((KM & K_BR) != 0) {
        bf16_t* MG = (bf16_t*)act_ptr(C, A_XR); const bf16_t* G = (const bf16_t*)act_ptr(C, A_G);
        { StaticOrder S; S.init(M, D, C.G, C.bid, (const bf16_t*)act_ptr(C, A_Q), 512, (const bf16_t*)wl_ptr(C, l, WL_A), 512); EpiBranch<0> E{MG, G, 0}; GEMM(C, S, E, 512, 512, 512); }
        { StaticOrder S; S.init(M, D, C.G, C.bid, (const bf16_t*)act_ptr(C, A_XN), D, (const bf16_t*)wl_ptr(C, l, WL_L2), D); EpiBranch<1> E{MG, G, 1}; GEMM(C, S, E, D, D, D); }
        { StaticOrder S; S.init(M, D, C.G, C.bid, (const bf16_t*)act_ptr(C, A_Z), D, (const bf16_t*)wl_ptr(C, l, WL_F2), D); EpiBranch<1> E{MG, G, 2}; GEMM(C, S, E, D, D, D); } } }
    else if (s == 9) { if constexpr ((KM & K_RES) != 0) { StaticOrder S; S.init(M, D, C.G, C.bid, (const bf16_t*)act_ptr(C, A_XR), D, (const bf16_t*)wl_ptr(C, l, WL_O), D);
        EpiRes E{C.out, MODB, l, 1, 1.0f}; GEMM(C, S, E, D, D, D); } }
}

template <int KM>
__global__ void __launch_bounds__(NTHREADS, 2) fwd_kernel(Args args_byval) {
    extern __shared__ __attribute__((aligned(16))) unsigned char lds_raw[];
    ArgsP args0 = (ArgsP)__builtin_amdgcn_kernarg_segment_ptr();
    const int lo = args0->ph_lo, hi = args0->ph_hi;
    for (int ph = lo; ph < hi; ++ph) {
        ArgsP args = args0; asm volatile("" : "+s"(args));
        int tid = threadIdx.x; asm volatile("" : "+v"(tid));
        int bid = blockIdx.x; asm volatile("" : "+s"(bid));
        Ctx C; C.out = args->out; C.ws = args->ws; C.lds = (LAS unsigned char*)lds_raw;
        C.tid = tid; C.lane = tid & 63; C.wave = __builtin_amdgcn_readfirstlane(tid >> 6); C.bid = bid; C.G = gridDim.x;
        run_phase<KM>(args, C, ph);
        if constexpr (KM == K_ALL) { if (ph + 1 < hi && sync_after_phase(ph)) cooperative_groups::this_grid().sync(); }
    }
}

template <int KM> static void launch_kind(const Args& a, hipStream_t stream) {
    static bool attr = false;
    if (!attr) { if (hipFuncSetAttribute((const void*)fwd_kernel<KM>, hipFuncAttributeMaxDynamicSharedMemorySize, LDS_BYTES) != hipSuccess) fprintf(stderr, "hipFuncSetAttribute failed\n"); attr = true; }
    hipLaunchKernelGGL(fwd_kernel<KM>, dim3(256), dim3(NTHREADS), LDS_BYTES, stream, a);
}
extern "C" void kernel_launch(void* const* d_in, const int* in_sizes, int n_in, void* d_out, int out_size, void* d_ws, size_t ws_size, hipStream_t stream) {
    if (n_in != 32 || ws_size < WS_END) { fprintf(stderr, "kernel_launch: n_in %d ws %zu (need %zu)\n", n_in, ws_size, (size_t)WS_END); return; }
    Args a{};
    for (int i = 0; i < 32; ++i) a.in[i] = (const float*)d_in[i];
    a.out = (float*)d_out; a.ws = (unsigned char*)d_ws;
#if N_LAUNCH_MODE == 1
    static bool attr = false;
    if (!attr) { if (hipFuncSetAttribute((const void*)fwd_kernel<K_ALL>, hipFuncAttributeMaxDynamicSharedMemorySize, LDS_BYTES) != hipSuccess) fprintf(stderr, "hipFuncSetAttribute failed\n"); attr = true; }
    a.ph_lo = 0; a.ph_hi = N_PHASES;
    void* kargs[] = {&a};
    hipError_t e = hipLaunchCooperativeKernel((const void*)fwd_kernel<K_ALL>, dim3(256), dim3(NTHREADS), kargs, LDS_BYTES, stream);
    if (e != hipSuccess) fprintf(stderr, "cooperative launch failed: %s\n", hipGetErrorString(e));
#else
    for (int p = 0; p < N_PHASES; ++p) { a.ph_lo = p; a.ph_hi = p + 1;
        switch (kind_of_phase(p)) {
            case K_P0: launch_kind<K_P0>(a, stream); break; case K_NORM: launch_kind<K_NORM>(a, stream); break; case K_GU: launch_kind<K_GU>(a, stream); break;
            case K_RES: launch_kind<K_RES>(a, stream); break; case K_IN: launch_kind<K_IN>(a, stream); break; case K_ATTN: launch_kind<K_ATTN>(a, stream); break;
            case K_LRU: launch_kind<K_LRU>(a, stream); break; case K_DFT: launch_kind<K_DFT>(a, stream); break; default: launch_kind<K_BR>(a, stream); break; } }
#endif
}
```

```cpp
#include <hip/hip_runtime.h>
#include <hip/hip_cooperative_groups.h>
#include <cstdint>
#include <cstdio>

#ifndef N_LAUNCH_MODE
#define N_LAUNCH_MODE 1
#endif

#define LAS __attribute__((address_space(3)))
typedef unsigned short bf16_t;
typedef short bf16x8 __attribute__((ext_vector_type(8)));
typedef float f32x4 __attribute__((ext_vector_type(4)));
typedef float f32x2 __attribute__((ext_vector_type(2)));
typedef unsigned u32x4 __attribute__((ext_vector_type(4)));
typedef unsigned u32x2 __attribute__((ext_vector_type(2)));

constexpr int D = 1024, MP = 4096, MS = 8192, M = MP + MS, DFF = 2816, DEPTH = 2;
constexpr int LC = 256, LS = 2048;
constexpr int NB_C = 16, NB_S = 4;
constexpr int NIN = 2304 + 3072;
constexpr int NMOD = 9216;
constexpr float EPS = 1e-6f;
constexpr float LOG2E = 1.4426950408889634f;
constexpr float QSCALE = 0.125f * LOG2E;

constexpr size_t MiB = 1u << 20;
constexpr size_t SZ_WGU = (size_t)2 * DFF * D * 2, SZ_WD = (size_t)D * DFF * 2, SZ_WIN = (size_t)NIN * D * 2;
constexpr size_t SZ_WA = (size_t)D * 512 * 2, SZ_W1K = (size_t)D * D * 2;
constexpr size_t WL_GU1 = 0, WL_D1 = WL_GU1 + SZ_WGU, WL_GU2 = WL_D1 + SZ_WD, WL_D2 = WL_GU2 + SZ_WGU, WL_IN = WL_D2 + SZ_WD,
                 WL_A = WL_IN + SZ_WIN, WL_L2 = WL_A + SZ_WA, WL_F2 = WL_L2 + SZ_W1K, WL_O = WL_F2 + SZ_W1K, WL_SIZE = WL_O + SZ_W1K;
constexpr size_t WS_CTL = 0;
constexpr size_t WS_MISC = 1 * MiB;
constexpr size_t OFF_MOD = WS_MISC;
constexpr size_t OFF_ROPE = OFF_MOD + (size_t)2 * 5 * NMOD * 4;
constexpr size_t OFF_CK = OFF_ROPE + 2 * 1024 * 4;
constexpr size_t OFF_CVT = OFF_CK + (size_t)4 * 2 * 256 * 128 * 2;
constexpr size_t WS_DFTC = 3 * MiB;
constexpr size_t WS_DFTL = 4 * MiB;
constexpr size_t WS_W = 20 * MiB;
constexpr size_t WS_ACT = WS_W + 2 * WL_SIZE;
constexpr size_t A_G = 0;
constexpr size_t A_XN = 72 * MiB;
constexpr size_t A_XR = 96 * MiB;
constexpr size_t A_GY = 120 * MiB;
constexpr size_t A_XFT = 132 * MiB;
constexpr size_t A_Q = 144 * MiB;
constexpr size_t A_K = 156 * MiB;
constexpr size_t A_VT = 159 * MiB;
constexpr size_t A_Z = 162 * MiB;
constexpr size_t A_END = 186 * MiB;
constexpr size_t WS_END = WS_ACT + A_END;

constexpr int OUT_YS = MP * D, OUT_CK = M * D, OUT_CV = OUT_CK + 16 * 2 * 256 * 128, OUT_ST = OUT_CV + 16 * 2 * 256 * 128;

constexpr int NTHREADS = 512, NWAVES = 8;
constexpr int LDS_BYTES = 147456;

typedef __bf16 bf16x2_t __attribute__((ext_vector_type(2)));
__device__ __forceinline__ unsigned cvt_pk_bf16(float lo, float hi) { f32x2 v = {lo, hi}; bf16x2_t b = __builtin_convertvector(v, bf16x2_t); return __builtin_bit_cast(unsigned, b); }
__device__ __forceinline__ bf16_t f2bf(float f) { return (bf16_t)(cvt_pk_bf16(f, 0.f) & 0xffffu); }
__device__ __forceinline__ float bf2f(unsigned h) { return __uint_as_float(h << 16); }
__device__ __forceinline__ float bflo(unsigned w) { return __uint_as_float(w << 16); }
__device__ __forceinline__ float bfhi(unsigned w) { return __uint_as_float(w & 0xffff0000u); }
__device__ __forceinline__ float sigmoidf_(float x) { return 1.0f / (1.0f + __expf(-x)); }
__device__ __forceinline__ float siluf_(float x) { return x / (1.0f + __expf(-x)); }
__device__ __forceinline__ float gelu_tanh(float x) { const float u = 0.7978845608028654f * (x + 0.044715f * x * x * x); return x / (1.0f + __expf(-2.0f * u)); }
__device__ __forceinline__ float wave_sum(float v) {
#pragma unroll
    for (int o = 1; o < 64; o <<= 1) v += __shfl_xor(v, o);
    return v;
}
__device__ __forceinline__ int cond_of_row(int r) { return r < MP ? 4 : ((r - MP) >> 11); }

struct Args {
    const float* in[32];
    float* out;
    unsigned char* ws;
    int ph_lo, ph_hi;
};

typedef const __attribute__((address_space(4))) Args* ArgsP;
struct Ctx {
    float* out; unsigned char* ws; LAS unsigned char* lds;
    int tid, lane, wave, bid, G;
};
__device__ __forceinline__ unsigned char* wl_ptr(const Ctx& C, int l, size_t off) { return C.ws + WS_W + (size_t)l * WL_SIZE + off; }
__device__ __forceinline__ unsigned char* act_ptr(const Ctx& C, size_t off) { return C.ws + WS_ACT + off; }
__device__ __forceinline__ const float* mod_ptr(const Ctx& C, int l, int c, int sub, int which) { return (const float*)(C.ws + OFF_MOD) + ((size_t)(l * 5 + c) * NMOD + (sub * 3 + which) * D); }

__device__ __forceinline__ void p0_transpose_item(const float* W, int ldw, bf16_t* WT, int ldt, int drow0, int dcol0, int k0, int n0, LAS float* scr, int lane) {
#pragma unroll 8
    for (int i = 0; i < 32; ++i) { const int kk = 2 * i + (lane >> 5); scr[kk * 33 + (lane & 31)] = W[(size_t)(k0 + kk) * ldw + n0 + (lane & 31)]; }
    asm volatile("s_waitcnt lgkmcnt(0)" ::: "memory");
    const int c = lane & 7;
#pragma unroll
    for (int j = 0; j < 4; ++j) { const int n = (lane >> 3) + 8 * j; const LAS float* s = scr + (8 * c) * 33 + n;
        u32x4 o; o.x = cvt_pk_bf16(s[0 * 33], s[1 * 33]); o.y = cvt_pk_bf16(s[2 * 33], s[3 * 33]); o.z = cvt_pk_bf16(s[4 * 33], s[5 * 33]); o.w = cvt_pk_bf16(s[6 * 33], s[7 * 33]);
        *(u32x4*)(WT + (size_t)(drow0 + n) * ldt + dcol0 + k0 + 8 * c) = o; }
    asm volatile("s_waitcnt lgkmcnt(0)" ::: "memory");
}

__device__ __forceinline__ void p0_prologue(ArgsP args, const Ctx& C) {
    LAS float* SC = (LAS float*)C.lds;
    LAS float* TAB = (LAS float*)(C.lds + 20480);
    LAS float* SCR = (LAS float*)(C.lds + 32768);
    const float* c_in = args->in[2]; const float* cctx = args->in[6];
    for (int i = C.tid; i < 5 * 1024; i += NTHREADS) { const float v = (i < 4096) ? c_in[i] : cctx[i - 4096]; SC[i] = siluf_(v); }
    for (int i = C.tid; i < 2048; i += NTHREADS) TAB[i] = cospif((float)i * (1.0f / 1024.0f));
    __syncthreads();
    for (int it = C.bid; it < 288 + 128; it += C.G) {
        if (it < 288) {
            const int l = it / 144, j0 = (it % 144) * 64;
            const float* W = args->in[7] + (size_t)l * D * NMOD + j0 + C.lane;
            float a0 = 0.f, a1 = 0.f, a2 = 0.f, a3 = 0.f, a4 = 0.f;
            const int kb = C.wave * 128;
#pragma unroll 8
            for (int k = 0; k < 128; ++k) { const float w = W[(size_t)(kb + k) * NMOD];
                a0 += SC[kb + k] * w; a1 += SC[1024 + kb + k] * w; a2 += SC[2048 + kb + k] * w; a3 += SC[3072 + kb + k] * w; a4 += SC[4096 + kb + k] * w; }
            SCR[(C.wave * 5 + 0) * 64 + C.lane] = a0; SCR[(C.wave * 5 + 1) * 64 + C.lane] = a1; SCR[(C.wave * 5 + 2) * 64 + C.lane] = a2;
            SCR[(C.wave * 5 + 3) * 64 + C.lane] = a3; SCR[(C.wave * 5 + 4) * 64 + C.lane] = a4;
            __syncthreads();
            if (C.tid < 320) { const int c = C.tid >> 6, j = C.tid & 63; float s = args->in[8][(size_t)l * NMOD + j0 + j];
#pragma unroll
                for (int w = 0; w < 8; ++w) s += SCR[(w * 5 + c) * 64 + j];
                ((float*)(C.ws + OFF_MOD))[(size_t)(l * 5 + c) * NMOD + j0 + j] = s; }
            __syncthreads();
        } else {
            const int r = it - 288, l = r >> 6, g = (r >> 4) & 3, n0 = (r & 15) * 64;
            const float* Wf = args->in[30] + (size_t)l * 512 * D + (size_t)(g * 128) * D + n0;
            for (int i = C.tid; i < 128 * 64; i += NTHREADS) SCR[i] = Wf[(size_t)(i >> 6) * D + (i & 63)];
            __syncthreads();
            const int n = C.tid & 63, cw = C.tid >> 6;
            bf16_t* dst = (bf16_t*)wl_ptr(C, l, WL_F2) + (size_t)(n0 + n) * D + g * 128;
            const float s = 0.08838834764831845f;
            for (int j = 0; j < 16; ++j) { const int c = cw + 8 * j; float ac = 0.f, as = 0.f;
#pragma unroll 8
                for (int q = 0; q < 128; ++q) { const int idx = ((q * c) & 127) * 16; const float w = SCR[q * 64 + n];
                    ac += TAB[idx] * w; as += TAB[(idx - 512) & 2047] * w; }
                dst[c] = f2bf(ac * s); dst[512 + c] = f2bf(-as * s); }
            __syncthreads();
        }
    }
    __syncthreads();
    {
        LAS float* scr = SCR + C.wave * (64 * 33);
        const int gw = C.bid * NWAVES + C.wave, NGW = C.G * NWAVES;
        constexpr int I_G = 16 * 88, I_D = 44 * 32, I_IN = 16 * 72, I_BG = 16 * 96, I_A = 8 * 32, I_L = 8 * 32, I_O = 16 * 32;
        constexpr int PER_LAYER = 4 * I_G + 2 * I_D + I_IN + I_BG + I_A + I_L + I_O;
        for (int it = gw; it < 2 * PER_LAYER; it += NGW) {
            const int l = it / PER_LAYER; int r = it % PER_LAYER;
            if (r < I_G) { const int kb = r / 88, n0 = (r % 88) * 32; p0_transpose_item(args->in[11] + (size_t)l * D * DFF, DFF, (bf16_t*)wl_ptr(C, l, WL_GU1), D, 256 * (n0 >> 7) + (n0 & 127), 0, kb * 64, n0, scr, C.lane); continue; } r -= I_G;
            if (r < I_G) { const int kb = r / 88, n0 = (r % 88) * 32; p0_transpose_item(args->in[12] + (size_t)l * D * DFF, DFF, (bf16_t*)wl_ptr(C, l, WL_GU1), D, 256 * (n0 >> 7) + 128 + (n0 & 127), 0, kb * 64, n0, scr, C.lane); continue; } r -= I_G;
            if (r < I_D) { const int kb = r / 32, nb = r % 32; p0_transpose_item(args->in[13] + (size_t)l * DFF * D, D, (bf16_t*)wl_ptr(C, l, WL_D1), DFF, nb * 32, 0, kb * 64, nb * 32, scr, C.lane); continue; } r -= I_D;
            if (r < I_G) { const int kb = r / 88, n0 = (r % 88) * 32; p0_transpose_item(args->in[14] + (size_t)l * D * DFF, DFF, (bf16_t*)wl_ptr(C, l, WL_GU2), D, 256 * (n0 >> 7) + (n0 & 127), 0, kb * 64, n0, scr, C.lane); continue; } r -= I_G;
            if (r < I_G) { const int kb = r / 88, n0 = (r % 88) * 32; p0_transpose_item(args->in[15] + (size_t)l * D * DFF, DFF, (bf16_t*)wl_ptr(C, l, WL_GU2), D, 256 * (n0 >> 7) + 128 + (n0 & 127), 0, kb * 64, n0, scr, C.lane); continue; } r -= I_G;
            if (r < I_D) { const int kb = r / 32, nb = r % 32; p0_transpose_item(args->in[16] + (size_t)l * DFF * D, D, (bf16_t*)wl_ptr(C, l, WL_D2), DFF, nb * 32, 0, kb * 64, nb * 32, scr, C.lane); continue; } r -= I_D;
            if (r < I_IN) { const int kb = r / 72, nb = r % 72; p0_transpose_item(args->in[17] + (size_t)l * D * 2304, 2304, (bf16_t*)wl_ptr(C, l, WL_IN), D, nb * 32, 0, kb * 64, nb * 32, scr, C.lane); continue; } r -= I_IN;
            if (r < I_BG) { const int kb = r / 96, nb = r % 96; p0_transpose_item(args->in[18] + (size_t)l * D * 3072, 3072, (bf16_t*)wl_ptr(C, l, WL_IN), D, 2304 + nb * 32, 0, kb * 64, nb * 32, scr, C.lane); continue; } r -= I_BG;
            if (r < I_A) { const int kb = r / 32, nb = r % 32; p0_transpose_item(args->in[21] + (size_t)l * 512 * D, D, (bf16_t*)wl_ptr(C, l, WL_A), 512, nb * 32, 0, kb * 64, nb * 32, scr, C.lane); continue; } r -= I_A;
            if (r < I_L) { const int kb = r / 32, nb = r % 32;
                p0_transpose_item(args->in[29] + (size_t)l * 512 * D, D, (bf16_t*)wl_ptr(C, l, WL_L2), D, nb * 32, 0, kb * 64, nb * 32, scr, C.lane);
                p0_transpose_item(args->in[29] + (size_t)l * 512 * D, D, (bf16_t*)wl_ptr(C, l, WL_L2), D, nb * 32, 512, kb * 64, nb * 32, scr, C.lane); continue; } r -= I_L;
            { const int kb = r / 32, nb = r % 32; p0_transpose_item(args->in[31] + (size_t)l * D * D, D, (bf16_t*)wl_ptr(C, l, WL_O), D, nb * 32, 0, kb * 64, nb * 32, scr, C.lane); }
        }
    }
    const int gt = C.bid * NTHREADS + C.tid, NGT = C.G * NTHREADS;
    for (int i = gt; i < M * D / 4; i += NGT) { const f32x4 v = (i < MP * D / 4) ? ((const f32x4*)args->in[0])[i] : ((const f32x4*)args->in[1])[i - MP * D / 4]; ((f32x4*)C.out)[i] = v; }
    for (int i = gt; i < 4096 * 256; i += NGT) { const int pr = i >> 8, t0 = (i & 255) * 8, p = pr & 2047, sh = (pr >= 2048) ? 512 : 0; const float s = 0.022097086912079608f;
        float v[8];
#pragma unroll
        for (int j = 0; j < 8; ++j) v[j] = TAB[((p * (t0 + j)) - sh) & 2047] * s;
        u32x4 o; o.x = cvt_pk_bf16(v[0], v[1]); o.y = cvt_pk_bf16(v[2], v[3]); o.z = cvt_pk_bf16(v[4], v[5]); o.w = cvt_pk_bf16(v[6], v[7]);
        *(u32x4*)((bf16_t*)(C.ws + WS_DFTL) + (size_t)pr * 2048 + t0) = o; }
    for (int i = gt; i < 512 * 32; i += NGT) { const int pr = i >> 5, t0 = (i & 31) * 8, p = pr & 255, sh = (pr >= 256) ? 512 : 0; const float s = 0.0625f;
        float v[8];
#pragma unroll
        for (int j = 0; j < 8; ++j) v[j] = TAB[((p * (t0 + j) * 8) - sh) & 2047] * s;
        u32x4 o; o.x = cvt_pk_bf16(v[0], v[1]); o.y = cvt_pk_bf16(v[2], v[3]); o.z = cvt_pk_bf16(v[4], v[5]); o.w = cvt_pk_bf16(v[6], v[7]);
        *(u32x4*)((bf16_t*)(C.ws + WS_DFTC) + (size_t)pr * 256 + t0) = o; }
    for (int i = gt; i < 1024; i += NGT) { const int pos = i >> 4, f = i & 15; const float inv = exp2f(-(float)f * (13.287712379549449f / 16.0f)); const float ang = (float)pos * inv; const float af = (float)((double)ang * 0.3183098861837907);
        ((float*)(C.ws + OFF_ROPE))[i] = cospif(af); ((float*)(C.ws + OFF_ROPE))[1024 + i] = sinpif(af); }
    for (int i = gt; i < 4 * 2 * 256 * 128; i += NGT) { ((bf16_t*)(C.ws + OFF_CK))[i] = f2bf(args->in[3][i]);
        const int d = i & 63, kvh = (i >> 6) & 1, t = (i >> 7) & 255, bl = i >> 15;
        ((bf16_t*)(C.ws + OFF_CVT))[((size_t)(bl * 2 + kvh) * 64 + d) * 256 + t] = f2bf(args->in[4][i]); }
}

__device__ __forceinline__ void modnorm_phase(ArgsP args, const Ctx& C, int l, int sub) {
    const int gw = C.bid * NWAVES + C.wave, NGW = C.G * NWAVES;
    const float* nw = args->in[9] + (size_t)(l * 3 + sub) * D;
    bf16_t* XN = (bf16_t*)act_ptr(C, A_XN);
    for (int r = gw; r < M; r += NGW) {
        const int c = cond_of_row(r);
        const float* sh = mod_ptr(C, l, c, sub, 0); const float* sc = mod_ptr(C, l, c, sub, 1);
        const f32x4* xr = (const f32x4*)(C.out + (size_t)r * D) + C.lane;
        f32x4 v[4]; float s = 0.f;
#pragma unroll
        for (int j = 0; j < 4; ++j) { v[j] = xr[64 * j]; s += (v[j].x * v[j].x + v[j].y * v[j].y) + (v[j].z * v[j].z + v[j].w * v[j].w); }
        const float rstd = rsqrtf(wave_sum(s) * (1.0f / D) + EPS);
        u32x2* o = (u32x2*)(XN + (size_t)r * D) + C.lane;
#pragma unroll
        for (int j = 0; j < 4; ++j) { const int col = 4 * C.lane + 256 * j; const f32x4 w = *(const f32x4*)(nw + col), a = *(const f32x4*)(sc + col), b = *(const f32x4*)(sh + col);
            f32x4 y = v[j] * rstd * w * (a + 1.0f) + b; u32x2 p; p.x = cvt_pk_bf16(y.x, y.y); p.y = cvt_pk_bf16(y.z, y.w); o[64 * j] = p; }
    }
}
__device__ __forceinline__ void finalnorm_phase(ArgsP args, const Ctx& C) {
    const int gw = C.bid * NWAVES + C.wave, NGW = C.G * NWAVES;
    const float* nw = args->in[10];
    for (int r = gw; r < M; r += NGW) {
        f32x4* xr = (f32x4*)(C.out + (size_t)r * D) + C.lane;
        f32x4 v[4]; float s = 0.f;
#pragma unroll
        for (int j = 0; j < 4; ++j) { v[j] = xr[64 * j]; s += (v[j].x * v[j].x + v[j].y * v[j].y) + (v[j].z * v[j].z + v[j].w * v[j].w); }
        const float rstd = rsqrtf(wave_sum(s) * (1.0f / D) + EPS);
#pragma unroll
        for (int j = 0; j < 4; ++j) { const f32x4 w = *(const f32x4*)(nw + 4 * C.lane + 256 * j); xr[64 * j] = v[j] * rstd * w; }
    }
}

struct Unit { int pm, pn, z; const bf16_t* A; const bf16_t* B; };

struct StaticOrder {
    int nM, nN, nwg, G, c; const bf16_t* A; const bf16_t* B; int lda, ldb;
    __device__ void init(int Mr, int N, int G_, int c_, const bf16_t* A_, int lda_, const bf16_t* B_, int ldb_) { nM = Mr / 256; nN = N / 256; nwg = nM * nN; G = G_; c = c_; A = A_; B = B_; lda = lda_; ldb = ldb_; }
    __device__ bool next(int i, Unit& u) const {
        const long L = (long)i * G + c; if (L >= nwg) return false;
        int wgid = (int)L; { const int q = nwg / 8, r = nwg % 8, xcd = wgid % 8, off = wgid / 8; wgid = (xcd < r ? xcd * (q + 1) : r * (q + 1) + (xcd - r) * q) + off; }
        const int nig = 8 * nN, gid = wgid / nig, fm = gid * 8, gsz = (nM - fm) < 8 ? (nM - fm) : 8;
        u.pm = fm + ((wgid % nig) % gsz); u.pn = (wgid % nig) / gsz; u.z = 0;
        u.A = A + (size_t)u.pm * 256 * lda; u.B = B + (size_t)u.pn * 256 * ldb; return true;
    }
};
struct DftOrder {
    int nseq, nPm, L, G, c; const bf16_t* A; const bf16_t* XFT;
    __device__ bool next(int i, Unit& u) const {
        const int idx = i * G + c; if (idx >= nseq * nPm * 2) return false;
        u.z = idx / (nPm * 2); const int r = idx % (nPm * 2); u.pm = r >> 1; u.pn = r & 1;
        u.A = A + (size_t)u.pm * 256 * L; u.B = XFT + ((size_t)u.z * 512 + u.pn * 256) * L; return true;
    }
};

template <class Epi, class Sched>
__device__ __forceinline__ void gemm_simple(const Ctx& C, const Sched& S, const Epi& E, int lda, int ldb, int K) {
    const int wr = C.wave >> 2, wc = C.wave & 3, fr = C.lane & 15, fq = C.lane >> 4;
    Unit u;
    for (int ui = 0; S.next(ui, u); ++ui) {
        f32x4 acc[2][2][4][2];
#pragma unroll
        for (int a = 0; a < 2; ++a)
#pragma unroll
            for (int b = 0; b < 2; ++b)
#pragma unroll
                for (int m = 0; m < 4; ++m)
#pragma unroll
                    for (int n = 0; n < 2; ++n) acc[a][b][m][n] = (f32x4){0.f, 0.f, 0.f, 0.f};
        const bf16_t* pa = u.A + (size_t)(wr * 64 + fr) * lda + fq * 8;
        const bf16_t* pb = u.B + (size_t)(wc * 32 + fr) * ldb + fq * 8;
        for (int k0 = 0; k0 < K; k0 += 32) {
            bf16x8 At[2][4], Bt[2][2];
#pragma unroll
            for (int a = 0; a < 2; ++a)
#pragma unroll
                for (int m = 0; m < 4; ++m) At[a][m] = *(const bf16x8*)(pa + (size_t)(a * 128 + m * 16) * lda + k0);
#pragma unroll
            for (int b = 0; b < 2; ++b)
#pragma unroll
                for (int n = 0; n < 2; ++n) Bt[b][n] = *(const bf16x8*)(pb + (size_t)(b * 128 + n * 16) * ldb + k0);
#pragma unroll
            for (int a = 0; a < 2; ++a)
#pragma unroll
                for (int b = 0; b < 2; ++b)
#pragma unroll
                    for (int m = 0; m < 4; ++m)
#pragma unroll
                        for (int n = 0; n < 2; ++n) acc[a][b][m][n] = __builtin_amdgcn_mfma_f32_16x16x32_bf16(Bt[b][n], At[a][m], acc[a][b][m][n], 0, 0, 0);
        }
        E(acc, u, wr, wc, fr, fq);
    }
}

namespace pg8 {
#define PG8_LAS __attribute__((address_space(3)))
constexpr int BM = 256, BK = 64, HALF = 128, HTB = HALF * BK * 2  , STAGE_BYTES = 8 * HTB, NXCD = 8, WGM = 8;

__host__ __device__ __forceinline__ int lds_byte(int r, int c) { const int st = (r >> 4) * 2 + (c >> 5), rr = r & 15, cc = c & 31, ob = rr * 64 + cc * 2; return st * 1024 + (ob ^ (((ob >> 9) & 1) << 5)); }
__host__ __device__ __forceinline__ void stage_rc(int b, int& R, int& C) { const int st = b / 1024, sb = b % 1024, swz = sb ^ (((sb >> 9) & 1) << 5); R = (st >> 1) * 16 + swz / 64; C = (st & 1) * 32 + (swz % 64) / 2; }
__host__ __device__ __forceinline__ int perm32(int rho) { const int n = rho >> 4, i = rho & 15; return 8 * (i >> 2) + 4 * n + (i & 3); }
template <class Epi, class Sched, bool ALIGN_EPI = true, bool SP2 = true>
__device__ __forceinline__ void gemm_phase(PG8_LAS unsigned char* lds, const int tid, const Sched& S, const Epi& E, const int lda, const int ldb, const int K) {
    const int wid = __builtin_amdgcn_readfirstlane(tid >> 6), lane = tid & 63, wr = wid >> 2, wc = wid & 3, fr = lane & 15, fq = lane >> 4;
    const int nt = K / BK;
    unsigned voffA[2], voffB[2];
#pragma unroll
    for (int i = 0; i < 2; ++i) { int R, C; stage_rc(tid * 16 + i * 8192, R, C); const int Rb = Epi::PERM ? ((R & ~31) + perm32(R & 31)) : R;
        voffA[i] = (unsigned)(R * lda + C) * 2u; voffB[i] = (unsigned)(Rb * ldb + C) * 2u; }
    const size_t kstep = (size_t)(BK * 2);
    const size_t hstepA = (size_t)HALF * lda * 2, hstepB = (size_t)HALF * ldb * 2;
    const unsigned ldsw = (unsigned)wid * 1024u;
    const int aoff = lds_byte(wr * 64 + fr, fq * 8), boff = lds_byte(wc * 32 + fr, fq * 8);
#define PG8_SA(b, h) (((b) * 2 + (h)) * HTB)
#define PG8_SB(b, h) ((4 + (b) * 2 + (h)) * HTB)
#define PG8_STAGE(bufoff, gbase, voff) do { _Pragma("unroll") for (int _i = 0; _i < 2; ++_i) \
        __builtin_amdgcn_global_load_lds((const unsigned*)((const char*)(gbase) + (voff)[_i]), (PG8_LAS unsigned*)(lds + (bufoff) + ldsw + _i * 8192), 16, 0, 0); } while (0)
#define PG8_LDA(dst, b, h) do { _Pragma("unroll") for (int m = 0; m < 4; ++m) _Pragma("unroll") for (int k = 0; k < 2; ++k) dst[m][k] = *(const PG8_LAS bf16x8*)(lds + PG8_SA(b, h) + aoff + m * 2048 + k * 1024); } while (0)
#define PG8_LDB(dst, b, h) do { _Pragma("unroll") for (int n = 0; n < 2; ++n) _Pragma("unroll") for (int k = 0; k < 2; ++k) dst[n][k] = *(const PG8_LAS bf16x8*)(lds + PG8_SB(b, h) + boff + n * 2048 + k * 1024); } while (0)
#define PG8_MMA(ai, bj, At, Bt) do { __builtin_amdgcn_s_setprio(1); _Pragma("unroll") for (int m = 0; m < 4; ++m) _Pragma("unroll") for (int n = 0; n < 2; ++n) _Pragma("unroll") for (int k = 0; k < 2; ++k) \
        acc[ai][bj][m][n] = __builtin_amdgcn_mfma_f32_16x16x32_bf16(Bt[n][k], At[m][k], acc[ai][bj][m][n], 0, 0, 0); __builtin_amdgcn_s_setprio(0); } while (0)
#define PG8_WAIT_V(n) asm volatile("s_waitcnt vmcnt(" #n ")" ::: "memory")
#define PG8_WAIT_L(n) asm volatile("s_waitcnt lgkmcnt(" #n ")" ::: "memory")
#define PG8_BAR __builtin_amdgcn_s_barrier()
#define PG8_SCHED __builtin_amdgcn_sched_barrier(0)
    Unit cur, nxt; int ui = 0;
    if (!S.next(0, cur)) return;
    f32x4 acc[2][2][4][2];
#pragma unroll
    for (int a = 0; a < 2; ++a)
#pragma unroll
        for (int b = 0; b < 2; ++b)
#pragma unroll
            for (int m = 0; m < 4; ++m)
#pragma unroll
                for (int n = 0; n < 2; ++n) acc[a][b][m][n] = (f32x4){0.f, 0.f, 0.f, 0.f};
    bf16x8 At[4][2], B0[2][2], B1[2][2];
    const char* cA = (const char*)cur.A; const char* cB = (const char*)cur.B;
    if constexpr (SP2) {
        PG8_STAGE(PG8_SB(0, 0), cB, voffB); PG8_STAGE(PG8_SB(0, 1), cB + hstepB, voffB); PG8_STAGE(PG8_SA(0, 0), cA, voffA); PG8_STAGE(PG8_SA(0, 1), cA + hstepA, voffA);
        if (wr == 1) PG8_BAR;
        PG8_WAIT_V(2); PG8_BAR;
        PG8_STAGE(PG8_SB(1, 0), cB + kstep, voffB); PG8_STAGE(PG8_SA(1, 0), cA + kstep, voffA); PG8_STAGE(PG8_SB(1, 1), cB + hstepB + kstep, voffB);
        PG8_WAIT_V(6); PG8_BAR;
    } else {
        PG8_STAGE(PG8_SB(0, 0), cB, voffB); PG8_STAGE(PG8_SA(0, 0), cA, voffA); PG8_STAGE(PG8_SB(0, 1), cB + hstepB, voffB); PG8_STAGE(PG8_SA(0, 1), cA + hstepA, voffA);
        if (wr == 1) PG8_BAR;
        PG8_WAIT_V(4); PG8_BAR;
        PG8_STAGE(PG8_SB(1, 0), cB + kstep, voffB); PG8_STAGE(PG8_SA(1, 0), cA + kstep, voffA); PG8_STAGE(PG8_SB(1, 1), cB + hstepB + kstep, voffB);
        PG8_WAIT_V(6); PG8_BAR;
    }
    for (;;) {
        const bool has_next = S.next(ui + 1, nxt);
        const char* nA = has_next ? (const char*)nxt.A : cA; const char* nB = has_next ? (const char*)nxt.B : cB;
        for (int t = 0; t < nt; t += 2) {
            const bool last = (t == nt - 2);
            const char* a1 = cA + (size_t)(t + 1) * kstep;
            const char* a2 = last ? nA : cA + (size_t)(t + 2) * kstep; const char* b2 = last ? nB : cB + (size_t)(t + 2) * kstep;
            const char* a3 = a2 + kstep; const char* b3 = b2 + kstep;
            if constexpr (SP2) {
            PG8_LDB(B0, 0, 0); PG8_LDB(B1, 0, 1); PG8_SCHED; PG8_LDA(At, 0, 0); PG8_STAGE(PG8_SA(1, 1), a1 + hstepA, voffA);
            PG8_WAIT_V(8); PG8_WAIT_L(0); PG8_BAR; PG8_MMA(0, 0, At, B0); PG8_MMA(0, 1, At, B1); PG8_BAR; PG8_SCHED;
            PG8_LDA(At, 0, 1); PG8_STAGE(PG8_SB(0, 0), b2, voffB); PG8_STAGE(PG8_SB(0, 1), b2 + hstepB, voffB); PG8_STAGE(PG8_SA(0, 0), a2, voffA);
            PG8_WAIT_V(8); PG8_WAIT_L(0); PG8_BAR; PG8_MMA(1, 0, At, B0); PG8_MMA(1, 1, At, B1); PG8_BAR; PG8_SCHED;
            PG8_LDB(B0, 1, 0); PG8_LDB(B1, 1, 1); PG8_SCHED; PG8_LDA(At, 1, 0); PG8_STAGE(PG8_SA(0, 1), a2 + hstepA, voffA);
            PG8_WAIT_V(8); PG8_WAIT_L(0); PG8_BAR; PG8_MMA(0, 0, At, B0); PG8_MMA(0, 1, At, B1); PG8_BAR; PG8_SCHED;
            PG8_LDA(At, 1, 1); PG8_STAGE(PG8_SB(1, 0), b3, voffB); PG8_STAGE(PG8_SB(1, 1), b3 + hstepB, voffB); PG8_STAGE(PG8_SA(1, 0), a3, voffA);
            PG8_WAIT_V(8); PG8_WAIT_L(0); PG8_BAR; PG8_MMA(1, 0, At, B0); PG8_MMA(1, 1, At, B1); PG8_BAR; PG8_SCHED;
            } else {
            PG8_LDB(B0, 0, 0); PG8_SCHED; PG8_LDA(At, 0, 0); PG8_STAGE(PG8_SA(1, 1), a1 + hstepA, voffA);
            PG8_WAIT_L(8); PG8_BAR; PG8_WAIT_L(0); PG8_MMA(0, 0, At, B0); PG8_BAR; PG8_SCHED;
            PG8_LDB(B1, 0, 1); PG8_STAGE(PG8_SB(0, 0), b2, voffB);
            PG8_BAR; PG8_WAIT_L(0); PG8_MMA(0, 1, At, B1); PG8_BAR;
            PG8_LDA(At, 0, 1); PG8_STAGE(PG8_SA(0, 0), a2, voffA);
            PG8_BAR; PG8_WAIT_L(0); PG8_MMA(1, 0, At, B0); PG8_BAR; PG8_SCHED;
            PG8_STAGE(PG8_SB(0, 1), b2 + hstepB, voffB);
            PG8_WAIT_V(6); PG8_BAR; PG8_MMA(1, 1, At, B1); PG8_BAR;
            PG8_LDB(B0, 1, 0); PG8_SCHED; PG8_LDA(At, 1, 0); PG8_STAGE(PG8_SA(0, 1), a2 + hstepA, voffA);
            PG8_WAIT_L(8); PG8_BAR; PG8_WAIT_L(0); PG8_MMA(0, 0, At, B0); PG8_BAR; PG8_SCHED;
            PG8_LDB(B1, 1, 1); PG8_STAGE(PG8_SB(1, 0), b3, voffB);
            PG8_BAR; PG8_WAIT_L(0); PG8_MMA(0, 1, At, B1); PG8_BAR;
            PG8_LDA(At, 1, 1); PG8_STAGE(PG8_SA(1, 0), a3, voffA);
            PG8_BAR; PG8_WAIT_L(0); PG8_MMA(1, 0, At, B0); PG8_BAR; PG8_SCHED;
            PG8_STAGE(PG8_SB(1, 1), b3 + hstepB, voffB);
            PG8_WAIT_V(6); PG8_BAR; PG8_MMA(1, 1, At, B1); PG8_BAR;
            }
        }
        if constexpr (ALIGN_EPI) { if (wr == 0) PG8_BAR; }
        if constexpr (!Epi::AFTER_DRAIN) { E(acc, cur, wr, wc, fr, fq); }
        if (!has_next) break;
#pragma unroll
        for (int a = 0; a < 2; ++a)
#pragma unroll
            for (int b = 0; b < 2; ++b)
#pragma unroll
                for (int m = 0; m < 4; ++m)
#pragma unroll
                    for (int n = 0; n < 2; ++n) acc[a][b][m][n] = (f32x4){0.f, 0.f, 0.f, 0.f};
        cur = nxt; cA = nA; cB = nB; ++ui;
        if constexpr (ALIGN_EPI) { if (wr == 1) PG8_BAR; }
    }
    PG8_WAIT_V(0);
    if constexpr (!ALIGN_EPI) { if (wr == 0) PG8_BAR; }
    PG8_BAR;
    if constexpr (Epi::AFTER_DRAIN) { E.fused(acc, cur, wr, wc, fr, fq, lds, wid, lane); }
#undef PG8_SA
#undef PG8_SB
#undef PG8_STAGE
#undef PG8_LDA
#undef PG8_LDB
#undef PG8_MMA
#undef PG8_WAIT_V
#undef PG8_WAIT_L
#undef PG8_BAR
#undef PG8_SCHED
}
}

#ifndef USE_NAIVE_ATTN
#define USE_NAIVE_ATTN 0
#endif
#ifndef USE_NAIVE_LRU
#define USE_NAIVE_LRU 0
#endif
#ifndef USE_PG8
#define USE_PG8 1
#endif
#if USE_PG8
#define GEMM(C, S, E, lda, ldb, K) pg8::gemm_phase(C.lds, C.tid, S, E, lda, ldb, K)
#else
#define GEMM(C, S, E, lda, ldb, K) GEMM(C, S, E, lda, ldb, K)
#endif

#define EPI_LOOP_AM for (int ai = 0; ai < 2; ++ai) _Pragma("unroll") for (int m = 0; m < 4; ++m)
struct EpiGU {
    static constexpr bool PERM = false, AFTER_DRAIN = false;
    bf16_t* H;
    __device__ __forceinline__ void operator()(const f32x4 (&acc)[2][2][4][2], const Unit& u, int wr, int wc, int fr, int fq) const {
#pragma unroll
        EPI_LOOP_AM { const int row = u.pm * 256 + ai * 128 + wr * 64 + m * 16 + fr;
#pragma unroll
            for (int n = 0; n < 2; ++n) { const f32x4 g = acc[ai][0][m][n], up = acc[ai][1][m][n];
                u32x2 p; p.x = cvt_pk_bf16(siluf_(g.x) * up.x, siluf_(g.y) * up.y); p.y = cvt_pk_bf16(siluf_(g.z) * up.z, siluf_(g.w) * up.w);
                *(u32x2*)(H + (size_t)row * DFF + u.pn * 128 + wc * 32 + n * 16 + fq * 4) = p; } }
    }
};
struct EpiRes {
    static constexpr bool PERM = false, AFTER_DRAIN = false;
    float* X; const float* modbase; int l, sub; float coef;
    __device__ __forceinline__ void operator()(const f32x4 (&acc)[2][2][4][2], const Unit& u, int wr, int wc, int fr, int fq) const {
        const int c = cond_of_row(u.pm * 256);
        const float* gate = modbase + ((size_t)(l * 5 + c) * NMOD + (sub * 3 + 2) * D) + u.pn * 256 + wc * 32 + fq * 4;
        f32x4 g[2][2];
#pragma unroll
        for (int bj = 0; bj < 2; ++bj)
#pragma unroll
            for (int n = 0; n < 2; ++n) g[bj][n] = *(const f32x4*)(gate + bj * 128 + n * 16) * coef;
#pragma unroll
        EPI_LOOP_AM { float* xrow = X + (size_t)(u.pm * 256 + ai * 128 + wr * 64 + m * 16 + fr) * D + u.pn * 256 + wc * 32 + fq * 4;
#pragma unroll
            for (int bj = 0; bj < 2; ++bj)
#pragma unroll
                for (int n = 0; n < 2; ++n) { f32x4* p = (f32x4*)(xrow + bj * 128 + n * 16); *p = *p + g[bj][n] * acc[ai][bj][m][n]; }
            asm volatile("" ::: "memory"); }
    }
};
struct EpiIn {
    static constexpr bool PERM = false, AFTER_DRAIN = false;
    bf16_t *Q, *Kb, *VT, *GY, *XFT, *G; float* XR; float* out; const float* rope; const float* bgate; int l;
    __device__ __forceinline__ void operator()(const f32x4 (&acc)[2][2][4][2], const Unit& u, int wr, int wc, int fr, int fq) const {
        const int row0 = u.pm * 256 + wr * 64 + fr; const bool latent = u.pm >= 16;
        if (u.pn <= 2) {
#pragma unroll
            for (int bj = 0; bj < 2; ++bj) {
                if (u.pn == 2 && bj == 1) {
#pragma unroll
                    EPI_LOOP_AM { const int row = row0 + ai * 128 + m * 16; int seqoff, L, t;
                        if (latent) { const int b = (row - MP) >> 11; t = (row - MP) & 2047; L = LS; seqoff = 16 * 128 * LC + b * 128 * LS; } else { const int b = row >> 8; t = row & 255; L = LC; seqoff = b * 128 * LC; }
#pragma unroll
                        for (int n = 0; n < 2; ++n) { const f32x4 v = acc[ai][1][m][n]; const int d128 = wc * 32 + n * 16 + fq * 4;
                            bf16_t* p = VT + seqoff + (size_t)d128 * L + t; p[0] = f2bf(v.x); p[L] = f2bf(v.y); p[2 * L] = f2bf(v.z); p[3 * L] = f2bf(v.w);
                            if (!latent) *(f32x4*)(out + OUT_CV + ((size_t)((row >> 8) * 2 + l) * 256 + t) * 128 + d128) = v; } }
                } else {
                    const bool isk = (u.pn == 2); const int axis = wc & 1;
#pragma unroll
                    EPI_LOOP_AM { const int row = row0 + ai * 128 + m * 16; f32x4 x1 = acc[ai][bj][m][0], x2 = acc[ai][bj][m][1];
                        if (isk && !latent) { float* o = out + OUT_CK + ((size_t)((row >> 8) * 2 + l) * 256 + (row & 255)) * 128 + wc * 32 + fq * 4; *(f32x4*)o = x1; *(f32x4*)(o + 16) = x2; }
                        if (latent) { const int t = (row - MP) & 2047, pos = axis ? (t & 63) : (t >> 6);
                            const f32x4 cs = *(const f32x4*)(rope + pos * 16 + fq * 4), sn = *(const f32x4*)(rope + 1024 + pos * 16 + fq * 4);
                            const f32x4 o1 = x1 * cs - x2 * sn, o2 = x1 * sn + x2 * cs; x1 = o1; x2 = o2; }
                        if (!isk) { x1 = x1 * QSCALE; x2 = x2 * QSCALE; }
                        bf16_t* o = isk ? (Kb + (size_t)row * 128 + wc * 32 + fq * 4) : (Q + (size_t)row * 512 + u.pn * 256 + bj * 128 + wc * 32 + fq * 4);
                        u32x2 p; p.x = cvt_pk_bf16(x1.x, x1.y); p.y = cvt_pk_bf16(x1.z, x1.w); *(u32x2*)o = p;
                        p.x = cvt_pk_bf16(x2.x, x2.y); p.y = cvt_pk_bf16(x2.z, x2.w); *(u32x2*)(o + 16) = p; }
                }
            }
        } else if (u.pn <= 4) {
#pragma unroll
            EPI_LOOP_AM { const int row = row0 + ai * 128 + m * 16;
#pragma unroll
                for (int bj = 0; bj < 2; ++bj)
#pragma unroll
                    for (int n = 0; n < 2; ++n) *(f32x4*)(XR + (size_t)row * 512 + (u.pn - 3) * 256 + bj * 128 + wc * 32 + n * 16 + fq * 4) = acc[ai][bj][m][n]; }
        } else if (u.pn <= 6) {
#pragma unroll
            EPI_LOOP_AM { const int row = row0 + ai * 128 + m * 16;
#pragma unroll
                for (int bj = 0; bj < 2; ++bj)
#pragma unroll
                    for (int n = 0; n < 2; ++n) { const f32x4 v = acc[ai][bj][m][n]; u32x2 p; p.x = cvt_pk_bf16(gelu_tanh(v.x), gelu_tanh(v.y)); p.y = cvt_pk_bf16(gelu_tanh(v.z), gelu_tanh(v.w));
                        *(u32x2*)(GY + (size_t)row * 512 + (u.pn - 5) * 256 + bj * 128 + wc * 32 + n * 16 + fq * 4) = p; } }
        } else if (u.pn <= 8) {
#pragma unroll
            EPI_LOOP_AM { const int row = row0 + ai * 128 + m * 16; size_t seqoff; int L, t;
                if (latent) { const int b = (row - MP) >> 11; t = (row - MP) & 2047; L = LS; seqoff = (size_t)16 * 512 * LC + (size_t)b * 512 * LS; } else { const int b = row >> 8; t = row & 255; L = LC; seqoff = (size_t)b * 512 * LC; }
#pragma unroll
                for (int bj = 0; bj < 2; ++bj)
#pragma unroll
                    for (int n = 0; n < 2; ++n) { const f32x4 v = acc[ai][bj][m][n]; bf16_t* p = XFT + seqoff + (size_t)((u.pn - 7) * 256 + bj * 128 + wc * 32 + n * 16 + fq * 4) * L + t;
                        p[0] = f2bf(v.x); p[L] = f2bf(v.y); p[2 * L] = f2bf(v.z); p[3 * L] = f2bf(v.w); } }
        } else {
#pragma unroll
            for (int bj = 0; bj < 2; ++bj)
#pragma unroll
                for (int n = 0; n < 2; ++n) { const int col = (u.pn - 9) * 256 + bj * 128 + wc * 32 + n * 16 + fq * 4; const f32x4 b = *(const f32x4*)(bgate + col);
#pragma unroll
                    EPI_LOOP_AM { const int row = row0 + ai * 128 + m * 16; const f32x4 v = acc[ai][bj][m][n] + b;
                        u32x2 p; p.x = cvt_pk_bf16(sigmoidf_(v.x), sigmoidf_(v.y)); p.y = cvt_pk_bf16(sigmoidf_(v.z), sigmoidf_(v.w)); *(u32x2*)(G + (size_t)row * 3072 + col) = p; } }
        }
    }
};
template <int MODE> struct EpiBranch {
    static constexpr bool PERM = false, AFTER_DRAIN = false;
    bf16_t* MG; const bf16_t* G; int br;
    __device__ __forceinline__ void operator()(const f32x4 (&acc)[2][2][4][2], const Unit& u, int wr, int wc, int fr, int fq) const {
#pragma unroll
        EPI_LOOP_AM { const int row = u.pm * 256 + ai * 128 + wr * 64 + m * 16 + fr;
#pragma unroll
            for (int bj = 0; bj < 2; ++bj)
#pragma unroll
                for (int n = 0; n < 2; ++n) { const int col = u.pn * 256 + bj * 128 + wc * 32 + n * 16 + fq * 4;
                    const u32x2 g = *(const u32x2*)(G + (size_t)row * 3072 + br * 1024 + col); f32x4 v = acc[ai][bj][m][n];
                    v.x *= bflo(g.x); v.y *= bfhi(g.x); v.z *= bflo(g.y); v.w *= bfhi(g.y);
                    u32x2* p = (u32x2*)(MG + (size_t)row * D + col);
                    if (MODE == 1) { const u32x2 o = *p; v.x += bflo(o.x); v.y += bfhi(o.x); v.z += bflo(o.y); v.w += bfhi(o.y); }
                    u32x2 w; w.x = cvt_pk_bf16(v.x, v.y); w.y = cvt_pk_bf16(v.z, v.w); *p = w; }
            asm volatile("" ::: "memory"); }
    }
};
struct EpiDft {
    static constexpr bool PERM = false, AFTER_DRAIN = false;
    bf16_t* Z; int L, rowbase0;
    __device__ __forceinline__ void operator()(const f32x4 (&acc)[2][2][4][2], const Unit& u, int wr, int wc, int fr, int fq) const {
        const int pp = u.pm * 256, soff = (pp >= L) ? 512 : 0, p0 = (pp >= L) ? pp - L : pp;
#pragma unroll
        EPI_LOOP_AM { const int row = rowbase0 + u.z * L + p0 + ai * 128 + wr * 64 + m * 16 + fr;
#pragma unroll
            for (int bj = 0; bj < 2; ++bj)
#pragma unroll
                for (int n = 0; n < 2; ++n) { const f32x4 v = acc[ai][bj][m][n]; u32x2 w; w.x = cvt_pk_bf16(v.x, v.y); w.y = cvt_pk_bf16(v.z, v.w);
                    *(u32x2*)(Z + (size_t)row * D + soff + u.pn * 256 + bj * 128 + wc * 32 + n * 16 + fq * 4) = w; } }
    }
};

__device__ __forceinline__ void attn_naive_phase(ArgsP args, const Ctx& C, int l) {
    bf16_t* Q = (bf16_t*)act_ptr(C, A_Q); const bf16_t* Kb = (const bf16_t*)act_ptr(C, A_K); const bf16_t* VT = (const bf16_t*)act_ptr(C, A_VT);
    const bf16_t* CK = (const bf16_t*)(C.ws + OFF_CK); const bf16_t* CVT = (const bf16_t*)(C.ws + OFF_CVT);
    const int gw = C.bid * NWAVES + C.wave, NGW = C.G * NWAVES;
    for (int it = gw; it < (M / 64) * 8; it += NGW) {
        const int h = it & 7, row = (it >> 3) * 64 + C.lane, kvh = h >> 2;
        float q[64], o[64];
        { const u32x4* qp = (const u32x4*)(Q + (size_t)row * 512 + h * 64);
#pragma unroll
          for (int j = 0; j < 8; ++j) { const u32x4 w = qp[j]; q[8 * j] = bflo(w.x); q[8 * j + 1] = bfhi(w.x); q[8 * j + 2] = bflo(w.y); q[8 * j + 3] = bfhi(w.y); q[8 * j + 4] = bflo(w.z); q[8 * j + 5] = bfhi(w.z); q[8 * j + 6] = bflo(w.w); q[8 * j + 7] = bfhi(w.w); } }
#pragma unroll
        for (int d = 0; d < 64; ++d) o[d] = 0.f;
        float mx = args->in[20][l * 8 + h] * LOG2E, lsum = 1.0f;
        const bool latent = row >= MP;
        const int b = latent ? ((row - MP) >> 11) : (row >> 8), t = latent ? ((row - MP) & 2047) : (row & 255);
        for (int seg = 0; seg < (latent ? 2 : 1); ++seg) {
            const int nk = (seg == 1 || !latent) ? 256 : 257;
            for (int jj = 0; jj < nk; ++jj) {
                int j; bool ok = true; const bf16_t* kp; const bf16_t* vp; int L;
                if (seg == 1) { j = jj; kp = CK + ((size_t)(b * 2 + l) * 256 + j) * 128 + kvh * 64; vp = CVT + ((size_t)((b * 2 + l) * 2 + kvh) * 64) * 256 + j; L = 256; }
                else if (!latent) { j = jj; kp = Kb + ((size_t)(b * 256 + j)) * 128 + kvh * 64; vp = VT + (size_t)b * 128 * LC + (size_t)(kvh * 64) * LC + j; L = LC; }
                else { j = t - 128 + jj; ok = (j >= 0 && j < LS); const int jc = ok ? j : t; kp = Kb + ((size_t)(MP + b * LS + jc)) * 128 + kvh * 64; vp = VT + (size_t)16 * 128 * LC + (size_t)b * 128 * LS + (size_t)(kvh * 64) * LS + jc; L = LS; }
                float s = 0.f;
#pragma unroll
                for (int jq = 0; jq < 8; ++jq) { const u32x4 w = ((const u32x4*)kp)[jq];
                    s += q[8 * jq] * bflo(w.x) + q[8 * jq + 1] * bfhi(w.x) + q[8 * jq + 2] * bflo(w.y) + q[8 * jq + 3] * bfhi(w.y) + q[8 * jq + 4] * bflo(w.z) + q[8 * jq + 5] * bfhi(w.z) + q[8 * jq + 6] * bflo(w.w) + q[8 * jq + 7] * bfhi(w.w); }
                if (!ok) s = -1e30f;
                const float mn = fmaxf(mx, s), alpha = exp2f(mx - mn), p = exp2f(s - mn);
                lsum = lsum * alpha + p; mx = mn;
#pragma unroll
                for (int d = 0; d < 64; ++d) o[d] = o[d] * alpha + p * bf2f(vp[(size_t)d * L]);
            }
        }
        const float inv = 1.0f / lsum;
        u32x4* op = (u32x4*)(Q + (size_t)row * 512 + h * 64);
#pragma unroll
        for (int j = 0; j < 8; ++j) { u32x4 w; w.x = cvt_pk_bf16(o[8 * j] * inv, o[8 * j + 1] * inv); w.y = cvt_pk_bf16(o[8 * j + 2] * inv, o[8 * j + 3] * inv); w.z = cvt_pk_bf16(o[8 * j + 4] * inv, o[8 * j + 5] * inv); w.w = cvt_pk_bf16(o[8 * j + 6] * inv, o[8 * j + 7] * inv); op[j] = w; }
    }
}

__device__ __forceinline__ void lru_naive_phase(ArgsP args, const Ctx& C, int l) {
    const float* XR = (const float*)act_ptr(C, A_XR); const bf16_t* GY = (const bf16_t*)act_ptr(C, A_GY); bf16_t* REC = (bf16_t*)act_ptr(C, A_XN);
    const int gw = C.bid * NWAVES + C.wave, NGW = C.G * NWAVES;
    for (int it = gw; it < 20 * 8 * 2; it += NGW) {
        const int dir = it & 1, nb = (it >> 1) & 7, sq = it >> 4;
        const bool latent = sq < 4; const int b = latent ? sq : sq - 4, L = latent ? LS : LC, rowbase = latent ? MP + b * LS : b * LC;
        const int ch = nb * 64 + C.lane;
        float wa[64], wi[64];
        { const float* pa = args->in[24] + ((size_t)((l * 2 + dir) * 8 + nb) * 64) * 64 + C.lane; const float* pi = args->in[26] + ((size_t)((l * 2 + dir) * 8 + nb) * 64) * 64 + C.lane;
#pragma unroll
          for (int k = 0; k < 64; ++k) { wa[k] = pa[k * 64]; wi[k] = pi[k * 64]; } }
        const float ba = args->in[25][(l * 2 + dir) * 512 + ch], bi = args->in[27][(l * 2 + dir) * 512 + ch], lam = args->in[28][(l * 2 + dir) * 512 + ch];
        const float sp = log1pf(__expf(-lam));
        const float cw0 = args->in[22][(l * 4 + 0) * 512 + ch], cw1 = args->in[22][(l * 4 + 1) * 512 + ch], cw2 = args->in[22][(l * 4 + 2) * 512 + ch], cw3 = args->in[22][(l * 4 + 3) * 512 + ch], cb = args->in[23][l * 512 + ch];
        float h = latent ? args->in[5][((size_t)(b * 2 + l) * 2 + dir) * 512 + ch] : 0.f;
        for (int s = 0; s < L; ++s) {
            const int t = dir ? (L - 1 - s) : s;
            const float* xp = XR + (size_t)(rowbase + t) * 512 + ch;
            const float xm2 = (t >= 2) ? xp[-2 * 512] : 0.f, xm1 = (t >= 1) ? xp[-512] : 0.f, x0 = xp[0], xp1 = (t + 1 < L) ? xp[512] : 0.f;
            const float xc = cb + cw0 * xm2 + cw1 * xm1 + cw2 * x0 + cw3 * xp1;
            float ra = ba, ri = bi;
#pragma unroll
            for (int k = 0; k < 64; ++k) { const float xk = __shfl(xc, k); ra += xk * wa[k]; ri += xk * wi[k]; }
            const float r = sigmoidf_(ra), ig = sigmoidf_(ri);
            const float log_a = -8.0f * r * sp, a = __expf(log_a), bb = sqrtf(fmaxf(-expm1f(2.0f * log_a), 0.f)) * (ig * xc);
            h = a * h + bb;
            REC[(size_t)(rowbase + t) * D + dir * 512 + ch] = f2bf(h * bf2f(GY[(size_t)(rowbase + t) * 512 + ch]));
        }
        if (!latent) C.out[OUT_ST + ((size_t)(b * 2 + l) * 2 + dir) * 512 + ch] = h;
    }
}


typedef float f32x16 __attribute__((ext_vector_type(16)));
typedef short s16x4 __attribute__((ext_vector_type(4)));
#define MFMA32(a, b, c) __builtin_amdgcn_mfma_f32_32x32x16_bf16((a), (b), (c), 0, 0, 0)
constexpr int AT_KSTR = 144, AT_VSTR = 136, AT_KBYTES = 64 * AT_KSTR, AT_VBYTES = 64 * AT_VSTR, AT_BUF = AT_KBYTES + AT_VBYTES;
struct AttnSrc { const bf16_t* kp; const bf16_t* vp; int vstride; int kbase; };
__device__ __forceinline__ AttnSrc attn_src(int t, bool latent, int nband, int lo, int b, int l, int kvh, const bf16_t* Kb, const bf16_t* VT, const bf16_t* CK, const bf16_t* CVT) {
    AttnSrc s;
    if (!latent) { s.kp = Kb + (size_t)(b * LC + 64 * t) * 128 + kvh * 64; s.vp = VT + (size_t)b * 128 * LC + (size_t)(kvh * 64) * LC + 64 * t; s.vstride = LC; s.kbase = 0; }
    else if (t < nband) { const int kb = lo + 64 * t; s.kp = Kb + (size_t)(MP + b * LS + kb) * 128 + kvh * 64; s.vp = VT + (size_t)16 * 128 * LC + (size_t)b * 128 * LS + (size_t)(kvh * 64) * LS + kb; s.vstride = LS; s.kbase = kb; }
    else { const int c = t - nband; s.kp = CK + (size_t)((b * 2 + l) * 256 + 64 * c) * 128 + kvh * 64; s.vp = CVT + (size_t)((b * 2 + l) * 2 + kvh) * 64 * 256 + 64 * c; s.vstride = 256; s.kbase = 0; }
    return s;
}
__device__ __forceinline__ void attn_phase(ArgsP args, const Ctx& C, int l) {
    bf16_t* Q = (bf16_t*)act_ptr(C, A_Q); const bf16_t* Kb = (const bf16_t*)act_ptr(C, A_K); const bf16_t* VT = (const bf16_t*)act_ptr(C, A_VT);
    const bf16_t* CK = (const bf16_t*)(C.ws + OFF_CK); const bf16_t* CVT = (const bf16_t*)(C.ws + OFF_CVT);
    const int q32 = C.lane & 31, half = C.lane >> 5, w = C.wave;
    const int srow = C.tid >> 3, schunk = C.tid & 7;
    for (int ui = C.bid; ui < 256 + 128; ui += C.G) {
        const bool latent = ui < 256;
        int b, h, qb; if (latent) { b = ui >> 6; h = (ui >> 3) & 7; qb = ui & 7; } else { const int r = ui - 256; b = r >> 3; h = r & 7; qb = 0; }
        const int kvh = h >> 2, rowbase = latent ? (MP + b * LS + qb * 256) : b * LC;
        int lo = 0, nband = 4, nt = 4;
        if (latent) { lo = 256 * qb - 128; if (lo < 0) lo = 0; int hi = 256 * qb + 384; if (hi > LS) hi = LS; nband = (hi - lo) >> 6; nt = nband + 4; }
        const int qw_lo = qb * 256 + 32 * w, qpos = qw_lo + q32;
        bf16x8 qf[4];
        { const bf16_t* qp = Q + (size_t)(rowbase + 32 * w + q32) * 512 + h * 64 + 8 * half;
#pragma unroll
          for (int ks = 0; ks < 4; ++ks) qf[ks] = *(const bf16x8*)(qp + 16 * ks); }
        f32x16 O0, O1;
#pragma unroll
        for (int r = 0; r < 16; ++r) { O0[r] = 0.f; O1[r] = 0.f; }
        float mrun = args->in[20][l * 8 + h] * LOG2E, lsum = half ? 0.f : 1.0f;
        { const AttnSrc s0 = attn_src(0, latent, nband, lo, b, l, kvh, Kb, VT, CK, CVT);
          const u32x4 kreg = *(const u32x4*)(s0.kp + (size_t)srow * 128 + schunk * 8), vreg = *(const u32x4*)(s0.vp + (size_t)srow * s0.vstride + schunk * 8);
          *(LAS u32x4*)(C.lds + srow * AT_KSTR + schunk * 16) = kreg;
          LAS u32x2* vd = (LAS u32x2*)(C.lds + AT_KBYTES + srow * AT_VSTR + schunk * 16); vd[0] = (u32x2){vreg.x, vreg.y}; vd[1] = (u32x2){vreg.z, vreg.w}; }
        __syncthreads();
        for (int t = 0; t < nt; ++t) {
            const int buf = t & 1;
            u32x4 kreg, vreg; const bool more = (t + 1 < nt);
            if (more) { const AttnSrc s1 = attn_src(t + 1, latent, nband, lo, b, l, kvh, Kb, VT, CK, CVT);
                kreg = *(const u32x4*)(s1.kp + (size_t)srow * 128 + schunk * 8); vreg = *(const u32x4*)(s1.vp + (size_t)srow * s1.vstride + schunk * 8); }
            bool skip = false, domask = false;
            if (latent && t < nband) { const int kb = lo + 64 * t; skip = (kb > qw_lo + 31 + 128) || (kb + 63 < qw_lo - 128); domask = !((kb + 63 - qw_lo <= 128) && (qw_lo + 31 - kb <= 128)); }
            if (!skip) {
                const LAS unsigned char* kbp = C.lds + buf * AT_BUF; const LAS unsigned char* vbp = kbp + AT_KBYTES;
                f32x16 S0, S1;
#pragma unroll
                for (int r = 0; r < 16; ++r) { S0[r] = 0.f; S1[r] = 0.f; }
#pragma unroll
                for (int ks = 0; ks < 4; ++ks) { const bf16x8 k0 = *(const LAS bf16x8*)(kbp + q32 * AT_KSTR + ks * 32 + half * 16), k1 = *(const LAS bf16x8*)(kbp + (32 + q32) * AT_KSTR + ks * 32 + half * 16);
                    S0 = MFMA32(k0, qf[ks], S0); S1 = MFMA32(k1, qf[ks], S1); }
                if (domask) { const int kb = lo + 64 * t;
#pragma unroll
                    for (int r = 0; r < 16; ++r) { const int d0 = kb + (r & 3) + 8 * (r >> 2) + 4 * half - qpos, d1 = d0 + 32;
                        S0[r] = (d0 > 128 || d0 < -128) ? -1e30f : S0[r]; S1[r] = (d1 > 128 || d1 < -128) ? -1e30f : S1[r]; } }
                float mx = fmaxf(S0[0], S1[0]);
#pragma unroll
                for (int r = 1; r < 16; ++r) mx = fmaxf(mx, fmaxf(S0[r], S1[r]));
                mx = fmaxf(mx, __shfl_xor(mx, 32));
                const float mnew = fmaxf(mrun, mx), alpha = __builtin_amdgcn_exp2f(mrun - mnew); mrun = mnew;
                float ps = 0.f;
#pragma unroll
                for (int r = 0; r < 16; ++r) { S0[r] = __builtin_amdgcn_exp2f(S0[r] - mnew); S1[r] = __builtin_amdgcn_exp2f(S1[r] - mnew); ps += S0[r] + S1[r]; }
                lsum = lsum * alpha + ps;
#pragma unroll
                for (int r = 0; r < 16; ++r) { O0[r] *= alpha; O1[r] *= alpha; }
                bf16x8 pf[4];
#pragma unroll
                for (int s2 = 0; s2 < 2; ++s2) { u32x4 a, c2;
                    a.x = cvt_pk_bf16(S0[8 * s2 + 0], S0[8 * s2 + 1]); a.y = cvt_pk_bf16(S0[8 * s2 + 2], S0[8 * s2 + 3]); a.z = cvt_pk_bf16(S0[8 * s2 + 4], S0[8 * s2 + 5]); a.w = cvt_pk_bf16(S0[8 * s2 + 6], S0[8 * s2 + 7]);
                    c2.x = cvt_pk_bf16(S1[8 * s2 + 0], S1[8 * s2 + 1]); c2.y = cvt_pk_bf16(S1[8 * s2 + 2], S1[8 * s2 + 3]); c2.z = cvt_pk_bf16(S1[8 * s2 + 4], S1[8 * s2 + 5]); c2.w = cvt_pk_bf16(S1[8 * s2 + 6], S1[8 * s2 + 7]);
                    pf[s2] = __builtin_bit_cast(bf16x8, a); pf[2 + s2] = __builtin_bit_cast(bf16x8, c2); }
#pragma unroll
                for (int s4 = 0; s4 < 4; ++s4) {
                    const LAS unsigned char* v0p = vbp + q32 * AT_VSTR + s4 * 32 + half * 8; const LAS unsigned char* v1p = v0p + 32 * AT_VSTR;
                    const s16x4 a0 = *(const LAS s16x4*)v0p, a1 = *(const LAS s16x4*)(v0p + 16), b0 = *(const LAS s16x4*)v1p, b1 = *(const LAS s16x4*)(v1p + 16);
                    const bf16x8 vf0 = __builtin_shufflevector(a0, a1, 0, 1, 2, 3, 4, 5, 6, 7), vf1 = __builtin_shufflevector(b0, b1, 0, 1, 2, 3, 4, 5, 6, 7);
                    O0 = MFMA32(vf0, pf[s4], O0); O1 = MFMA32(vf1, pf[s4], O1); }
            }
            if (more) { *(LAS u32x4*)(C.lds + (buf ^ 1) * AT_BUF + srow * AT_KSTR + schunk * 16) = kreg;
                LAS u32x2* vd = (LAS u32x2*)(C.lds + (buf ^ 1) * AT_BUF + AT_KBYTES + srow * AT_VSTR + schunk * 16); vd[0] = (u32x2){vreg.x, vreg.y}; vd[1] = (u32x2){vreg.z, vreg.w}; }
            __syncthreads();
        }
        const float inv = 1.0f / (lsum + __shfl_xor(lsum, 32));
        bf16_t* op = Q + (size_t)(rowbase + 32 * w + q32) * 512 + h * 64 + 4 * half;
#pragma unroll
        for (int g = 0; g < 4; ++g) { u32x2 o; o.x = cvt_pk_bf16(O0[4 * g] * inv, O0[4 * g + 1] * inv); o.y = cvt_pk_bf16(O0[4 * g + 2] * inv, O0[4 * g + 3] * inv); *(u32x2*)(op + 8 * g) = o;
            o.x = cvt_pk_bf16(O1[4 * g] * inv, O1[4 * g + 1] * inv); o.y = cvt_pk_bf16(O1[4 * g + 2] * inv, O1[4 * g + 3] * inv); *(u32x2*)(op + 32 + 8 * g) = o; }
    }
}

constexpr int LR_XCB = 0, LR_WT = 18432, LR_BX = 36864, LR_AA = LR_BX + 128 * 272, LR_PH = LR_AA + 128 * 272, LR_CAR = LR_PH + 4096, LR_CONST = LR_CAR + 512, LR_END = LR_CONST + 768;
static_assert(LR_END <= 131072, "lru LDS map");
__device__ __forceinline__ void lru_phase(ArgsP args, const Ctx& C, int l) {
    const float* XR = (const float*)act_ptr(C, A_XR); const bf16_t* GY = (const bf16_t*)act_ptr(C, A_GY); bf16_t* REC = (bf16_t*)act_ptr(C, A_XN);
    LAS bf16_t* XCB = (LAS bf16_t*)(C.lds + LR_XCB); LAS bf16_t* WT = (LAS bf16_t*)(C.lds + LR_WT);
    LAS float* BX = (LAS float*)(C.lds + LR_BX); LAS float* AA = (LAS float*)(C.lds + LR_AA); LAS float* PH = (LAS float*)(C.lds + LR_PH);
    LAS float* CAR = (LAS float*)(C.lds + LR_CAR); LAS float* CST = (LAS float*)(C.lds + LR_CONST);
    const int ch = C.tid & 63, sub = C.wave, fr = C.lane & 15, fq = C.lane >> 4;
    for (int it = C.bid; it < 320; it += C.G) {
        const int dir = it & 1, nb = (it >> 1) & 7, sq = it >> 4;
        const bool latent = sq < 4; const int b = latent ? sq : sq - 4, L = latent ? LS : LC, rowbase = latent ? MP + b * LS : b * LC;
        __syncthreads();
        { const float* pa = args->in[24] + ((size_t)((l * 2 + dir) * 8 + nb) * 64) * 64; const float* pi = args->in[26] + ((size_t)((l * 2 + dir) * 8 + nb) * 64) * 64;
          for (int i = C.tid; i < 4096; i += NTHREADS) { const int k = i >> 6, n = i & 63; WT[n * 72 + k] = f2bf(pa[i]); WT[(64 + n) * 72 + k] = f2bf(pi[i]); } }
        if (C.tid < 64) { const int cg = (l * 2 + dir) * 512 + nb * 64 + C.tid; CST[C.tid] = args->in[25][cg]; CST[64 + C.tid] = args->in[27][cg]; CST[128 + C.tid] = -8.0f * log1pf(__expf(-args->in[28][cg]));
            CAR[C.tid] = latent ? args->in[5][((size_t)(b * 2 + l) * 2 + dir) * 512 + nb * 64 + C.tid] : 0.f; }
        const int cgl = nb * 64 + ch;
        const float cw0 = args->in[22][(l * 4 + 0) * 512 + cgl], cw1 = args->in[22][(l * 4 + 1) * 512 + cgl], cw2 = args->in[22][(l * 4 + 2) * 512 + cgl], cw3 = args->in[22][(l * 4 + 3) * 512 + cgl], cb = args->in[23][l * 512 + cgl];
        const int nch = L >> 7;
        float hfin = 0.f;
        for (int c = 0; c < nch; ++c) {
            const int t0 = dir ? (L - 128 * (c + 1)) : 128 * c;
            { const float* xp = XR + (size_t)(rowbase + t0) * 512 + cgl;
#pragma unroll 4
              for (int i = 0; i < 16; ++i) { const int e = sub + 8 * i, t = t0 + e; const float* x = xp + (size_t)e * 512;
                  const float xm2 = (t >= 2) ? x[-1024] : 0.f, xm1 = (t >= 1) ? x[-512] : 0.f, x0 = x[0], xp1 = (t + 1 < L) ? x[512] : 0.f;
                  const float xc = cb + cw0 * xm2 + cw1 * xm1 + cw2 * x0 + cw3 * xp1;
                  BX[e * 68 + ch] = xc; XCB[e * 72 + ch] = f2bf(xc); } }
            __syncthreads();
            { f32x4 acc[8];
#pragma unroll
              for (int nt = 0; nt < 8; ++nt) acc[nt] = (f32x4){0.f, 0.f, 0.f, 0.f};
              const int e = 16 * sub + fr;
#pragma unroll
              for (int kk = 0; kk < 2; ++kk) { const bf16x8 xf = *(const LAS bf16x8*)(XCB + e * 72 + 8 * fq + 32 * kk);
#pragma unroll
                  for (int nt = 0; nt < 8; ++nt) { const bf16x8 wf = *(const LAS bf16x8*)(WT + (16 * nt + fr) * 72 + 8 * fq + 32 * kk); acc[nt] = __builtin_amdgcn_mfma_f32_16x16x32_bf16(wf, xf, acc[nt], 0, 0, 0); } }
#pragma unroll
              for (int nt = 0; nt < 4; ++nt) { const int c0 = 16 * nt + 4 * fq; const f32x4 ba = *(const LAS f32x4*)(CST + c0), bi = *(const LAS f32x4*)(CST + 64 + c0), sp = *(const LAS f32x4*)(CST + 128 + c0);
                  const f32x4 xcv = *(const LAS f32x4*)(BX + e * 68 + c0); f32x4 av, bv;
#pragma unroll
                  for (int i = 0; i < 4; ++i) { const float r = sigmoidf_(acc[nt][i] + ba[i]), ig = sigmoidf_(acc[nt + 4][i] + bi[i]); const float la = r * sp[i], a = __expf(la), y = 2.0f * la;
                      const float om = (y > -0.05f) ? -y * (1.0f + 0.5f * y * (1.0f + (1.0f / 3.0f) * y * (1.0f + 0.25f * y))) : (1.0f - a * a);
                      av[i] = a; bv[i] = sqrtf(fmaxf(om, 0.f)) * (ig * xcv[i]); }
                  *(LAS f32x4*)(AA + e * 68 + c0) = av; *(LAS f32x4*)(BX + e * 68 + c0) = bv; } }
            __syncthreads();
            float av[16], bv[16], gy[16];
            { float P = 1.f, H = 0.f;
#pragma unroll
              for (int j = 0; j < 16; ++j) { const int sl = 16 * sub + j, e = dir ? 127 - sl : sl; av[j] = AA[e * 68 + ch]; bv[j] = BX[e * 68 + ch];
                  gy[j] = bf2f(GY[(size_t)(rowbase + t0 + e) * 512 + cgl]); H = av[j] * H + bv[j]; P *= av[j]; }
              PH[sub * 64 + ch] = P; PH[512 + sub * 64 + ch] = H; }
            __syncthreads();
            float h = CAR[(c & 1) * 64 + ch];
            for (int s2 = 0; s2 < sub; ++s2) h = PH[s2 * 64 + ch] * h + PH[512 + s2 * 64 + ch];
#pragma unroll
            for (int j = 0; j < 16; ++j) { const int sl = 16 * sub + j, e = dir ? 127 - sl : sl; h = av[j] * h + bv[j];
                REC[(size_t)(rowbase + t0 + e) * D + dir * 512 + cgl] = f2bf(h * gy[j]); }
            if (sub == 7) { CAR[((c + 1) & 1) * 64 + ch] = h; hfin = h; }
        }
        if (!latent && sub == 7) C.out[OUT_ST + ((size_t)(b * 2 + l) * 2 + dir) * 512 + cgl] = hfin;
    }
}

#define XB_TMO      128
#define XB_XCNT(j)  (256  + 64 * (j))
#define XB_XSUB(j)  (1280 + 64 * (j))
#define XB_XGEN(j)  (2304 + 64 * (j))
#define XB_TOP      3328
#define XB_TOPGEN   3392
#define XCD_BAR_WORDS 3456
#define XB_SPIN_CAP (1u << 18)

__device__ __forceinline__ unsigned xb_ld(unsigned* p)              { return __hip_atomic_load(p, __ATOMIC_RELAXED, __HIP_MEMORY_SCOPE_AGENT); }
__device__ __forceinline__ unsigned xb_add(unsigned* p, unsigned v) { return __hip_atomic_fetch_add(p, v, __ATOMIC_RELAXED, __HIP_MEMORY_SCOPE_AGENT); }
__device__ __forceinline__ unsigned xb_xcc_id() { return (unsigned)__builtin_amdgcn_s_getreg((3 << 11) | 20) & 0xFu; }
#define XB_SPIN(cond, bar) do { unsigned _sp = 0; while (cond) { __builtin_amdgcn_s_sleep(1); \
    if ((++_sp & 255u) == 0u) { if (xb_ld(&(bar)[XB_TMO])) break; if (_sp > XB_SPIN_CAP) { atomicAdd(&(bar)[XB_TMO], 1u); break; } } } } while (0)

struct XcdBarrier {
    unsigned* bar; unsigned x;
    volatile LAS unsigned* st;
};

__device__ __forceinline__ XcdBarrier xcd_barrier_post(unsigned* bar, volatile LAS unsigned* st) {
    XcdBarrier b; b.bar = bar; b.x = xb_xcc_id(); b.st = st;
    if (threadIdx.x == 0) (void)xb_add(&bar[XB_XCNT(b.x)], 1u);
    return b;
}
__device__ __forceinline__ void xcd_barrier_complete(unsigned* bar, unsigned x, unsigned& nloc, unsigned& nx) {
    const unsigned G = gridDim.x * gridDim.y * gridDim.z;
    unsigned sum, cnt, mine, sp = 0u;
    for (;;) {
        sum = 0u; cnt = 0u; mine = 0u;
#pragma unroll
        for (unsigned j = 0; j < 16; ++j) { const unsigned c = xb_ld(&bar[XB_XCNT(j)]); sum += c; cnt += (c > 0u) ? 1u : 0u; mine = (j == x) ? c : mine; }
        if (sum == G) break;
        __builtin_amdgcn_s_sleep(1);
        if ((++sp & 255u) == 0u) { if (xb_ld(&bar[XB_TMO])) break; if (sp > XB_SPIN_CAP) { atomicAdd(&bar[XB_TMO], 1u); break; } }
    }
    nloc = mine > 0u ? mine : 1u; nx = cnt > 0u ? cnt : 1u;
}

__device__ __forceinline__ void xcd_barrier(const XcdBarrier& b) {
    asm volatile("s_waitcnt vmcnt(0)" ::: "memory");
    __syncthreads();
    if (threadIdx.x == 0) {
        unsigned* bar = b.bar;
        __builtin_amdgcn_s_waitcnt(0);
        unsigned nloc = b.st[0], nx = b.st[1];
        if (nloc == 0u) { xcd_barrier_complete(bar, b.x, nloc, nx); b.st[0] = nloc; b.st[1] = nx; }
        const unsigned old = xb_add(&bar[XB_XSUB(b.x)], 1u);
        const unsigned gen = old / nloc;
        if (old + 1u == (gen + 1u) * nloc) {
            __builtin_amdgcn_fence(__ATOMIC_RELEASE, "agent");
            asm volatile("s_waitcnt vmcnt(0)" ::: "memory");
            const unsigned og = xb_add(&bar[XB_TOP], 1u);
            const unsigned tg = og / nx;
            if (og + 1u == (tg + 1u) * nx) xb_add(&bar[XB_TOPGEN], 1u);
            else XB_SPIN(xb_ld(&bar[XB_TOPGEN]) == tg, bar);
            __builtin_amdgcn_fence(__ATOMIC_ACQUIRE, "agent");
            xb_add(&bar[XB_XGEN(b.x)], 1u);
            asm volatile("s_waitcnt vmcnt(0)" ::: "memory");
        } else {
            XB_SPIN(xb_ld(&bar[XB_XGEN(b.x)]) == gen, bar);
            __builtin_amdgcn_fence(__ATOMIC_ACQUIRE, "agent");
            asm volatile("s_waitcnt vmcnt(0)" ::: "memory");
        }
    }
    __syncthreads();
}

constexpr int N_PHASES = 28;
enum { K_P0 = 1, K_NORM = 2, K_GU = 4, K_RES = 8, K_IN = 16, K_ATTN = 32, K_LRU = 64, K_DFT = 128, K_BR = 256, K_ALL = 511 };
__host__ __device__ constexpr int kind_of_phase(int ph) {
    if (ph == 0) return K_P0;
    if (ph == N_PHASES - 1) return K_NORM;
    const int s = (ph - 1) % 13;
    return (s == 0 || s == 3 || s == 10) ? K_NORM : (s == 1 || s == 11) ? K_GU : (s == 2 || s == 12 || s == 9) ? K_RES : (s == 4) ? K_IN : (s == 5) ? K_ATTN : (s == 6) ? K_LRU : (s == 7) ? K_DFT : K_BR;
}
__host__ __device__ constexpr bool sync_after_phase(int ph) { const int s = (ph - 1) % 13; return !(ph >= 1 && ph < N_PHASES - 1 && (s == 5 || s == 6)); }

template <int KM>
__device__ __forceinline__ void run_phase(ArgsP args, const Ctx& C, int ph) {
    if (ph == 0) { if constexpr ((KM & K_P0) != 0) p0_prologue(args, C); return; }
    if (ph == N_PHASES - 1) { if constexpr ((KM & K_NORM) != 0) finalnorm_phase(args, C); return; }
    const int l = (ph - 1) / 13, s = (ph - 1) % 13;
    const float* MODB = (const float*)(C.ws + OFF_MOD);
    if (s == 0 || s == 3 || s == 10) { if constexpr ((KM & K_NORM) != 0) modnorm_phase(args, C, l, s == 0 ? 0 : (s == 3 ? 1 : 2)); }
    else if (s == 1 || s == 11) { if constexpr ((KM & K_GU) != 0) { StaticOrder S; S.init(M, 2 * DFF, C.G, C.bid, (const bf16_t*)act_ptr(C, A_XN), D, (const bf16_t*)wl_ptr(C, l, s == 1 ? WL_GU1 : WL_GU2), D);
        EpiGU E{(bf16_t*)act_ptr(C, A_G)}; GEMM(C, S, E, D, D, D); } }
    else if (s == 2 || s == 12) { if constexpr ((KM & K_RES) != 0) { StaticOrder S; S.init(M, D, C.G, C.bid, (const bf16_t*)act_ptr(C, A_G), DFF, (const bf16_t*)wl_ptr(C, l, s == 2 ? WL_D1 : WL_D2), DFF);
        EpiRes E{C.out, MODB, l, s == 2 ? 0 : 2, 0.5f}; GEMM(C, S, E, DFF, DFF, DFF); } }
    else if (s == 4) { if constexpr ((KM & K_IN) != 0) { StaticOrder S; S.init(M, NIN, C.G, C.bid, (const bf16_t*)act_ptr(C, A_XN), D, (const bf16_t*)wl_ptr(C, l, WL_IN), D);
        EpiIn E{(bf16_t*)act_ptr(C, A_Q), (bf16_t*)act_ptr(C, A_K), (bf16_t*)act_ptr(C, A_VT), (bf16_t*)act_ptr(C, A_GY), (bf16_t*)act_ptr(C, A_XFT), (bf16_t*)act_ptr(C, A_G),
                (float*)act_ptr(C, A_XR), C.out, (const float*)(C.ws + OFF_ROPE), args->in[19] + (size_t)l * 3072, l};
        GEMM(C, S, E, D, D, D); } }
    else if (s == 5) { if constexpr ((KM & K_ATTN) != 0) { if (USE_NAIVE_ATTN) attn_naive_phase(args, C, l); else attn_phase(args, C, l); } }
    else if (s == 6) { if constexpr ((KM & K_LRU) != 0) { if (USE_NAIVE_LRU) lru_naive_phase(args, C, l); else lru_phase(args, C, l); } }
    else if (s == 7) { if constexpr ((KM & K_DFT) != 0) {
        { DftOrder S{4, 16, LS, C.G, C.bid, (const bf16_t*)(C.ws + WS_DFTL), (const bf16_t*)act_ptr(C, A_XFT) + (size_t)16 * 512 * LC}; EpiDft E{(bf16_t*)act_ptr(C, A_Z), LS, MP}; GEMM(C, S, E, LS, LS, LS); }
        { DftOrder S{16, 2, LC, C.G, C.bid, (const bf16_t*)(C.ws + WS_DFTC), (const bf16_t*)act_ptr(C, A_XFT)}; EpiDft E{(bf16_t*)act_ptr(C, A_Z), LC, 0}; GEMM(C, S, E, LC, LC, LC); } } }
    else if (s == 8) { if constexpr ((KM & K_BR) != 0) {
        bf16_t* MG = (bf16_t*)act_ptr(C, A_XR); const bf16_t* G = (const bf16_t*)act_ptr(C, A_G);
        { StaticOrder S; S.init(M, D, C.G, C.bid, (const bf16_t*)act_ptr(C, A_Q), 512, (const bf16_t*)wl_ptr(C, l, WL_A), 512); EpiBranch<0> E{MG, G, 0}; GEMM(C, S, E, 512, 512, 512); }
        { StaticOrder S; S.init(M, D, C.G, C.bid, (const bf16_t*)act_ptr(C, A_XN), D, (const bf16_t*)wl_ptr(C, l, WL_L2), D); EpiBranch<1> E{MG, G, 1}; GEMM(C, S, E, D, D, D); }
        { StaticOrder S; S.init(M, D, C.G, C.bid, (const bf16_t*)act_ptr(C, A_Z), D, (const bf16_t*)wl_ptr(C, l, WL_F2), D); EpiBranch<1> E{MG, G, 2}; GEMM(C, S, E, D, D, D); } } }
    else if (s == 9) { if constexpr ((KM & K_RES) != 0) { StaticOrder S; S.init(M, D, C.G, C.bid, (const bf16_t*)act_ptr(C, A_XR), D, (const bf16_t*)wl_ptr(C, l, WL_O), D);
        EpiRes E{C.out, MODB, l, 1, 1.0f}; GEMM(C, S, E, D, D, D); } }
}

template <int KM>
__global__ void __launch_bounds__(NTHREADS, 2) fwd_kernel(Args args_byval) {
    extern __shared__ __attribute__((aligned(16))) unsigned char lds_raw[];
    ArgsP args0 = (ArgsP)__builtin_amdgcn_kernarg_segment_ptr();
    const int lo = args0->ph_lo, hi = args0->ph_hi;
    volatile LAS unsigned* bst = (volatile LAS unsigned*)((LAS unsigned char*)lds_raw + 131072);
    if constexpr (KM == K_ALL) { if (threadIdx.x < 2) bst[threadIdx.x] = 0u; __syncthreads(); (void)xcd_barrier_post((unsigned*)(args0->ws + WS_CTL), bst); }
    for (int ph = lo; ph < hi; ++ph) {
        ArgsP args = args0; asm volatile("" : "+s"(args));
        int tid = threadIdx.x; asm volatile("" : "+v"(tid));
        int bid = blockIdx.x; asm volatile("" : "+s"(bid));
        Ctx C; C.out = args->out; C.ws = args->ws; C.lds = (LAS unsigned char*)lds_raw;
        C.tid = tid; C.lane = tid & 63; C.wave = __builtin_amdgcn_readfirstlane(tid >> 6); C.bid = bid; C.G = gridDim.x;
        run_phase<KM>(args, C, ph);
        if constexpr (KM == K_ALL) { if (ph + 1 < hi && sync_after_phase(ph)) {
            if (ph == 0) cooperative_groups::this_grid().sync();
            else { XcdBarrier xb; xb.bar = (unsigned*)(args->ws + WS_CTL); xb.x = xb_xcc_id(); xb.st = bst; xcd_barrier(xb); } } }
    }
}

template <int KM> static void launch_kind(const Args& a, hipStream_t stream) {
    static bool attr = false;
    if (!attr) { if (hipFuncSetAttribute((const void*)fwd_kernel<KM>, hipFuncAttributeMaxDynamicSharedMemorySize, LDS_BYTES) != hipSuccess) fprintf(stderr, "hipFuncSetAttribute failed\n"); attr = true; }
    hipLaunchKernelGGL(fwd_kernel<KM>, dim3(256), dim3(NTHREADS), LDS_BYTES, stream, a);
}
extern "C" void kernel_launch(void* const* d_in, const int* in_sizes, int n_in, void* d_out, int out_size, void* d_ws, size_t ws_size, hipStream_t stream) {
    if (n_in != 32 || ws_size < WS_END) { fprintf(stderr, "kernel_launch: n_in %d ws %zu (need %zu)\n", n_in, ws_size, (size_t)WS_END); return; }
    Args a{};
    for (int i = 0; i < 32; ++i) a.in[i] = (const float*)d_in[i];
    a.out = (float*)d_out; a.ws = (unsigned char*)d_ws;
#if N_LAUNCH_MODE == 1
    static bool attr = false;
    if (!attr) { if (hipFuncSetAttribute((const void*)fwd_kernel<K_ALL>, hipFuncAttributeMaxDynamicSharedMemorySize, LDS_BYTES) != hipSuccess) fprintf(stderr, "hipFuncSetAttribute failed\n"); attr = true; }
    a.ph_lo = 0; a.ph_hi = N_PHASES;
    if (hipMemsetAsync((char*)d_ws + WS_CTL, 0, 16384, stream) != hipSuccess) { fprintf(stderr, "hipMemsetAsync failed\n"); return; }
    void* kargs[] = {&a};
    hipError_t e = hipLaunchCooperativeKernel((const void*)fwd_kernel<K_ALL>, dim3(256), dim3(NTHREADS), kargs, LDS_BYTES, stream);
    if (e != hipSuccess) fprintf(stderr, "cooperative launch failed: %s\n", hipGetErrorString(e));
#else
    for (int p = 0; p < N_PHASES; ++p) { a.ph_lo = p; a.ph_hi = p + 1;
        switch (kind_of_phase(p)) {
            case K_P0: launch_kind<K_P0>(a, stream); break; case K_NORM: launch_kind<K_NORM>(a, stream); break; case K_GU: launch_kind<K_GU>(a, stream); break;
            case K_RES: launch_kind<K_RES>(a, stream); break; case K_IN: launch_kind<K_IN>(a, stream); break; case K_ATTN: launch_kind<K_ATTN>(a, stream); break;
            case K_LRU: launch_kind<K_LRU>(a, stream); break; case K_DFT: launch_kind<K_DFT>(a, stream); break; default: launch_kind<K_BR>(a, stream); break; } }
#endif
}
```

```cpp
#include <hip/hip_runtime.h>
#include <hip/hip_cooperative_groups.h>
#include <cstdint>
#include <cstdio>


#define LAS __attribute__((address_space(3)))
typedef unsigned short bf16_t;
typedef short bf16x8 __attribute__((ext_vector_type(8)));
typedef float f32x4 __attribute__((ext_vector_type(4)));
typedef float f32x2 __attribute__((ext_vector_type(2)));
typedef unsigned u32x4 __attribute__((ext_vector_type(4)));
typedef unsigned u32x2 __attribute__((ext_vector_type(2)));

constexpr int D = 1024, MP = 4096, MS = 8192, M = MP + MS, DFF = 2816, DEPTH = 2;
constexpr int LC = 256, LS = 2048;
constexpr int NB_C = 16, NB_S = 4;
constexpr int NIN = 2304 + 3072;
constexpr int NMOD = 9216;
constexpr float EPS = 1e-6f;
constexpr float LOG2E = 1.4426950408889634f;
constexpr float QSCALE = 0.125f * LOG2E;

constexpr size_t MiB = 1u << 20;
constexpr size_t SZ_WGU = (size_t)2 * DFF * D * 2, SZ_WD = (size_t)D * DFF * 2, SZ_WIN = (size_t)NIN * D * 2;
constexpr size_t SZ_WA = (size_t)D * 512 * 2, SZ_W1K = (size_t)D * D * 2;
constexpr size_t WL_GU1 = 0, WL_D1 = WL_GU1 + SZ_WGU, WL_GU2 = WL_D1 + SZ_WD, WL_D2 = WL_GU2 + SZ_WGU, WL_IN = WL_D2 + SZ_WD,
                 WL_A = WL_IN + SZ_WIN, WL_L2 = WL_A + SZ_WA, WL_F2 = WL_L2 + SZ_W1K, WL_O = WL_F2 + SZ_W1K, WL_SIZE = WL_O + SZ_W1K;
constexpr size_t WS_CTL = 0;
constexpr size_t WS_MISC = 1 * MiB;
constexpr size_t OFF_MOD = WS_MISC;
constexpr size_t OFF_ROPE = OFF_MOD + (size_t)2 * 5 * NMOD * 4;
constexpr size_t OFF_CK = OFF_ROPE + 2 * 1024 * 4;
constexpr size_t OFF_CVT = OFF_CK + (size_t)4 * 2 * 256 * 128 * 2;
constexpr size_t OFF_LWT = OFF_CVT + (size_t)4 * 2 * 2 * 64 * 256 * 2;
constexpr size_t WS_DFTC = 3 * MiB;
constexpr size_t WS_DFTL = 4 * MiB;
constexpr size_t WS_W = 20 * MiB;
constexpr size_t WS_ACT = WS_W + 2 * WL_SIZE;
constexpr size_t A_G = 0;
constexpr size_t A_XN = 72 * MiB;
constexpr size_t A_XR = 96 * MiB;
constexpr size_t A_GY = 120 * MiB;
constexpr size_t A_XFT = 132 * MiB;
constexpr size_t A_Q = 144 * MiB;
constexpr size_t A_K = 156 * MiB;
constexpr size_t A_VT = 159 * MiB;
constexpr size_t A_Z = 162 * MiB;
constexpr size_t A_END = 186 * MiB;
constexpr size_t WS_END = WS_ACT + A_END;

constexpr int OUT_YS = MP * D, OUT_CK = M * D, OUT_CV = OUT_CK + 16 * 2 * 256 * 128, OUT_ST = OUT_CV + 16 * 2 * 256 * 128;

constexpr int NTHREADS = 512, NWAVES = 8;
constexpr int LDS_BYTES = 147456;

typedef __bf16 bf16x2_t __attribute__((ext_vector_type(2)));
__device__ __forceinline__ unsigned cvt_pk_bf16(float lo, float hi) { f32x2 v = {lo, hi}; bf16x2_t b = __builtin_convertvector(v, bf16x2_t); return __builtin_bit_cast(unsigned, b); }
__device__ __forceinline__ bf16_t f2bf(float f) { return (bf16_t)(cvt_pk_bf16(f, 0.f) & 0xffffu); }
__device__ __forceinline__ float bf2f(unsigned h) { return __uint_as_float(h << 16); }
__device__ __forceinline__ float bflo(unsigned w) { return __uint_as_float(w << 16); }
__device__ __forceinline__ float bfhi(unsigned w) { return __uint_as_float(w & 0xffff0000u); }
__device__ __forceinline__ float sigmoidf_(float x) { return 1.0f / (1.0f + __expf(-x)); }
__device__ __forceinline__ float siluf_(float x) { return x / (1.0f + __expf(-x)); }
__device__ __forceinline__ float gelu_tanh(float x) { const float u = 0.7978845608028654f * (x + 0.044715f * x * x * x); return x / (1.0f + __expf(-2.0f * u)); }
__device__ __forceinline__ float wave_sum(float v) {
#pragma unroll
    for (int o = 1; o < 64; o <<= 1) v += __shfl_xor(v, o);
    return v;
}
__device__ __forceinline__ int cond_of_row(int r) { return r < MP ? 4 : ((r - MP) >> 11); }

struct Args {
    const float* in[32];
    float* out;
    unsigned char* ws;
    int ph_lo, ph_hi;
};

typedef const __attribute__((address_space(4))) Args* ArgsP;
struct Ctx {
    float* out; unsigned char* ws; LAS unsigned char* lds;
    int tid, lane, wave, bid, G;
};
__device__ __forceinline__ unsigned char* wl_ptr(const Ctx& C, int l, size_t off) { return C.ws + WS_W + (size_t)l * WL_SIZE + off; }
__device__ __forceinline__ unsigned char* act_ptr(const Ctx& C, size_t off) { return C.ws + WS_ACT + off; }
__device__ __forceinline__ const float* mod_ptr(const Ctx& C, int l, int c, int sub, int which) { return (const float*)(C.ws + OFF_MOD) + ((size_t)(l * 5 + c) * NMOD + (sub * 3 + which) * D); }

__device__ __forceinline__ void p0_transpose_item(const float* W, int ldw, bf16_t* WT, int ldt, int drow0, int dcol0, int k0, int n0, LAS float* scr, int lane) {
#pragma unroll 8
    for (int i = 0; i < 32; ++i) { const int kk = 2 * i + (lane >> 5); scr[kk * 33 + (lane & 31)] = W[(size_t)(k0 + kk) * ldw + n0 + (lane & 31)]; }
    asm volatile("s_waitcnt lgkmcnt(0)" ::: "memory");
    const int c = lane & 7;
#pragma unroll
    for (int j = 0; j < 4; ++j) { const int n = (lane >> 3) + 8 * j; const LAS float* s = scr + (8 * c) * 33 + n;
        u32x4 o; o.x = cvt_pk_bf16(s[0 * 33], s[1 * 33]); o.y = cvt_pk_bf16(s[2 * 33], s[3 * 33]); o.z = cvt_pk_bf16(s[4 * 33], s[5 * 33]); o.w = cvt_pk_bf16(s[6 * 33], s[7 * 33]);
        *(u32x4*)(WT + (size_t)(drow0 + n) * ldt + dcol0 + k0 + 8 * c) = o; }
    asm volatile("s_waitcnt lgkmcnt(0)" ::: "memory");
}

__device__ __forceinline__ void p0_prologue(ArgsP args, const Ctx& C) {
    LAS float* SC = (LAS float*)C.lds;
    LAS float* TAB = (LAS float*)(C.lds + 20480);
    LAS float* SCR = (LAS float*)(C.lds + 32768);
    const float* c_in = args->in[2]; const float* cctx = args->in[6];
    for (int i = C.tid; i < 5 * 1024; i += NTHREADS) { const float v = (i < 4096) ? c_in[i] : cctx[i - 4096]; SC[i] = siluf_(v); }
    for (int i = C.tid; i < 2048; i += NTHREADS) TAB[i] = cospif((float)i * (1.0f / 1024.0f));
    __syncthreads();
    for (int it = C.bid; it < 288 + 128; it += C.G) {
        if (it < 288) {
            const int l = it / 144, j0 = (it % 144) * 64;
            const float* W = args->in[7] + (size_t)l * D * NMOD + j0 + C.lane;
            float a0 = 0.f, a1 = 0.f, a2 = 0.f, a3 = 0.f, a4 = 0.f;
            const int kb = C.wave * 128;
#pragma unroll 8
            for (int k = 0; k < 128; ++k) { const float w = W[(size_t)(kb + k) * NMOD];
                a0 += SC[kb + k] * w; a1 += SC[1024 + kb + k] * w; a2 += SC[2048 + kb + k] * w; a3 += SC[3072 + kb + k] * w; a4 += SC[4096 + kb + k] * w; }
            SCR[(C.wave * 5 + 0) * 64 + C.lane] = a0; SCR[(C.wave * 5 + 1) * 64 + C.lane] = a1; SCR[(C.wave * 5 + 2) * 64 + C.lane] = a2;
            SCR[(C.wave * 5 + 3) * 64 + C.lane] = a3; SCR[(C.wave * 5 + 4) * 64 + C.lane] = a4;
            __syncthreads();
            if (C.tid < 320) { const int c = C.tid >> 6, j = C.tid & 63; float s = args->in[8][(size_t)l * NMOD + j0 + j];
#pragma unroll
                for (int w = 0; w < 8; ++w) s += SCR[(w * 5 + c) * 64 + j];
                ((float*)(C.ws + OFF_MOD))[(size_t)(l * 5 + c) * NMOD + j0 + j] = s; }
            __syncthreads();
        } else {
            const int r = it - 288, l = r >> 6, g = (r >> 4) & 3, n0 = (r & 15) * 64;
            const float* Wf = args->in[30] + (size_t)l * 512 * D + (size_t)(g * 128) * D + n0;
            for (int i = C.tid; i < 128 * 64; i += NTHREADS) SCR[i] = Wf[(size_t)(i >> 6) * D + (i & 63)];
            __syncthreads();
            const int n = C.tid & 63, cw = C.tid >> 6;
            bf16_t* dst = (bf16_t*)wl_ptr(C, l, WL_F2) + (size_t)(n0 + n) * D + g * 128;
            const float s = 0.08838834764831845f;
            for (int j = 0; j < 16; ++j) { const int c = cw + 8 * j; float ac = 0.f, as = 0.f;
#pragma unroll 8
                for (int q = 0; q < 128; ++q) { const int idx = ((q * c) & 127) * 16; const float w = SCR[q * 64 + n];
                    ac += TAB[idx] * w; as += TAB[(idx - 512) & 2047] * w; }
                dst[c] = f2bf(ac * s); dst[512 + c] = f2bf(-as * s); }
            __syncthreads();
        }
    }
    __syncthreads();
    {
        LAS float* scr = SCR + C.wave * (64 * 33);
        const int gw = C.bid * NWAVES + C.wave, NGW = C.G * NWAVES;
        constexpr int I_G = 16 * 88, I_D = 44 * 32, I_IN = 16 * 72, I_BG = 16 * 96, I_A = 8 * 32, I_L = 8 * 32, I_O = 16 * 32;
        constexpr int PER_LAYER = 4 * I_G + 2 * I_D + I_IN + I_BG + I_A + I_L + I_O;
        for (int it = gw; it < 2 * PER_LAYER; it += NGW) {
            const int l = it / PER_LAYER; int r = it % PER_LAYER;
            if (r < I_G) { const int kb = r / 88, n0 = (r % 88) * 32; p0_transpose_item(args->in[11] + (size_t)l * D * DFF, DFF, (bf16_t*)wl_ptr(C, l, WL_GU1), D, 256 * (n0 >> 7) + (n0 & 127), 0, kb * 64, n0, scr, C.lane); continue; } r -= I_G;
            if (r < I_G) { const int kb = r / 88, n0 = (r % 88) * 32; p0_transpose_item(args->in[12] + (size_t)l * D * DFF, DFF, (bf16_t*)wl_ptr(C, l, WL_GU1), D, 256 * (n0 >> 7) + 128 + (n0 & 127), 0, kb * 64, n0, scr, C.lane); continue; } r -= I_G;
            if (r < I_D) { const int kb = r / 32, nb = r % 32; p0_transpose_item(args->in[13] + (size_t)l * DFF * D, D, (bf16_t*)wl_ptr(C, l, WL_D1), DFF, nb * 32, 0, kb * 64, nb * 32, scr, C.lane); continue; } r -= I_D;
            if (r < I_G) { const int kb = r / 88, n0 = (r % 88) * 32; p0_transpose_item(args->in[14] + (size_t)l * D * DFF, DFF, (bf16_t*)wl_ptr(C, l, WL_GU2), D, 256 * (n0 >> 7) + (n0 & 127), 0, kb * 64, n0, scr, C.lane); continue; } r -= I_G;
            if (r < I_G) { const int kb = r / 88, n0 = (r % 88) * 32; p0_transpose_item(args->in[15] + (size_t)l * D * DFF, DFF, (bf16_t*)wl_ptr(C, l, WL_GU2), D, 256 * (n0 >> 7) + 128 + (n0 & 127), 0, kb * 64, n0, scr, C.lane); continue; } r -= I_G;
            if (r < I_D) { const int kb = r / 32, nb = r % 32; p0_transpose_item(args->in[16] + (size_t)l * DFF * D, D, (bf16_t*)wl_ptr(C, l, WL_D2), DFF, nb * 32, 0, kb * 64, nb * 32, scr, C.lane); continue; } r -= I_D;
            if (r < I_IN) { const int kb = r / 72, nb = r % 72; p0_transpose_item(args->in[17] + (size_t)l * D * 2304, 2304, (bf16_t*)wl_ptr(C, l, WL_IN), D, nb * 32, 0, kb * 64, nb * 32, scr, C.lane); continue; } r -= I_IN;
            if (r < I_BG) { const int kb = r / 96, nb = r % 96; p0_transpose_item(args->in[18] + (size_t)l * D * 3072, 3072, (bf16_t*)wl_ptr(C, l, WL_IN), D, 2304 + nb * 32, 0, kb * 64, nb * 32, scr, C.lane); continue; } r -= I_BG;
            if (r < I_A) { const int kb = r / 32, nb = r % 32; p0_transpose_item(args->in[21] + (size_t)l * 512 * D, D, (bf16_t*)wl_ptr(C, l, WL_A), 512, nb * 32, 0, kb * 64, nb * 32, scr, C.lane); continue; } r -= I_A;
            if (r < I_L) { const int kb = r / 32, nb = r % 32;
                p0_transpose_item(args->in[29] + (size_t)l * 512 * D, D, (bf16_t*)wl_ptr(C, l, WL_L2), D, nb * 32, 0, kb * 64, nb * 32, scr, C.lane);
                p0_transpose_item(args->in[29] + (size_t)l * 512 * D, D, (bf16_t*)wl_ptr(C, l, WL_L2), D, nb * 32, 512, kb * 64, nb * 32, scr, C.lane); continue; } r -= I_L;
            { const int kb = r / 32, nb = r % 32; p0_transpose_item(args->in[31] + (size_t)l * D * D, D, (bf16_t*)wl_ptr(C, l, WL_O), D, nb * 32, 0, kb * 64, nb * 32, scr, C.lane); }
        }
    }
    const int gt = C.bid * NTHREADS + C.tid, NGT = C.G * NTHREADS;
    for (int i = gt; i < M * D / 4; i += NGT) { const f32x4 v = (i < MP * D / 4) ? ((const f32x4*)args->in[0])[i] : ((const f32x4*)args->in[1])[i - MP * D / 4]; ((f32x4*)C.out)[i] = v; }
    for (int i = gt; i < 2048 * 256; i += NGT) { const int pr = i >> 8, t0 = (i & 255) * 8, p = (pr <= 1024) ? pr : pr - 1024, sh = (pr > 1024) ? 512 : 0; const float s = 0.022097086912079608f;
        float v[8];
#pragma unroll
        for (int j = 0; j < 8; ++j) v[j] = TAB[((p * (t0 + j)) - sh) & 2047] * s;
        u32x4 o; o.x = cvt_pk_bf16(v[0], v[1]); o.y = cvt_pk_bf16(v[2], v[3]); o.z = cvt_pk_bf16(v[4], v[5]); o.w = cvt_pk_bf16(v[6], v[7]);
        *(u32x4*)((bf16_t*)(C.ws + WS_DFTL) + (size_t)pr * 2048 + t0) = o; }
    for (int i = gt; i < 256 * 32; i += NGT) { const int pr = i >> 5, t0 = (i & 31) * 8, p = (pr <= 128) ? pr : pr - 128, sh = (pr > 128) ? 512 : 0; const float s = 0.0625f;
        float v[8];
#pragma unroll
        for (int j = 0; j < 8; ++j) v[j] = TAB[((p * (t0 + j) * 8) - sh) & 2047] * s;
        u32x4 o; o.x = cvt_pk_bf16(v[0], v[1]); o.y = cvt_pk_bf16(v[2], v[3]); o.z = cvt_pk_bf16(v[4], v[5]); o.w = cvt_pk_bf16(v[6], v[7]);
        *(u32x4*)((bf16_t*)(C.ws + WS_DFTC) + (size_t)pr * 256 + t0) = o; }
    for (int i = gt; i < 1024; i += NGT) { const int pos = i >> 4, f = i & 15; const float inv = exp2f(-(float)f * (13.287712379549449f / 16.0f)); const float ang = (float)pos * inv; const float af = (float)((double)ang * 0.3183098861837907);
        ((float*)(C.ws + OFF_ROPE))[i] = cospif(af); ((float*)(C.ws + OFF_ROPE))[1024 + i] = sinpif(af); }
    for (int i = gt; i < 4 * 2 * 256 * 128; i += NGT) { ((bf16_t*)(C.ws + OFF_CK))[i] = f2bf(args->in[3][i]);
        const int d = i & 63, kvh = (i >> 6) & 1, t = (i >> 7) & 255, bl = i >> 15;
        ((bf16_t*)(C.ws + OFF_CVT))[((size_t)(bl * 2 + kvh) * 64 + d) * 256 + t] = f2bf(args->in[4][i]); }
    for (int i = gt; i < 2 * 2 * 8 * 128 * 64; i += NGT) { const int k = i & 63, n = (i >> 6) & 127, g = i >> 13;
        const float v = (n < 64) ? args->in[24][((size_t)g * 64 + k) * 64 + n] : args->in[26][((size_t)g * 64 + k) * 64 + (n - 64)]; ((bf16_t*)(C.ws + OFF_LWT))[i] = f2bf(v); }
}

__device__ __forceinline__ void modnorm_phase(ArgsP args, const Ctx& C, int l, int sub) {
    const int gw = C.bid * NWAVES + C.wave, NGW = C.G * NWAVES;
    const float* nw = args->in[9] + (size_t)(l * 3 + sub) * D;
    bf16_t* XN = (bf16_t*)act_ptr(C, A_XN);
    for (int r = gw; r < M; r += NGW) {
        const int c = cond_of_row(r);
        const float* sh = mod_ptr(C, l, c, sub, 0); const float* sc = mod_ptr(C, l, c, sub, 1);
        const f32x4* xr = (const f32x4*)(C.out + (size_t)r * D) + C.lane;
        f32x4 v[4]; float s = 0.f;
#pragma unroll
        for (int j = 0; j < 4; ++j) { v[j] = xr[64 * j]; s += (v[j].x * v[j].x + v[j].y * v[j].y) + (v[j].z * v[j].z + v[j].w * v[j].w); }
        const float rstd = rsqrtf(wave_sum(s) * (1.0f / D) + EPS);
        u32x2* o = (u32x2*)(XN + (size_t)r * D) + C.lane;
#pragma unroll
        for (int j = 0; j < 4; ++j) { const int col = 4 * C.lane + 256 * j; const f32x4 w = *(const f32x4*)(nw + col), a = *(const f32x4*)(sc + col), b = *(const f32x4*)(sh + col);
            f32x4 y = v[j] * rstd * w * (a + 1.0f) + b; u32x2 p; p.x = cvt_pk_bf16(y.x, y.y); p.y = cvt_pk_bf16(y.z, y.w); o[64 * j] = p; }
    }
}
__device__ __forceinline__ void finalnorm_phase(ArgsP args, const Ctx& C) {
    const int gw = C.bid * NWAVES + C.wave, NGW = C.G * NWAVES;
    const float* nw = args->in[10];
    for (int r = gw; r < M; r += NGW) {
        f32x4* xr = (f32x4*)(C.out + (size_t)r * D) + C.lane;
        f32x4 v[4]; float s = 0.f;
#pragma unroll
        for (int j = 0; j < 4; ++j) { v[j] = xr[64 * j]; s += (v[j].x * v[j].x + v[j].y * v[j].y) + (v[j].z * v[j].z + v[j].w * v[j].w); }
        const float rstd = rsqrtf(wave_sum(s) * (1.0f / D) + EPS);
#pragma unroll
        for (int j = 0; j < 4; ++j) { const f32x4 w = *(const f32x4*)(nw + 4 * C.lane + 256 * j); xr[64 * j] = v[j] * rstd * w; }
    }
}

struct Unit { int pm, pn, z; const bf16_t* A; const bf16_t* B; };

struct StaticOrder {
    int nM, nN, nwg, G, c; const bf16_t* A; const bf16_t* B; int lda, ldb;
    __device__ void init(int Mr, int N, int G_, int c_, const bf16_t* A_, int lda_, const bf16_t* B_, int ldb_) { nM = Mr / 256; nN = N / 256; nwg = nM * nN; G = G_; c = c_; A = A_; B = B_; lda = lda_; ldb = ldb_; }
    __device__ bool next(int i, Unit& u) const {
        const long L = (long)i * G + c; if (L >= nwg) return false;
        int wgid = (int)L; { const int q = nwg / 8, r = nwg % 8, xcd = wgid % 8, off = wgid / 8; wgid = (xcd < r ? xcd * (q + 1) : r * (q + 1) + (xcd - r) * q) + off; }
        const int nig = 8 * nN, gid = wgid / nig, fm = gid * 8, gsz = (nM - fm) < 8 ? (nM - fm) : 8;
        u.pm = fm + ((wgid % nig) % gsz); u.pn = (wgid % nig) / gsz; u.z = 0;
        u.A = A + (size_t)u.pm * 256 * lda; u.B = B + (size_t)u.pn * 256 * ldb; return true;
    }
};
struct DftOrder {
    int nseq, nPm, L, G, c; const bf16_t* A; const bf16_t* XFT;
    __device__ bool next(int i, Unit& u) const {
        const int idx = i * G + c; if (idx >= nseq * nPm * 2) return false;
        u.z = idx / (nPm * 2); const int r = idx % (nPm * 2); u.pm = r >> 1; u.pn = r & 1;
        u.A = A + (size_t)u.pm * 256 * L; u.B = XFT + ((size_t)u.z * 512 + u.pn * 256) * L; return true;
    }
};

template <class Epi, class Sched>
__device__ __forceinline__ void gemm_simple(const Ctx& C, const Sched& S, const Epi& E, int lda, int ldb, int K) {
    const int wr = C.wave >> 2, wc = C.wave & 3, fr = C.lane & 15, fq = C.lane >> 4;
    Unit u;
    for (int ui = 0; S.next(ui, u); ++ui) {
        f32x4 acc[2][2][4][2];
#pragma unroll
        for (int a = 0; a < 2; ++a)
#pragma unroll
            for (int b = 0; b < 2; ++b)
#pragma unroll
                for (int m = 0; m < 4; ++m)
#pragma unroll
                    for (int n = 0; n < 2; ++n) acc[a][b][m][n] = (f32x4){0.f, 0.f, 0.f, 0.f};
        const bf16_t* pa = u.A + (size_t)(wr * 64 + fr) * lda + fq * 8;
        const bf16_t* pb = u.B + (size_t)(wc * 32 + fr) * ldb + fq * 8;
        for (int k0 = 0; k0 < K; k0 += 32) {
            bf16x8 At[2][4], Bt[2][2];
#pragma unroll
            for (int a = 0; a < 2; ++a)
#pragma unroll
                for (int m = 0; m < 4; ++m) At[a][m] = *(const bf16x8*)(pa + (size_t)(a * 128 + m * 16) * lda + k0);
#pragma unroll
            for (int b = 0; b < 2; ++b)
#pragma unroll
                for (int n = 0; n < 2; ++n) Bt[b][n] = *(const bf16x8*)(pb + (size_t)(b * 128 + n * 16) * ldb + k0);
#pragma unroll
            for (int a = 0; a < 2; ++a)
#pragma unroll
                for (int b = 0; b < 2; ++b)
#pragma unroll
                    for (int m = 0; m < 4; ++m)
#pragma unroll
                        for (int n = 0; n < 2; ++n) acc[a][b][m][n] = __builtin_amdgcn_mfma_f32_16x16x32_bf16(Bt[b][n], At[a][m], acc[a][b][m][n], 0, 0, 0);
        }
        E(acc, u, wr, wc, fr, fq);
    }
}

namespace pg8 {
#define PG8_LAS __attribute__((address_space(3)))
constexpr int BM = 256, BK = 64, HALF = 128, HTB = HALF * BK * 2  , STAGE_BYTES = 8 * HTB, NXCD = 8, WGM = 8;

__host__ __device__ __forceinline__ int lds_byte(int r, int c) { const int st = (r >> 4) * 2 + (c >> 5), rr = r & 15, cc = c & 31, ob = rr * 64 + cc * 2; return st * 1024 + (ob ^ (((ob >> 9) & 1) << 5)); }
__host__ __device__ __forceinline__ void stage_rc(int b, int& R, int& C) { const int st = b / 1024, sb = b % 1024, swz = sb ^ (((sb >> 9) & 1) << 5); R = (st >> 1) * 16 + swz / 64; C = (st & 1) * 32 + (swz % 64) / 2; }
__host__ __device__ __forceinline__ int perm32(int rho) { const int n = rho >> 4, i = rho & 15; return 8 * (i >> 2) + 4 * n + (i & 3); }
template <class Epi, class Sched, bool ALIGN_EPI = true, bool SP2 = true>
__device__ __forceinline__ void gemm_phase(PG8_LAS unsigned char* lds, const int tid, const Sched& S, const Epi& E, const int lda, const int ldb, const int K) {
    const int wid = __builtin_amdgcn_readfirstlane(tid >> 6), lane = tid & 63, wr = wid >> 2, wc = wid & 3, fr = lane & 15, fq = lane >> 4;
    const int nt = K / BK;
    unsigned voffA[2], voffB[2];
#pragma unroll
    for (int i = 0; i < 2; ++i) { int R, C; stage_rc(tid * 16 + i * 8192, R, C); const int Rb = Epi::PERM ? ((R & ~31) + perm32(R & 31)) : R;
        voffA[i] = (unsigned)(R * lda + C) * 2u; voffB[i] = (unsigned)(Rb * ldb + C) * 2u; }
    const size_t kstep = (size_t)(BK * 2);
    const size_t hstepA = (size_t)HALF * lda * 2, hstepB = (size_t)HALF * ldb * 2;
    const unsigned ldsw = (unsigned)wid * 1024u;
    const int aoff = lds_byte(wr * 64 + fr, fq * 8), boff = lds_byte(wc * 32 + fr, fq * 8);
#define PG8_SA(b, h) (((b) * 2 + (h)) * HTB)
#define PG8_SB(b, h) ((4 + (b) * 2 + (h)) * HTB)
#define PG8_STAGE(bufoff, gbase, voff) do { _Pragma("unroll") for (int _i = 0; _i < 2; ++_i) \
        __builtin_amdgcn_global_load_lds((const unsigned*)((const char*)(gbase) + (voff)[_i]), (PG8_LAS unsigned*)(lds + (bufoff) + ldsw + _i * 8192), 16, 0, 0); } while (0)
#define PG8_LDA(dst, b, h) do { _Pragma("unroll") for (int m = 0; m < 4; ++m) _Pragma("unroll") for (int k = 0; k < 2; ++k) dst[m][k] = *(const PG8_LAS bf16x8*)(lds + PG8_SA(b, h) + aoff + m * 2048 + k * 1024); } while (0)
#define PG8_LDB(dst, b, h) do { _Pragma("unroll") for (int n = 0; n < 2; ++n) _Pragma("unroll") for (int k = 0; k < 2; ++k) dst[n][k] = *(const PG8_LAS bf16x8*)(lds + PG8_SB(b, h) + boff + n * 2048 + k * 1024); } while (0)
#define PG8_MMA(ai, bj, At, Bt) do { __builtin_amdgcn_s_setprio(1); _Pragma("unroll") for (int m = 0; m < 4; ++m) _Pragma("unroll") for (int n = 0; n < 2; ++n) _Pragma("unroll") for (int k = 0; k < 2; ++k) \
        acc[ai][bj][m][n] = __builtin_amdgcn_mfma_f32_16x16x32_bf16(Bt[n][k], At[m][k], acc[ai][bj][m][n], 0, 0, 0); __builtin_amdgcn_s_setprio(0); } while (0)
#define PG8_WAIT_V(n) asm volatile("s_waitcnt vmcnt(" #n ")" ::: "memory")
#define PG8_WAIT_L(n) asm volatile("s_waitcnt lgkmcnt(" #n ")" ::: "memory")
#define PG8_BAR __builtin_amdgcn_s_barrier()
#define PG8_SCHED __builtin_amdgcn_sched_barrier(0)
    Unit cur, nxt; int ui = 0;
    if (!S.next(0, cur)) return;
    f32x4 acc[2][2][4][2];
#pragma unroll
    for (int a = 0; a < 2; ++a)
#pragma unroll
        for (int b = 0; b < 2; ++b)
#pragma unroll
            for (int m = 0; m < 4; ++m)
#pragma unroll
                for (int n = 0; n < 2; ++n) acc[a][b][m][n] = (f32x4){0.f, 0.f, 0.f, 0.f};
    bf16x8 At[4][2], B0[2][2], B1[2][2];
    const char* cA = (const char*)cur.A; const char* cB = (const char*)cur.B;
    if constexpr (SP2) {
        PG8_STAGE(PG8_SB(0, 0), cB, voffB); PG8_STAGE(PG8_SB(0, 1), cB + hstepB, voffB); PG8_STAGE(PG8_SA(0, 0), cA, voffA); PG8_STAGE(PG8_SA(0, 1), cA + hstepA, voffA);
        if (wr == 1) PG8_BAR;
        PG8_WAIT_V(2); PG8_BAR;
        PG8_STAGE(PG8_SB(1, 0), cB + kstep, voffB); PG8_STAGE(PG8_SA(1, 0), cA + kstep, voffA); PG8_STAGE(PG8_SB(1, 1), cB + hstepB + kstep, voffB);
        PG8_WAIT_V(6); PG8_BAR;
    } else {
        PG8_STAGE(PG8_SB(0, 0), cB, voffB); PG8_STAGE(PG8_SA(0, 0), cA, voffA); PG8_STAGE(PG8_SB(0, 1), cB + hstepB, voffB); PG8_STAGE(PG8_SA(0, 1), cA + hstepA, voffA);
        if (wr == 1) PG8_BAR;
        PG8_WAIT_V(4); PG8_BAR;
        PG8_STAGE(PG8_SB(1, 0), cB + kstep, voffB); PG8_STAGE(PG8_SA(1, 0), cA + kstep, voffA); PG8_STAGE(PG8_SB(1, 1), cB + hstepB + kstep, voffB);
        PG8_WAIT_V(6); PG8_BAR;
    }
    for (;;) {
        const bool has_next = S.next(ui + 1, nxt);
        const char* nA = has_next ? (const char*)nxt.A : cA; const char* nB = has_next ? (const char*)nxt.B : cB;
        for (int t = 0; t < nt; t += 2) {
            const bool last = (t == nt - 2);
            const char* a1 = cA + (size_t)(t + 1) * kstep;
            const char* a2 = last ? nA : cA + (size_t)(t + 2) * kstep; const char* b2 = last ? nB : cB + (size_t)(t + 2) * kstep;
            const char* a3 = a2 + kstep; const char* b3 = b2 + kstep;
            if constexpr (SP2) {
            PG8_LDB(B0, 0, 0); PG8_LDB(B1, 0, 1); PG8_SCHED; PG8_LDA(At, 0, 0); PG8_STAGE(PG8_SA(1, 1), a1 + hstepA, voffA);
            PG8_WAIT_V(8); PG8_WAIT_L(0); PG8_BAR; PG8_MMA(0, 0, At, B0); PG8_MMA(0, 1, At, B1); PG8_BAR; PG8_SCHED;
            PG8_LDA(At, 0, 1); PG8_STAGE(PG8_SB(0, 0), b2, voffB); PG8_STAGE(PG8_SB(0, 1), b2 + hstepB, voffB); PG8_STAGE(PG8_SA(0, 0), a2, voffA);
            PG8_WAIT_V(8); PG8_WAIT_L(0); PG8_BAR; PG8_MMA(1, 0, At, B0); PG8_MMA(1, 1, At, B1); PG8_BAR; PG8_SCHED;
            PG8_LDB(B0, 1, 0); PG8_LDB(B1, 1, 1); PG8_SCHED; PG8_LDA(At, 1, 0); PG8_STAGE(PG8_SA(0, 1), a2 + hstepA, voffA);
            PG8_WAIT_V(8); PG8_WAIT_L(0); PG8_BAR; PG8_MMA(0, 0, At, B0); PG8_MMA(0, 1, At, B1); PG8_BAR; PG8_SCHED;
            PG8_LDA(At, 1, 1); PG8_STAGE(PG8_SB(1, 0), b3, voffB); PG8_STAGE(PG8_SB(1, 1), b3 + hstepB, voffB); PG8_STAGE(PG8_SA(1, 0), a3, voffA);
            PG8_WAIT_V(8); PG8_WAIT_L(0); PG8_BAR; PG8_MMA(1, 0, At, B0); PG8_MMA(1, 1, At, B1); PG8_BAR; PG8_SCHED;
            } else {
            PG8_LDB(B0, 0, 0); PG8_SCHED; PG8_LDA(At, 0, 0); PG8_STAGE(PG8_SA(1, 1), a1 + hstepA, voffA);
            PG8_WAIT_L(8); PG8_BAR; PG8_WAIT_L(0); PG8_MMA(0, 0, At, B0); PG8_BAR; PG8_SCHED;
            PG8_LDB(B1, 0, 1); PG8_STAGE(PG8_SB(0, 0), b2, voffB);
            PG8_BAR; PG8_WAIT_L(0); PG8_MMA(0, 1, At, B1); PG8_BAR;
            PG8_LDA(At, 0, 1); PG8_STAGE(PG8_SA(0, 0), a2, voffA);
            PG8_BAR; PG8_WAIT_L(0); PG8_MMA(1, 0, At, B0); PG8_BAR; PG8_SCHED;
            PG8_STAGE(PG8_SB(0, 1), b2 + hstepB, voffB);
            PG8_WAIT_V(6); PG8_BAR; PG8_MMA(1, 1, At, B1); PG8_BAR;
            PG8_LDB(B0, 1, 0); PG8_SCHED; PG8_LDA(At, 1, 0); PG8_STAGE(PG8_SA(0, 1), a2 + hstepA, voffA);
            PG8_WAIT_L(8); PG8_BAR; PG8_WAIT_L(0); PG8_MMA(0, 0, At, B0); PG8_BAR; PG8_SCHED;
            PG8_LDB(B1, 1, 1); PG8_STAGE(PG8_SB(1, 0), b3, voffB);
            PG8_BAR; PG8_WAIT_L(0); PG8_MMA(0, 1, At, B1); PG8_BAR;
            PG8_LDA(At, 1, 1); PG8_STAGE(PG8_SA(1, 0), a3, voffA);
            PG8_BAR; PG8_WAIT_L(0); PG8_MMA(1, 0, At, B0); PG8_BAR; PG8_SCHED;
            PG8_STAGE(PG8_SB(1, 1), b3 + hstepB, voffB);
            PG8_WAIT_V(6); PG8_BAR; PG8_MMA(1, 1, At, B1); PG8_BAR;
            }
        }
        if constexpr (ALIGN_EPI) { if (wr == 0) PG8_BAR; }
        if constexpr (!Epi::AFTER_DRAIN) { E(acc, cur, wr, wc, fr, fq); }
        if (!has_next) break;
#pragma unroll
        for (int a = 0; a < 2; ++a)
#pragma unroll
            for (int b = 0; b < 2; ++b)
#pragma unroll
                for (int m = 0; m < 4; ++m)
#pragma unroll
                    for (int n = 0; n < 2; ++n) acc[a][b][m][n] = (f32x4){0.f, 0.f, 0.f, 0.f};
        cur = nxt; cA = nA; cB = nB; ++ui;
        if constexpr (ALIGN_EPI) { if (wr == 1) PG8_BAR; }
    }
    PG8_WAIT_V(0);
    if constexpr (!ALIGN_EPI) { if (wr == 0) PG8_BAR; }
    PG8_BAR;
    if constexpr (Epi::AFTER_DRAIN) { E.fused(acc, cur, wr, wc, fr, fq, lds, wid, lane); }
#undef PG8_SA
#undef PG8_SB
#undef PG8_STAGE
#undef PG8_LDA
#undef PG8_LDB
#undef PG8_MMA
#undef PG8_WAIT_V
#undef PG8_WAIT_L
#undef PG8_BAR
#undef PG8_SCHED
}
}

#ifndef USE_PG8
#define USE_PG8 1
#endif
#if USE_PG8
#define GEMM(C, S, E, lda, ldb, K) pg8::gemm_phase(C.lds, C.tid, S, E, lda, ldb, K)
#else
#define GEMM(C, S, E, lda, ldb, K) GEMM(C, S, E, lda, ldb, K)
#endif

#define EPI_LOOP_AM for (int ai = 0; ai < 2; ++ai) _Pragma("unroll") for (int m = 0; m < 4; ++m)
struct EpiGU {
    static constexpr bool PERM = false, AFTER_DRAIN = false;
    bf16_t* H;
    __device__ __forceinline__ void operator()(const f32x4 (&acc)[2][2][4][2], const Unit& u, int wr, int wc, int fr, int fq) const {
#pragma unroll
        EPI_LOOP_AM { const int row = u.pm * 256 + ai * 128 + wr * 64 + m * 16 + fr;
#pragma unroll
            for (int n = 0; n < 2; ++n) { const f32x4 g = acc[ai][0][m][n], up = acc[ai][1][m][n];
                u32x2 p; p.x = cvt_pk_bf16(siluf_(g.x) * up.x, siluf_(g.y) * up.y); p.y = cvt_pk_bf16(siluf_(g.z) * up.z, siluf_(g.w) * up.w);
                *(u32x2*)(H + (size_t)row * DFF + u.pn * 128 + wc * 32 + n * 16 + fq * 4) = p; } }
    }
};
struct EpiRes {
    static constexpr bool PERM = false, AFTER_DRAIN = false;
    float* X; const float* modbase; int l, sub; float coef;
    __device__ __forceinline__ void operator()(const f32x4 (&acc)[2][2][4][2], const Unit& u, int wr, int wc, int fr, int fq) const {
        const int c = cond_of_row(u.pm * 256);
        const float* gate = modbase + ((size_t)(l * 5 + c) * NMOD + (sub * 3 + 2) * D) + u.pn * 256 + wc * 32 + fq * 4;
        f32x4 g[2][2];
#pragma unroll
        for (int bj = 0; bj < 2; ++bj)
#pragma unroll
            for (int n = 0; n < 2; ++n) g[bj][n] = *(const f32x4*)(gate + bj * 128 + n * 16) * coef;
#pragma unroll
        EPI_LOOP_AM { float* xrow = X + (size_t)(u.pm * 256 + ai * 128 + wr * 64 + m * 16 + fr) * D + u.pn * 256 + wc * 32 + fq * 4;
#pragma unroll
            for (int bj = 0; bj < 2; ++bj)
#pragma unroll
                for (int n = 0; n < 2; ++n) { f32x4* p = (f32x4*)(xrow + bj * 128 + n * 16); *p = *p + g[bj][n] * acc[ai][bj][m][n]; }
            asm volatile("" ::: "memory"); }
    }
};
struct EpiIn {
    static constexpr bool PERM = false, AFTER_DRAIN = false;
    bf16_t *Q, *Kb, *VT, *GY, *XFT, *G; float* XR; float* out; const float* rope; const float* bgate; int l;
    __device__ __forceinline__ void operator()(const f32x4 (&acc)[2][2][4][2], const Unit& u, int wr, int wc, int fr, int fq) const {
        const int row0 = u.pm * 256 + wr * 64 + fr; const bool latent = u.pm >= 16;
        if (u.pn <= 2) {
#pragma unroll
            for (int bj = 0; bj < 2; ++bj) {
                if (u.pn == 2 && bj == 1) {
#pragma unroll
                    EPI_LOOP_AM { const int row = row0 + ai * 128 + m * 16; int seqoff, L, t;
                        if (latent) { const int b = (row - MP) >> 11; t = (row - MP) & 2047; L = LS; seqoff = 16 * 128 * LC + b * 128 * LS; } else { const int b = row >> 8; t = row & 255; L = LC; seqoff = b * 128 * LC; }
#pragma unroll
                        for (int n = 0; n < 2; ++n) { const f32x4 v = acc[ai][1][m][n]; const int d128 = wc * 32 + n * 16 + fq * 4;
                            bf16_t* p = VT + seqoff + (size_t)d128 * L + t; p[0] = f2bf(v.x); p[L] = f2bf(v.y); p[2 * L] = f2bf(v.z); p[3 * L] = f2bf(v.w);
                            if (!latent) *(f32x4*)(out + OUT_CV + ((size_t)((row >> 8) * 2 + l) * 256 + t) * 128 + d128) = v; } }
                } else {
                    const bool isk = (u.pn == 2); const int axis = wc & 1;
#pragma unroll
                    EPI_LOOP_AM { const int row = row0 + ai * 128 + m * 16; f32x4 x1 = acc[ai][bj][m][0], x2 = acc[ai][bj][m][1];
                        if (isk && !latent) { float* o = out + OUT_CK + ((size_t)((row >> 8) * 2 + l) * 256 + (row & 255)) * 128 + wc * 32 + fq * 4; *(f32x4*)o = x1; *(f32x4*)(o + 16) = x2; }
                        if (latent) { const int t = (row - MP) & 2047, pos = axis ? (t & 63) : (t >> 6);
                            const f32x4 cs = *(const f32x4*)(rope + pos * 16 + fq * 4), sn = *(const f32x4*)(rope + 1024 + pos * 16 + fq * 4);
                            const f32x4 o1 = x1 * cs - x2 * sn, o2 = x1 * sn + x2 * cs; x1 = o1; x2 = o2; }
                        if (!isk) { x1 = x1 * QSCALE; x2 = x2 * QSCALE; }
                        bf16_t* o = isk ? (Kb + (size_t)row * 128 + wc * 32 + fq * 4) : (Q + (size_t)row * 512 + u.pn * 256 + bj * 128 + wc * 32 + fq * 4);
                        u32x2 p; p.x = cvt_pk_bf16(x1.x, x1.y); p.y = cvt_pk_bf16(x1.z, x1.w); *(u32x2*)o = p;
                        p.x = cvt_pk_bf16(x2.x, x2.y); p.y = cvt_pk_bf16(x2.z, x2.w); *(u32x2*)(o + 16) = p; }
                }
            }
        } else if (u.pn <= 4) {
#pragma unroll
            EPI_LOOP_AM { const int row = row0 + ai * 128 + m * 16;
#pragma unroll
                for (int bj = 0; bj < 2; ++bj)
#pragma unroll
                    for (int n = 0; n < 2; ++n) *(f32x4*)(XR + (size_t)row * 512 + (u.pn - 3) * 256 + bj * 128 + wc * 32 + n * 16 + fq * 4) = acc[ai][bj][m][n]; }
        } else if (u.pn <= 6) {
#pragma unroll
            EPI_LOOP_AM { const int row = row0 + ai * 128 + m * 16;
#pragma unroll
                for (int bj = 0; bj < 2; ++bj)
#pragma unroll
                    for (int n = 0; n < 2; ++n) { const f32x4 v = acc[ai][bj][m][n]; u32x2 p; p.x = cvt_pk_bf16(gelu_tanh(v.x), gelu_tanh(v.y)); p.y = cvt_pk_bf16(gelu_tanh(v.z), gelu_tanh(v.w));
                        *(u32x2*)(GY + (size_t)row * 512 + (u.pn - 5) * 256 + bj * 128 + wc * 32 + n * 16 + fq * 4) = p; } }
        } else if (u.pn <= 8) {
#pragma unroll
            EPI_LOOP_AM { const int row = row0 + ai * 128 + m * 16; size_t seqoff; int L, t;
                if (latent) { const int b = (row - MP) >> 11; t = (row - MP) & 2047; L = LS; seqoff = (size_t)16 * 512 * LC + (size_t)b * 512 * LS; } else { const int b = row >> 8; t = row & 255; L = LC; seqoff = (size_t)b * 512 * LC; }
#pragma unroll
                for (int bj = 0; bj < 2; ++bj)
#pragma unroll
                    for (int n = 0; n < 2; ++n) { const f32x4 v = acc[ai][bj][m][n]; bf16_t* p = XFT + seqoff + (size_t)((u.pn - 7) * 256 + bj * 128 + wc * 32 + n * 16 + fq * 4) * L + t;
                        p[0] = f2bf(v.x); p[L] = f2bf(v.y); p[2 * L] = f2bf(v.z); p[3 * L] = f2bf(v.w); } }
        } else {
#pragma unroll
            for (int bj = 0; bj < 2; ++bj)
#pragma unroll
                for (int n = 0; n < 2; ++n) { const int col = (u.pn - 9) * 256 + bj * 128 + wc * 32 + n * 16 + fq * 4; const f32x4 b = *(const f32x4*)(bgate + col);
#pragma unroll
                    EPI_LOOP_AM { const int row = row0 + ai * 128 + m * 16; const f32x4 v = acc[ai][bj][m][n] + b;
                        u32x2 p; p.x = cvt_pk_bf16(sigmoidf_(v.x), sigmoidf_(v.y)); p.y = cvt_pk_bf16(sigmoidf_(v.z), sigmoidf_(v.w)); *(u32x2*)(G + (size_t)row * 3072 + col) = p; } }
        }
    }
};
template <int MODE> struct EpiBranch {
    static constexpr bool PERM = false, AFTER_DRAIN = false;
    bf16_t* MG; const bf16_t* G; int br;
    __device__ __forceinline__ void operator()(const f32x4 (&acc)[2][2][4][2], const Unit& u, int wr, int wc, int fr, int fq) const {
#pragma unroll
        EPI_LOOP_AM { const int row = u.pm * 256 + ai * 128 + wr * 64 + m * 16 + fr;
#pragma unroll
            for (int bj = 0; bj < 2; ++bj)
#pragma unroll
                for (int n = 0; n < 2; ++n) { const int col = u.pn * 256 + bj * 128 + wc * 32 + n * 16 + fq * 4;
                    const u32x2 g = *(const u32x2*)(G + (size_t)row * 3072 + br * 1024 + col); f32x4 v = acc[ai][bj][m][n];
                    v.x *= bflo(g.x); v.y *= bfhi(g.x); v.z *= bflo(g.y); v.w *= bfhi(g.y);
                    u32x2* p = (u32x2*)(MG + (size_t)row * D + col);
                    if (MODE == 1) { const u32x2 o = *p; v.x += bflo(o.x); v.y += bfhi(o.x); v.z += bflo(o.y); v.w += bfhi(o.y); }
                    u32x2 w; w.x = cvt_pk_bf16(v.x, v.y); w.y = cvt_pk_bf16(v.z, v.w); *p = w; }
            asm volatile("" ::: "memory"); }
    }
};
struct EpiDft {
    static constexpr bool PERM = false, AFTER_DRAIN = false;
    bf16_t* Z; int L, rowbase;
    __device__ __forceinline__ void operator()(const f32x4 (&acc)[2][2][4][2], const Unit& u, int wr, int wc, int fr, int fq) const {
        const int hl = L >> 1;
#pragma unroll
        EPI_LOOP_AM { const int rr = u.pm * 256 + ai * 128 + wr * 64 + m * 16 + fr; const bool sn = rr >= hl; const int p = sn ? rr - hl : rr;
            bf16_t* z0 = Z + (size_t)rowbase * D + u.pn * 256 + wc * 32 + fq * 4;
#pragma unroll
            for (int bj = 0; bj < 2; ++bj)
#pragma unroll
                for (int n = 0; n < 2; ++n) { const f32x4 v = acc[ai][bj][m][n]; u32x2 w; w.x = cvt_pk_bf16(v.x, v.y); w.y = cvt_pk_bf16(v.z, v.w); const int co = bj * 128 + n * 16;
                    if (!sn) { *(u32x2*)(z0 + (size_t)p * D + co) = w; if (p) *(u32x2*)(z0 + (size_t)(L - p) * D + co) = w; }
                    else if (p == 0) { *(u32x2*)(z0 + (size_t)hl * D + co) = w; const u32x2 zz = {0u, 0u}; *(u32x2*)(z0 + 512 + co) = zz; *(u32x2*)(z0 + (size_t)hl * D + 512 + co) = zz; }
                    else { *(u32x2*)(z0 + (size_t)p * D + 512 + co) = w; u32x2 nw; nw.x = w.x ^ 0x80008000u; nw.y = w.y ^ 0x80008000u; *(u32x2*)(z0 + (size_t)(L - p) * D + 512 + co) = nw; } } }
    }
};

typedef float f32x16 __attribute__((ext_vector_type(16)));
typedef short s16x4 __attribute__((ext_vector_type(4)));
#define MFMA32(a, b, c) __builtin_amdgcn_mfma_f32_32x32x16_bf16((a), (b), (c), 0, 0, 0)
constexpr int AT_KSTR = 144, AT_VSTR = 136, AT_KBYTES = 64 * AT_KSTR, AT_VBYTES = 64 * AT_VSTR, AT_BUF = AT_KBYTES + AT_VBYTES;
struct AttnSrc { const bf16_t* kp; const bf16_t* vp; int vstride; int kbase; };
__device__ __forceinline__ AttnSrc attn_src(int t, bool latent, int nband, int lo, int b, int l, int kvh, const bf16_t* Kb, const bf16_t* VT, const bf16_t* CK, const bf16_t* CVT) {
    AttnSrc s;
    if (!latent) { s.kp = Kb + (size_t)(b * LC + 64 * t) * 128 + kvh * 64; s.vp = VT + (size_t)b * 128 * LC + (size_t)(kvh * 64) * LC + 64 * t; s.vstride = LC; s.kbase = 0; }
    else if (t < nband) { const int kb = lo + 64 * t; s.kp = Kb + (size_t)(MP + b * LS + kb) * 128 + kvh * 64; s.vp = VT + (size_t)16 * 128 * LC + (size_t)b * 128 * LS + (size_t)(kvh * 64) * LS + kb; s.vstride = LS; s.kbase = kb; }
    else { const int c = t - nband; s.kp = CK + (size_t)((b * 2 + l) * 256 + 64 * c) * 128 + kvh * 64; s.vp = CVT + (size_t)((b * 2 + l) * 2 + kvh) * 64 * 256 + 64 * c; s.vstride = 256; s.kbase = 0; }
    return s;
}
__device__ __forceinline__ void attn_unit(ArgsP args, const Ctx& C, int l, int ui) {
    bf16_t* Q = (bf16_t*)act_ptr(C, A_Q); const bf16_t* Kb = (const bf16_t*)act_ptr(C, A_K); const bf16_t* VT = (const bf16_t*)act_ptr(C, A_VT);
    const bf16_t* CK = (const bf16_t*)(C.ws + OFF_CK); const bf16_t* CVT = (const bf16_t*)(C.ws + OFF_CVT);
    const int q32 = C.lane & 31, half = C.lane >> 5, w = C.wave;
    const int srow = C.tid >> 3, schunk = C.tid & 7;
    {
        const bool latent = ui < 256;
        int b, h, qb; if (latent) { b = ui >> 6; h = (ui >> 3) & 7; qb = ui & 7; } else { const int r = ui - 256; b = r >> 3; h = r & 7; qb = 0; }
        const int kvh = h >> 2, rowbase = latent ? (MP + b * LS + qb * 256) : b * LC;
        int lo = 0, nband = 4, nt = 4;
        if (latent) { lo = 256 * qb - 128; if (lo < 0) lo = 0; int hi = 256 * qb + 384; if (hi > LS) hi = LS; nband = (hi - lo) >> 6; nt = nband + 4; }
        const int qw_lo = qb * 256 + 32 * w, qpos = qw_lo + q32;
        bf16x8 qf[4];
        { const bf16_t* qp = Q + (size_t)(rowbase + 32 * w + q32) * 512 + h * 64 + 8 * half;
#pragma unroll
          for (int ks = 0; ks < 4; ++ks) qf[ks] = *(const bf16x8*)(qp + 16 * ks); }
        f32x16 O0, O1;
#pragma unroll
        for (int r = 0; r < 16; ++r) { O0[r] = 0.f; O1[r] = 0.f; }
        float mrun = args->in[20][l * 8 + h] * LOG2E, lsum = half ? 0.f : 1.0f;
        { const AttnSrc s0 = attn_src(0, latent, nband, lo, b, l, kvh, Kb, VT, CK, CVT);
          const u32x4 kreg = *(const u32x4*)(s0.kp + (size_t)srow * 128 + schunk * 8), vreg = *(const u32x4*)(s0.vp + (size_t)srow * s0.vstride + schunk * 8);
          *(LAS u32x4*)(C.lds + srow * AT_KSTR + schunk * 16) = kreg;
          LAS u32x2* vd = (LAS u32x2*)(C.lds + AT_KBYTES + srow * AT_VSTR + schunk * 16); vd[0] = (u32x2){vreg.x, vreg.y}; vd[1] = (u32x2){vreg.z, vreg.w}; }
        __syncthreads();
        for (int t = 0; t < nt; ++t) {
            const int buf = t & 1;
            u32x4 kreg, vreg; const bool more = (t + 1 < nt);
            if (more) { const AttnSrc s1 = attn_src(t + 1, latent, nband, lo, b, l, kvh, Kb, VT, CK, CVT);
                kreg = *(const u32x4*)(s1.kp + (size_t)srow * 128 + schunk * 8); vreg = *(const u32x4*)(s1.vp + (size_t)srow * s1.vstride + schunk * 8); }
            bool skip = false, domask = false;
            if (latent && t < nband) { const int kb = lo + 64 * t; skip = (kb > qw_lo + 31 + 128) || (kb + 63 < qw_lo - 128); domask = !((kb + 63 - qw_lo <= 128) && (qw_lo + 31 - kb <= 128)); }
            if (!skip) {
                const LAS unsigned char* kbp = C.lds + buf * AT_BUF; const LAS unsigned char* vbp = kbp + AT_KBYTES;
                f32x16 S0, S1;
#pragma unroll
                for (int r = 0; r < 16; ++r) { S0[r] = 0.f; S1[r] = 0.f; }
#pragma unroll
                for (int ks = 0; ks < 4; ++ks) { const bf16x8 k0 = *(const LAS bf16x8*)(kbp + q32 * AT_KSTR + ks * 32 + half * 16), k1 = *(const LAS bf16x8*)(kbp + (32 + q32) * AT_KSTR + ks * 32 + half * 16);
                    S0 = MFMA32(k0, qf[ks], S0); S1 = MFMA32(k1, qf[ks], S1); }
                if (domask) { const int kb = lo + 64 * t;
#pragma unroll
                    for (int r = 0; r < 16; ++r) { const int d0 = kb + (r & 3) + 8 * (r >> 2) + 4 * half - qpos, d1 = d0 + 32;
                        S0[r] = (d0 > 128 || d0 < -128) ? -1e30f : S0[r]; S1[r] = (d1 > 128 || d1 < -128) ? -1e30f : S1[r]; } }
                float mx = fmaxf(S0[0], S1[0]);
#pragma unroll
                for (int r = 1; r < 16; ++r) mx = fmaxf(mx, fmaxf(S0[r], S1[r]));
                mx = fmaxf(mx, __shfl_xor(mx, 32));
                const float mnew = fmaxf(mrun, mx), alpha = __builtin_amdgcn_exp2f(mrun - mnew); mrun = mnew;
                float ps = 0.f;
#pragma unroll
                for (int r = 0; r < 16; ++r) { S0[r] = __builtin_amdgcn_exp2f(S0[r] - mnew); S1[r] = __builtin_amdgcn_exp2f(S1[r] - mnew); ps += S0[r] + S1[r]; }
                lsum = lsum * alpha + ps;
#pragma unroll
                for (int r = 0; r < 16; ++r) { O0[r] *= alpha; O1[r] *= alpha; }
                bf16x8 pf[4];
#pragma unroll
                for (int s2 = 0; s2 < 2; ++s2) { u32x4 a, c2;
                    a.x = cvt_pk_bf16(S0[8 * s2 + 0], S0[8 * s2 + 1]); a.y = cvt_pk_bf16(S0[8 * s2 + 2], S0[8 * s2 + 3]); a.z = cvt_pk_bf16(S0[8 * s2 + 4], S0[8 * s2 + 5]); a.w = cvt_pk_bf16(S0[8 * s2 + 6], S0[8 * s2 + 7]);
                    c2.x = cvt_pk_bf16(S1[8 * s2 + 0], S1[8 * s2 + 1]); c2.y = cvt_pk_bf16(S1[8 * s2 + 2], S1[8 * s2 + 3]); c2.z = cvt_pk_bf16(S1[8 * s2 + 4], S1[8 * s2 + 5]); c2.w = cvt_pk_bf16(S1[8 * s2 + 6], S1[8 * s2 + 7]);
                    pf[s2] = __builtin_bit_cast(bf16x8, a); pf[2 + s2] = __builtin_bit_cast(bf16x8, c2); }
#pragma unroll
                for (int s4 = 0; s4 < 4; ++s4) {
                    const LAS unsigned char* v0p = vbp + q32 * AT_VSTR + s4 * 32 + half * 8; const LAS unsigned char* v1p = v0p + 32 * AT_VSTR;
                    const s16x4 a0 = *(const LAS s16x4*)v0p, a1 = *(const LAS s16x4*)(v0p + 16), b0 = *(const LAS s16x4*)v1p, b1 = *(const LAS s16x4*)(v1p + 16);
                    const bf16x8 vf0 = __builtin_shufflevector(a0, a1, 0, 1, 2, 3, 4, 5, 6, 7), vf1 = __builtin_shufflevector(b0, b1, 0, 1, 2, 3, 4, 5, 6, 7);
                    O0 = MFMA32(vf0, pf[s4], O0); O1 = MFMA32(vf1, pf[s4], O1); }
            }
            if (more) { *(LAS u32x4*)(C.lds + (buf ^ 1) * AT_BUF + srow * AT_KSTR + schunk * 16) = kreg;
                LAS u32x2* vd = (LAS u32x2*)(C.lds + (buf ^ 1) * AT_BUF + AT_KBYTES + srow * AT_VSTR + schunk * 16); vd[0] = (u32x2){vreg.x, vreg.y}; vd[1] = (u32x2){vreg.z, vreg.w}; }
            __syncthreads();
        }
        const float inv = 1.0f / (lsum + __shfl_xor(lsum, 32));
        bf16_t* op = Q + (size_t)(rowbase + 32 * w + q32) * 512 + h * 64 + 4 * half;
#pragma unroll
        for (int g = 0; g < 4; ++g) { u32x2 o; o.x = cvt_pk_bf16(O0[4 * g] * inv, O0[4 * g + 1] * inv); o.y = cvt_pk_bf16(O0[4 * g + 2] * inv, O0[4 * g + 3] * inv); *(u32x2*)(op + 8 * g) = o;
            o.x = cvt_pk_bf16(O1[4 * g] * inv, O1[4 * g + 1] * inv); o.y = cvt_pk_bf16(O1[4 * g + 2] * inv, O1[4 * g + 3] * inv); *(u32x2*)(op + 32 + 8 * g) = o; }
    }
}

constexpr int LRW_BYTES = 11008, LR_PH = 8 * LRW_BYTES, LR_CAR = LR_PH + 8192, LR_CONST = LR_CAR + 512, LR_END = LR_CONST + 768;
static_assert(LR_END <= 131072, "lru LDS map");
__device__ __forceinline__ void lru_load_rows(float (&xr)[19], const float* XRc, int trow0, int L) {
#pragma unroll
    for (int r = 0; r < 19; ++r) { const int t = trow0 + r; const bool ok = (t >= 0) && (t < L); const float v = XRc[(size_t)(ok ? t : 0) * 512]; xr[r] = ok ? v : 0.f; }
}
__device__ __forceinline__ void lru_item(ArgsP args, const Ctx& C, int l, int it) {
    const float* XR = (const float*)act_ptr(C, A_XR); const bf16_t* GY = (const bf16_t*)act_ptr(C, A_GY); bf16_t* REC = (bf16_t*)act_ptr(C, A_XN);
    const int w = C.wave, ch = C.lane, fr = C.lane & 15, fq = C.lane >> 4;
    LAS float* XF = (LAS float*)(C.lds + w * LRW_BYTES); LAS float* AA = XF + 16 * 68; LAS bf16_t* XCB = (LAS bf16_t*)(AA + 16 * 68);
    LAS float* PH = (LAS float*)(C.lds + LR_PH); LAS float* CAR = (LAS float*)(C.lds + LR_CAR); LAS float* CST = (LAS float*)(C.lds + LR_CONST);
    const int dir = it & 1, nb = (it >> 1) & 7, sq = it >> 4;
    const bool latent = sq < 4; const int b = latent ? sq : sq - 4, L = latent ? LS : LC, rowbase = latent ? MP + b * LS : b * LC;
    const int cgl = nb * 64 + ch, g = (l * 2 + dir) * 8 + nb;
    __syncthreads();
    if (C.tid < 64) { const int cg = (l * 2 + dir) * 512 + nb * 64 + C.tid; CST[C.tid] = args->in[25][cg]; CST[64 + C.tid] = args->in[27][cg]; CST[128 + C.tid] = -8.0f * log1pf(__expf(-args->in[28][cg]));
        CAR[C.tid] = latent ? args->in[5][((size_t)(b * 2 + l) * 2 + dir) * 512 + nb * 64 + C.tid] : 0.f; }
    bf16x8 wf[8][2];
    { const bf16_t* lw = (const bf16_t*)(C.ws + OFF_LWT) + (size_t)g * 128 * 64 + fr * 64 + 8 * fq;
#pragma unroll
      for (int nt = 0; nt < 8; ++nt)
#pragma unroll
          for (int kk = 0; kk < 2; ++kk) wf[nt][kk] = *(const bf16x8*)(lw + nt * 16 * 64 + 32 * kk); }
    const float cw0 = args->in[22][(l * 4 + 0) * 512 + cgl], cw1 = args->in[22][(l * 4 + 1) * 512 + cgl], cw2 = args->in[22][(l * 4 + 2) * 512 + cgl], cw3 = args->in[22][(l * 4 + 3) * 512 + cgl], cb = args->in[23][l * 512 + cgl];
    const float* XRc = XR + (size_t)rowbase * 512 + cgl;
    const int nch = L >> 7, e0 = dir ? 16 * (7 - w) : 16 * w;
    float xr[19];
    lru_load_rows(xr, XRc, (dir ? (L - 128) : 0) + e0 - 2, L);
    __syncthreads();
    float hfin = 0.f;
    for (int c = 0; c < nch; ++c) {
        const int t0 = dir ? (L - 128 * (c + 1)) : 128 * c, par = c & 1;
#pragma unroll
        for (int e = 0; e < 16; ++e) { const float xc = cb + cw0 * xr[e] + cw1 * xr[e + 1] + cw2 * xr[e + 2] + cw3 * xr[e + 3]; XF[e * 68 + ch] = xc; XCB[e * 72 + ch] = f2bf(xc); }
        asm volatile("" ::: "memory");
        float gy[16];
        { const bf16_t* gp = GY + (size_t)(rowbase + t0 + e0) * 512 + cgl;
#pragma unroll
          for (int j = 0; j < 16; ++j) gy[j] = bf2f(gp[(size_t)(dir ? 15 - j : j) * 512]); }
        if (c + 1 < nch) lru_load_rows(xr, XRc, (dir ? (L - 128 * (c + 2)) : 128 * (c + 1)) + e0 - 2, L);
        f32x4 acc[8];
#pragma unroll
        for (int nt = 0; nt < 8; ++nt) acc[nt] = (f32x4){0.f, 0.f, 0.f, 0.f};
#pragma unroll
        for (int kk = 0; kk < 2; ++kk) { const bf16x8 xf = *(const LAS bf16x8*)(XCB + fr * 72 + 8 * fq + 32 * kk);
#pragma unroll
            for (int nt = 0; nt < 8; ++nt) acc[nt] = __builtin_amdgcn_mfma_f32_16x16x32_bf16(wf[nt][kk], xf, acc[nt], 0, 0, 0); }
#pragma unroll
        for (int nt = 0; nt < 4; ++nt) { const int c0 = 16 * nt + 4 * fq; const f32x4 ba = *(const LAS f32x4*)(CST + c0), bi = *(const LAS f32x4*)(CST + 64 + c0), sp = *(const LAS f32x4*)(CST + 128 + c0);
            const f32x4 xcv = *(const LAS f32x4*)(XF + fr * 68 + c0); f32x4 av, bv;
#pragma unroll
            for (int i = 0; i < 4; ++i) { const float r = sigmoidf_(acc[nt][i] + ba[i]), ig = sigmoidf_(acc[nt + 4][i] + bi[i]); const float la = r * sp[i], a = __expf(la), y = 2.0f * la;
                const float om = (y > -0.05f) ? -y * (1.0f + 0.5f * y * (1.0f + (1.0f / 3.0f) * y * (1.0f + 0.25f * y))) : (1.0f - a * a);
                av[i] = a; bv[i] = sqrtf(fmaxf(om, 0.f)) * (ig * xcv[i]); }
            *(LAS f32x4*)(AA + fr * 68 + c0) = av; *(LAS f32x4*)(XF + fr * 68 + c0) = bv; }
        asm volatile("" ::: "memory");
        { float P = 1.f, H = 0.f;
#pragma unroll
          for (int j = 0; j < 16; ++j) { const int e = dir ? 15 - j : j; const float a = AA[e * 68 + ch], bb = XF[e * 68 + ch]; H = a * H + bb; P *= a; }
          PH[(par * 2 + 0) * 512 + w * 64 + ch] = P; PH[(par * 2 + 1) * 512 + w * 64 + ch] = H; }
        __syncthreads();
        float h = CAR[par * 64 + ch];
        for (int s2 = 0; s2 < w; ++s2) h = PH[(par * 2 + 0) * 512 + s2 * 64 + ch] * h + PH[(par * 2 + 1) * 512 + s2 * 64 + ch];
        { bf16_t* rp = REC + (size_t)(rowbase + t0 + e0) * D + dir * 512 + cgl;
#pragma unroll
          for (int j = 0; j < 16; ++j) { const int e = dir ? 15 - j : j; h = AA[e * 68 + ch] * h + XF[e * 68 + ch]; rp[(size_t)e * D] = f2bf(h * gy[j]); } }
        asm volatile("" ::: "memory");
        if (w == 7) { CAR[(par ^ 1) * 64 + ch] = h; hfin = h; }
    }
    if (!latent && w == 7) C.out[OUT_ST + ((size_t)(b * 2 + l) * 2 + dir) * 512 + cgl] = hfin;
}

#define XB_TMO      128
#define XB_XCNT(j)  (256  + 64 * (j))
#define XB_XSUB(j)  (1280 + 64 * (j))
#define XB_XGEN(j)  (2304 + 64 * (j))
#define XB_TOP      3328
#define XB_TOPGEN   3392
#define XCD_BAR_WORDS 3456
#define XB_SPIN_CAP (1u << 18)

__device__ __forceinline__ unsigned xb_ld(unsigned* p)              { return __hip_atomic_load(p, __ATOMIC_RELAXED, __HIP_MEMORY_SCOPE_AGENT); }
__device__ __forceinline__ unsigned xb_add(unsigned* p, unsigned v) { return __hip_atomic_fetch_add(p, v, __ATOMIC_RELAXED, __HIP_MEMORY_SCOPE_AGENT); }
__device__ __forceinline__ unsigned xb_xcc_id() { return (unsigned)__builtin_amdgcn_s_getreg((3 << 11) | 20) & 0xFu; }
#define XB_SPIN(cond, bar) do { unsigned _sp = 0; while (cond) { __builtin_amdgcn_s_sleep(1); \
    if ((++_sp & 255u) == 0u) { if (xb_ld(&(bar)[XB_TMO])) break; if (_sp > XB_SPIN_CAP) { atomicAdd(&(bar)[XB_TMO], 1u); break; } } } } while (0)

struct XcdBarrier {
    unsigned* bar; unsigned x;
    volatile LAS unsigned* st;
};

__device__ __forceinline__ XcdBarrier xcd_barrier_post(unsigned* bar, volatile LAS unsigned* st, int tid) {
    XcdBarrier b; b.bar = bar; b.x = xb_xcc_id(); b.st = st;
    if (tid == 0) (void)xb_add(&bar[XB_XCNT(b.x)], 1u);
    return b;
}
__device__ __forceinline__ void xcd_barrier_complete(unsigned* bar, unsigned x, unsigned& nloc, unsigned& nx) {
    const unsigned G = gridDim.x * gridDim.y * gridDim.z;
    unsigned sum, cnt, mine, sp = 0u;
    for (;;) {
        sum = 0u; cnt = 0u; mine = 0u;
#pragma unroll
        for (unsigned j = 0; j < 16; ++j) { const unsigned c = xb_ld(&bar[XB_XCNT(j)]); sum += c; cnt += (c > 0u) ? 1u : 0u; mine = (j == x) ? c : mine; }
        if (sum == G) break;
        __builtin_amdgcn_s_sleep(1);
        if ((++sp & 255u) == 0u) { if (xb_ld(&bar[XB_TMO])) break; if (sp > XB_SPIN_CAP) { atomicAdd(&bar[XB_TMO], 1u); break; } }
    }
    nloc = mine > 0u ? mine : 1u; nx = cnt > 0u ? cnt : 1u;
}

__device__ __forceinline__ void xcd_barrier(const XcdBarrier& b, int tid) {
    asm volatile("s_waitcnt vmcnt(0)" ::: "memory");
    __syncthreads();
    if (tid == 0) {
        unsigned* bar = b.bar;
        __builtin_amdgcn_s_waitcnt(0);
        unsigned nloc = b.st[0], nx = b.st[1];
        if (nloc == 0u) { xcd_barrier_complete(bar, b.x, nloc, nx); b.st[0] = nloc; b.st[1] = nx; }
        const unsigned old = xb_add(&bar[XB_XSUB(b.x)], 1u);
        const unsigned gen = old / nloc;
        if (old + 1u == (gen + 1u) * nloc) {
            __builtin_amdgcn_fence(__ATOMIC_RELEASE, "agent");
            asm volatile("s_waitcnt vmcnt(0)" ::: "memory");
            const unsigned og = xb_add(&bar[XB_TOP], 1u);
            const unsigned tg = og / nx;
            if (og + 1u == (tg + 1u) * nx) xb_add(&bar[XB_TOPGEN], 1u);
            else XB_SPIN(xb_ld(&bar[XB_TOPGEN]) == tg, bar);
            __builtin_amdgcn_fence(__ATOMIC_ACQUIRE, "agent");
            xb_add(&bar[XB_XGEN(b.x)], 1u);
            asm volatile("s_waitcnt vmcnt(0)" ::: "memory");
        } else {
            XB_SPIN(xb_ld(&bar[XB_XGEN(b.x)]) == gen, bar);
            __builtin_amdgcn_fence(__ATOMIC_ACQUIRE, "agent");
            asm volatile("s_waitcnt vmcnt(0)" ::: "memory");
        }
    }
    __syncthreads();
}

struct OneUnit { Unit u; __device__ bool next(int i, Unit& o) const { if (i) return false; o = u; return true; } };
constexpr int MX_DFTL = 64, MX_LRUL = 64, MX_ATTL = 256, MX_LRUC = 256, MX_ATTC = 128, MX_DFTC = 32;
constexpr int MX_N = MX_DFTL + MX_LRUL + MX_ATTL + MX_LRUC + MX_ATTC + MX_DFTC;
constexpr int CW_QUEUE = 3520;
__device__ __forceinline__ void mixer_phase(ArgsP args_in, const Ctx& C_in, int l_in) {
    for (;;) {
        ArgsP args = args_in; asm volatile("" : "+s"(args));
        int tid_ = C_in.tid; asm volatile("" : "+v"(tid_));
        int l = l_in; asm volatile("" : "+s"(l));
        Ctx C; C.out = args->out; C.ws = args->ws; C.lds = C_in.lds; C.tid = tid_; C.lane = tid_ & 63; C.wave = __builtin_amdgcn_readfirstlane(tid_ >> 6); C.bid = C_in.bid; C.G = C_in.G;
        volatile LAS int* qslot = (volatile LAS int*)(C.lds + 131072 + 64);
        unsigned* qhead = (unsigned*)(C.ws + WS_CTL) + CW_QUEUE + 64 * l;
        __syncthreads();
        if (C.tid == 0) qslot[0] = (int)__hip_atomic_fetch_add(qhead, 1u, __ATOMIC_RELAXED, __HIP_MEMORY_SCOPE_AGENT);
        __syncthreads();
        int idx = __builtin_amdgcn_readfirstlane(qslot[0]);
        if (idx >= MX_N) break;
        if (idx < MX_DFTL) { const int z = idx >> 4, pm = (idx >> 1) & 7, pn = idx & 1;
            OneUnit S; S.u.pm = pm; S.u.pn = pn; S.u.z = z; S.u.A = (const bf16_t*)(C.ws + WS_DFTL) + (size_t)pm * 256 * LS; S.u.B = (const bf16_t*)act_ptr(C, A_XFT) + (size_t)16 * 512 * LC + ((size_t)z * 512 + pn * 256) * LS;
            EpiDft E{(bf16_t*)act_ptr(C, A_Z), LS, MP + z * LS}; GEMM(C, S, E, LS, LS, LS); continue; } idx -= MX_DFTL;
        if (idx < MX_LRUL) { lru_item(args, C, l, idx); continue; } idx -= MX_LRUL;
        if (idx < MX_ATTL) { attn_unit(args, C, l, idx); continue; } idx -= MX_ATTL;
        if (idx < MX_LRUC) { lru_item(args, C, l, 64 + idx); continue; } idx -= MX_LRUC;
        if (idx < MX_ATTC) { attn_unit(args, C, l, 256 + idx); continue; } idx -= MX_ATTC;
        { const int z = idx >> 1, pn = idx & 1;
            OneUnit S; S.u.pm = 0; S.u.pn = pn; S.u.z = z; S.u.A = (const bf16_t*)(C.ws + WS_DFTC); S.u.B = (const bf16_t*)act_ptr(C, A_XFT) + ((size_t)z * 512 + pn * 256) * LC;
            EpiDft E{(bf16_t*)act_ptr(C, A_Z), LC, z * LC}; GEMM(C, S, E, LC, LC, LC); }
    }
}

#ifndef PROBE_MASK
#define PROBE_MASK 0u
#endif
constexpr int N_PHASES = 24;
__device__ __forceinline__ void run_phase(ArgsP args, const Ctx& C, int ph) {
    if (ph == 0) { p0_prologue(args, C); return; }
    if (ph == N_PHASES - 1) { finalnorm_phase(args, C); return; }
    const int l = (ph - 1) / 11, s = (ph - 1) % 11;
    const float* MODB = (const float*)(C.ws + OFF_MOD);
    if (s == 0 || s == 3 || s == 8) { modnorm_phase(args, C, l, s == 0 ? 0 : (s == 3 ? 1 : 2)); }
    else if (s == 1 || s == 9) { StaticOrder S; S.init(M, 2 * DFF, C.G, C.bid, (const bf16_t*)act_ptr(C, A_XN), D, (const bf16_t*)wl_ptr(C, l, s == 1 ? WL_GU1 : WL_GU2), D);
        EpiGU E{(bf16_t*)act_ptr(C, A_G)}; GEMM(C, S, E, D, D, D); }
    else if (s == 2 || s == 10) { StaticOrder S; S.init(M, D, C.G, C.bid, (const bf16_t*)act_ptr(C, A_G), DFF, (const bf16_t*)wl_ptr(C, l, s == 2 ? WL_D1 : WL_D2), DFF);
        EpiRes E{C.out, MODB, l, s == 2 ? 0 : 2, 0.5f}; GEMM(C, S, E, DFF, DFF, DFF); }
    else if (s == 4) { StaticOrder S; S.init(M, NIN, C.G, C.bid, (const bf16_t*)act_ptr(C, A_XN), D, (const bf16_t*)wl_ptr(C, l, WL_IN), D);
        EpiIn E{(bf16_t*)act_ptr(C, A_Q), (bf16_t*)act_ptr(C, A_K), (bf16_t*)act_ptr(C, A_VT), (bf16_t*)act_ptr(C, A_GY), (bf16_t*)act_ptr(C, A_XFT), (bf16_t*)act_ptr(C, A_G),
                (float*)act_ptr(C, A_XR), C.out, (const float*)(C.ws + OFF_ROPE), args->in[19] + (size_t)l * 3072, l};
        GEMM(C, S, E, D, D, D); }
    else if (s == 5) { mixer_phase(args, C, l); }
    else if (s == 6) {
        bf16_t* MG = (bf16_t*)act_ptr(C, A_XR); const bf16_t* G = (const bf16_t*)act_ptr(C, A_G);
        { StaticOrder S; S.init(M, D, C.G, C.bid, (const bf16_t*)act_ptr(C, A_Q), 512, (const bf16_t*)wl_ptr(C, l, WL_A), 512); EpiBranch<0> E{MG, G, 0}; GEMM(C, S, E, 512, 512, 512); }
        { StaticOrder S; S.init(M, D, C.G, C.bid, (const bf16_t*)act_ptr(C, A_XN), D, (const bf16_t*)wl_ptr(C, l, WL_L2), D); EpiBranch<1> E{MG, G, 1}; GEMM(C, S, E, D, D, D); }
        { StaticOrder S; S.init(M, D, C.G, C.bid, (const bf16_t*)act_ptr(C, A_Z), D, (const bf16_t*)wl_ptr(C, l, WL_F2), D); EpiBranch<1> E{MG, G, 2}; GEMM(C, S, E, D, D, D); } }
    else if (s == 7) { StaticOrder S; S.init(M, D, C.G, C.bid, (const bf16_t*)act_ptr(C, A_XR), D, (const bf16_t*)wl_ptr(C, l, WL_O), D);
        EpiRes E{C.out, MODB, l, 1, 1.0f}; GEMM(C, S, E, D, D, D); }
}

__global__ void __launch_bounds__(NTHREADS, 2) fwd_kernel(Args args_byval) {
    extern __shared__ __attribute__((aligned(16))) unsigned char lds_raw[];
    ArgsP args0 = (ArgsP)__builtin_amdgcn_kernarg_segment_ptr();
    const int lo = args0->ph_lo, hi = args0->ph_hi;
    volatile LAS unsigned* bst = (volatile LAS unsigned*)((LAS unsigned char*)lds_raw + 131072);
    const int wave0 = __builtin_amdgcn_readfirstlane(threadIdx.x >> 6);
#define TID_NOW() ({ unsigned z_ = 0u; asm volatile("" : "+s"(z_)); wave0 * 64 + (int)__builtin_amdgcn_mbcnt_hi(~0u, __builtin_amdgcn_mbcnt_lo(~0u, z_)); })
    { const int t = TID_NOW(); if (t < 2) bst[t] = 0u; }
    __syncthreads();
    (void)xcd_barrier_post((unsigned*)(args0->ws + WS_CTL), bst, TID_NOW());
    volatile LAS unsigned long long* tacc = (volatile LAS unsigned long long*)((LAS unsigned char*)lds_raw + 131072 + 128);
    if (PROBE_MASK != 0u && blockIdx.x == 0 && TID_NOW() == 0) { tacc[0] = __builtin_amdgcn_s_memrealtime(); tacc[1] = 0ull; }
    for (int ph = lo; ph < hi; ++ph) {
        ArgsP args = args0; asm volatile("" : "+s"(args));
        int tid = TID_NOW(); asm volatile("" : "+v"(tid));
        int bid = blockIdx.x; asm volatile("" : "+s"(bid));
        Ctx C; C.out = args->out; C.ws = args->ws; C.lds = (LAS unsigned char*)lds_raw;
        C.tid = tid; C.lane = tid & 63; C.wave = __builtin_amdgcn_readfirstlane(tid >> 6); C.bid = bid; C.G = gridDim.x;
        run_phase(args, C, ph);
        if (ph + 1 < hi) {
            if (ph == 0) cooperative_groups::this_grid().sync();
            else { XcdBarrier xb; xb.bar = (unsigned*)(args->ws + WS_CTL); xb.x = xb_xcc_id(); xb.st = bst; xcd_barrier(xb, TID_NOW()); } }
        if (PROBE_MASK != 0u && blockIdx.x == 0 && TID_NOW() == 0) { const unsigned long long now = __builtin_amdgcn_s_memrealtime(); if ((PROBE_MASK >> ph) & 1u) tacc[1] = tacc[1] + (now - tacc[0]); tacc[0] = now; }
    }
    if (PROBE_MASK != 0u && blockIdx.x == 0 && TID_NOW() == 0) { const unsigned long long t0 = tacc[0], want = tacc[1]; while (__builtin_amdgcn_s_memrealtime() - t0 < want) __builtin_amdgcn_s_sleep(8); }
#undef TID_NOW
}

extern "C" void kernel_launch(void* const* d_in, const int* in_sizes, int n_in, void* d_out, int out_size, void* d_ws, size_t ws_size, hipStream_t stream) {
    if (n_in != 32 || ws_size < WS_END) { fprintf(stderr, "kernel_launch: n_in %d ws %zu (need %zu)\n", n_in, ws_size, (size_t)WS_END); return; }
    static bool attr = false;
    if (!attr) { if (hipFuncSetAttribute((const void*)fwd_kernel, hipFuncAttributeMaxDynamicSharedMemorySize, LDS_BYTES) != hipSuccess) fprintf(stderr, "hipFuncSetAttribute failed\n"); attr = true; }
    Args a{};
    for (int i = 0; i < 32; ++i) a.in[i] = (const float*)d_in[i];
    a.out = (float*)d_out; a.ws = (unsigned char*)d_ws;
    a.ph_lo = 0; a.ph_hi = N_PHASES;
    if (hipMemsetAsync((char*)d_ws + WS_CTL, 0, 16384, stream) != hipSuccess) { fprintf(stderr, "hipMemsetAsync failed\n"); return; }
    void* kargs[] = {&a};
    hipError_t e = hipLaunchCooperativeKernel((const void*)fwd_kernel, dim3(256), dim3(NTHREADS), kargs, LDS_BYTES, stream);
    if (e != hipSuccess) fprintf(stderr, "cooperative launch failed: %s\n", hipGetErrorString(e));
}
```

```cpp
#include <hip/hip_runtime.h>
#include <hip/hip_cooperative_groups.h>
#include <cstdint>
#include <cstdio>


#define LAS __attribute__((address_space(3)))
typedef unsigned short bf16_t;
typedef short bf16x8 __attribute__((ext_vector_type(8)));
typedef float f32x4 __attribute__((ext_vector_type(4)));
typedef float f32x2 __attribute__((ext_vector_type(2)));
typedef unsigned u32x4 __attribute__((ext_vector_type(4)));
typedef unsigned u32x2 __attribute__((ext_vector_type(2)));

constexpr int D = 1024, MP = 4096, MS = 8192, M = MP + MS, DFF = 2816, DEPTH = 2;
constexpr int LC = 256, LS = 2048;
constexpr int NB_C = 16, NB_S = 4;
constexpr int NIN = 2304 + 3072;
constexpr int NMOD = 9216;
constexpr float EPS = 1e-6f;
constexpr float LOG2E = 1.4426950408889634f;
constexpr float QSCALE = 0.125f * LOG2E;

constexpr size_t MiB = 1u << 20;
constexpr size_t SZ_WGU = (size_t)2 * DFF * D * 2, SZ_WD = (size_t)D * DFF * 2, SZ_WIN = (size_t)NIN * D * 2;
constexpr size_t SZ_WA = (size_t)D * 512 * 2, SZ_W1K = (size_t)D * D * 2;
constexpr size_t WL_GU1 = 0, WL_D1 = WL_GU1 + SZ_WGU, WL_GU2 = WL_D1 + SZ_WD, WL_D2 = WL_GU2 + SZ_WGU, WL_IN = WL_D2 + SZ_WD,
                 WL_A = WL_IN + SZ_WIN, WL_L2 = WL_A + SZ_WA, WL_F2 = WL_L2 + SZ_W1K, WL_O = WL_F2 + SZ_W1K, WL_SIZE = WL_O + SZ_W1K;
constexpr size_t WS_CTL = 0;
constexpr size_t WS_MISC = 1 * MiB;
constexpr size_t OFF_MOD = WS_MISC;
constexpr size_t OFF_ROPE = OFF_MOD + (size_t)2 * 5 * NMOD * 4;
constexpr size_t OFF_CK = OFF_ROPE + 2 * 1024 * 4;
constexpr size_t OFF_CVT = OFF_CK + (size_t)4 * 2 * 256 * 128 * 2;
constexpr size_t OFF_LWT = OFF_CVT + (size_t)4 * 2 * 2 * 64 * 256 * 2;
constexpr size_t WS_DFTC = 3 * MiB;
constexpr size_t WS_DFTL = 4 * MiB;
constexpr size_t WS_W = 20 * MiB;
constexpr size_t WS_ACT = WS_W + 2 * WL_SIZE;
constexpr size_t A_G = 0;
constexpr size_t A_XN = 72 * MiB;
constexpr size_t A_XR = 96 * MiB;
constexpr size_t A_GY = 120 * MiB;
constexpr size_t A_XFT = 132 * MiB;
constexpr size_t A_Q = 144 * MiB;
constexpr size_t A_K = 156 * MiB;
constexpr size_t A_VT = 159 * MiB;
constexpr size_t A_Z = 162 * MiB;
constexpr size_t A_END = 186 * MiB;
constexpr size_t WS_END = WS_ACT + A_END;

constexpr int OUT_YS = MP * D, OUT_CK = M * D, OUT_CV = OUT_CK + 16 * 2 * 256 * 128, OUT_ST = OUT_CV + 16 * 2 * 256 * 128;

constexpr int NTHREADS = 512, NWAVES = 8;
constexpr int LDS_BYTES = 147456;

typedef __bf16 bf16x2_t __attribute__((ext_vector_type(2)));
__device__ __forceinline__ unsigned cvt_pk_bf16(float lo, float hi) { f32x2 v = {lo, hi}; bf16x2_t b = __builtin_convertvector(v, bf16x2_t); return __builtin_bit_cast(unsigned, b); }
__device__ __forceinline__ bf16_t f2bf(float f) { return (bf16_t)(cvt_pk_bf16(f, 0.f) & 0xffffu); }
__device__ __forceinline__ float bf2f(unsigned h) { return __uint_as_float(h << 16); }
__device__ __forceinline__ float bflo(unsigned w) { return __uint_as_float(w << 16); }
__device__ __forceinline__ float bfhi(unsigned w) { return __uint_as_float(w & 0xffff0000u); }
__device__ __forceinline__ float fast_rcp(float x) { return __builtin_amdgcn_rcpf(x); }
__device__ __forceinline__ float sigmoidf_(float x) { return fast_rcp(1.0f + __builtin_amdgcn_exp2f(-LOG2E * x)); }
__device__ __forceinline__ float siluf_(float x) { return x * sigmoidf_(x); }
__device__ __forceinline__ float gelu_tanh(float x) { const float u = (-2.0f * LOG2E * 0.7978845608028654f) * (x + 0.044715f * x * x * x); return x * fast_rcp(1.0f + __builtin_amdgcn_exp2f(u)); }
__device__ __forceinline__ float wave_sum(float v) {
#pragma unroll
    for (int o = 1; o < 64; o <<= 1) v += __shfl_xor(v, o);
    return v;
}
__device__ __forceinline__ int cond_of_row(int r) { return r < MP ? 4 : ((r - MP) >> 11); }

struct Args {
    const float* in[32];
    float* out;
    unsigned char* ws;
    int ph_lo, ph_hi;
};

typedef const __attribute__((address_space(4))) Args* ArgsP;
struct Ctx {
    float* out; unsigned char* ws; LAS unsigned char* lds;
    int tid, lane, wave, bid, G;
};
__device__ __forceinline__ unsigned char* wl_ptr(const Ctx& C, int l, size_t off) { return C.ws + WS_W + (size_t)l * WL_SIZE + off; }
__device__ __forceinline__ unsigned char* act_ptr(const Ctx& C, size_t off) { return C.ws + WS_ACT + off; }
__device__ __forceinline__ const float* mod_ptr(const Ctx& C, int l, int c, int sub, int which) { return (const float*)(C.ws + OFF_MOD) + ((size_t)(l * 5 + c) * NMOD + (sub * 3 + which) * D); }

__device__ __forceinline__ void p0_transpose_item(const float* W, int ldw, bf16_t* WT, int ldt, int drow0, int dcol0, int k0, int n0, LAS float* scr, int lane) {
#pragma unroll 8
    for (int i = 0; i < 32; ++i) { const int kk = 2 * i + (lane >> 5); scr[kk * 33 + (lane & 31)] = W[(size_t)(k0 + kk) * ldw + n0 + (lane & 31)]; }
    asm volatile("s_waitcnt lgkmcnt(0)" ::: "memory");
    const int c = lane & 7;
#pragma unroll
    for (int j = 0; j < 4; ++j) { const int n = (lane >> 3) + 8 * j; const LAS float* s = scr + (8 * c) * 33 + n;
        u32x4 o; o.x = cvt_pk_bf16(s[0 * 33], s[1 * 33]); o.y = cvt_pk_bf16(s[2 * 33], s[3 * 33]); o.z = cvt_pk_bf16(s[4 * 33], s[5 * 33]); o.w = cvt_pk_bf16(s[6 * 33], s[7 * 33]);
        *(u32x4*)(WT + (size_t)(drow0 + n) * ldt + dcol0 + k0 + 8 * c) = o; }
    asm volatile("s_waitcnt lgkmcnt(0)" ::: "memory");
}

__device__ __forceinline__ void p0_prologue(ArgsP args, const Ctx& C) {
    LAS float* SC = (LAS float*)C.lds;
    LAS float* TAB = (LAS float*)(C.lds + 20480);
    LAS float* SCR = (LAS float*)(C.lds + 32768);
    const float* c_in = args->in[2]; const float* cctx = args->in[6];
    for (int i = C.tid; i < 5 * 1024; i += NTHREADS) { const float v = (i < 4096) ? c_in[i] : cctx[i - 4096]; SC[i] = siluf_(v); }
    for (int i = C.tid; i < 2048; i += NTHREADS) TAB[i] = cospif((float)i * (1.0f / 1024.0f));
    __syncthreads();
    for (int it = C.bid; it < 288 + 128; it += C.G) {
        if (it < 288) {
            const int l = it / 144, j0 = (it % 144) * 64;
            const float* W = args->in[7] + (size_t)l * D * NMOD + j0 + C.lane;
            float a0 = 0.f, a1 = 0.f, a2 = 0.f, a3 = 0.f, a4 = 0.f;
            const int kb = C.wave * 128;
#pragma unroll 8
            for (int k = 0; k < 128; ++k) { const float w = W[(size_t)(kb + k) * NMOD];
                a0 += SC[kb + k] * w; a1 += SC[1024 + kb + k] * w; a2 += SC[2048 + kb + k] * w; a3 += SC[3072 + kb + k] * w; a4 += SC[4096 + kb + k] * w; }
            SCR[(C.wave * 5 + 0) * 64 + C.lane] = a0; SCR[(C.wave * 5 + 1) * 64 + C.lane] = a1; SCR[(C.wave * 5 + 2) * 64 + C.lane] = a2;
            SCR[(C.wave * 5 + 3) * 64 + C.lane] = a3; SCR[(C.wave * 5 + 4) * 64 + C.lane] = a4;
            __syncthreads();
            if (C.tid < 320) { const int c = C.tid >> 6, j = C.tid & 63; float s = args->in[8][(size_t)l * NMOD + j0 + j];
#pragma unroll
                for (int w = 0; w < 8; ++w) s += SCR[(w * 5 + c) * 64 + j];
                ((float*)(C.ws + OFF_MOD))[(size_t)(l * 5 + c) * NMOD + j0 + j] = s; }
            __syncthreads();
        } else {
            const int r = it - 288, l = r >> 6, g = (r >> 4) & 3, n0 = (r & 15) * 64;
            const float* Wf = args->in[30] + (size_t)l * 512 * D + (size_t)(g * 128) * D + n0;
            for (int i = C.tid; i < 128 * 64; i += NTHREADS) SCR[i] = Wf[(size_t)(i >> 6) * D + (i & 63)];
            __syncthreads();
            const int n = C.tid & 63, cw = C.tid >> 6;
            bf16_t* dst = (bf16_t*)wl_ptr(C, l, WL_F2) + (size_t)(n0 + n) * D + g * 128;
            const float s = 0.08838834764831845f;
            for (int j = 0; j < 16; ++j) { const int c = cw + 8 * j; float ac = 0.f, as = 0.f;
#pragma unroll 8
                for (int q = 0; q < 128; ++q) { const int idx = ((q * c) & 127) * 16; const float w = SCR[q * 64 + n];
                    ac += TAB[idx] * w; as += TAB[(idx - 512) & 2047] * w; }
                dst[c] = f2bf(ac * s); dst[512 + c] = f2bf(-as * s); }
            __syncthreads();
        }
    }
    __syncthreads();
    {
        LAS float* scr = SCR + C.wave * (64 * 33);
        const int gw = C.bid * NWAVES + C.wave, NGW = C.G * NWAVES;
        constexpr int I_G = 16 * 88, I_D = 44 * 32, I_IN = 16 * 72, I_BG = 16 * 96, I_A = 8 * 32, I_L = 8 * 32, I_O = 16 * 32;
        constexpr int PER_LAYER = 4 * I_G + 2 * I_D + I_IN + I_BG + I_A + I_L + I_O;
        for (int it = gw; it < 2 * PER_LAYER; it += NGW) {
            const int l = it / PER_LAYER; int r = it % PER_LAYER;
            if (r < I_G) { const int kb = r / 88, n0 = (r % 88) * 32; p0_transpose_item(args->in[11] + (size_t)l * D * DFF, DFF, (bf16_t*)wl_ptr(C, l, WL_GU1), D, 256 * (n0 >> 7) + (n0 & 127), 0, kb * 64, n0, scr, C.lane); continue; } r -= I_G;
            if (r < I_G) { const int kb = r / 88, n0 = (r % 88) * 32; p0_transpose_item(args->in[12] + (size_t)l * D * DFF, DFF, (bf16_t*)wl_ptr(C, l, WL_GU1), D, 256 * (n0 >> 7) + 128 + (n0 & 127), 0, kb * 64, n0, scr, C.lane); continue; } r -= I_G;
            if (r < I_D) { const int kb = r / 32, nb = r % 32; p0_transpose_item(args->in[13] + (size_t)l * DFF * D, D, (bf16_t*)wl_ptr(C, l, WL_D1), DFF, nb * 32, 0, kb * 64, nb * 32, scr, C.lane); continue; } r -= I_D;
            if (r < I_G) { const int kb = r / 88, n0 = (r % 88) * 32; p0_transpose_item(args->in[14] + (size_t)l * D * DFF, DFF, (bf16_t*)wl_ptr(C, l, WL_GU2), D, 256 * (n0 >> 7) + (n0 & 127), 0, kb * 64, n0, scr, C.lane); continue; } r -= I_G;
            if (r < I_G) { const int kb = r / 88, n0 = (r % 88) * 32; p0_transpose_item(args->in[15] + (size_t)l * D * DFF, DFF, (bf16_t*)wl_ptr(C, l, WL_GU2), D, 256 * (n0 >> 7) + 128 + (n0 & 127), 0, kb * 64, n0, scr, C.lane); continue; } r -= I_G;
            if (r < I_D) { const int kb = r / 32, nb = r % 32; p0_transpose_item(args->in[16] + (size_t)l * DFF * D, D, (bf16_t*)wl_ptr(C, l, WL_D2), DFF, nb * 32, 0, kb * 64, nb * 32, scr, C.lane); continue; } r -= I_D;
            if (r < I_IN) { const int kb = r / 72, nb = r % 72; p0_transpose_item(args->in[17] + (size_t)l * D * 2304, 2304, (bf16_t*)wl_ptr(C, l, WL_IN), D, nb * 32, 0, kb * 64, nb * 32, scr, C.lane); continue; } r -= I_IN;
            if (r < I_BG) { const int kb = r / 96, nb = r % 96; p0_transpose_item(args->in[18] + (size_t)l * D * 3072, 3072, (bf16_t*)wl_ptr(C, l, WL_IN), D, 2304 + nb * 32, 0, kb * 64, nb * 32, scr, C.lane); continue; } r -= I_BG;
            if (r < I_A) { const int kb = r / 32, nb = r % 32; p0_transpose_item(args->in[21] + (size_t)l * 512 * D, D, (bf16_t*)wl_ptr(C, l, WL_A), 512, nb * 32, 0, kb * 64, nb * 32, scr, C.lane); continue; } r -= I_A;
            if (r < I_L) { const int kb = r / 32, nb = r % 32;
                p0_transpose_item(args->in[29] + (size_t)l * 512 * D, D, (bf16_t*)wl_ptr(C, l, WL_L2), D, nb * 32, 0, kb * 64, nb * 32, scr, C.lane);
                p0_transpose_item(args->in[29] + (size_t)l * 512 * D, D, (bf16_t*)wl_ptr(C, l, WL_L2), D, nb * 32, 512, kb * 64, nb * 32, scr, C.lane); continue; } r -= I_L;
            { const int kb = r / 32, nb = r % 32; p0_transpose_item(args->in[31] + (size_t)l * D * D, D, (bf16_t*)wl_ptr(C, l, WL_O), D, nb * 32, 0, kb * 64, nb * 32, scr, C.lane); }
        }
    }
    const int gt = C.bid * NTHREADS + C.tid, NGT = C.G * NTHREADS;
    for (int i = gt; i < M * D / 4; i += NGT) { const f32x4 v = (i < MP * D / 4) ? ((const f32x4*)args->in[0])[i] : ((const f32x4*)args->in[1])[i - MP * D / 4]; ((f32x4*)C.out)[i] = v; }
    for (int i = gt; i < 2048 * 256; i += NGT) { const int pr = i >> 8, t0 = (i & 255) * 8, p = (pr <= 1024) ? pr : pr - 1024, sh = (pr > 1024) ? 512 : 0; const float s = 0.022097086912079608f;
        float v[8];
#pragma unroll
        for (int j = 0; j < 8; ++j) v[j] = TAB[((p * (t0 + j)) - sh) & 2047] * s;
        u32x4 o; o.x = cvt_pk_bf16(v[0], v[1]); o.y = cvt_pk_bf16(v[2], v[3]); o.z = cvt_pk_bf16(v[4], v[5]); o.w = cvt_pk_bf16(v[6], v[7]);
        *(u32x4*)((bf16_t*)(C.ws + WS_DFTL) + (size_t)pr * 2048 + t0) = o; }
    for (int i = gt; i < 256 * 32; i += NGT) { const int pr = i >> 5, t0 = (i & 31) * 8, p = (pr <= 128) ? pr : pr - 128, sh = (pr > 128) ? 512 : 0; const float s = 0.0625f;
        float v[8];
#pragma unroll
        for (int j = 0; j < 8; ++j) v[j] = TAB[((p * (t0 + j) * 8) - sh) & 2047] * s;
        u32x4 o; o.x = cvt_pk_bf16(v[0], v[1]); o.y = cvt_pk_bf16(v[2], v[3]); o.z = cvt_pk_bf16(v[4], v[5]); o.w = cvt_pk_bf16(v[6], v[7]);
        *(u32x4*)((bf16_t*)(C.ws + WS_DFTC) + (size_t)pr * 256 + t0) = o; }
    for (int i = gt; i < 1024; i += NGT) { const int pos = i >> 4, f = i & 15; const float inv = exp2f(-(float)f * (13.287712379549449f / 16.0f)); const float ang = (float)pos * inv; const float af = (float)((double)ang * 0.3183098861837907);
        ((float*)(C.ws + OFF_ROPE))[i] = cospif(af); ((float*)(C.ws + OFF_ROPE))[1024 + i] = sinpif(af); }
    for (int i = gt; i < 4 * 2 * 256 * 128; i += NGT) { ((bf16_t*)(C.ws + OFF_CK))[i] = f2bf(args->in[3][i]);
        const int d = i & 63, kvh = (i >> 6) & 1, t = (i >> 7) & 255, bl = i >> 15;
        ((bf16_t*)(C.ws + OFF_CVT))[((size_t)(bl * 2 + kvh) * 64 + d) * 256 + t] = f2bf(args->in[4][i]); }
    for (int i = gt; i < 2 * 2 * 8 * 128 * 64; i += NGT) { const int k = i & 63, n = (i >> 6) & 127, g = i >> 13;
        const float v = (n < 64) ? args->in[24][((size_t)g * 64 + k) * 64 + n] : args->in[26][((size_t)g * 64 + k) * 64 + (n - 64)]; ((bf16_t*)(C.ws + OFF_LWT))[i] = f2bf(v); }
}

__device__ __forceinline__ void modnorm_phase(ArgsP args, const Ctx& C, int l, int sub) {
    const int gw = C.bid * NWAVES + C.wave, NGW = C.G * NWAVES;
    const float* nw = args->in[9] + (size_t)(l * 3 + sub) * D;
    bf16_t* XN = (bf16_t*)act_ptr(C, A_XN);
    for (int r = gw; r < M; r += NGW) {
        const int c = cond_of_row(r);
        const float* sh = mod_ptr(C, l, c, sub, 0); const float* sc = mod_ptr(C, l, c, sub, 1);
        const f32x4* xr = (const f32x4*)(C.out + (size_t)r * D) + C.lane;
        f32x4 v[4]; float s = 0.f;
#pragma unroll
        for (int j = 0; j < 4; ++j) { v[j] = xr[64 * j]; s += (v[j].x * v[j].x + v[j].y * v[j].y) + (v[j].z * v[j].z + v[j].w * v[j].w); }
        const float rstd = __builtin_amdgcn_rsqf(wave_sum(s) * (1.0f / D) + EPS);
        u32x2* o = (u32x2*)(XN + (size_t)r * D) + C.lane;
#pragma unroll
        for (int j = 0; j < 4; ++j) { const int col = 4 * C.lane + 256 * j; const f32x4 w = *(const f32x4*)(nw + col), a = *(const f32x4*)(sc + col), b = *(const f32x4*)(sh + col);
            f32x4 y = v[j] * rstd * w * (a + 1.0f) + b; u32x2 p; p.x = cvt_pk_bf16(y.x, y.y); p.y = cvt_pk_bf16(y.z, y.w); o[64 * j] = p; }
    }
}
__device__ __forceinline__ void finalnorm_phase(ArgsP args, const Ctx& C) {
    const int gw = C.bid * NWAVES + C.wave, NGW = C.G * NWAVES;
    const float* nw = args->in[10];
    for (int r = gw; r < M; r += NGW) {
        f32x4* xr = (f32x4*)(C.out + (size_t)r * D) + C.lane;
        f32x4 v[4]; float s = 0.f;
#pragma unroll
        for (int j = 0; j < 4; ++j) { v[j] = xr[64 * j]; s += (v[j].x * v[j].x + v[j].y * v[j].y) + (v[j].z * v[j].z + v[j].w * v[j].w); }
        const float rstd = __builtin_amdgcn_rsqf(wave_sum(s) * (1.0f / D) + EPS);
#pragma unroll
        for (int j = 0; j < 4; ++j) { const f32x4 w = *(const f32x4*)(nw + 4 * C.lane + 256 * j); xr[64 * j] = v[j] * rstd * w; }
    }
}

struct Unit { int pm, pn, z; const bf16_t* A; const bf16_t* B; };

struct StaticOrder {
    int nM, nN, nwg, G, c; const bf16_t* A; const bf16_t* B; int lda, ldb;
    __device__ void init(int Mr, int N, int G_, int c_, const bf16_t* A_, int lda_, const bf16_t* B_, int ldb_) { nM = Mr / 256; nN = N / 256; nwg = nM * nN; G = G_; c = c_; A = A_; B = B_; lda = lda_; ldb = ldb_; }
    __device__ bool next(int i, Unit& u) const {
        const long L = (long)i * G + c; if (L >= nwg) return false;
        int wgid = (int)L; { const int q = nwg / 8, r = nwg % 8, xcd = wgid % 8, off = wgid / 8; wgid = (xcd < r ? xcd * (q + 1) : r * (q + 1) + (xcd - r) * q) + off; }
        const int nig = 8 * nN, gid = wgid / nig, fm = gid * 8, gsz = (nM - fm) < 8 ? (nM - fm) : 8;
        u.pm = fm + ((wgid % nig) % gsz); u.pn = (wgid % nig) / gsz; u.z = 0;
        u.A = A + (size_t)u.pm * 256 * lda; u.B = B + (size_t)u.pn * 256 * ldb; return true;
    }
};
struct DftOrder {
    int nseq, nPm, L, G, c; const bf16_t* A; const bf16_t* XFT;
    __device__ bool next(int i, Unit& u) const {
        const int idx = i * G + c; if (idx >= nseq * nPm * 2) return false;
        u.z = idx / (nPm * 2); const int r = idx % (nPm * 2); u.pm = r >> 1; u.pn = r & 1;
        u.A = A + (size_t)u.pm * 256 * L; u.B = XFT + ((size_t)u.z * 512 + u.pn * 256) * L; return true;
    }
};

template <class Epi, class Sched>
__device__ __forceinline__ void gemm_simple(const Ctx& C, const Sched& S, const Epi& E, int lda, int ldb, int K) {
    const int wr = C.wave >> 2, wc = C.wave & 3, fr = C.lane & 15, fq = C.lane >> 4;
    Unit u;
    for (int ui = 0; S.next(ui, u); ++ui) {
        f32x4 acc[2][2][4][2];
#pragma unroll
        for (int a = 0; a < 2; ++a)
#pragma unroll
            for (int b = 0; b < 2; ++b)
#pragma unroll
                for (int m = 0; m < 4; ++m)
#pragma unroll
                    for (int n = 0; n < 2; ++n) acc[a][b][m][n] = (f32x4){0.f, 0.f, 0.f, 0.f};
        const bf16_t* pa = u.A + (size_t)(wr * 64 + fr) * lda + fq * 8;
        const bf16_t* pb = u.B + (size_t)(wc * 32 + fr) * ldb + fq * 8;
        for (int k0 = 0; k0 < K; k0 += 32) {
            bf16x8 At[2][4], Bt[2][2];
#pragma unroll
            for (int a = 0; a < 2; ++a)
#pragma unroll
                for (int m = 0; m < 4; ++m) At[a][m] = *(const bf16x8*)(pa + (size_t)(a * 128 + m * 16) * lda + k0);
#pragma unroll
            for (int b = 0; b < 2; ++b)
#pragma unroll
                for (int n = 0; n < 2; ++n) Bt[b][n] = *(const bf16x8*)(pb + (size_t)(b * 128 + n * 16) * ldb + k0);
#pragma unroll
            for (int a = 0; a < 2; ++a)
#pragma unroll
                for (int b = 0; b < 2; ++b)
#pragma unroll
                    for (int m = 0; m < 4; ++m)
#pragma unroll
                        for (int n = 0; n < 2; ++n) acc[a][b][m][n] = __builtin_amdgcn_mfma_f32_16x16x32_bf16(Bt[b][n], At[a][m], acc[a][b][m][n], 0, 0, 0);
        }
        E(acc, u, wr, wc, fr, fq);
    }
}

namespace pg8 {
#define PG8_LAS __attribute__((address_space(3)))
constexpr int BM = 256, BK = 64, HALF = 128, HTB = HALF * BK * 2  , STAGE_BYTES = 8 * HTB, NXCD = 8, WGM = 8;

__host__ __device__ __forceinline__ int lds_byte(int r, int c) { const int st = (r >> 4) * 2 + (c >> 5), rr = r & 15, cc = c & 31, ob = rr * 64 + cc * 2; return st * 1024 + (ob ^ (((ob >> 9) & 1) << 5)); }
__host__ __device__ __forceinline__ void stage_rc(int b, int& R, int& C) { const int st = b / 1024, sb = b % 1024, swz = sb ^ (((sb >> 9) & 1) << 5); R = (st >> 1) * 16 + swz / 64; C = (st & 1) * 32 + (swz % 64) / 2; }
__host__ __device__ __forceinline__ int perm32(int rho) { const int n = rho >> 4, i = rho & 15; return 8 * (i >> 2) + 4 * n + (i & 3); }
template <class Epi, class Sched, bool ALIGN_EPI = true, bool SP2 = true>
__device__ __forceinline__ void gemm_phase(PG8_LAS unsigned char* lds, const int tid, const Sched& S, const Epi& E, const int lda, const int ldb, const int K) {
    const int wid = __builtin_amdgcn_readfirstlane(tid >> 6), lane = tid & 63, wr = wid >> 2, wc = wid & 3, fr = lane & 15, fq = lane >> 4;
    const int nt = K / BK;
    unsigned voffA[2], voffB[2];
#pragma unroll
    for (int i = 0; i < 2; ++i) { int R, C; stage_rc(tid * 16 + i * 8192, R, C); const int Rb = Epi::PERM ? ((R & ~31) + perm32(R & 31)) : R;
        voffA[i] = (unsigned)(R * lda + C) * 2u; voffB[i] = (unsigned)(Rb * ldb + C) * 2u; }
    const size_t kstep = (size_t)(BK * 2);
    const size_t hstepA = (size_t)HALF * lda * 2, hstepB = (size_t)HALF * ldb * 2;
    const unsigned ldsw = (unsigned)wid * 1024u;
    const int aoff = lds_byte(wr * 64 + fr, fq * 8), boff = lds_byte(wc * 32 + fr, fq * 8);
#define PG8_SA(b, h) (((b) * 2 + (h)) * HTB)
#define PG8_SB(b, h) ((4 + (b) * 2 + (h)) * HTB)
#define PG8_STAGE(bufoff, gbase, voff) do { _Pragma("unroll") for (int _i = 0; _i < 2; ++_i) \
        __builtin_amdgcn_global_load_lds((const unsigned*)((const char*)(gbase) + (voff)[_i]), (PG8_LAS unsigned*)(lds + (bufoff) + ldsw + _i * 8192), 16, 0, 0); } while (0)
#define PG8_LDA(dst, b, h) do { _Pragma("unroll") for (int m = 0; m < 4; ++m) _Pragma("unroll") for (int k = 0; k < 2; ++k) dst[m][k] = *(const PG8_LAS bf16x8*)(lds + PG8_SA(b, h) + aoff + m * 2048 + k * 1024); } while (0)
#define PG8_LDB(dst, b, h) do { _Pragma("unroll") for (int n = 0; n < 2; ++n) _Pragma("unroll") for (int k = 0; k < 2; ++k) dst[n][k] = *(const PG8_LAS bf16x8*)(lds + PG8_SB(b, h) + boff + n * 2048 + k * 1024); } while (0)
#define PG8_MMA(ai, bj, At, Bt) do { __builtin_amdgcn_s_setprio(1); _Pragma("unroll") for (int m = 0; m < 4; ++m) _Pragma("unroll") for (int n = 0; n < 2; ++n) _Pragma("unroll") for (int k = 0; k < 2; ++k) \
        acc[ai][bj][m][n] = __builtin_amdgcn_mfma_f32_16x16x32_bf16(Bt[n][k], At[m][k], acc[ai][bj][m][n], 0, 0, 0); __builtin_amdgcn_s_setprio(0); } while (0)
#define PG8_WAIT_V(n) asm volatile("s_waitcnt vmcnt(" #n ")" ::: "memory")
#define PG8_WAIT_L(n) asm volatile("s_waitcnt lgkmcnt(" #n ")" ::: "memory")
#define PG8_BAR __builtin_amdgcn_s_barrier()
#define PG8_SCHED __builtin_amdgcn_sched_barrier(0)
    Unit cur, nxt; int ui = 0;
    if (!S.next(0, cur)) return;
    f32x4 acc[2][2][4][2];
#pragma unroll
    for (int a = 0; a < 2; ++a)
#pragma unroll
        for (int b = 0; b < 2; ++b)
#pragma unroll
            for (int m = 0; m < 4; ++m)
#pragma unroll
                for (int n = 0; n < 2; ++n) acc[a][b][m][n] = (f32x4){0.f, 0.f, 0.f, 0.f};
    bf16x8 At[4][2], B0[2][2], B1[2][2];
    const char* cA = (const char*)cur.A; const char* cB = (const char*)cur.B;
    if constexpr (SP2) {
        PG8_STAGE(PG8_SB(0, 0), cB, voffB); PG8_STAGE(PG8_SB(0, 1), cB + hstepB, voffB); PG8_STAGE(PG8_SA(0, 0), cA, voffA); PG8_STAGE(PG8_SA(0, 1), cA + hstepA, voffA);
        if (wr == 1) PG8_BAR;
        PG8_WAIT_V(2); PG8_BAR;
        PG8_STAGE(PG8_SB(1, 0), cB + kstep, voffB); PG8_STAGE(PG8_SA(1, 0), cA + kstep, voffA); PG8_STAGE(PG8_SB(1, 1), cB + hstepB + kstep, voffB);
        PG8_WAIT_V(6); PG8_BAR;
    } else {
        PG8_STAGE(PG8_SB(0, 0), cB, voffB); PG8_STAGE(PG8_SA(0, 0), cA, voffA); PG8_STAGE(PG8_SB(0, 1), cB + hstepB, voffB); PG8_STAGE(PG8_SA(0, 1), cA + hstepA, voffA);
        if (wr == 1) PG8_BAR;
        PG8_WAIT_V(4); PG8_BAR;
        PG8_STAGE(PG8_SB(1, 0), cB + kstep, voffB); PG8_STAGE(PG8_SA(1, 0), cA + kstep, voffA); PG8_STAGE(PG8_SB(1, 1), cB + hstepB + kstep, voffB);
        PG8_WAIT_V(6); PG8_BAR;
    }
    for (;;) {
        const bool has_next = S.next(ui + 1, nxt);
        const char* nA = has_next ? (const char*)nxt.A : cA; const char* nB = has_next ? (const char*)nxt.B : cB;
        for (int t = 0; t < nt; t += 2) {
            const bool last = (t == nt - 2);
            const char* a1 = cA + (size_t)(t + 1) * kstep;
            const char* a2 = last ? nA : cA + (size_t)(t + 2) * kstep; const char* b2 = last ? nB : cB + (size_t)(t + 2) * kstep;
            const char* a3 = a2 + kstep; const char* b3 = b2 + kstep;
            if constexpr (SP2) {
            PG8_LDB(B0, 0, 0); PG8_LDB(B1, 0, 1); PG8_SCHED; PG8_LDA(At, 0, 0); PG8_STAGE(PG8_SA(1, 1), a1 + hstepA, voffA);
            PG8_WAIT_V(8); PG8_WAIT_L(0); PG8_BAR; PG8_MMA(0, 0, At, B0); PG8_MMA(0, 1, At, B1); PG8_BAR; PG8_SCHED;
            PG8_LDA(At, 0, 1); PG8_STAGE(PG8_SB(0, 0), b2, voffB); PG8_STAGE(PG8_SB(0, 1), b2 + hstepB, voffB); PG8_STAGE(PG8_SA(0, 0), a2, voffA);
            PG8_WAIT_V(8); PG8_WAIT_L(0); PG8_BAR; PG8_MMA(1, 0, At, B0); PG8_MMA(1, 1, At, B1); PG8_BAR; PG8_SCHED;
            PG8_LDB(B0, 1, 0); PG8_LDB(B1, 1, 1); PG8_SCHED; PG8_LDA(At, 1, 0); PG8_STAGE(PG8_SA(0, 1), a2 + hstepA, voffA);
            PG8_WAIT_V(8); PG8_WAIT_L(0); PG8_BAR; PG8_MMA(0, 0, At, B0); PG8_MMA(0, 1, At, B1); PG8_BAR; PG8_SCHED;
            PG8_LDA(At, 1, 1); PG8_STAGE(PG8_SB(1, 0), b3, voffB); PG8_STAGE(PG8_SB(1, 1), b3 + hstepB, voffB); PG8_STAGE(PG8_SA(1, 0), a3, voffA);
            PG8_WAIT_V(8); PG8_WAIT_L(0); PG8_BAR; PG8_MMA(1, 0, At, B0); PG8_MMA(1, 1, At, B1); PG8_BAR; PG8_SCHED;
            } else {
            PG8_LDB(B0, 0, 0); PG8_SCHED; PG8_LDA(At, 0, 0); PG8_STAGE(PG8_SA(1, 1), a1 + hstepA, voffA);
            PG8_WAIT_L(8); PG8_BAR; PG8_WAIT_L(0); PG8_MMA(0, 0, At, B0); PG8_BAR; PG8_SCHED;
            PG8_LDB(B1, 0, 1); PG8_STAGE(PG8_SB(0, 0), b2, voffB);
            PG8_BAR; PG8_WAIT_L(0); PG8_MMA(0, 1, At, B1); PG8_BAR;
            PG8_LDA(At, 0, 1); PG8_STAGE(PG8_SA(0, 0), a2, voffA);
            PG8_BAR; PG8_WAIT_L(0); PG8_MMA(1, 0, At, B0); PG8_BAR; PG8_SCHED;
            PG8_STAGE(PG8_SB(0, 1), b2 + hstepB, voffB);
            PG8_WAIT_V(6); PG8_BAR; PG8_MMA(1, 1, At, B1); PG8_BAR;
            PG8_LDB(B0, 1, 0); PG8_SCHED; PG8_LDA(At, 1, 0); PG8_STAGE(PG8_SA(0, 1), a2 + hstepA, voffA);
            PG8_WAIT_L(8); PG8_BAR; PG8_WAIT_L(0); PG8_MMA(0, 0, At, B0); PG8_BAR; PG8_SCHED;
            PG8_LDB(B1, 1, 1); PG8_STAGE(PG8_SB(1, 0), b3, voffB);
            PG8_BAR; PG8_WAIT_L(0); PG8_MMA(0, 1, At, B1); PG8_BAR;
            PG8_LDA(At, 1, 1); PG8_STAGE(PG8_SA(1, 0), a3, voffA);
            PG8_BAR; PG8_WAIT_L(0); PG8_MMA(1, 0, At, B0); PG8_BAR; PG8_SCHED;
            PG8_STAGE(PG8_SB(1, 1), b3 + hstepB, voffB);
            PG8_WAIT_V(6); PG8_BAR; PG8_MMA(1, 1, At, B1); PG8_BAR;
            }
        }
        if constexpr (ALIGN_EPI) { if (wr == 0) PG8_BAR; }
        if constexpr (!Epi::AFTER_DRAIN) { E(acc, cur, wr, wc, fr, fq); }
        if (!has_next) break;
#pragma unroll
        for (int a = 0; a < 2; ++a)
#pragma unroll
            for (int b = 0; b < 2; ++b)
#pragma unroll
                for (int m = 0; m < 4; ++m)
#pragma unroll
                    for (int n = 0; n < 2; ++n) acc[a][b][m][n] = (f32x4){0.f, 0.f, 0.f, 0.f};
        cur = nxt; cA = nA; cB = nB; ++ui;
        if constexpr (ALIGN_EPI) { if (wr == 1) PG8_BAR; }
    }
    PG8_WAIT_V(0);
    if constexpr (!ALIGN_EPI) { if (wr == 0) PG8_BAR; }
    PG8_BAR;
    if constexpr (Epi::AFTER_DRAIN) { E.fused(acc, cur, wr, wc, fr, fq, lds, wid, lane); }
#undef PG8_SA
#undef PG8_SB
#undef PG8_STAGE
#undef PG8_LDA
#undef PG8_LDB
#undef PG8_MMA
#undef PG8_WAIT_V
#undef PG8_WAIT_L
#undef PG8_BAR
#undef PG8_SCHED
}
}

#ifndef USE_PG8
#define USE_PG8 1
#endif
#if USE_PG8
#define GEMM(C, S, E, lda, ldb, K) pg8::gemm_phase(C.lds, C.tid, S, E, lda, ldb, K)
#else
#define GEMM(C, S, E, lda, ldb, K) GEMM(C, S, E, lda, ldb, K)
#endif

#define EPI_LOOP_AM for (int ai = 0; ai < 2; ++ai) _Pragma("unroll") for (int m = 0; m < 4; ++m)
struct EpiGU {
    static constexpr bool PERM = false, AFTER_DRAIN = false;
    bf16_t* H;
    __device__ __forceinline__ void operator()(const f32x4 (&acc)[2][2][4][2], const Unit& u, int wr, int wc, int fr, int fq) const {
#pragma unroll
        EPI_LOOP_AM { const int row = u.pm * 256 + ai * 128 + wr * 64 + m * 16 + fr;
#pragma unroll
            for (int n = 0; n < 2; ++n) { const f32x4 g = acc[ai][0][m][n], up = acc[ai][1][m][n];
                u32x2 p; p.x = cvt_pk_bf16(siluf_(g.x) * up.x, siluf_(g.y) * up.y); p.y = cvt_pk_bf16(siluf_(g.z) * up.z, siluf_(g.w) * up.w);
                *(u32x2*)(H + (size_t)row * DFF + u.pn * 128 + wc * 32 + n * 16 + fq * 4) = p; } }
    }
};
struct EpiRes {
    static constexpr bool PERM = false, AFTER_DRAIN = false;
    float* X; const float* modbase; int l, sub; float coef;
    __device__ __forceinline__ void operator()(const f32x4 (&acc)[2][2][4][2], const Unit& u, int wr, int wc, int fr, int fq) const {
        const int c = cond_of_row(u.pm * 256);
        const float* gate = modbase + ((size_t)(l * 5 + c) * NMOD + (sub * 3 + 2) * D) + u.pn * 256 + wc * 32 + fq * 4;
        f32x4 g[2][2];
#pragma unroll
        for (int bj = 0; bj < 2; ++bj)
#pragma unroll
            for (int n = 0; n < 2; ++n) g[bj][n] = *(const f32x4*)(gate + bj * 128 + n * 16) * coef;
#pragma unroll
        EPI_LOOP_AM { float* xrow = X + (size_t)(u.pm * 256 + ai * 128 + wr * 64 + m * 16 + fr) * D + u.pn * 256 + wc * 32 + fq * 4;
#pragma unroll
            for (int bj = 0; bj < 2; ++bj)
#pragma unroll
                for (int n = 0; n < 2; ++n) { f32x4* p = (f32x4*)(xrow + bj * 128 + n * 16); *p = *p + g[bj][n] * acc[ai][bj][m][n]; }
            asm volatile("" ::: "memory"); }
    }
};
struct EpiIn {
    static constexpr bool PERM = false, AFTER_DRAIN = false;
    bf16_t *Q, *Kb, *VT, *GY, *XFT, *G; float* XR; float* out; const float* rope; const float* bgate; int l;
    __device__ __forceinline__ void operator()(const f32x4 (&acc)[2][2][4][2], const Unit& u, int wr, int wc, int fr, int fq) const {
        const int row0 = u.pm * 256 + wr * 64 + fr; const bool latent = u.pm >= 16;
        if (u.pn <= 2) {
#pragma unroll
            for (int bj = 0; bj < 2; ++bj) {
                if (u.pn == 2 && bj == 1) {
#pragma unroll
                    EPI_LOOP_AM { const int row = row0 + ai * 128 + m * 16; int seqoff, L, t;
                        if (latent) { const int b = (row - MP) >> 11; t = (row - MP) & 2047; L = LS; seqoff = 16 * 128 * LC + b * 128 * LS; } else { const int b = row >> 8; t = row & 255; L = LC; seqoff = b * 128 * LC; }
#pragma unroll
                        for (int n = 0; n < 2; ++n) { const f32x4 v = acc[ai][1][m][n]; const int d128 = wc * 32 + n * 16 + fq * 4;
                            bf16_t* p = VT + seqoff + (size_t)d128 * L + t; p[0] = f2bf(v.x); p[L] = f2bf(v.y); p[2 * L] = f2bf(v.z); p[3 * L] = f2bf(v.w);
                            if (!latent) *(f32x4*)(out + OUT_CV + ((size_t)((row >> 8) * 2 + l) * 256 + t) * 128 + d128) = v; } }
                } else {
                    const bool isk = (u.pn == 2); const int axis = wc & 1;
#pragma unroll
                    EPI_LOOP_AM { const int row = row0 + ai * 128 + m * 16; f32x4 x1 = acc[ai][bj][m][0], x2 = acc[ai][bj][m][1];
                        if (isk && !latent) { float* o = out + OUT_CK + ((size_t)((row >> 8) * 2 + l) * 256 + (row & 255)) * 128 + wc * 32 + fq * 4; *(f32x4*)o = x1; *(f32x4*)(o + 16) = x2; }
                        if (latent) { const int t = (row - MP) & 2047, pos = axis ? (t & 63) : (t >> 6);
                            const f32x4 cs = *(const f32x4*)(rope + pos * 16 + fq * 4), sn = *(const f32x4*)(rope + 1024 + pos * 16 + fq * 4);
                            const f32x4 o1 = x1 * cs - x2 * sn, o2 = x1 * sn + x2 * cs; x1 = o1; x2 = o2; }
                        if (!isk) { x1 = x1 * QSCALE; x2 = x2 * QSCALE; }
                        bf16_t* o = isk ? (Kb + (size_t)row * 128 + wc * 32 + fq * 4) : (Q + (size_t)row * 512 + u.pn * 256 + bj * 128 + wc * 32 + fq * 4);
                        u32x2 p; p.x = cvt_pk_bf16(x1.x, x1.y); p.y = cvt_pk_bf16(x1.z, x1.w); *(u32x2*)o = p;
                        p.x = cvt_pk_bf16(x2.x, x2.y); p.y = cvt_pk_bf16(x2.z, x2.w); *(u32x2*)(o + 16) = p; }
                }
            }
        } else if (u.pn <= 4) {
#pragma unroll
            EPI_LOOP_AM { const int row = row0 + ai * 128 + m * 16;
#pragma unroll
                for (int bj = 0; bj < 2; ++bj)
#pragma unroll
                    for (int n = 0; n < 2; ++n) *(f32x4*)(XR + (size_t)row * 512 + (u.pn - 3) * 256 + bj * 128 + wc * 32 + n * 16 + fq * 4) = acc[ai][bj][m][n]; }
        } else if (u.pn <= 6) {
#pragma unroll
            EPI_LOOP_AM { const int row = row0 + ai * 128 + m * 16;
#pragma unroll
                for (int bj = 0; bj < 2; ++bj)
#pragma unroll
                    for (int n = 0; n < 2; ++n) { const f32x4 v = acc[ai][bj][m][n]; u32x2 p; p.x = cvt_pk_bf16(gelu_tanh(v.x), gelu_tanh(v.y)); p.y = cvt_pk_bf16(gelu_tanh(v.z), gelu_tanh(v.w));
                        *(u32x2*)(GY + (size_t)row * 512 + (u.pn - 5) * 256 + bj * 128 + wc * 32 + n * 16 + fq * 4) = p; } }
        } else if (u.pn <= 8) {
#pragma unroll
            EPI_LOOP_AM { const int row = row0 + ai * 128 + m * 16; size_t seqoff; int L, t;
                if (latent) { const int b = (row - MP) >> 11; t = (row - MP) & 2047; L = LS; seqoff = (size_t)16 * 512 * LC + (size_t)b * 512 * LS; } else { const int b = row >> 8; t = row & 255; L = LC; seqoff = (size_t)b * 512 * LC; }
#pragma unroll
                for (int bj = 0; bj < 2; ++bj)
#pragma unroll
                    for (int n = 0; n < 2; ++n) { const f32x4 v = acc[ai][bj][m][n]; bf16_t* p = XFT + seqoff + (size_t)((u.pn - 7) * 256 + bj * 128 + wc * 32 + n * 16 + fq * 4) * L + t;
                        p[0] = f2bf(v.x); p[L] = f2bf(v.y); p[2 * L] = f2bf(v.z); p[3 * L] = f2bf(v.w); } }
        } else {
#pragma unroll
            for (int bj = 0; bj < 2; ++bj)
#pragma unroll
                for (int n = 0; n < 2; ++n) { const int col = (u.pn - 9) * 256 + bj * 128 + wc * 32 + n * 16 + fq * 4; const f32x4 b = *(const f32x4*)(bgate + col);
#pragma unroll
                    EPI_LOOP_AM { const int row = row0 + ai * 128 + m * 16; const f32x4 v = acc[ai][bj][m][n] + b;
                        u32x2 p; p.x = cvt_pk_bf16(sigmoidf_(v.x), sigmoidf_(v.y)); p.y = cvt_pk_bf16(sigmoidf_(v.z), sigmoidf_(v.w)); *(u32x2*)(G + (size_t)row * 3072 + col) = p; } }
        }
    }
};
template <int MODE> struct EpiBranch {
    static constexpr bool PERM = false, AFTER_DRAIN = false;
    bf16_t* MG; const bf16_t* G; int br;
    __device__ __forceinline__ void operator()(const f32x4 (&acc)[2][2][4][2], const Unit& u, int wr, int wc, int fr, int fq) const {
#pragma unroll
        EPI_LOOP_AM { const int row = u.pm * 256 + ai * 128 + wr * 64 + m * 16 + fr;
#pragma unroll
            for (int bj = 0; bj < 2; ++bj)
#pragma unroll
                for (int n = 0; n < 2; ++n) { const int col = u.pn * 256 + bj * 128 + wc * 32 + n * 16 + fq * 4;
                    const u32x2 g = *(const u32x2*)(G + (size_t)row * 3072 + br * 1024 + col); f32x4 v = acc[ai][bj][m][n];
                    v.x *= bflo(g.x); v.y *= bfhi(g.x); v.z *= bflo(g.y); v.w *= bfhi(g.y);
                    u32x2* p = (u32x2*)(MG + (size_t)row * D + col);
                    if (MODE == 1) { const u32x2 o = *p; v.x += bflo(o.x); v.y += bfhi(o.x); v.z += bflo(o.y); v.w += bfhi(o.y); }
                    u32x2 w; w.x = cvt_pk_bf16(v.x, v.y); w.y = cvt_pk_bf16(v.z, v.w); *p = w; }
            asm volatile("" ::: "memory"); }
    }
};
struct EpiDft {
    static constexpr bool PERM = false, AFTER_DRAIN = false;
    bf16_t* Z; int L, rowbase;
    __device__ __forceinline__ void operator()(const f32x4 (&acc)[2][2][4][2], const Unit& u, int wr, int wc, int fr, int fq) const {
        const int hl = L >> 1;
#pragma unroll
        EPI_LOOP_AM { const int rr = u.pm * 256 + ai * 128 + wr * 64 + m * 16 + fr; const bool sn = rr >= hl; const int p = sn ? rr - hl : rr;
            bf16_t* z0 = Z + (size_t)rowbase * D + u.pn * 256 + wc * 32 + fq * 4;
#pragma unroll
            for (int bj = 0; bj < 2; ++bj)
#pragma unroll
                for (int n = 0; n < 2; ++n) { const f32x4 v = acc[ai][bj][m][n]; u32x2 w; w.x = cvt_pk_bf16(v.x, v.y); w.y = cvt_pk_bf16(v.z, v.w); const int co = bj * 128 + n * 16;
                    if (!sn) { *(u32x2*)(z0 + (size_t)p * D + co) = w; if (p) *(u32x2*)(z0 + (size_t)(L - p) * D + co) = w; }
                    else if (p == 0) { *(u32x2*)(z0 + (size_t)hl * D + co) = w; const u32x2 zz = {0u, 0u}; *(u32x2*)(z0 + 512 + co) = zz; *(u32x2*)(z0 + (size_t)hl * D + 512 + co) = zz; }
                    else { *(u32x2*)(z0 + (size_t)p * D + 512 + co) = w; u32x2 nw; nw.x = w.x ^ 0x80008000u; nw.y = w.y ^ 0x80008000u; *(u32x2*)(z0 + (size_t)(L - p) * D + 512 + co) = nw; } } }
    }
};

typedef float f32x16 __attribute__((ext_vector_type(16)));
typedef short s16x4 __attribute__((ext_vector_type(4)));
#define MFMA32(a, b, c) __builtin_amdgcn_mfma_f32_32x32x16_bf16((a), (b), (c), 0, 0, 0)
constexpr int AT_KSTR = 144, AT_VSTR = 136, AT_KBYTES = 64 * AT_KSTR, AT_VBYTES = 64 * AT_VSTR, AT_BUF = AT_KBYTES + AT_VBYTES;
struct AttnSrc { const bf16_t* kp; const bf16_t* vp; int vstride; int kbase; };
__device__ __forceinline__ AttnSrc attn_src(int t, bool latent, int nband, int lo, int b, int l, int kvh, const bf16_t* Kb, const bf16_t* VT, const bf16_t* CK, const bf16_t* CVT) {
    AttnSrc s;
    if (!latent) { s.kp = Kb + (size_t)(b * LC + 64 * t) * 128 + kvh * 64; s.vp = VT + (size_t)b * 128 * LC + (size_t)(kvh * 64) * LC + 64 * t; s.vstride = LC; s.kbase = 0; }
    else if (t < nband) { const int kb = lo + 64 * t; s.kp = Kb + (size_t)(MP + b * LS + kb) * 128 + kvh * 64; s.vp = VT + (size_t)16 * 128 * LC + (size_t)b * 128 * LS + (size_t)(kvh * 64) * LS + kb; s.vstride = LS; s.kbase = kb; }
    else { const int c = t - nband; s.kp = CK + (size_t)((b * 2 + l) * 256 + 64 * c) * 128 + kvh * 64; s.vp = CVT + (size_t)((b * 2 + l) * 2 + kvh) * 64 * 256 + 64 * c; s.vstride = 256; s.kbase = 0; }
    return s;
}
__device__ __forceinline__ void attn_tile(const LAS unsigned char* kbp, const bf16x8 (&qf)[4], f32x16& O0, f32x16& O1, float& mrun, float& lsum, bool domask, int dk0, int q32, int half) {
    const LAS unsigned char* vbp = kbp + AT_KBYTES;
    f32x16 S0, S1;
#pragma unroll
    for (int r = 0; r < 16; ++r) { S0[r] = 0.f; S1[r] = 0.f; }
#pragma unroll
    for (int ks = 0; ks < 4; ++ks) { const bf16x8 k0 = *(const LAS bf16x8*)(kbp + q32 * AT_KSTR + ks * 32 + half * 16), k1 = *(const LAS bf16x8*)(kbp + (32 + q32) * AT_KSTR + ks * 32 + half * 16);
        S0 = MFMA32(k0, qf[ks], S0); S1 = MFMA32(k1, qf[ks], S1); }
    if (domask) {
#pragma unroll
        for (int r = 0; r < 16; ++r) { const int d0 = dk0 + (r & 3) + 8 * (r >> 2) + 4 * half, d1 = d0 + 32;
            S0[r] = (d0 > 128 || d0 < -128) ? -1e30f : S0[r]; S1[r] = (d1 > 128 || d1 < -128) ? -1e30f : S1[r]; } }
    float mx = fmaxf(S0[0], S1[0]);
#pragma unroll
    for (int r = 1; r < 16; ++r) mx = fmaxf(mx, fmaxf(S0[r], S1[r]));
    mx = fmaxf(mx, __shfl_xor(mx, 32));
    const float mnew = fmaxf(mrun, mx), alpha = __builtin_amdgcn_exp2f(mrun - mnew); mrun = mnew;
    float ps = 0.f;
#pragma unroll
    for (int r = 0; r < 16; ++r) { S0[r] = __builtin_amdgcn_exp2f(S0[r] - mnew); S1[r] = __builtin_amdgcn_exp2f(S1[r] - mnew); ps += S0[r] + S1[r]; }
    lsum = lsum * alpha + ps;
#pragma unroll
    for (int r = 0; r < 16; ++r) { O0[r] *= alpha; O1[r] *= alpha; }
    bf16x8 pf[4];
#pragma unroll
    for (int s2 = 0; s2 < 2; ++s2) { u32x4 a, c2;
        a.x = cvt_pk_bf16(S0[8 * s2 + 0], S0[8 * s2 + 1]); a.y = cvt_pk_bf16(S0[8 * s2 + 2], S0[8 * s2 + 3]); a.z = cvt_pk_bf16(S0[8 * s2 + 4], S0[8 * s2 + 5]); a.w = cvt_pk_bf16(S0[8 * s2 + 6], S0[8 * s2 + 7]);
        c2.x = cvt_pk_bf16(S1[8 * s2 + 0], S1[8 * s2 + 1]); c2.y = cvt_pk_bf16(S1[8 * s2 + 2], S1[8 * s2 + 3]); c2.z = cvt_pk_bf16(S1[8 * s2 + 4], S1[8 * s2 + 5]); c2.w = cvt_pk_bf16(S1[8 * s2 + 6], S1[8 * s2 + 7]);
        pf[s2] = __builtin_bit_cast(bf16x8, a); pf[2 + s2] = __builtin_bit_cast(bf16x8, c2); }
#pragma unroll
    for (int s4 = 0; s4 < 4; ++s4) {
        const LAS unsigned char* v0p = vbp + q32 * AT_VSTR + s4 * 32 + half * 8; const LAS unsigned char* v1p = v0p + 32 * AT_VSTR;
        const s16x4 a0 = *(const LAS s16x4*)v0p, a1 = *(const LAS s16x4*)(v0p + 16), b0 = *(const LAS s16x4*)v1p, b1 = *(const LAS s16x4*)(v1p + 16);
        const bf16x8 vf0 = __builtin_shufflevector(a0, a1, 0, 1, 2, 3, 4, 5, 6, 7), vf1 = __builtin_shufflevector(b0, b1, 0, 1, 2, 3, 4, 5, 6, 7);
        O0 = MFMA32(vf0, pf[s4], O0); O1 = MFMA32(vf1, pf[s4], O1); }
}
__device__ __forceinline__ void attn_unit(ArgsP args, const Ctx& C, int l, int ui) {
    bf16_t* Q = (bf16_t*)act_ptr(C, A_Q); const bf16_t* Kb = (const bf16_t*)act_ptr(C, A_K); const bf16_t* VT = (const bf16_t*)act_ptr(C, A_VT);
    const bf16_t* CK = (const bf16_t*)(C.ws + OFF_CK); const bf16_t* CVT = (const bf16_t*)(C.ws + OFF_CVT);
    const int q32 = C.lane & 31, half = C.lane >> 5, w = C.wave;
    const int srow = C.tid >> 3, schunk = C.tid & 7;
    {
        const bool latent = ui < 256;
        int b, h, qb; if (latent) { b = ui >> 6; h = (ui >> 3) & 7; qb = ui & 7; } else { const int r = ui - 256; b = r >> 3; h = r & 7; qb = 0; }
        const int kvh = h >> 2, rowbase = latent ? (MP + b * LS + qb * 256) : b * LC;
        int lo = 0, nband = 4, nt = 4;
        if (latent) { lo = 256 * qb - 128; if (lo < 0) lo = 0; int hi = 256 * qb + 384; if (hi > LS) hi = LS; nband = (hi - lo) >> 6; nt = nband + 4; }
        const int qw_lo = qb * 256 + 32 * w, qpos = qw_lo + q32;
        bf16x8 qf[4];
        { const bf16_t* qp = Q + (size_t)(rowbase + 32 * w + q32) * 512 + h * 64 + 8 * half;
#pragma unroll
          for (int ks = 0; ks < 4; ++ks) qf[ks] = *(const bf16x8*)(qp + 16 * ks); }
        f32x16 O0, O1;
#pragma unroll
        for (int r = 0; r < 16; ++r) { O0[r] = 0.f; O1[r] = 0.f; }
        float mrun = args->in[20][l * 8 + h] * LOG2E, lsum = half ? 0.f : 1.0f;
        u32x4 kA, vA, kB, vB;
#define ATT_LOAD(kk, vv, tt) do { const AttnSrc s_ = attn_src((tt), latent, nband, lo, b, l, kvh, Kb, VT, CK, CVT); \
            kk = *(const u32x4*)(s_.kp + (size_t)srow * 128 + schunk * 8); vv = *(const u32x4*)(s_.vp + (size_t)srow * s_.vstride + schunk * 8); } while (0)
#define ATT_WRITE(kk, vv, bufi) do { *(LAS u32x4*)(C.lds + (bufi) * AT_BUF + srow * AT_KSTR + schunk * 16) = kk; \
            LAS u32x2* vd_ = (LAS u32x2*)(C.lds + (bufi) * AT_BUF + AT_KBYTES + srow * AT_VSTR + schunk * 16); vd_[0] = (u32x2){vv.x, vv.y}; vd_[1] = (u32x2){vv.z, vv.w}; } while (0)
        ATT_LOAD(kA, vA, 0); ATT_WRITE(kA, vA, 0); ATT_LOAD(kA, vA, 1);
        __syncthreads();
#define ATT_STEP(t, kcur, vcur, knext, vnext) do { const int buf = (t) & 1; \
            if ((t) + 2 < nt) ATT_LOAD(knext, vnext, (t) + 2); \
            bool skip = false, domask = false; \
            if (latent && (t) < nband) { const int kb = lo + 64 * (t); skip = (kb > qw_lo + 31 + 128) || (kb + 63 < qw_lo - 128); domask = !((kb + 63 - qw_lo <= 128) && (qw_lo + 31 - kb <= 128)); } \
            if (!skip) attn_tile(C.lds + buf * AT_BUF, qf, O0, O1, mrun, lsum, domask, lo + 64 * (t) - qpos, q32, half); \
            if ((t) + 1 < nt) ATT_WRITE(kcur, vcur, buf ^ 1); \
            __syncthreads(); } while (0)
        for (int t = 0; t < nt; t += 2) { ATT_STEP(t, kA, vA, kB, vB); ATT_STEP(t + 1, kB, vB, kA, vA); }
#undef ATT_STEP
#undef ATT_LOAD
#undef ATT_WRITE
        const float inv = fast_rcp(lsum + __shfl_xor(lsum, 32));
        bf16_t* op = Q + (size_t)(rowbase + 32 * w + q32) * 512 + h * 64 + 4 * half;
#pragma unroll
        for (int g = 0; g < 4; ++g) { u32x2 o; o.x = cvt_pk_bf16(O0[4 * g] * inv, O0[4 * g + 1] * inv); o.y = cvt_pk_bf16(O0[4 * g + 2] * inv, O0[4 * g + 3] * inv); *(u32x2*)(op + 8 * g) = o;
            o.x = cvt_pk_bf16(O1[4 * g] * inv, O1[4 * g + 1] * inv); o.y = cvt_pk_bf16(O1[4 * g + 2] * inv, O1[4 * g + 3] * inv); *(u32x2*)(op + 32 + 8 * g) = o; }
    }
}

constexpr int LRW_BYTES = 11008, LR_PH = 8 * LRW_BYTES, LR_CAR = LR_PH + 8192, LR_CONST = LR_CAR + 512, LR_END = LR_CONST + 768;
static_assert(LR_END <= 131072, "lru LDS map");
__device__ __forceinline__ void lru_load_rows(float (&xr)[19], const float* XRc, int trow0, int L) {
#pragma unroll
    for (int r = 0; r < 19; ++r) { const int t = trow0 + r; const bool ok = (t >= 0) && (t < L); const float v = XRc[(size_t)(ok ? t : 0) * 512]; xr[r] = ok ? v : 0.f; }
}
__device__ __forceinline__ void lru_item(ArgsP args, const Ctx& C, int l, int it) {
    const float* XR = (const float*)act_ptr(C, A_XR); const bf16_t* GY = (const bf16_t*)act_ptr(C, A_GY); bf16_t* REC = (bf16_t*)act_ptr(C, A_XN);
    const int w = C.wave, ch = C.lane, fr = C.lane & 15, fq = C.lane >> 4;
    LAS float* XF = (LAS float*)(C.lds + w * LRW_BYTES); LAS float* AA = XF + 16 * 68; LAS bf16_t* XCB = (LAS bf16_t*)(AA + 16 * 68);
    LAS float* PH = (LAS float*)(C.lds + LR_PH); LAS float* CAR = (LAS float*)(C.lds + LR_CAR); LAS float* CST = (LAS float*)(C.lds + LR_CONST);
    const int dir = it & 1, nb = (it >> 1) & 7, sq = it >> 4;
    const bool latent = sq < 4; const int b = latent ? sq : sq - 4, L = latent ? LS : LC, rowbase = latent ? MP + b * LS : b * LC;
    const int cgl = nb * 64 + ch, g = (l * 2 + dir) * 8 + nb;
    __syncthreads();
    if (C.tid < 64) { const int cg = (l * 2 + dir) * 512 + nb * 64 + C.tid; CST[C.tid] = args->in[25][cg]; CST[64 + C.tid] = args->in[27][cg]; CST[128 + C.tid] = -8.0f * log1pf(__expf(-args->in[28][cg]));
        CAR[C.tid] = latent ? args->in[5][((size_t)(b * 2 + l) * 2 + dir) * 512 + nb * 64 + C.tid] : 0.f; }
    bf16x8 wf[8][2];
    { const bf16_t* lw = (const bf16_t*)(C.ws + OFF_LWT) + (size_t)g * 128 * 64 + fr * 64 + 8 * fq;
#pragma unroll
      for (int nt = 0; nt < 8; ++nt)
#pragma unroll
          for (int kk = 0; kk < 2; ++kk) wf[nt][kk] = *(const bf16x8*)(lw + nt * 16 * 64 + 32 * kk); }
    const float cw0 = args->in[22][(l * 4 + 0) * 512 + cgl], cw1 = args->in[22][(l * 4 + 1) * 512 + cgl], cw2 = args->in[22][(l * 4 + 2) * 512 + cgl], cw3 = args->in[22][(l * 4 + 3) * 512 + cgl], cb = args->in[23][l * 512 + cgl];
    const float* XRc = XR + (size_t)rowbase * 512 + cgl;
    const int nch = L >> 7, e0 = dir ? 16 * (7 - w) : 16 * w;
    float xr[19];
    lru_load_rows(xr, XRc, (dir ? (L - 128) : 0) + e0 - 2, L);
    __syncthreads();
    float hfin = 0.f;
    for (int c = 0; c < nch; ++c) {
        const int t0 = dir ? (L - 128 * (c + 1)) : 128 * c, par = c & 1;
#pragma unroll
        for (int e = 0; e < 16; ++e) { const float xc = cb + cw0 * xr[e] + cw1 * xr[e + 1] + cw2 * xr[e + 2] + cw3 * xr[e + 3]; XF[e * 68 + ch] = xc; XCB[e * 72 + ch] = f2bf(xc); }
        asm volatile("" ::: "memory");
        float gy[16];
        { const bf16_t* gp = GY + (size_t)(rowbase + t0 + e0) * 512 + cgl;
#pragma unroll
          for (int j = 0; j < 16; ++j) gy[j] = bf2f(gp[(size_t)(dir ? 15 - j : j) * 512]); }
        if (c + 1 < nch) lru_load_rows(xr, XRc, (dir ? (L - 128 * (c + 2)) : 128 * (c + 1)) + e0 - 2, L);
        f32x4 acc[8];
#pragma unroll
        for (int nt = 0; nt < 8; ++nt) acc[nt] = (f32x4){0.f, 0.f, 0.f, 0.f};
#pragma unroll
        for (int kk = 0; kk < 2; ++kk) { const bf16x8 xf = *(const LAS bf16x8*)(XCB + fr * 72 + 8 * fq + 32 * kk);
#pragma unroll
            for (int nt = 0; nt < 8; ++nt) acc[nt] = __builtin_amdgcn_mfma_f32_16x16x32_bf16(wf[nt][kk], xf, acc[nt], 0, 0, 0); }
#pragma unroll
        for (int nt = 0; nt < 4; ++nt) { const int c0 = 16 * nt + 4 * fq; const f32x4 ba = *(const LAS f32x4*)(CST + c0), bi = *(const LAS f32x4*)(CST + 64 + c0), sp = *(const LAS f32x4*)(CST + 128 + c0);
            const f32x4 xcv = *(const LAS f32x4*)(XF + fr * 68 + c0); f32x4 av, bv;
#pragma unroll
            for (int i = 0; i < 4; ++i) { const float r = sigmoidf_(acc[nt][i] + ba[i]), ig = sigmoidf_(acc[nt + 4][i] + bi[i]); const float la = r * sp[i], a = __builtin_amdgcn_exp2f(LOG2E * la), y = 2.0f * la;
                const float om_s = -y * (1.0f + 0.5f * y * (1.0f + (1.0f / 3.0f) * y * (1.0f + 0.25f * y))), om_l = 1.0f - a * a; const float om = (y > -0.05f) ? om_s : om_l;
                av[i] = a; bv[i] = __builtin_amdgcn_sqrtf(fmaxf(om, 0.f)) * (ig * xcv[i]); }
            *(LAS f32x4*)(AA + fr * 68 + c0) = av; *(LAS f32x4*)(XF + fr * 68 + c0) = bv; }
        asm volatile("" ::: "memory");
        { float P = 1.f, H = 0.f;
#pragma unroll
          for (int j = 0; j < 16; ++j) { const int e = dir ? 15 - j : j; const float a = AA[e * 68 + ch], bb = XF[e * 68 + ch]; H = a * H + bb; P *= a; }
          PH[(par * 2 + 0) * 512 + w * 64 + ch] = P; PH[(par * 2 + 1) * 512 + w * 64 + ch] = H; }
        __syncthreads();
        float h = CAR[par * 64 + ch];
        for (int s2 = 0; s2 < w; ++s2) h = PH[(par * 2 + 0) * 512 + s2 * 64 + ch] * h + PH[(par * 2 + 1) * 512 + s2 * 64 + ch];
        { bf16_t* rp = REC + (size_t)(rowbase + t0 + e0) * D + dir * 512 + cgl;
#pragma unroll
          for (int j = 0; j < 16; ++j) { const int e = dir ? 15 - j : j; h = AA[e * 68 + ch] * h + XF[e * 68 + ch]; rp[(size_t)e * D] = f2bf(h * gy[j]); } }
        asm volatile("" ::: "memory");
        if (w == 7) { CAR[(par ^ 1) * 64 + ch] = h; hfin = h; }
    }
    if (!latent && w == 7) C.out[OUT_ST + ((size_t)(b * 2 + l) * 2 + dir) * 512 + cgl] = hfin;
}

#define XB_TMO      128
#define XB_XCNT(j)  (256  + 64 * (j))
#define XB_XSUB(j)  (1280 + 64 * (j))
#define XB_XGEN(j)  (2304 + 64 * (j))
#define XB_TOP      3328
#define XB_TOPGEN   3392
#define XCD_BAR_WORDS 3456
#define XB_SPIN_CAP (1u << 18)

__device__ __forceinline__ unsigned xb_ld(unsigned* p)              { return __hip_atomic_load(p, __ATOMIC_RELAXED, __HIP_MEMORY_SCOPE_AGENT); }
__device__ __forceinline__ unsigned xb_add(unsigned* p, unsigned v) { return __hip_atomic_fetch_add(p, v, __ATOMIC_RELAXED, __HIP_MEMORY_SCOPE_AGENT); }
__device__ __forceinline__ unsigned xb_xcc_id() { return (unsigned)__builtin_amdgcn_s_getreg((3 << 11) | 20) & 0xFu; }
#define XB_SPIN(cond, bar) do { unsigned _sp = 0; while (cond) { __builtin_amdgcn_s_sleep(1); \
    if ((++_sp & 255u) == 0u) { if (xb_ld(&(bar)[XB_TMO])) break; if (_sp > XB_SPIN_CAP) { atomicAdd(&(bar)[XB_TMO], 1u); break; } } } } while (0)

struct XcdBarrier {
    unsigned* bar; unsigned x;
    volatile LAS unsigned* st;
};

__device__ __forceinline__ XcdBarrier xcd_barrier_post(unsigned* bar, volatile LAS unsigned* st, int tid) {
    XcdBarrier b; b.bar = bar; b.x = xb_xcc_id(); b.st = st;
    if (tid == 0) (void)xb_add(&bar[XB_XCNT(b.x)], 1u);
    return b;
}
__device__ __forceinline__ void xcd_barrier_complete(unsigned* bar, unsigned x, unsigned& nloc, unsigned& nx) {
    const unsigned G = gridDim.x * gridDim.y * gridDim.z;
    unsigned sum, cnt, mine, sp = 0u;
    for (;;) {
        sum = 0u; cnt = 0u; mine = 0u;
#pragma unroll
        for (unsigned j = 0; j < 16; ++j) { const unsigned c = xb_ld(&bar[XB_XCNT(j)]); sum += c; cnt += (c > 0u) ? 1u : 0u; mine = (j == x) ? c : mine; }
        if (sum == G) break;
        __builtin_amdgcn_s_sleep(1);
        if ((++sp & 255u) == 0u) { if (xb_ld(&bar[XB_TMO])) break; if (sp > XB_SPIN_CAP) { atomicAdd(&bar[XB_TMO], 1u); break; } }
    }
    nloc = mine > 0u ? mine : 1u; nx = cnt > 0u ? cnt : 1u;
}

__device__ __forceinline__ void xcd_barrier(const XcdBarrier& b, int tid) {
    asm volatile("s_waitcnt vmcnt(0)" ::: "memory");
    __syncthreads();
    if (tid == 0) {
        unsigned* bar = b.bar;
        __builtin_amdgcn_s_waitcnt(0);
        unsigned nloc = b.st[0], nx = b.st[1];
        if (nloc == 0u) { xcd_barrier_complete(bar, b.x, nloc, nx); b.st[0] = nloc; b.st[1] = nx; }
        const unsigned old = xb_add(&bar[XB_XSUB(b.x)], 1u);
        const unsigned gen = old / nloc;
        if (old + 1u == (gen + 1u) * nloc) {
            __builtin_amdgcn_fence(__ATOMIC_RELEASE, "agent");
            asm volatile("s_waitcnt vmcnt(0)" ::: "memory");
            const unsigned og = xb_add(&bar[XB_TOP], 1u);
            const unsigned tg = og / nx;
            if (og + 1u == (tg + 1u) * nx) xb_add(&bar[XB_TOPGEN], 1u);
            else XB_SPIN(xb_ld(&bar[XB_TOPGEN]) == tg, bar);
            __builtin_amdgcn_fence(__ATOMIC_ACQUIRE, "agent");
            xb_add(&bar[XB_XGEN(b.x)], 1u);
            asm volatile("s_waitcnt vmcnt(0)" ::: "memory");
        } else {
            XB_SPIN(xb_ld(&bar[XB_XGEN(b.x)]) == gen, bar);
            __builtin_amdgcn_fence(__ATOMIC_ACQUIRE, "agent");
            asm volatile("s_waitcnt vmcnt(0)" ::: "memory");
        }
    }
    __syncthreads();
}

#ifndef PROBE_ITEM
#define PROBE_ITEM 0
#endif
#ifndef PROBE_STAT
#define PROBE_STAT 0
#endif
constexpr int CW_PROBE = 3700;
struct OneUnit { Unit u; __device__ bool next(int i, Unit& o) const { if (i) return false; o = u; return true; } };
constexpr int MX_DFTL = 64, MX_LRUL = 64, MX_ATTL = 256, MX_LRUC = 256, MX_ATTC = 128, MX_DFTC = 32;
constexpr int MX_N = MX_DFTL + MX_LRUL + MX_ATTL + MX_LRUC + MX_ATTC + MX_DFTC;
constexpr int CW_QUEUE = 3520;
__device__ __forceinline__ void mixer_phase(ArgsP args_in, const Ctx& C_in, int l_in) {
    for (;;) {
        ArgsP args = args_in; asm volatile("" : "+s"(args));
        int tid_ = C_in.tid; asm volatile("" : "+v"(tid_));
        int l = l_in; asm volatile("" : "+s"(l));
        Ctx C; C.out = args->out; C.ws = args->ws; C.lds = C_in.lds; C.tid = tid_; C.lane = tid_ & 63; C.wave = __builtin_amdgcn_readfirstlane(tid_ >> 6); C.bid = C_in.bid; C.G = C_in.G;
        volatile LAS int* qslot = (volatile LAS int*)(C.lds + 131072 + 64);
        unsigned* qhead = (unsigned*)(C.ws + WS_CTL) + CW_QUEUE + 64 * l;
        __syncthreads();
        if (C.tid == 0) qslot[0] = (int)__hip_atomic_fetch_add(qhead, 1u, __ATOMIC_RELAXED, __HIP_MEMORY_SCOPE_AGENT);
        __syncthreads();
        int idx = __builtin_amdgcn_readfirstlane(qslot[0]);
        if (idx >= MX_N) break;
        const unsigned long long pt0 = (PROBE_ITEM != 0) ? __builtin_amdgcn_s_memrealtime() : 0ull; int ptype = 0;
        if (idx < MX_DFTL) { const int z = idx >> 4, pm = (idx >> 1) & 7, pn = idx & 1;
            OneUnit S; S.u.pm = pm; S.u.pn = pn; S.u.z = z; S.u.A = (const bf16_t*)(C.ws + WS_DFTL) + (size_t)pm * 256 * LS; S.u.B = (const bf16_t*)act_ptr(C, A_XFT) + (size_t)16 * 512 * LC + ((size_t)z * 512 + pn * 256) * LS;
            EpiDft E{(bf16_t*)act_ptr(C, A_Z), LS, MP + z * LS}; GEMM(C, S, E, LS, LS, LS); ptype = 1; }
        else { idx -= MX_DFTL;
        if (idx < MX_LRUL) { lru_item(args, C, l, idx); ptype = 2; } else { idx -= MX_LRUL;
        if (idx < MX_ATTL) { attn_unit(args, C, l, idx); ptype = 3; } else { idx -= MX_ATTL;
        if (idx < MX_LRUC) { lru_item(args, C, l, 64 + idx); ptype = 4; } else { idx -= MX_LRUC;
        if (idx < MX_ATTC) { attn_unit(args, C, l, 256 + idx); ptype = 5; } else { idx -= MX_ATTC;
        { const int z = idx >> 1, pn = idx & 1; ptype = 6;
            OneUnit S; S.u.pm = 0; S.u.pn = pn; S.u.z = z; S.u.A = (const bf16_t*)(C.ws + WS_DFTC); S.u.B = (const bf16_t*)act_ptr(C, A_XFT) + ((size_t)z * 512 + pn * 256) * LC;
            EpiDft E{(bf16_t*)act_ptr(C, A_Z), LC, z * LC}; GEMM(C, S, E, LC, LC, LC); } } } } } }
        if (PROBE_ITEM != 0 && ptype == PROBE_ITEM && C.tid == 0) { const unsigned dt = (unsigned)(__builtin_amdgcn_s_memrealtime() - pt0); unsigned* pw = (unsigned*)(C.ws + WS_CTL) + CW_PROBE;
            if (PROBE_STAT == 0) atomicMax(pw, dt); else atomicAdd(pw, dt); }
    }
}

#ifndef PROBE_MASK
#define PROBE_MASK 0u
#endif
constexpr int N_PHASES = 24;
__device__ __forceinline__ void run_phase(ArgsP args, const Ctx& C, int ph) {
    if (ph == 0) { p0_prologue(args, C); return; }
    if (ph == N_PHASES - 1) { finalnorm_phase(args, C); return; }
    const int l = (ph - 1) / 11, s = (ph - 1) % 11;
    const float* MODB = (const float*)(C.ws + OFF_MOD);
    if (s == 0 || s == 3 || s == 8) { modnorm_phase(args, C, l, s == 0 ? 0 : (s == 3 ? 1 : 2)); }
    else if (s == 1 || s == 9) { StaticOrder S; S.init(M, 2 * DFF, C.G, C.bid, (const bf16_t*)act_ptr(C, A_XN), D, (const bf16_t*)wl_ptr(C, l, s == 1 ? WL_GU1 : WL_GU2), D);
        EpiGU E{(bf16_t*)act_ptr(C, A_G)}; GEMM(C, S, E, D, D, D); }
    else if (s == 2 || s == 10) { StaticOrder S; S.init(M, D, C.G, C.bid, (const bf16_t*)act_ptr(C, A_G), DFF, (const bf16_t*)wl_ptr(C, l, s == 2 ? WL_D1 : WL_D2), DFF);
        EpiRes E{C.out, MODB, l, s == 2 ? 0 : 2, 0.5f}; GEMM(C, S, E, DFF, DFF, DFF); }
    else if (s == 4) { StaticOrder S; S.init(M, NIN, C.G, C.bid, (const bf16_t*)act_ptr(C, A_XN), D, (const bf16_t*)wl_ptr(C, l, WL_IN), D);
        EpiIn E{(bf16_t*)act_ptr(C, A_Q), (bf16_t*)act_ptr(C, A_K), (bf16_t*)act_ptr(C, A_VT), (bf16_t*)act_ptr(C, A_GY), (bf16_t*)act_ptr(C, A_XFT), (bf16_t*)act_ptr(C, A_G),
                (float*)act_ptr(C, A_XR), C.out, (const float*)(C.ws + OFF_ROPE), args->in[19] + (size_t)l * 3072, l};
        GEMM(C, S, E, D, D, D); }
    else if (s == 5) { mixer_phase(args, C, l); }
    else if (s == 6) {
        bf16_t* MG = (bf16_t*)act_ptr(C, A_XR); const bf16_t* G = (const bf16_t*)act_ptr(C, A_G);
        { StaticOrder S; S.init(M, D, C.G, C.bid, (const bf16_t*)act_ptr(C, A_Q), 512, (const bf16_t*)wl_ptr(C, l, WL_A), 512); EpiBranch<0> E{MG, G, 0}; GEMM(C, S, E, 512, 512, 512); }
        { StaticOrder S; S.init(M, D, C.G, C.bid, (const bf16_t*)act_ptr(C, A_XN), D, (const bf16_t*)wl_ptr(C, l, WL_L2), D); EpiBranch<1> E{MG, G, 1}; GEMM(C, S, E, D, D, D); }
        { StaticOrder S; S.init(M, D, C.G, C.bid, (const bf16_t*)act_ptr(C, A_Z), D, (const bf16_t*)wl_ptr(C, l, WL_F2), D); EpiBranch<1> E{MG, G, 2}; GEMM(C, S, E, D, D, D); } }
    else if (s == 7) { StaticOrder S; S.init(M, D, C.G, C.bid, (const bf16_t*)act_ptr(C, A_XR), D, (const bf16_t*)wl_ptr(C, l, WL_O), D);
        EpiRes E{C.out, MODB, l, 1, 1.0f}; GEMM(C, S, E, D, D, D); }
}

__global__ void __launch_bounds__(NTHREADS, 2) fwd_kernel(Args args_byval) {
    extern __shared__ __attribute__((aligned(16))) unsigned char lds_raw[];
    ArgsP args0 = (ArgsP)__builtin_amdgcn_kernarg_segment_ptr();
    const int lo = args0->ph_lo, hi = args0->ph_hi;
    volatile LAS unsigned* bst = (volatile LAS unsigned*)((LAS unsigned char*)lds_raw + 131072);
    const int wave0 = __builtin_amdgcn_readfirstlane(threadIdx.x >> 6);
#define TID_NOW() ({ unsigned z_ = 0u; asm volatile("" : "+s"(z_)); wave0 * 64 + (int)__builtin_amdgcn_mbcnt_hi(~0u, __builtin_amdgcn_mbcnt_lo(~0u, z_)); })
    { const int t = TID_NOW(); if (t < 2) bst[t] = 0u; }
    __syncthreads();
    (void)xcd_barrier_post((unsigned*)(args0->ws + WS_CTL), bst, TID_NOW());
    volatile LAS unsigned long long* tacc = (volatile LAS unsigned long long*)((LAS unsigned char*)lds_raw + 131072 + 128);
    if (PROBE_MASK != 0u && blockIdx.x == 0 && TID_NOW() == 0) { tacc[0] = __builtin_amdgcn_s_memrealtime(); tacc[1] = 0ull; }
    for (int ph = lo; ph < hi; ++ph) {
        ArgsP args = args0; asm volatile("" : "+s"(args));
        int tid = TID_NOW(); asm volatile("" : "+v"(tid));
        int bid = blockIdx.x; asm volatile("" : "+s"(bid));
        Ctx C; C.out = args->out; C.ws = args->ws; C.lds = (LAS unsigned char*)lds_raw;
        C.tid = tid; C.lane = tid & 63; C.wave = __builtin_amdgcn_readfirstlane(tid >> 6); C.bid = bid; C.G = gridDim.x;
        run_phase(args, C, ph);
        if (ph + 1 < hi) {
            if (ph == 0) cooperative_groups::this_grid().sync();
            else { XcdBarrier xb; xb.bar = (unsigned*)(args->ws + WS_CTL); xb.x = xb_xcc_id(); xb.st = bst; xcd_barrier(xb, TID_NOW()); } }
        if (PROBE_MASK != 0u && blockIdx.x == 0 && TID_NOW() == 0) { const unsigned long long now = __builtin_amdgcn_s_memrealtime(); if ((PROBE_MASK >> ph) & 1u) tacc[1] = tacc[1] + (now - tacc[0]); tacc[0] = now; }
    }
    if (PROBE_ITEM != 0 && blockIdx.x == 0 && TID_NOW() == 0) { const unsigned v = __hip_atomic_load((unsigned*)(args0->ws + WS_CTL) + CW_PROBE, __ATOMIC_RELAXED, __HIP_MEMORY_SCOPE_AGENT); const unsigned long long want = PROBE_STAT ? v / 256u : v, t0 = __builtin_amdgcn_s_memrealtime(); while (__builtin_amdgcn_s_memrealtime() - t0 < want) __builtin_amdgcn_s_sleep(8); }
    if (PROBE_MASK != 0u && blockIdx.x == 0 && TID_NOW() == 0) { const unsigned long long t0 = tacc[0], want = tacc[1]; while (__builtin_amdgcn_s_memrealtime() - t0 < want) __builtin_amdgcn_s_sleep(8); }
#undef TID_NOW
}

extern "C" void kernel_launch(void* const* d_in, const int* in_sizes, int n_in, void* d_out, int out_size, void* d_ws, size_t ws_size, hipStream_t stream) {
    if (n_in != 32 || ws_size < WS_END) { fprintf(stderr, "kernel_launch: n_in %d ws %zu (need %zu)\n", n_in, ws_size, (size_t)WS_END); return; }
    static bool attr = false;
    if (!attr) { if (hipFuncSetAttribute((const void*)fwd_kernel, hipFuncAttributeMaxDynamicSharedMemorySize, LDS_BYTES) != hipSuccess) fprintf(stderr, "hipFuncSetAttribute failed\n"); attr = true; }
    Args a{};
    for (int i = 0; i < 32; ++i) a.in[i] = (const float*)d_in[i];
    a.out = (float*)d_out; a.ws = (unsigned char*)d_ws;
    a.ph_lo = 0; a.ph_hi = N_PHASES;
    if (hipMemsetAsync((char*)d_ws + WS_CTL, 0, 16384, stream) != hipSuccess) { fprintf(stderr, "hipMemsetAsync failed\n"); return; }
    void* kargs[] = {&a};
    hipError_t e = hipLaunchCooperativeKernel((const void*)fwd_kernel, dim3(256), dim3(NTHREADS), kargs, LDS_BYTES, stream);
    if (e != hipSuccess) fprintf(stderr, "cooperative launch failed: %s\n", hipGetErrorString(e));
}
```

```cpp
#include <hip/hip_runtime.h>
#include <hip/hip_cooperative_groups.h>
#include <cstdint>
#include <cstdio>


#define LAS __attribute__((address_space(3)))
typedef unsigned short bf16_t;
typedef short bf16x8 __attribute__((ext_vector_type(8)));
typedef float f32x4 __attribute__((ext_vector_type(4)));
typedef float f32x2 __attribute__((ext_vector_type(2)));
typedef unsigned u32x4 __attribute__((ext_vector_type(4)));
typedef unsigned u32x2 __attribute__((ext_vector_type(2)));

constexpr int D = 1024, MP = 4096, MS = 8192, M = MP + MS, DFF = 2816, DEPTH = 2;
constexpr int LC = 256, LS = 2048;
constexpr int NB_C = 16, NB_S = 4;
constexpr int NIN = 2304 + 3072;
constexpr int NMOD = 9216;
constexpr float EPS = 1e-6f;
constexpr float LOG2E = 1.4426950408889634f;
constexpr float QSCALE = 0.125f * LOG2E;

constexpr size_t MiB = 1u << 20;
constexpr size_t SZ_WGU = (size_t)2 * DFF * D * 2, SZ_WD = (size_t)D * DFF * 2, SZ_WIN = (size_t)NIN * D * 2;
constexpr size_t SZ_WA = (size_t)D * 512 * 2, SZ_W1K = (size_t)D * D * 2;
constexpr size_t WL_GU1 = 0, WL_D1 = WL_GU1 + SZ_WGU, WL_GU2 = WL_D1 + SZ_WD, WL_D2 = WL_GU2 + SZ_WGU, WL_IN = WL_D2 + SZ_WD,
                 WL_A = WL_IN + SZ_WIN, WL_L2 = WL_A + SZ_WA, WL_F2 = WL_L2 + SZ_W1K, WL_O = WL_F2 + SZ_W1K, WL_SIZE = WL_O + SZ_W1K;
constexpr size_t WS_CTL = 0;
constexpr size_t WS_MISC = 1 * MiB;
constexpr size_t OFF_MOD = WS_MISC;
constexpr size_t OFF_ROPE = OFF_MOD + (size_t)2 * 5 * NMOD * 4;
constexpr size_t OFF_CK = OFF_ROPE + 2 * 1024 * 4;
constexpr size_t OFF_CVT = OFF_CK + (size_t)4 * 2 * 256 * 128 * 2;
constexpr size_t OFF_LWT = OFF_CVT + (size_t)4 * 2 * 2 * 64 * 256 * 2;
constexpr size_t WS_DFTC = 3 * MiB;
constexpr size_t WS_DFTL = 4 * MiB;
constexpr size_t WS_W = 20 * MiB;
constexpr size_t WS_ACT = WS_W + 2 * WL_SIZE;
constexpr size_t A_G = 0;
constexpr size_t A_XN = 72 * MiB;
constexpr size_t A_XR = 96 * MiB;
constexpr size_t A_GY = 120 * MiB;
constexpr size_t A_XFT = 132 * MiB;
constexpr size_t A_Q = 144 * MiB;
constexpr size_t A_K = 156 * MiB;
constexpr size_t A_VT = 159 * MiB;
constexpr size_t A_Z = 162 * MiB;
constexpr size_t A_END = 186 * MiB;
constexpr size_t WS_END = WS_ACT + A_END;

constexpr int OUT_YS = MP * D, OUT_CK = M * D, OUT_CV = OUT_CK + 16 * 2 * 256 * 128, OUT_ST = OUT_CV + 16 * 2 * 256 * 128;

constexpr int NTHREADS = 512, NWAVES = 8;
constexpr int LDS_BYTES = 147456;

typedef __bf16 bf16x2_t __attribute__((ext_vector_type(2)));
__device__ __forceinline__ unsigned cvt_pk_bf16(float lo, float hi) { f32x2 v = {lo, hi}; bf16x2_t b = __builtin_convertvector(v, bf16x2_t); return __builtin_bit_cast(unsigned, b); }
__device__ __forceinline__ bf16_t f2bf(float f) { return (bf16_t)(cvt_pk_bf16(f, 0.f) & 0xffffu); }
__device__ __forceinline__ float bf2f(unsigned h) { return __uint_as_float(h << 16); }
__device__ __forceinline__ float bflo(unsigned w) { return __uint_as_float(w << 16); }
__device__ __forceinline__ float bfhi(unsigned w) { return __uint_as_float(w & 0xffff0000u); }
__device__ __forceinline__ float fast_rcp(float x) { return __builtin_amdgcn_rcpf(x); }
__device__ __forceinline__ float sigmoidf_(float x) { return fast_rcp(1.0f + __builtin_amdgcn_exp2f(-LOG2E * x)); }
__device__ __forceinline__ float siluf_(float x) { return x * sigmoidf_(x); }
__device__ __forceinline__ float gelu_tanh(float x) { const float u = (-2.0f * LOG2E * 0.7978845608028654f) * (x + 0.044715f * x * x * x); return x * fast_rcp(1.0f + __builtin_amdgcn_exp2f(u)); }
__device__ __forceinline__ float wave_sum(float v) {
#pragma unroll
    for (int o = 1; o < 64; o <<= 1) v += __shfl_xor(v, o);
    return v;
}
__device__ __forceinline__ int cond_of_row(int r) { return r < MP ? 4 : ((r - MP) >> 11); }

struct Args {
    const float* in[32];
    float* out;
    unsigned char* ws;
    int ph_lo, ph_hi;
};

typedef const __attribute__((address_space(4))) Args* ArgsP;
struct Ctx {
    float* out; unsigned char* ws; LAS unsigned char* lds;
    int tid, lane, wave, bid, G;
};
__device__ __forceinline__ unsigned char* wl_ptr(const Ctx& C, int l, size_t off) { return C.ws + WS_W + (size_t)l * WL_SIZE + off; }
__device__ __forceinline__ unsigned char* act_ptr(const Ctx& C, size_t off) { return C.ws + WS_ACT + off; }
__device__ __forceinline__ const float* mod_ptr(const Ctx& C, int l, int c, int sub, int which) { return (const float*)(C.ws + OFF_MOD) + ((size_t)(l * 5 + c) * NMOD + (sub * 3 + which) * D); }

__device__ __forceinline__ void p0_transpose_item(const float* W, int ldw, bf16_t* WT, int ldt, int drow0, int dcol0, int k0, int n0, LAS float* scr, int lane) {
#pragma unroll 8
    for (int i = 0; i < 32; ++i) { const int kk = 2 * i + (lane >> 5); scr[kk * 33 + (lane & 31)] = W[(size_t)(k0 + kk) * ldw + n0 + (lane & 31)]; }
    asm volatile("s_waitcnt lgkmcnt(0)" ::: "memory");
    const int c = lane & 7;
#pragma unroll
    for (int j = 0; j < 4; ++j) { const int n = (lane >> 3) + 8 * j; const LAS float* s = scr + (8 * c) * 33 + n;
        u32x4 o; o.x = cvt_pk_bf16(s[0 * 33], s[1 * 33]); o.y = cvt_pk_bf16(s[2 * 33], s[3 * 33]); o.z = cvt_pk_bf16(s[4 * 33], s[5 * 33]); o.w = cvt_pk_bf16(s[6 * 33], s[7 * 33]);
        *(u32x4*)(WT + (size_t)(drow0 + n) * ldt + dcol0 + k0 + 8 * c) = o; }
    asm volatile("s_waitcnt lgkmcnt(0)" ::: "memory");
}

__device__ __forceinline__ void p0_prologue(ArgsP args, const Ctx& C) {
    LAS float* SC = (LAS float*)C.lds;
    LAS float* TAB = (LAS float*)(C.lds + 20480);
    LAS float* SCR = (LAS float*)(C.lds + 32768);
    const float* c_in = args->in[2]; const float* cctx = args->in[6];
    for (int i = C.tid; i < 5 * 1024; i += NTHREADS) { const float v = (i < 4096) ? c_in[i] : cctx[i - 4096]; SC[i] = siluf_(v); }
    for (int i = C.tid; i < 2048; i += NTHREADS) TAB[i] = cospif((float)i * (1.0f / 1024.0f));
    __syncthreads();
    for (int it = C.bid; it < 288 + 128; it += C.G) {
        if (it < 288) {
            const int l = it / 144, j0 = (it % 144) * 64;
            const float* W = args->in[7] + (size_t)l * D * NMOD + j0 + C.lane;
            float a0 = 0.f, a1 = 0.f, a2 = 0.f, a3 = 0.f, a4 = 0.f;
            const int kb = C.wave * 128;
#pragma unroll 8
            for (int k = 0; k < 128; ++k) { const float w = W[(size_t)(kb + k) * NMOD];
                a0 += SC[kb + k] * w; a1 += SC[1024 + kb + k] * w; a2 += SC[2048 + kb + k] * w; a3 += SC[3072 + kb + k] * w; a4 += SC[4096 + kb + k] * w; }
            SCR[(C.wave * 5 + 0) * 64 + C.lane] = a0; SCR[(C.wave * 5 + 1) * 64 + C.lane] = a1; SCR[(C.wave * 5 + 2) * 64 + C.lane] = a2;
            SCR[(C.wave * 5 + 3) * 64 + C.lane] = a3; SCR[(C.wave * 5 + 4) * 64 + C.lane] = a4;
            __syncthreads();
            if (C.tid < 320) { const int c = C.tid >> 6, j = C.tid & 63; float s = args->in[8][(size_t)l * NMOD + j0 + j];
#pragma unroll
                for (int w = 0; w < 8; ++w) s += SCR[(w * 5 + c) * 64 + j];
                ((float*)(C.ws + OFF_MOD))[(size_t)(l * 5 + c) * NMOD + j0 + j] = s; }
            __syncthreads();
        } else {
            const int r = it - 288, l = r >> 6, g = (r >> 4) & 3, n0 = (r & 15) * 64;
            const float* Wf = args->in[30] + (size_t)l * 512 * D + (size_t)(g * 128) * D + n0;
            for (int i = C.tid; i < 128 * 64; i += NTHREADS) SCR[i] = Wf[(size_t)(i >> 6) * D + (i & 63)];
            __syncthreads();
            const int n = C.tid & 63, cw = C.tid >> 6;
            bf16_t* dst = (bf16_t*)wl_ptr(C, l, WL_F2) + (size_t)(n0 + n) * D + g * 128;
            const float s = 0.08838834764831845f;
            for (int j = 0; j < 16; ++j) { const int c = cw + 8 * j; float ac = 0.f, as = 0.f;
#pragma unroll 8
                for (int q = 0; q < 128; ++q) { const int idx = ((q * c) & 127) * 16; const float w = SCR[q * 64 + n];
                    ac += TAB[idx] * w; as += TAB[(idx - 512) & 2047] * w; }
                dst[c] = f2bf(ac * s); dst[512 + c] = f2bf(-as * s); }
            __syncthreads();
        }
    }
    __syncthreads();
    {
        LAS float* scr = SCR + C.wave * (64 * 33);
        const int gw = C.bid * NWAVES + C.wave, NGW = C.G * NWAVES;
        constexpr int I_G = 16 * 88, I_D = 44 * 32, I_IN = 16 * 72, I_BG = 16 * 96, I_A = 8 * 32, I_L = 8 * 32, I_O = 16 * 32;
        constexpr int PER_LAYER = 4 * I_G + 2 * I_D + I_IN + I_BG + I_A + I_L + I_O;
        for (int it = gw; it < 2 * PER_LAYER; it += NGW) {
            const int l = it / PER_LAYER; int r = it % PER_LAYER;
            if (r < I_G) { const int kb = r / 88, n0 = (r % 88) * 32; p0_transpose_item(args->in[11] + (size_t)l * D * DFF, DFF, (bf16_t*)wl_ptr(C, l, WL_GU1), D, 256 * (n0 >> 7) + (n0 & 127), 0, kb * 64, n0, scr, C.lane); continue; } r -= I_G;
            if (r < I_G) { const int kb = r / 88, n0 = (r % 88) * 32; p0_transpose_item(args->in[12] + (size_t)l * D * DFF, DFF, (bf16_t*)wl_ptr(C, l, WL_GU1), D, 256 * (n0 >> 7) + 128 + (n0 & 127), 0, kb * 64, n0, scr, C.lane); continue; } r -= I_G;
            if (r < I_D) { const int kb = r / 32, nb = r % 32; p0_transpose_item(args->in[13] + (size_t)l * DFF * D, D, (bf16_t*)wl_ptr(C, l, WL_D1), DFF, nb * 32, 0, kb * 64, nb * 32, scr, C.lane); continue; } r -= I_D;
            if (r < I_G) { const int kb = r / 88, n0 = (r % 88) * 32; p0_transpose_item(args->in[14] + (size_t)l * D * DFF, DFF, (bf16_t*)wl_ptr(C, l, WL_GU2), D, 256 * (n0 >> 7) + (n0 & 127), 0, kb * 64, n0, scr, C.lane); continue; } r -= I_G;
            if (r < I_G) { const int kb = r / 88, n0 = (r % 88) * 32; p0_transpose_item(args->in[15] + (size_t)l * D * DFF, DFF, (bf16_t*)wl_ptr(C, l, WL_GU2), D, 256 * (n0 >> 7) + 128 + (n0 & 127), 0, kb * 64, n0, scr, C.lane); continue; } r -= I_G;
            if (r < I_D) { const int kb = r / 32, nb = r % 32; p0_transpose_item(args->in[16] + (size_t)l * DFF * D, D, (bf16_t*)wl_ptr(C, l, WL_D2), DFF, nb * 32, 0, kb * 64, nb * 32, scr, C.lane); continue; } r -= I_D;
            if (r < I_IN) { const int kb = r / 72, nb = r % 72; p0_transpose_item(args->in[17] + (size_t)l * D * 2304, 2304, (bf16_t*)wl_ptr(C, l, WL_IN), D, nb * 32, 0, kb * 64, nb * 32, scr, C.lane); continue; } r -= I_IN;
            if (r < I_BG) { const int kb = r / 96, nb = r % 96; p0_transpose_item(args->in[18] + (size_t)l * D * 3072, 3072, (bf16_t*)wl_ptr(C, l, WL_IN), D, 2304 + nb * 32, 0, kb * 64, nb * 32, scr, C.lane); continue; } r -= I_BG;
            if (r < I_A) { const int kb = r / 32, nb = r % 32; p0_transpose_item(args->in[21] + (size_t)l * 512 * D, D, (bf16_t*)wl_ptr(C, l, WL_A), 512, nb * 32, 0, kb * 64, nb * 32, scr, C.lane); continue; } r -= I_A;
            if (r < I_L) { const int kb = r / 32, nb = r % 32;
                p0_transpose_item(args->in[29] + (size_t)l * 512 * D, D, (bf16_t*)wl_ptr(C, l, WL_L2), D, nb * 32, 0, kb * 64, nb * 32, scr, C.lane);
                p0_transpose_item(args->in[29] + (size_t)l * 512 * D, D, (bf16_t*)wl_ptr(C, l, WL_L2), D, nb * 32, 512, kb * 64, nb * 32, scr, C.lane); continue; } r -= I_L;
            { const int kb = r / 32, nb = r % 32; p0_transpose_item(args->in[31] + (size_t)l * D * D, D, (bf16_t*)wl_ptr(C, l, WL_O), D, nb * 32, 0, kb * 64, nb * 32, scr, C.lane); }
        }
    }
    const int gt = C.bid * NTHREADS + C.tid, NGT = C.G * NTHREADS;
    for (int i = gt; i < M * D / 4; i += NGT) { const f32x4 v = (i < MP * D / 4) ? ((const f32x4*)args->in[0])[i] : ((const f32x4*)args->in[1])[i - MP * D / 4]; ((f32x4*)C.out)[i] = v; }
    for (int i = gt; i < 2048 * 256; i += NGT) { const int pr = i >> 8, t0 = (i & 255) * 8, p = (pr <= 1024) ? pr : pr - 1024, sh = (pr > 1024) ? 512 : 0; const float s = 0.022097086912079608f;
        float v[8];
#pragma unroll
        for (int j = 0; j < 8; ++j) v[j] = TAB[((p * (t0 + j)) - sh) & 2047] * s;
        u32x4 o; o.x = cvt_pk_bf16(v[0], v[1]); o.y = cvt_pk_bf16(v[2], v[3]); o.z = cvt_pk_bf16(v[4], v[5]); o.w = cvt_pk_bf16(v[6], v[7]);
        *(u32x4*)((bf16_t*)(C.ws + WS_DFTL) + (size_t)pr * 2048 + t0) = o; }
    for (int i = gt; i < 256 * 32; i += NGT) { const int pr = i >> 5, t0 = (i & 31) * 8, p = (pr <= 128) ? pr : pr - 128, sh = (pr > 128) ? 512 : 0; const float s = 0.0625f;
        float v[8];
#pragma unroll
        for (int j = 0; j < 8; ++j) v[j] = TAB[((p * (t0 + j) * 8) - sh) & 2047] * s;
        u32x4 o; o.x = cvt_pk_bf16(v[0], v[1]); o.y = cvt_pk_bf16(v[2], v[3]); o.z = cvt_pk_bf16(v[4], v[5]); o.w = cvt_pk_bf16(v[6], v[7]);
        *(u32x4*)((bf16_t*)(C.ws + WS_DFTC) + (size_t)pr * 256 + t0) = o; }
    for (int i = gt; i < 1024; i += NGT) { const int pos = i >> 4, f = i & 15; const float inv = exp2f(-(float)f * (13.287712379549449f / 16.0f)); const float ang = (float)pos * inv; const float af = (float)((double)ang * 0.3183098861837907);
        ((float*)(C.ws + OFF_ROPE))[i] = cospif(af); ((float*)(C.ws + OFF_ROPE))[1024 + i] = sinpif(af); }
    for (int i = gt; i < 4 * 2 * 256 * 128; i += NGT) { ((bf16_t*)(C.ws + OFF_CK))[i] = f2bf(args->in[3][i]);
        const int d = i & 63, kvh = (i >> 6) & 1, t = (i >> 7) & 255, bl = i >> 15;
        ((bf16_t*)(C.ws + OFF_CVT))[((size_t)(bl * 2 + kvh) * 64 + d) * 256 + t] = f2bf(args->in[4][i]); }
    for (int i = gt; i < 2 * 2 * 8 * 128 * 64; i += NGT) { const int k = i & 63, n = (i >> 6) & 127, g = i >> 13;
        const float v = (n < 64) ? args->in[24][((size_t)g * 64 + k) * 64 + n] : args->in[26][((size_t)g * 64 + k) * 64 + (n - 64)]; ((bf16_t*)(C.ws + OFF_LWT))[i] = f2bf(v); }
}

__device__ __forceinline__ void modnorm_phase(ArgsP args, const Ctx& C, int l, int sub) {
    const int gw = C.bid * NWAVES + C.wave, NGW = C.G * NWAVES;
    const float* nw = args->in[9] + (size_t)(l * 3 + sub) * D;
    bf16_t* XN = (bf16_t*)act_ptr(C, A_XN);
    for (int r = gw; r < M; r += NGW) {
        const int c = cond_of_row(r);
        const float* sh = mod_ptr(C, l, c, sub, 0); const float* sc = mod_ptr(C, l, c, sub, 1);
        const f32x4* xr = (const f32x4*)(C.out + (size_t)r * D) + C.lane;
        f32x4 v[4]; float s = 0.f;
#pragma unroll
        for (int j = 0; j < 4; ++j) { v[j] = xr[64 * j]; s += (v[j].x * v[j].x + v[j].y * v[j].y) + (v[j].z * v[j].z + v[j].w * v[j].w); }
        const float rstd = __builtin_amdgcn_rsqf(wave_sum(s) * (1.0f / D) + EPS);
        u32x2* o = (u32x2*)(XN + (size_t)r * D) + C.lane;
#pragma unroll
        for (int j = 0; j < 4; ++j) { const int col = 4 * C.lane + 256 * j; const f32x4 w = *(const f32x4*)(nw + col), a = *(const f32x4*)(sc + col), b = *(const f32x4*)(sh + col);
            f32x4 y = v[j] * rstd * w * (a + 1.0f) + b; u32x2 p; p.x = cvt_pk_bf16(y.x, y.y); p.y = cvt_pk_bf16(y.z, y.w); o[64 * j] = p; }
    }
}
__device__ __forceinline__ void finalnorm_phase(ArgsP args, const Ctx& C) {
    const int gw = C.bid * NWAVES + C.wave, NGW = C.G * NWAVES;
    const float* nw = args->in[10];
    for (int r = gw; r < M; r += NGW) {
        f32x4* xr = (f32x4*)(C.out + (size_t)r * D) + C.lane;
        f32x4 v[4]; float s = 0.f;
#pragma unroll
        for (int j = 0; j < 4; ++j) { v[j] = xr[64 * j]; s += (v[j].x * v[j].x + v[j].y * v[j].y) + (v[j].z * v[j].z + v[j].w * v[j].w); }
        const float rstd = __builtin_amdgcn_rsqf(wave_sum(s) * (1.0f / D) + EPS);
#pragma unroll
        for (int j = 0; j < 4; ++j) { const f32x4 w = *(const f32x4*)(nw + 4 * C.lane + 256 * j); xr[64 * j] = v[j] * rstd * w; }
    }
}

struct Unit { int pm, pn, z; const bf16_t* A; const bf16_t* B; };

struct StaticOrder {
    int nM, nN, nwg, G, c; const bf16_t* A; const bf16_t* B; int lda, ldb;
    __device__ void init(int Mr, int N, int G_, int c_, const bf16_t* A_, int lda_, const bf16_t* B_, int ldb_) { nM = Mr / 256; nN = N / 256; nwg = nM * nN; G = G_; c = c_; A = A_; B = B_; lda = lda_; ldb = ldb_; }
    __device__ bool next(int i, Unit& u) const {
        const long L = (long)i * G + c; if (L >= nwg) return false;
        int wgid = (int)L; { const int q = nwg / 8, r = nwg % 8, xcd = wgid % 8, off = wgid / 8; wgid = (xcd < r ? xcd * (q + 1) : r * (q + 1) + (xcd - r) * q) + off; }
        const int nig = 8 * nN, gid = wgid / nig, fm = gid * 8, gsz = (nM - fm) < 8 ? (nM - fm) : 8;
        u.pm = fm + ((wgid % nig) % gsz); u.pn = (wgid % nig) / gsz; u.z = 0;
        u.A = A + (size_t)u.pm * 256 * lda; u.B = B + (size_t)u.pn * 256 * ldb; return true;
    }
};
struct DftOrder {
    int nseq, nPm, L, G, c; const bf16_t* A; const bf16_t* XFT;
    __device__ bool next(int i, Unit& u) const {
        const int idx = i * G + c; if (idx >= nseq * nPm * 2) return false;
        u.z = idx / (nPm * 2); const int r = idx % (nPm * 2); u.pm = r >> 1; u.pn = r & 1;
        u.A = A + (size_t)u.pm * 256 * L; u.B = XFT + ((size_t)u.z * 512 + u.pn * 256) * L; return true;
    }
};

template <class Epi, class Sched>
__device__ __forceinline__ void gemm_simple(const Ctx& C, const Sched& S, const Epi& E, int lda, int ldb, int K) {
    const int wr = C.wave >> 2, wc = C.wave & 3, fr = C.lane & 15, fq = C.lane >> 4;
    Unit u;
    for (int ui = 0; S.next(ui, u); ++ui) {
        f32x4 acc[2][2][4][2];
#pragma unroll
        for (int a = 0; a < 2; ++a)
#pragma unroll
            for (int b = 0; b < 2; ++b)
#pragma unroll
                for (int m = 0; m < 4; ++m)
#pragma unroll
                    for (int n = 0; n < 2; ++n) acc[a][b][m][n] = (f32x4){0.f, 0.f, 0.f, 0.f};
        const bf16_t* pa = u.A + (size_t)(wr * 64 + fr) * lda + fq * 8;
        const bf16_t* pb = u.B + (size_t)(wc * 32 + fr) * ldb + fq * 8;
        for (int k0 = 0; k0 < K; k0 += 32) {
            bf16x8 At[2][4], Bt[2][2];
#pragma unroll
            for (int a = 0; a < 2; ++a)
#pragma unroll
                for (int m = 0; m < 4; ++m) At[a][m] = *(const bf16x8*)(pa + (size_t)(a * 128 + m * 16) * lda + k0);
#pragma unroll
            for (int b = 0; b < 2; ++b)
#pragma unroll
                for (int n = 0; n < 2; ++n) Bt[b][n] = *(const bf16x8*)(pb + (size_t)(b * 128 + n * 16) * ldb + k0);
#pragma unroll
            for (int a = 0; a < 2; ++a)
#pragma unroll
                for (int b = 0; b < 2; ++b)
#pragma unroll
                    for (int m = 0; m < 4; ++m)
#pragma unroll
                        for (int n = 0; n < 2; ++n) acc[a][b][m][n] = __builtin_amdgcn_mfma_f32_16x16x32_bf16(Bt[b][n], At[a][m], acc[a][b][m][n], 0, 0, 0);
        }
        E(acc, u, wr, wc, fr, fq);
    }
}

namespace pg8 {
#define PG8_LAS __attribute__((address_space(3)))
constexpr int BM = 256, BK = 64, HALF = 128, HTB = HALF * BK * 2  , STAGE_BYTES = 8 * HTB, NXCD = 8, WGM = 8;

__host__ __device__ __forceinline__ int lds_byte(int r, int c) { const int st = (r >> 4) * 2 + (c >> 5), rr = r & 15, cc = c & 31, ob = rr * 64 + cc * 2; return st * 1024 + (ob ^ (((ob >> 9) & 1) << 5)); }
__host__ __device__ __forceinline__ void stage_rc(int b, int& R, int& C) { const int st = b / 1024, sb = b % 1024, swz = sb ^ (((sb >> 9) & 1) << 5); R = (st >> 1) * 16 + swz / 64; C = (st & 1) * 32 + (swz % 64) / 2; }
__host__ __device__ __forceinline__ int perm32(int rho) { const int n = rho >> 4, i = rho & 15; return 8 * (i >> 2) + 4 * n + (i & 3); }
template <class Epi, class Sched, bool ALIGN_EPI = true, bool SP2 = true>
__device__ __forceinline__ void gemm_phase(PG8_LAS unsigned char* lds, const int tid, const Sched& S, const Epi& E, const int lda, const int ldb, const int K) {
    const int wid = __builtin_amdgcn_readfirstlane(tid >> 6), lane = tid & 63, wr = wid >> 2, wc = wid & 3, fr = lane & 15, fq = lane >> 4;
    const int nt = K / BK;
    unsigned voffA[2], voffB[2];
#pragma unroll
    for (int i = 0; i < 2; ++i) { int R, C; stage_rc(tid * 16 + i * 8192, R, C); const int Rb = Epi::PERM ? ((R & ~31) + perm32(R & 31)) : R;
        voffA[i] = (unsigned)(R * lda + C) * 2u; voffB[i] = (unsigned)(Rb * ldb + C) * 2u; }
    const size_t kstep = (size_t)(BK * 2);
    const size_t hstepA = (size_t)HALF * lda * 2, hstepB = (size_t)HALF * ldb * 2;
    const unsigned ldsw = (unsigned)wid * 1024u;
    const int aoff = lds_byte(wr * 64 + fr, fq * 8), boff = lds_byte(wc * 32 + fr, fq * 8);
#define PG8_SA(b, h) (((b) * 2 + (h)) * HTB)
#define PG8_SB(b, h) ((4 + (b) * 2 + (h)) * HTB)
#define PG8_STAGE(bufoff, gbase, voff) do { _Pragma("unroll") for (int _i = 0; _i < 2; ++_i) \
        __builtin_amdgcn_global_load_lds((const unsigned*)((const char*)(gbase) + (voff)[_i]), (PG8_LAS unsigned*)(lds + (bufoff) + ldsw + _i * 8192), 16, 0, 0); } while (0)
#define PG8_LDA(dst, b, h) do { _Pragma("unroll") for (int m = 0; m < 4; ++m) _Pragma("unroll") for (int k = 0; k < 2; ++k) dst[m][k] = *(const PG8_LAS bf16x8*)(lds + PG8_SA(b, h) + aoff + m * 2048 + k * 1024); } while (0)
#define PG8_LDB(dst, b, h) do { _Pragma("unroll") for (int n = 0; n < 2; ++n) _Pragma("unroll") for (int k = 0; k < 2; ++k) dst[n][k] = *(const PG8_LAS bf16x8*)(lds + PG8_SB(b, h) + boff + n * 2048 + k * 1024); } while (0)
#define PG8_MMA(ai, bj, At, Bt) do { __builtin_amdgcn_s_setprio(1); _Pragma("unroll") for (int m = 0; m < 4; ++m) _Pragma("unroll") for (int n = 0; n < 2; ++n) _Pragma("unroll") for (int k = 0; k < 2; ++k) \
        acc[ai][bj][m][n] = __builtin_amdgcn_mfma_f32_16x16x32_bf16(Bt[n][k], At[m][k], acc[ai][bj][m][n], 0, 0, 0); __builtin_amdgcn_s_setprio(0); } while (0)
#define PG8_WAIT_V(n) asm volatile("s_waitcnt vmcnt(" #n ")" ::: "memory")
#define PG8_WAIT_L(n) asm volatile("s_waitcnt lgkmcnt(" #n ")" ::: "memory")
#define PG8_BAR __builtin_amdgcn_s_barrier()
#define PG8_SCHED __builtin_amdgcn_sched_barrier(0)
    Unit cur, nxt; int ui = 0;
    if (!S.next(0, cur)) return;
    f32x4 acc[2][2][4][2];
#pragma unroll
    for (int a = 0; a < 2; ++a)
#pragma unroll
        for (int b = 0; b < 2; ++b)
#pragma unroll
            for (int m = 0; m < 4; ++m)
#pragma unroll
                for (int n = 0; n < 2; ++n) acc[a][b][m][n] = (f32x4){0.f, 0.f, 0.f, 0.f};
    bf16x8 At[4][2], B0[2][2], B1[2][2];
    const char* cA = (const char*)cur.A; const char* cB = (const char*)cur.B;
    if constexpr (SP2) {
        PG8_STAGE(PG8_SB(0, 0), cB, voffB); PG8_STAGE(PG8_SB(0, 1), cB + hstepB, voffB); PG8_STAGE(PG8_SA(0, 0), cA, voffA); PG8_STAGE(PG8_SA(0, 1), cA + hstepA, voffA);
        if (wr == 1) PG8_BAR;
        PG8_WAIT_V(2); PG8_BAR;
        PG8_STAGE(PG8_SB(1, 0), cB + kstep, voffB); PG8_STAGE(PG8_SA(1, 0), cA + kstep, voffA); PG8_STAGE(PG8_SB(1, 1), cB + hstepB + kstep, voffB);
        PG8_WAIT_V(6); PG8_BAR;
    } else {
        PG8_STAGE(PG8_SB(0, 0), cB, voffB); PG8_STAGE(PG8_SA(0, 0), cA, voffA); PG8_STAGE(PG8_SB(0, 1), cB + hstepB, voffB); PG8_STAGE(PG8_SA(0, 1), cA + hstepA, voffA);
        if (wr == 1) PG8_BAR;
        PG8_WAIT_V(4); PG8_BAR;
        PG8_STAGE(PG8_SB(1, 0), cB + kstep, voffB); PG8_STAGE(PG8_SA(1, 0), cA + kstep, voffA); PG8_STAGE(PG8_SB(1, 1), cB + hstepB + kstep, voffB);
        PG8_WAIT_V(6); PG8_BAR;
    }
    for (;;) {
        const bool has_next = S.next(ui + 1, nxt);
        const char* nA = has_next ? (const char*)nxt.A : cA; const char* nB = has_next ? (const char*)nxt.B : cB;
        for (int t = 0; t < nt; t += 2) {
            const bool last = (t == nt - 2);
            const char* a1 = cA + (size_t)(t + 1) * kstep;
            const char* a2 = last ? nA : cA + (size_t)(t + 2) * kstep; const char* b2 = last ? nB : cB + (size_t)(t + 2) * kstep;
            const char* a3 = a2 + kstep; const char* b3 = b2 + kstep;
            if constexpr (SP2) {
            PG8_LDB(B0, 0, 0); PG8_LDB(B1, 0, 1); PG8_SCHED; PG8_LDA(At, 0, 0); PG8_STAGE(PG8_SA(1, 1), a1 + hstepA, voffA);
            PG8_WAIT_V(8); PG8_WAIT_L(0); PG8_BAR; PG8_MMA(0, 0, At, B0); PG8_MMA(0, 1, At, B1); PG8_BAR; PG8_SCHED;
            PG8_LDA(At, 0, 1); PG8_STAGE(PG8_SB(0, 0), b2, voffB); PG8_STAGE(PG8_SB(0, 1), b2 + hstepB, voffB); PG8_STAGE(PG8_SA(0, 0), a2, voffA);
            PG8_WAIT_V(8); PG8_WAIT_L(0); PG8_BAR; PG8_MMA(1, 0, At, B0); PG8_MMA(1, 1, At, B1); PG8_BAR; PG8_SCHED;
            PG8_LDB(B0, 1, 0); PG8_LDB(B1, 1, 1); PG8_SCHED; PG8_LDA(At, 1, 0); PG8_STAGE(PG8_SA(0, 1), a2 + hstepA, voffA);
            PG8_WAIT_V(8); PG8_WAIT_L(0); PG8_BAR; PG8_MMA(0, 0, At, B0); PG8_MMA(0, 1, At, B1); PG8_BAR; PG8_SCHED;
            PG8_LDA(At, 1, 1); PG8_STAGE(PG8_SB(1, 0), b3, voffB); PG8_STAGE(PG8_SB(1, 1), b3 + hstepB, voffB); PG8_STAGE(PG8_SA(1, 0), a3, voffA);
            PG8_WAIT_V(8); PG8_WAIT_L(0); PG8_BAR; PG8_MMA(1, 0, At, B0); PG8_MMA(1, 1, At, B1); PG8_BAR; PG8_SCHED;
            } else {
            PG8_LDB(B0, 0, 0); PG8_SCHED; PG8_LDA(At, 0, 0); PG8_STAGE(PG8_SA(1, 1), a1 + hstepA, voffA);
            PG8_WAIT_L(8); PG8_BAR; PG8_WAIT_L(0); PG8_MMA(0, 0, At, B0); PG8_BAR; PG8_SCHED;
            PG8_LDB(B1, 0, 1); PG8_STAGE(PG8_SB(0, 0), b2, voffB);
            PG8_BAR; PG8_WAIT_L(0); PG8_MMA(0, 1, At, B1); PG8_BAR;
            PG8_LDA(At, 0, 1); PG8_STAGE(PG8_SA(0, 0), a2, voffA);
            PG8_BAR; PG8_WAIT_L(0); PG8_MMA(1, 0, At, B0); PG8_BAR; PG8_SCHED;
            PG8_STAGE(PG8_SB(0, 1), b2 + hstepB, voffB);
            PG8_WAIT_V(6); PG8_BAR; PG8_MMA(1, 1, At, B1); PG8_BAR;
            PG8_LDB(B0, 1, 0); PG8_SCHED; PG8_LDA(At, 1, 0); PG8_STAGE(PG8_SA(0, 1), a2 + hstepA, voffA);
            PG8_WAIT_L(8); PG8_BAR; PG8_WAIT_L(0); PG8_MMA(0, 0, At, B0); PG8_BAR; PG8_SCHED;
            PG8_LDB(B1, 1, 1); PG8_STAGE(PG8_SB(1, 0), b3, voffB);
            PG8_BAR; PG8_WAIT_L(0); PG8_MMA(0, 1, At, B1); PG8_BAR;
            PG8_LDA(At, 1, 1); PG8_STAGE(PG8_SA(1, 0), a3, voffA);
            PG8_BAR; PG8_WAIT_L(0); PG8_MMA(1, 0, At, B0); PG8_BAR; PG8_SCHED;
            PG8_STAGE(PG8_SB(1, 1), b3 + hstepB, voffB);
            PG8_WAIT_V(6); PG8_BAR; PG8_MMA(1, 1, At, B1); PG8_BAR;
            }
        }
        if constexpr (ALIGN_EPI) { if (wr == 0) PG8_BAR; }
        if constexpr (!Epi::AFTER_DRAIN) { E(acc, cur, wr, wc, fr, fq); }
        if (!has_next) break;
#pragma unroll
        for (int a = 0; a < 2; ++a)
#pragma unroll
            for (int b = 0; b < 2; ++b)
#pragma unroll
                for (int m = 0; m < 4; ++m)
#pragma unroll
                    for (int n = 0; n < 2; ++n) acc[a][b][m][n] = (f32x4){0.f, 0.f, 0.f, 0.f};
        cur = nxt; cA = nA; cB = nB; ++ui;
        if constexpr (ALIGN_EPI) { if (wr == 1) PG8_BAR; }
    }
    PG8_WAIT_V(0);
    if constexpr (!ALIGN_EPI) { if (wr == 0) PG8_BAR; }
    PG8_BAR;
    if constexpr (Epi::AFTER_DRAIN) { E.fused(acc, cur, wr, wc, fr, fq, lds, wid, lane); }
#undef PG8_SA
#undef PG8_SB
#undef PG8_STAGE
#undef PG8_LDA
#undef PG8_LDB
#undef PG8_MMA
#undef PG8_WAIT_V
#undef PG8_WAIT_L
#undef PG8_BAR
#undef PG8_SCHED
}
}

#ifndef USE_PG8
#define USE_PG8 1
#endif
#if USE_PG8
#define GEMM(C, S, E, lda, ldb, K) pg8::gemm_phase(C.lds, C.tid, S, E, lda, ldb, K)
#else
#define GEMM(C, S, E, lda, ldb, K) GEMM(C, S, E, lda, ldb, K)
#endif

#define EPI_LOOP_AM for (int ai = 0; ai < 2; ++ai) _Pragma("unroll") for (int m = 0; m < 4; ++m)
struct EpiGU {
    static constexpr bool PERM = false, AFTER_DRAIN = false;
    bf16_t* H;
    __device__ __forceinline__ void operator()(const f32x4 (&acc)[2][2][4][2], const Unit& u, int wr, int wc, int fr, int fq) const {
#pragma unroll
        EPI_LOOP_AM { const int row = u.pm * 256 + ai * 128 + wr * 64 + m * 16 + fr;
#pragma unroll
            for (int n = 0; n < 2; ++n) { const f32x4 g = acc[ai][0][m][n], up = acc[ai][1][m][n];
                u32x2 p; p.x = cvt_pk_bf16(siluf_(g.x) * up.x, siluf_(g.y) * up.y); p.y = cvt_pk_bf16(siluf_(g.z) * up.z, siluf_(g.w) * up.w);
                *(u32x2*)(H + (size_t)row * DFF + u.pn * 128 + wc * 32 + n * 16 + fq * 4) = p; } }
    }
};
struct EpiRes {
    static constexpr bool PERM = false, AFTER_DRAIN = false;
    float* X; const float* modbase; int l, sub; float coef;
    __device__ __forceinline__ void operator()(const f32x4 (&acc)[2][2][4][2], const Unit& u, int wr, int wc, int fr, int fq) const {
        const int c = cond_of_row(u.pm * 256);
        const float* gate = modbase + ((size_t)(l * 5 + c) * NMOD + (sub * 3 + 2) * D) + u.pn * 256 + wc * 32 + fq * 4;
        f32x4 g[2][2];
#pragma unroll
        for (int bj = 0; bj < 2; ++bj)
#pragma unroll
            for (int n = 0; n < 2; ++n) g[bj][n] = *(const f32x4*)(gate + bj * 128 + n * 16) * coef;
#pragma unroll
        EPI_LOOP_AM { float* xrow = X + (size_t)(u.pm * 256 + ai * 128 + wr * 64 + m * 16 + fr) * D + u.pn * 256 + wc * 32 + fq * 4;
#pragma unroll
            for (int bj = 0; bj < 2; ++bj)
#pragma unroll
                for (int n = 0; n < 2; ++n) { f32x4* p = (f32x4*)(xrow + bj * 128 + n * 16); *p = *p + g[bj][n] * acc[ai][bj][m][n]; }
            asm volatile("" ::: "memory"); }
    }
};
struct EpiIn {
    static constexpr bool PERM = false, AFTER_DRAIN = false;
    bf16_t *Q, *Kb, *VT, *GY, *XFT, *G; float* XR; float* out; const float* rope; const float* bgate; int l;
    __device__ __forceinline__ void operator()(const f32x4 (&acc)[2][2][4][2], const Unit& u, int wr, int wc, int fr, int fq) const {
        const int row0 = u.pm * 256 + wr * 64 + fr; const bool latent = u.pm >= 16;
        if (u.pn <= 2) {
#pragma unroll
            for (int bj = 0; bj < 2; ++bj) {
                if (u.pn == 2 && bj == 1) {
#pragma unroll
                    EPI_LOOP_AM { const int row = row0 + ai * 128 + m * 16; int seqoff, L, t;
                        if (latent) { const int b = (row - MP) >> 11; t = (row - MP) & 2047; L = LS; seqoff = 16 * 128 * LC + b * 128 * LS; } else { const int b = row >> 8; t = row & 255; L = LC; seqoff = b * 128 * LC; }
#pragma unroll
                        for (int n = 0; n < 2; ++n) { const f32x4 v = acc[ai][1][m][n]; const int d128 = wc * 32 + n * 16 + fq * 4;
                            bf16_t* p = VT + seqoff + (size_t)d128 * L + t; p[0] = f2bf(v.x); p[L] = f2bf(v.y); p[2 * L] = f2bf(v.z); p[3 * L] = f2bf(v.w);
                            if (!latent) *(f32x4*)(out + OUT_CV + ((size_t)((row >> 8) * 2 + l) * 256 + t) * 128 + d128) = v; } }
                } else {
                    const bool isk = (u.pn == 2); const int axis = wc & 1;
#pragma unroll
                    EPI_LOOP_AM { const int row = row0 + ai * 128 + m * 16; f32x4 x1 = acc[ai][bj][m][0], x2 = acc[ai][bj][m][1];
                        if (isk && !latent) { float* o = out + OUT_CK + ((size_t)((row >> 8) * 2 + l) * 256 + (row & 255)) * 128 + wc * 32 + fq * 4; *(f32x4*)o = x1; *(f32x4*)(o + 16) = x2; }
                        if (latent) { const int t = (row - MP) & 2047, pos = axis ? (t & 63) : (t >> 6);
                            const f32x4 cs = *(const f32x4*)(rope + pos * 16 + fq * 4), sn = *(const f32x4*)(rope + 1024 + pos * 16 + fq * 4);
                            const f32x4 o1 = x1 * cs - x2 * sn, o2 = x1 * sn + x2 * cs; x1 = o1; x2 = o2; }
                        if (!isk) { x1 = x1 * QSCALE; x2 = x2 * QSCALE; }
                        bf16_t* o = isk ? (Kb + (size_t)row * 128 + wc * 32 + fq * 4) : (Q + (size_t)row * 512 + u.pn * 256 + bj * 128 + wc * 32 + fq * 4);
                        u32x2 p; p.x = cvt_pk_bf16(x1.x, x1.y); p.y = cvt_pk_bf16(x1.z, x1.w); *(u32x2*)o = p;
                        p.x = cvt_pk_bf16(x2.x, x2.y); p.y = cvt_pk_bf16(x2.z, x2.w); *(u32x2*)(o + 16) = p; }
                }
            }
        } else if (u.pn <= 4) {
#pragma unroll
            EPI_LOOP_AM { const int row = row0 + ai * 128 + m * 16;
#pragma unroll
                for (int bj = 0; bj < 2; ++bj)
#pragma unroll
                    for (int n = 0; n < 2; ++n) *(f32x4*)(XR + (size_t)row * 512 + (u.pn - 3) * 256 + bj * 128 + wc * 32 + n * 16 + fq * 4) = acc[ai][bj][m][n]; }
        } else if (u.pn <= 6) {
#pragma unroll
            EPI_LOOP_AM { const int row = row0 + ai * 128 + m * 16;
#pragma unroll
                for (int bj = 0; bj < 2; ++bj)
#pragma unroll
                    for (int n = 0; n < 2; ++n) { const f32x4 v = acc[ai][bj][m][n]; u32x2 p; p.x = cvt_pk_bf16(gelu_tanh(v.x), gelu_tanh(v.y)); p.y = cvt_pk_bf16(gelu_tanh(v.z), gelu_tanh(v.w));
                        *(u32x2*)(GY + (size_t)row * 512 + (u.pn - 5) * 256 + bj * 128 + wc * 32 + n * 16 + fq * 4) = p; } }
        } else if (u.pn <= 8) {
#pragma unroll
            EPI_LOOP_AM { const int row = row0 + ai * 128 + m * 16; size_t seqoff; int L, t;
                if (latent) { const int b = (row - MP) >> 11; t = (row - MP) & 2047; L = LS; seqoff = (size_t)16 * 512 * LC + (size_t)b * 512 * LS; } else { const int b = row >> 8; t = row & 255; L = LC; seqoff = (size_t)b * 512 * LC; }
#pragma unroll
                for (int bj = 0; bj < 2; ++bj)
#pragma unroll
                    for (int n = 0; n < 2; ++n) { const f32x4 v = acc[ai][bj][m][n]; bf16_t* p = XFT + seqoff + (size_t)((u.pn - 7) * 256 + bj * 128 + wc * 32 + n * 16 + fq * 4) * L + t;
                        p[0] = f2bf(v.x); p[L] = f2bf(v.y); p[2 * L] = f2bf(v.z); p[3 * L] = f2bf(v.w); } }
        } else {
#pragma unroll
            for (int bj = 0; bj < 2; ++bj)
#pragma unroll
                for (int n = 0; n < 2; ++n) { const int col = (u.pn - 9) * 256 + bj * 128 + wc * 32 + n * 16 + fq * 4; const f32x4 b = *(const f32x4*)(bgate + col);
#pragma unroll
                    EPI_LOOP_AM { const int row = row0 + ai * 128 + m * 16; const f32x4 v = acc[ai][bj][m][n] + b;
                        u32x2 p; p.x = cvt_pk_bf16(sigmoidf_(v.x), sigmoidf_(v.y)); p.y = cvt_pk_bf16(sigmoidf_(v.z), sigmoidf_(v.w)); *(u32x2*)(G + (size_t)row * 3072 + col) = p; } }
        }
    }
};
template <int MODE> struct EpiBranch {
    static constexpr bool PERM = false, AFTER_DRAIN = false;
    bf16_t* MG; const bf16_t* G; int br;
    __device__ __forceinline__ void operator()(const f32x4 (&acc)[2][2][4][2], const Unit& u, int wr, int wc, int fr, int fq) const {
#pragma unroll
        EPI_LOOP_AM { const int row = u.pm * 256 + ai * 128 + wr * 64 + m * 16 + fr;
#pragma unroll
            for (int bj = 0; bj < 2; ++bj)
#pragma unroll
                for (int n = 0; n < 2; ++n) { const int col = u.pn * 256 + bj * 128 + wc * 32 + n * 16 + fq * 4;
                    const u32x2 g = *(const u32x2*)(G + (size_t)row * 3072 + br * 1024 + col); f32x4 v = acc[ai][bj][m][n];
                    v.x *= bflo(g.x); v.y *= bfhi(g.x); v.z *= bflo(g.y); v.w *= bfhi(g.y);
                    u32x2* p = (u32x2*)(MG + (size_t)row * D + col);
                    if (MODE == 1) { const u32x2 o = *p; v.x += bflo(o.x); v.y += bfhi(o.x); v.z += bflo(o.y); v.w += bfhi(o.y); }
                    u32x2 w; w.x = cvt_pk_bf16(v.x, v.y); w.y = cvt_pk_bf16(v.z, v.w); *p = w; }
            asm volatile("" ::: "memory"); }
    }
};
struct EpiDft {
    static constexpr bool PERM = false, AFTER_DRAIN = false;
    bf16_t* Z; int L, rowbase;
    __device__ __forceinline__ void operator()(const f32x4 (&acc)[2][2][4][2], const Unit& u, int wr, int wc, int fr, int fq) const {
        const int hl = L >> 1;
#pragma unroll
        EPI_LOOP_AM { const int rr = u.pm * 256 + ai * 128 + wr * 64 + m * 16 + fr; const bool sn = rr >= hl; const int p = sn ? rr - hl : rr;
            bf16_t* z0 = Z + (size_t)rowbase * D + u.pn * 256 + wc * 32 + fq * 4;
#pragma unroll
            for (int bj = 0; bj < 2; ++bj)
#pragma unroll
                for (int n = 0; n < 2; ++n) { const f32x4 v = acc[ai][bj][m][n]; u32x2 w; w.x = cvt_pk_bf16(v.x, v.y); w.y = cvt_pk_bf16(v.z, v.w); const int co = bj * 128 + n * 16;
                    if (!sn) { *(u32x2*)(z0 + (size_t)p * D + co) = w; if (p) *(u32x2*)(z0 + (size_t)(L - p) * D + co) = w; }
                    else if (p == 0) { *(u32x2*)(z0 + (size_t)hl * D + co) = w; const u32x2 zz = {0u, 0u}; *(u32x2*)(z0 + 512 + co) = zz; *(u32x2*)(z0 + (size_t)hl * D + 512 + co) = zz; }
                    else { *(u32x2*)(z0 + (size_t)p * D + 512 + co) = w; u32x2 nw; nw.x = w.x ^ 0x80008000u; nw.y = w.y ^ 0x80008000u; *(u32x2*)(z0 + (size_t)(L - p) * D + 512 + co) = nw; } } }
    }
};

typedef float f32x16 __attribute__((ext_vector_type(16)));
typedef short s16x4 __attribute__((ext_vector_type(4)));
#define MFMA32(a, b, c) __builtin_amdgcn_mfma_f32_32x32x16_bf16((a), (b), (c), 0, 0, 0)
constexpr int AT_KSTR = 144, AT_VSTR = 136, AT_KBYTES = 64 * AT_KSTR, AT_VBYTES = 64 * AT_VSTR, AT_BUF = AT_KBYTES + AT_VBYTES;
struct AttnSrc { const bf16_t* kp; const bf16_t* vp; int vstride; int kbase; };
__device__ __forceinline__ AttnSrc attn_src(int t, bool latent, int nband, int lo, int b, int l, int kvh, const bf16_t* Kb, const bf16_t* VT, const bf16_t* CK, const bf16_t* CVT) {
    AttnSrc s;
    if (!latent) { s.kp = Kb + (size_t)(b * LC + 64 * t) * 128 + kvh * 64; s.vp = VT + (size_t)b * 128 * LC + (size_t)(kvh * 64) * LC + 64 * t; s.vstride = LC; s.kbase = 0; }
    else if (t < nband) { const int kb = lo + 64 * t; s.kp = Kb + (size_t)(MP + b * LS + kb) * 128 + kvh * 64; s.vp = VT + (size_t)16 * 128 * LC + (size_t)b * 128 * LS + (size_t)(kvh * 64) * LS + kb; s.vstride = LS; s.kbase = kb; }
    else { const int c = t - nband; s.kp = CK + (size_t)((b * 2 + l) * 256 + 64 * c) * 128 + kvh * 64; s.vp = CVT + (size_t)((b * 2 + l) * 2 + kvh) * 64 * 256 + 64 * c; s.vstride = 256; s.kbase = 0; }
    return s;
}
__device__ __forceinline__ void attn_tile(const LAS unsigned char* kbp, const bf16x8 (&qf)[4], f32x16& O0, f32x16& O1, float& mrun, float& lsum, bool domask, int dk0, int q32, int half) {
    const LAS unsigned char* vbp = kbp + AT_KBYTES;
    f32x16 S0, S1;
#pragma unroll
    for (int r = 0; r < 16; ++r) { S0[r] = 0.f; S1[r] = 0.f; }
#pragma unroll
    for (int ks = 0; ks < 4; ++ks) { const bf16x8 k0 = *(const LAS bf16x8*)(kbp + q32 * AT_KSTR + ks * 32 + half * 16), k1 = *(const LAS bf16x8*)(kbp + (32 + q32) * AT_KSTR + ks * 32 + half * 16);
        S0 = MFMA32(k0, qf[ks], S0); S1 = MFMA32(k1, qf[ks], S1); }
    if (domask) {
#pragma unroll
        for (int r = 0; r < 16; ++r) { const int d0 = dk0 + (r & 3) + 8 * (r >> 2) + 4 * half, d1 = d0 + 32;
            S0[r] = (d0 > 128 || d0 < -128) ? -1e30f : S0[r]; S1[r] = (d1 > 128 || d1 < -128) ? -1e30f : S1[r]; } }
    float mx = fmaxf(S0[0], S1[0]);
#pragma unroll
    for (int r = 1; r < 16; ++r) mx = fmaxf(mx, fmaxf(S0[r], S1[r]));
    mx = fmaxf(mx, __shfl_xor(mx, 32));
    const float mnew = fmaxf(mrun, mx), alpha = __builtin_amdgcn_exp2f(mrun - mnew); mrun = mnew;
    float ps = 0.f;
#pragma unroll
    for (int r = 0; r < 16; ++r) { S0[r] = __builtin_amdgcn_exp2f(S0[r] - mnew); S1[r] = __builtin_amdgcn_exp2f(S1[r] - mnew); ps += S0[r] + S1[r]; }
    lsum = lsum * alpha + ps;
#pragma unroll
    for (int r = 0; r < 16; ++r) { O0[r] *= alpha; O1[r] *= alpha; }
    bf16x8 pf[4];
#pragma unroll
    for (int s2 = 0; s2 < 2; ++s2) { u32x4 a, c2;
        a.x = cvt_pk_bf16(S0[8 * s2 + 0], S0[8 * s2 + 1]); a.y = cvt_pk_bf16(S0[8 * s2 + 2], S0[8 * s2 + 3]); a.z = cvt_pk_bf16(S0[8 * s2 + 4], S0[8 * s2 + 5]); a.w = cvt_pk_bf16(S0[8 * s2 + 6], S0[8 * s2 + 7]);
        c2.x = cvt_pk_bf16(S1[8 * s2 + 0], S1[8 * s2 + 1]); c2.y = cvt_pk_bf16(S1[8 * s2 + 2], S1[8 * s2 + 3]); c2.z = cvt_pk_bf16(S1[8 * s2 + 4], S1[8 * s2 + 5]); c2.w = cvt_pk_bf16(S1[8 * s2 + 6], S1[8 * s2 + 7]);
        pf[s2] = __builtin_bit_cast(bf16x8, a); pf[2 + s2] = __builtin_bit_cast(bf16x8, c2); }
#pragma unroll
    for (int s4 = 0; s4 < 4; ++s4) {
        const LAS unsigned char* v0p = vbp + q32 * AT_VSTR + s4 * 32 + half * 8; const LAS unsigned char* v1p = v0p + 32 * AT_VSTR;
        const s16x4 a0 = *(const LAS s16x4*)v0p, a1 = *(const LAS s16x4*)(v0p + 16), b0 = *(const LAS s16x4*)v1p, b1 = *(const LAS s16x4*)(v1p + 16);
        const bf16x8 vf0 = __builtin_shufflevector(a0, a1, 0, 1, 2, 3, 4, 5, 6, 7), vf1 = __builtin_shufflevector(b0, b1, 0, 1, 2, 3, 4, 5, 6, 7);
        O0 = MFMA32(vf0, pf[s4], O0); O1 = MFMA32(vf1, pf[s4], O1); }
}
__device__ __forceinline__ void attn_unit(ArgsP args, const Ctx& C, int l, int ui) {
    bf16_t* Q = (bf16_t*)act_ptr(C, A_Q); const bf16_t* Kb = (const bf16_t*)act_ptr(C, A_K); const bf16_t* VT = (const bf16_t*)act_ptr(C, A_VT);
    const bf16_t* CK = (const bf16_t*)(C.ws + OFF_CK); const bf16_t* CVT = (const bf16_t*)(C.ws + OFF_CVT);
    const int q32 = C.lane & 31, half = C.lane >> 5, w = C.wave;
    const int srow = C.tid >> 3, schunk = C.tid & 7;
    {
        const bool latent = ui < 256;
        int b, h, qb; if (latent) { b = ui >> 6; h = (ui >> 3) & 7; qb = ui & 7; } else { const int r = ui - 256; b = r >> 3; h = r & 7; qb = 0; }
        const int kvh = h >> 2, rowbase = latent ? (MP + b * LS + qb * 256) : b * LC;
        int lo = 0, nband = 4, nt = 4;
        if (latent) { lo = 256 * qb - 128; if (lo < 0) lo = 0; int hi = 256 * qb + 384; if (hi > LS) hi = LS; nband = (hi - lo) >> 6; nt = nband + 4; }
        const int qw_lo = qb * 256 + 32 * w, qpos = qw_lo + q32;
        bf16x8 qf[4];
        { const bf16_t* qp = Q + (size_t)(rowbase + 32 * w + q32) * 512 + h * 64 + 8 * half;
#pragma unroll
          for (int ks = 0; ks < 4; ++ks) qf[ks] = *(const bf16x8*)(qp + 16 * ks); }
        f32x16 O0, O1;
#pragma unroll
        for (int r = 0; r < 16; ++r) { O0[r] = 0.f; O1[r] = 0.f; }
        float mrun = args->in[20][l * 8 + h] * LOG2E, lsum = half ? 0.f : 1.0f;
        u32x4 kA, vA, kB, vB;
#define ATT_LOAD(kk, vv, tt) do { const AttnSrc s_ = attn_src((tt), latent, nband, lo, b, l, kvh, Kb, VT, CK, CVT); \
            kk = *(const u32x4*)(s_.kp + (size_t)srow * 128 + schunk * 8); vv = *(const u32x4*)(s_.vp + (size_t)srow * s_.vstride + schunk * 8); } while (0)
#define ATT_WRITE(kk, vv, bufi) do { *(LAS u32x4*)(C.lds + (bufi) * AT_BUF + srow * AT_KSTR + schunk * 16) = kk; \
            LAS u32x2* vd_ = (LAS u32x2*)(C.lds + (bufi) * AT_BUF + AT_KBYTES + srow * AT_VSTR + schunk * 16); vd_[0] = (u32x2){vv.x, vv.y}; vd_[1] = (u32x2){vv.z, vv.w}; } while (0)
        ATT_LOAD(kA, vA, 0); ATT_WRITE(kA, vA, 0); ATT_LOAD(kA, vA, 1);
        __syncthreads();
#define ATT_STEP(t, kcur, vcur, knext, vnext) do { const int buf = (t) & 1; \
            if ((t) + 2 < nt) ATT_LOAD(knext, vnext, (t) + 2); \
            bool skip = false, domask = false; \
            if (latent && (t) < nband) { const int kb = lo + 64 * (t); skip = (kb > qw_lo + 31 + 128) || (kb + 63 < qw_lo - 128); domask = !((kb + 63 - qw_lo <= 128) && (qw_lo + 31 - kb <= 128)); } \
            if (!skip) attn_tile(C.lds + buf * AT_BUF, qf, O0, O1, mrun, lsum, domask, lo + 64 * (t) - qpos, q32, half); \
            if ((t) + 1 < nt) ATT_WRITE(kcur, vcur, buf ^ 1); \
            __syncthreads(); } while (0)
        for (int t = 0; t < nt; t += 2) { ATT_STEP(t, kA, vA, kB, vB); ATT_STEP(t + 1, kB, vB, kA, vA); }
#undef ATT_STEP
#undef ATT_LOAD
#undef ATT_WRITE
        const float inv = fast_rcp(lsum + __shfl_xor(lsum, 32));
        bf16_t* op = Q + (size_t)(rowbase + 32 * w + q32) * 512 + h * 64 + 4 * half;
#pragma unroll
        for (int g = 0; g < 4; ++g) { u32x2 o; o.x = cvt_pk_bf16(O0[4 * g] * inv, O0[4 * g + 1] * inv); o.y = cvt_pk_bf16(O0[4 * g + 2] * inv, O0[4 * g + 3] * inv); *(u32x2*)(op + 8 * g) = o;
            o.x = cvt_pk_bf16(O1[4 * g] * inv, O1[4 * g + 1] * inv); o.y = cvt_pk_bf16(O1[4 * g + 2] * inv, O1[4 * g + 3] * inv); *(u32x2*)(op + 32 + 8 * g) = o; }
    }
}

constexpr int LRW_BYTES = 11008, LR_PH = 8 * LRW_BYTES, LR_CAR = LR_PH + 8192, LR_CONST = LR_CAR + 512, LR_END = LR_CONST + 768;
static_assert(LR_END <= 131072, "lru LDS map");
__device__ __forceinline__ void lru_load_rows(float (&xr)[19], const float* XRc, int trow0, int L) {
#pragma unroll
    for (int r = 0; r < 19; ++r) { const int t = trow0 + r; const bool ok = (t >= 0) && (t < L); const float v = XRc[(size_t)(ok ? t : 0) * 512]; xr[r] = ok ? v : 0.f; }
}
__device__ __forceinline__ void lru_item(ArgsP args, const Ctx& C, int l, int it) {
    const float* XR = (const float*)act_ptr(C, A_XR); const bf16_t* GY = (const bf16_t*)act_ptr(C, A_GY); bf16_t* REC = (bf16_t*)act_ptr(C, A_XN);
    const int w = C.wave, ch = C.lane, fr = C.lane & 15, fq = C.lane >> 4;
    LAS float* XF = (LAS float*)(C.lds + w * LRW_BYTES); LAS float* AA = XF + 16 * 68; LAS bf16_t* XCB = (LAS bf16_t*)(AA + 16 * 68);
    LAS float* PH = (LAS float*)(C.lds + LR_PH); LAS float* CAR = (LAS float*)(C.lds + LR_CAR); LAS float* CST = (LAS float*)(C.lds + LR_CONST);
    const int dir = it & 1, nb = (it >> 1) & 7, sq = it >> 4;
    const bool latent = sq < 4; const int b = latent ? sq : sq - 4, L = latent ? LS : LC, rowbase = latent ? MP + b * LS : b * LC;
    const int cgl = nb * 64 + ch, g = (l * 2 + dir) * 8 + nb;
    __syncthreads();
    if (C.tid < 64) { const int cg = (l * 2 + dir) * 512 + nb * 64 + C.tid; CST[C.tid] = args->in[25][cg]; CST[64 + C.tid] = args->in[27][cg]; CST[128 + C.tid] = -8.0f * log1pf(__expf(-args->in[28][cg]));
        CAR[C.tid] = latent ? args->in[5][((size_t)(b * 2 + l) * 2 + dir) * 512 + nb * 64 + C.tid] : 0.f; }
    bf16x8 wf[8][2];
    { const bf16_t* lw = (const bf16_t*)(C.ws + OFF_LWT) + (size_t)g * 128 * 64 + fr * 64 + 8 * fq;
#pragma unroll
      for (int nt = 0; nt < 8; ++nt)
#pragma unroll
          for (int kk = 0; kk < 2; ++kk) wf[nt][kk] = *(const bf16x8*)(lw + nt * 16 * 64 + 32 * kk); }
    const float cw0 = args->in[22][(l * 4 + 0) * 512 + cgl], cw1 = args->in[22][(l * 4 + 1) * 512 + cgl], cw2 = args->in[22][(l * 4 + 2) * 512 + cgl], cw3 = args->in[22][(l * 4 + 3) * 512 + cgl], cb = args->in[23][l * 512 + cgl];
    const float* XRc = XR + (size_t)rowbase * 512 + cgl;
    const int nch = L >> 7, e0 = dir ? 16 * (7 - w) : 16 * w;
    float xr[19];
    lru_load_rows(xr, XRc, (dir ? (L - 128) : 0) + e0 - 2, L);
    __syncthreads();
    float hfin = 0.f;
    for (int c = 0; c < nch; ++c) {
        const int t0 = dir ? (L - 128 * (c + 1)) : 128 * c, par = c & 1;
#pragma unroll
        for (int e = 0; e < 16; ++e) { const float xc = cb + cw0 * xr[e] + cw1 * xr[e + 1] + cw2 * xr[e + 2] + cw3 * xr[e + 3]; XF[e * 68 + ch] = xc; XCB[e * 72 + ch] = f2bf(xc); }
        asm volatile("" ::: "memory");
        float gy[16];
        { const bf16_t* gp = GY + (size_t)(rowbase + t0 + e0) * 512 + cgl;
#pragma unroll
          for (int j = 0; j < 16; ++j) gy[j] = bf2f(gp[(size_t)(dir ? 15 - j : j) * 512]); }
        if (c + 1 < nch) lru_load_rows(xr, XRc, (dir ? (L - 128 * (c + 2)) : 128 * (c + 1)) + e0 - 2, L);
        f32x4 acc[8];
#pragma unroll
        for (int nt = 0; nt < 8; ++nt) acc[nt] = (f32x4){0.f, 0.f, 0.f, 0.f};
#pragma unroll
        for (int kk = 0; kk < 2; ++kk) { const bf16x8 xf = *(const LAS bf16x8*)(XCB + fr * 72 + 8 * fq + 32 * kk);
#pragma unroll
            for (int nt = 0; nt < 8; ++nt) acc[nt] = __builtin_amdgcn_mfma_f32_16x16x32_bf16(wf[nt][kk], xf, acc[nt], 0, 0, 0); }
#pragma unroll
        for (int nt = 0; nt < 4; ++nt) { const int c0 = 16 * nt + 4 * fq; const f32x4 ba = *(const LAS f32x4*)(CST + c0), bi = *(const LAS f32x4*)(CST + 64 + c0), sp = *(const LAS f32x4*)(CST + 128 + c0);
            const f32x4 xcv = *(const LAS f32x4*)(XF + fr * 68 + c0); f32x4 av, bv;
#pragma unroll
            for (int i = 0; i < 4; ++i) { const float r = sigmoidf_(acc[nt][i] + ba[i]), ig = sigmoidf_(acc[nt + 4][i] + bi[i]); const float la = r * sp[i], a = __builtin_amdgcn_exp2f(LOG2E * la), y = 2.0f * la;
                const float om_s = -y * (1.0f + 0.5f * y * (1.0f + (1.0f / 3.0f) * y * (1.0f + 0.25f * y))), om_l = 1.0f - a * a; const float om = (y > -0.05f) ? om_s : om_l;
                av[i] = a; bv[i] = __builtin_amdgcn_sqrtf(fmaxf(om, 0.f)) * (ig * xcv[i]); }
            *(LAS f32x4*)(AA + fr * 68 + c0) = av; *(LAS f32x4*)(XF + fr * 68 + c0) = bv; }
        asm volatile("" ::: "memory");
        { float P = 1.f, H = 0.f;
#pragma unroll
          for (int j = 0; j < 16; ++j) { const int e = dir ? 15 - j : j; const float a = AA[e * 68 + ch], bb = XF[e * 68 + ch]; H = a * H + bb; P *= a; }
          PH[(par * 2 + 0) * 512 + w * 64 + ch] = P; PH[(par * 2 + 1) * 512 + w * 64 + ch] = H; }
        __syncthreads();
        float h = CAR[par * 64 + ch];
        for (int s2 = 0; s2 < w; ++s2) h = PH[(par * 2 + 0) * 512 + s2 * 64 + ch] * h + PH[(par * 2 + 1) * 512 + s2 * 64 + ch];
        { bf16_t* rp = REC + (size_t)(rowbase + t0 + e0) * D + dir * 512 + cgl;
#pragma unroll
          for (int j = 0; j < 16; ++j) { const int e = dir ? 15 - j : j; h = AA[e * 68 + ch] * h + XF[e * 68 + ch]; rp[(size_t)e * D] = f2bf(h * gy[j]); } }
        asm volatile("" ::: "memory");
        if (w == 7) { CAR[(par ^ 1) * 64 + ch] = h; hfin = h; }
    }
    if (!latent && w == 7) C.out[OUT_ST + ((size_t)(b * 2 + l) * 2 + dir) * 512 + cgl] = hfin;
}

#define XB_TMO      128
#define XB_XCNT(j)  (256  + 64 * (j))
#define XB_XSUB(j)  (1280 + 64 * (j))
#define XB_XGEN(j)  (2304 + 64 * (j))
#define XB_TOP      3328
#define XB_TOPGEN   3392
#define XCD_BAR_WORDS 3456
#define XB_SPIN_CAP (1u << 18)

__device__ __forceinline__ unsigned xb_ld(unsigned* p)              { return __hip_atomic_load(p, __ATOMIC_RELAXED, __HIP_MEMORY_SCOPE_AGENT); }
__device__ __forceinline__ unsigned xb_add(unsigned* p, unsigned v) { return __hip_atomic_fetch_add(p, v, __ATOMIC_RELAXED, __HIP_MEMORY_SCOPE_AGENT); }
__device__ __forceinline__ unsigned xb_xcc_id() { return (unsigned)__builtin_amdgcn_s_getreg((3 << 11) | 20) & 0xFu; }
#define XB_SPIN(cond, bar) do { unsigned _sp = 0; while (cond) { __builtin_amdgcn_s_sleep(1); \
    if ((++_sp & 255u) == 0u) { if (xb_ld(&(bar)[XB_TMO])) break; if (_sp > XB_SPIN_CAP) { atomicAdd(&(bar)[XB_TMO], 1u); break; } } } } while (0)

struct XcdBarrier {
    unsigned* bar; unsigned x;
    volatile LAS unsigned* st;
};

__device__ __forceinline__ XcdBarrier xcd_barrier_post(unsigned* bar, volatile LAS unsigned* st, int tid) {
    XcdBarrier b; b.bar = bar; b.x = xb_xcc_id(); b.st = st;
    if (tid == 0) (void)xb_add(&bar[XB_XCNT(b.x)], 1u);
    return b;
}
__device__ __forceinline__ void xcd_barrier_complete(unsigned* bar, unsigned x, unsigned& nloc, unsigned& nx) {
    const unsigned G = gridDim.x * gridDim.y * gridDim.z;
    unsigned sum, cnt, mine, sp = 0u;
    for (;;) {
        sum = 0u; cnt = 0u; mine = 0u;
#pragma unroll
        for (unsigned j = 0; j < 16; ++j) { const unsigned c = xb_ld(&bar[XB_XCNT(j)]); sum += c; cnt += (c > 0u) ? 1u : 0u; mine = (j == x) ? c : mine; }
        if (sum == G) break;
        __builtin_amdgcn_s_sleep(1);
        if ((++sp & 255u) == 0u) { if (xb_ld(&bar[XB_TMO])) break; if (sp > XB_SPIN_CAP) { atomicAdd(&bar[XB_TMO], 1u); break; } }
    }
    nloc = mine > 0u ? mine : 1u; nx = cnt > 0u ? cnt : 1u;
}

__device__ __forceinline__ void xcd_barrier(const XcdBarrier& b, int tid) {
    asm volatile("s_waitcnt vmcnt(0)" ::: "memory");
    __syncthreads();
    if (tid == 0) {
        unsigned* bar = b.bar;
        __builtin_amdgcn_s_waitcnt(0);
        unsigned nloc = b.st[0], nx = b.st[1];
        if (nloc == 0u) { xcd_barrier_complete(bar, b.x, nloc, nx); b.st[0] = nloc; b.st[1] = nx; }
        const unsigned old = xb_add(&bar[XB_XSUB(b.x)], 1u);
        const unsigned gen = old / nloc;
        if (old + 1u == (gen + 1u) * nloc) {
            __builtin_amdgcn_fence(__ATOMIC_RELEASE, "agent");
            asm volatile("s_waitcnt vmcnt(0)" ::: "memory");
            const unsigned og = xb_add(&bar[XB_TOP], 1u);
            const unsigned tg = og / nx;
            if (og + 1u == (tg + 1u) * nx) xb_add(&bar[XB_TOPGEN], 1u);
            else XB_SPIN(xb_ld(&bar[XB_TOPGEN]) == tg, bar);
            __builtin_amdgcn_fence(__ATOMIC_ACQUIRE, "agent");
            xb_add(&bar[XB_XGEN(b.x)], 1u);
            asm volatile("s_waitcnt vmcnt(0)" ::: "memory");
        } else {
            XB_SPIN(xb_ld(&bar[XB_XGEN(b.x)]) == gen, bar);
            __builtin_amdgcn_fence(__ATOMIC_ACQUIRE, "agent");
            asm volatile("s_waitcnt vmcnt(0)" ::: "memory");
        }
    }
    __syncthreads();
}

#ifndef PROBE_ITEM
#define PROBE_ITEM 0
#endif
#ifndef PROBE_STAT
#define PROBE_STAT 0
#endif
constexpr int CW_PROBE = 3700;
struct OneUnit { Unit u; __device__ bool next(int i, Unit& o) const { if (i) return false; o = u; return true; } };
constexpr int MX_DFTL = 64, MX_LRUL = 64, MX_ATTL = 256, MX_LRUC = 256, MX_ATTC = 128, MX_DFTC = 32;
constexpr int MX_N = MX_DFTL + MX_LRUL + MX_ATTL + MX_LRUC + MX_ATTC + MX_DFTC;
constexpr int CW_QUEUE = 3520;
__device__ __forceinline__ void mixer_phase(ArgsP args_in, const Ctx& C_in, int l_in) {
    for (;;) {
        ArgsP args = args_in; asm volatile("" : "+s"(args));
        int tid_ = C_in.tid; asm volatile("" : "+v"(tid_));
        int l = l_in; asm volatile("" : "+s"(l));
        Ctx C; C.out = args->out; C.ws = args->ws; C.lds = C_in.lds; C.tid = tid_; C.lane = tid_ & 63; C.wave = __builtin_amdgcn_readfirstlane(tid_ >> 6); C.bid = C_in.bid; C.G = C_in.G;
        volatile LAS int* qslot = (volatile LAS int*)(C.lds + 131072 + 64);
        unsigned* qhead = (unsigned*)(C.ws + WS_CTL) + CW_QUEUE + 64 * l;
        __syncthreads();
        if (C.tid == 0) qslot[0] = (int)__hip_atomic_fetch_add(qhead, 1u, __ATOMIC_RELAXED, __HIP_MEMORY_SCOPE_AGENT);
        __syncthreads();
        int idx = __builtin_amdgcn_readfirstlane(qslot[0]);
        if (idx >= MX_N) break;
        const unsigned long long pt0 = (PROBE_ITEM != 0) ? __builtin_amdgcn_s_memrealtime() : 0ull; int ptype = 0;
        if (idx < MX_DFTL) { const int z = idx >> 4, pm = (idx >> 1) & 7, pn = idx & 1;
            OneUnit S; S.u.pm = pm; S.u.pn = pn; S.u.z = z; S.u.A = (const bf16_t*)(C.ws + WS_DFTL) + (size_t)pm * 256 * LS; S.u.B = (const bf16_t*)act_ptr(C, A_XFT) + (size_t)16 * 512 * LC + ((size_t)z * 512 + pn * 256) * LS;
            EpiDft E{(bf16_t*)act_ptr(C, A_Z), LS, MP + z * LS}; GEMM(C, S, E, LS, LS, LS); ptype = 1; }
        else { idx -= MX_DFTL;
        if (idx < MX_LRUL) { lru_item(args, C, l, idx); ptype = 2; } else { idx -= MX_LRUL;
        if (idx < MX_ATTL) { attn_unit(args, C, l, idx); ptype = 3; } else { idx -= MX_ATTL;
        if (idx < MX_LRUC) { lru_item(args, C, l, 64 + idx); ptype = 4; } else { idx -= MX_LRUC;
        if (idx < MX_ATTC) { attn_unit(args, C, l, 256 + idx); ptype = 5; } else { idx -= MX_ATTC;
        { const int z = idx >> 1, pn = idx & 1; ptype = 6;
            OneUnit S; S.u.pm = 0; S.u.pn = pn; S.u.z = z; S.u.A = (const bf16_t*)(C.ws + WS_DFTC); S.u.B = (const bf16_t*)act_ptr(C, A_XFT) + ((size_t)z * 512 + pn * 256) * LC;
            EpiDft E{(bf16_t*)act_ptr(C, A_Z), LC, z * LC}; GEMM(C, S, E, LC, LC, LC); } } } } } }
        if (PROBE_ITEM != 0 && ptype == PROBE_ITEM && C.tid == 0) { const unsigned dt = (unsigned)(__builtin_amdgcn_s_memrealtime() - pt0); unsigned* pw = (unsigned*)(C.ws + WS_CTL) + CW_PROBE;
            if (PROBE_STAT == 0) atomicMax(pw, dt); else atomicAdd(pw, dt); }
    }
}

#ifndef PROBE_MASK
#define PROBE_MASK 0u
#endif
constexpr int N_PHASES = 24;
__device__ __forceinline__ void run_phase(ArgsP args, const Ctx& C, int ph) {
    if (ph == 0) { p0_prologue(args, C); return; }
    if (ph == N_PHASES - 1) { finalnorm_phase(args, C); return; }
    const int l = (ph - 1) / 11, s = (ph - 1) % 11;
    const float* MODB = (const float*)(C.ws + OFF_MOD);
    if (s == 0 || s == 3 || s == 8) { modnorm_phase(args, C, l, s == 0 ? 0 : (s == 3 ? 1 : 2)); }
    else if (s == 1 || s == 9) { StaticOrder S; S.init(M, 2 * DFF, C.G, C.bid, (const bf16_t*)act_ptr(C, A_XN), D, (const bf16_t*)wl_ptr(C, l, s == 1 ? WL_GU1 : WL_GU2), D);
        EpiGU E{(bf16_t*)act_ptr(C, A_G)}; GEMM(C, S, E, D, D, D); }
    else if (s == 2 || s == 10) { StaticOrder S; S.init(M, D, C.G, C.bid, (const bf16_t*)act_ptr(C, A_G), DFF, (const bf16_t*)wl_ptr(C, l, s == 2 ? WL_D1 : WL_D2), DFF);
        EpiRes E{C.out, MODB, l, s == 2 ? 0 : 2, 0.5f}; GEMM(C, S, E, DFF, DFF, DFF); }
    else if (s == 4) { StaticOrder S; S.init(M, NIN, C.G, C.bid, (const bf16_t*)act_ptr(C, A_XN), D, (const bf16_t*)wl_ptr(C, l, WL_IN), D);
        EpiIn E{(bf16_t*)act_ptr(C, A_Q), (bf16_t*)act_ptr(C, A_K), (bf16_t*)act_ptr(C, A_VT), (bf16_t*)act_ptr(C, A_GY), (bf16_t*)act_ptr(C, A_XFT), (bf16_t*)act_ptr(C, A_G),
                (float*)act_ptr(C, A_XR), C.out, (const float*)(C.ws + OFF_ROPE), args->in[19] + (size_t)l * 3072, l};
        GEMM(C, S, E, D, D, D); }
    else if (s == 5) { mixer_phase(args, C, l); }
    else if (s == 6) {
        bf16_t* MG = (bf16_t*)act_ptr(C, A_XR); const bf16_t* G = (const bf16_t*)act_ptr(C, A_G);
        { StaticOrder S; S.init(M, D, C.G, C.bid, (const bf16_t*)act_ptr(C, A_Q), 512, (const bf16_t*)wl_ptr(C, l, WL_A), 512); EpiBranch<0> E{MG, G, 0}; GEMM(C, S, E, 512, 512, 512); }
        { StaticOrder S; S.init(M, D, C.G, C.bid, (const bf16_t*)act_ptr(C, A_XN), D, (const bf16_t*)wl_ptr(C, l, WL_L2), D); EpiBranch<1> E{MG, G, 1}; GEMM(C, S, E, D, D, D); }
        { StaticOrder S; S.init(M, D, C.G, C.bid, (const bf16_t*)act_ptr(C, A_Z), D, (const bf16_t*)wl_ptr(C, l, WL_F2), D); EpiBranch<1> E{MG, G, 2}; GEMM(C, S, E, D, D, D); } }
    else if (s == 7) { StaticOrder S; S.init(M, D, C.G, C.bid, (const bf16_t*)act_ptr(C, A_XR), D, (const bf16_t*)wl_ptr(C, l, WL_O), D);
        EpiRes E{C.out, MODB, l, 1, 1.0f}; GEMM(C, S, E, D, D, D); }
}

__global__ void __launch_bounds__(NTHREADS, 2) fwd_kernel(Args args_byval) {
    extern __shared__ __attribute__((aligned(16))) unsigned char lds_raw[];
    ArgsP args0 = (ArgsP)__builtin_amdgcn_kernarg_segment_ptr();
    const int lo = args0->ph_lo, hi = args0->ph_hi;
    volatile LAS unsigned* bst = (volatile LAS unsigned*)((LAS unsigned char*)lds_raw + 131072);
    const int wave0 = __builtin_amdgcn_readfirstlane(threadIdx.x >> 6);
#define TID_NOW() ({ unsigned z_ = 0u; asm volatile("" : "+s"(z_)); wave0 * 64 + (int)__builtin_amdgcn_mbcnt_hi(~0u, __builtin_amdgcn_mbcnt_lo(~0u, z_)); })
    { const int t = TID_NOW(); if (t < 2) bst[t] = 0u; }
    __syncthreads();
    (void)xcd_barrier_post((unsigned*)(args0->ws + WS_CTL), bst, TID_NOW());
    volatile LAS unsigned long long* tacc = (volatile LAS unsigned long long*)((LAS unsigned char*)lds_raw + 131072 + 128);
    if (PROBE_MASK != 0u && blockIdx.x == 0 && TID_NOW() == 0) { tacc[0] = __builtin_amdgcn_s_memrealtime(); tacc[1] = 0ull; }
    for (int ph = lo; ph < hi; ++ph) {
        ArgsP args = args0; asm volatile("" : "+s"(args));
        int tid = TID_NOW(); asm volatile("" : "+v"(tid));
        int bid = blockIdx.x; asm volatile("" : "+s"(bid));
        Ctx C; C.out = args->out; C.ws = args->ws; C.lds = (LAS unsigned char*)lds_raw;
        C.tid = tid; C.lane = tid & 63; C.wave = __builtin_amdgcn_readfirstlane(tid >> 6); C.bid = bid; C.G = gridDim.x;
        run_phase(args, C, ph);
        if (ph + 1 < hi) {
            { XcdBarrier xb; xb.bar = (unsigned*)(args->ws + WS_CTL); xb.x = xb_xcc_id(); xb.st = bst; xcd_barrier(xb, TID_NOW()); } }
        if (PROBE_MASK != 0u && blockIdx.x == 0 && TID_NOW() == 0) { const unsigned long long now = __builtin_amdgcn_s_memrealtime(); if ((PROBE_MASK >> ph) & 1u) tacc[1] = tacc[1] + (now - tacc[0]); tacc[0] = now; }
    }
    if (PROBE_ITEM != 0 && blockIdx.x == 0 && TID_NOW() == 0) { const unsigned v = __hip_atomic_load((unsigned*)(args0->ws + WS_CTL) + CW_PROBE, __ATOMIC_RELAXED, __HIP_MEMORY_SCOPE_AGENT); const unsigned long long want = PROBE_STAT ? v / 256u : v, t0 = __builtin_amdgcn_s_memrealtime(); while (__builtin_amdgcn_s_memrealtime() - t0 < want) __builtin_amdgcn_s_sleep(8); }
    if (PROBE_MASK != 0u && blockIdx.x == 0 && TID_NOW() == 0) { const unsigned long long t0 = tacc[0], want = tacc[1]; while (__builtin_amdgcn_s_memrealtime() - t0 < want) __builtin_amdgcn_s_sleep(8); }
#undef TID_NOW
}

extern "C" void kernel_launch(void* const* d_in, const int* in_sizes, int n_in, void* d_out, int out_size, void* d_ws, size_t ws_size, hipStream_t stream) {
    if (n_in != 32 || ws_size < WS_END) { fprintf(stderr, "kernel_launch: n_in %d ws %zu (need %zu)\n", n_in, ws_size, (size_t)WS_END); return; }
    static int grid = 0;
    if (grid == 0) {
        int dev = 0, cus = 0, per_cu = 0;
        if (hipGetDevice(&dev) != hipSuccess || hipDeviceGetAttribute(&cus, hipDeviceAttributeMultiprocessorCount, dev) != hipSuccess) { fprintf(stderr, "kernel_launch: device query failed\n"); grid = -1; return; }
        if (hipFuncSetAttribute((const void*)fwd_kernel, hipFuncAttributeMaxDynamicSharedMemorySize, LDS_BYTES) != hipSuccess) { fprintf(stderr, "hipFuncSetAttribute failed\n"); grid = -1; return; }
        if (hipOccupancyMaxActiveBlocksPerMultiprocessor(&per_cu, (const void*)fwd_kernel, NTHREADS, LDS_BYTES) != hipSuccess || per_cu < 1) { fprintf(stderr, "kernel_launch: occupancy query says %d blocks per CU\n", per_cu); grid = -1; return; }
        if (per_cu > 1) per_cu = 1;
        grid = cus * per_cu;
    }
    if (grid < 0) return;
    Args a{};
    for (int i = 0; i < 32; ++i) a.in[i] = (const float*)d_in[i];
    a.out = (float*)d_out; a.ws = (unsigned char*)d_ws;
    a.ph_lo = 0; a.ph_hi = N_PHASES;
    if (hipMemsetAsync((char*)d_ws + WS_CTL, 0, 16384, stream) != hipSuccess) { fprintf(stderr, "hipMemsetAsync failed\n"); return; }
    void* kargs[] = {&a};
    hipError_t e = hipLaunchCooperativeKernel((const void*)fwd_kernel, dim3(grid), dim3(NTHREADS), kargs, LDS_BYTES, stream);
    if (e != hipSuccess) fprintf(stderr, "cooperative launch failed: %s (grid %d)\n", hipGetErrorString(e), grid);
}
```

```cpp
#include <hip/hip_runtime.h>
#include <hip/hip_cooperative_groups.h>
#include <cstdint>
#include <cstdio>


#define LAS __attribute__((address_space(3)))
typedef unsigned short bf16_t;
typedef short bf16x8 __attribute__((ext_vector_type(8)));
typedef float f32x4 __attribute__((ext_vector_type(4)));
typedef float f32x2 __attribute__((ext_vector_type(2)));
typedef float f32x16 __attribute__((ext_vector_type(16)));
typedef unsigned u32x4 __attribute__((ext_vector_type(4)));
typedef unsigned u32x2 __attribute__((ext_vector_type(2)));

constexpr int D = 1024, MP = 4096, MS = 8192, M = MP + MS, DFF = 2816, DEPTH = 2;
constexpr int LC = 256, LS = 2048;
constexpr int NB_C = 16, NB_S = 4;
constexpr int NIN = 2304 + 3072;
constexpr int NMOD = 9216;
constexpr float EPS = 1e-6f;
constexpr float LOG2E = 1.4426950408889634f;
constexpr float QSCALE = 0.125f * LOG2E;

constexpr size_t MiB = 1u << 20;
constexpr size_t SZ_WGU = (size_t)2 * DFF * D * 2, SZ_WD = (size_t)D * DFF * 2, SZ_WIN = (size_t)NIN * D * 2;
constexpr size_t SZ_WA = (size_t)D * 512 * 2, SZ_W1K = (size_t)D * D * 2;
constexpr size_t WL_GU1 = 0, WL_D1 = WL_GU1 + SZ_WGU, WL_GU2 = WL_D1 + SZ_WD, WL_D2 = WL_GU2 + SZ_WGU, WL_IN = WL_D2 + SZ_WD,
                 WL_A = WL_IN + SZ_WIN, WL_L2 = WL_A + SZ_WA, WL_F2 = WL_L2 + SZ_W1K, WL_O = WL_F2 + SZ_W1K, WL_SIZE = WL_O + SZ_W1K;
constexpr size_t WS_CTL = 0;
constexpr size_t WS_MISC = 1 * MiB;
constexpr size_t OFF_MOD = WS_CTL + 16384;
constexpr size_t OFF_SSQ = OFF_MOD + (size_t)2 * 5 * NMOD * 4;
constexpr size_t CTL_ZERO_BYTES = 16384;
static_assert(OFF_SSQ + (size_t)7 * M * 4 - WS_CTL <= 1048576, "control region");
constexpr size_t OFF_ROPE = WS_MISC;
constexpr size_t OFF_CK = OFF_ROPE + 2 * 1024 * 4;
constexpr size_t OFF_CVT = OFF_CK + (size_t)4 * 2 * 256 * 128 * 2;
constexpr size_t OFF_LWT = OFF_CVT + (size_t)4 * 2 * 2 * 64 * 256 * 2;
constexpr size_t WS_DFTC = 3 * MiB;
constexpr size_t WS_DFTL = 4 * MiB;
constexpr size_t OFF_SW = 12 * MiB;
constexpr size_t WS_W = 20 * MiB;
constexpr size_t WS_ACT = WS_W + 2 * WL_SIZE;
constexpr size_t A_G = 0;
constexpr size_t A_XN = 72 * MiB;
constexpr size_t A_XR = 96 * MiB;
constexpr size_t A_GY = 120 * MiB;
constexpr size_t A_XFT = 132 * MiB;
constexpr size_t A_Q = 144 * MiB;
constexpr size_t A_K = 156 * MiB;
constexpr size_t A_VT = 159 * MiB;
constexpr size_t A_Z = 162 * MiB;
constexpr size_t A_END = 186 * MiB;
constexpr size_t WS_END = WS_ACT + A_END;

constexpr int OUT_YS = MP * D, OUT_CK = M * D, OUT_CV = OUT_CK + 16 * 2 * 256 * 128, OUT_ST = OUT_CV + 16 * 2 * 256 * 128;

constexpr int NTHREADS = 512, NWAVES = 8;
constexpr int LDS_BYTES = 147456;

typedef __bf16 bf16x2_t __attribute__((ext_vector_type(2)));
__device__ __forceinline__ unsigned cvt_pk_bf16(float lo, float hi) { f32x2 v = {lo, hi}; bf16x2_t b = __builtin_convertvector(v, bf16x2_t); return __builtin_bit_cast(unsigned, b); }
__device__ __forceinline__ bf16_t f2bf(float f) { return (bf16_t)(cvt_pk_bf16(f, 0.f) & 0xffffu); }
__device__ __forceinline__ float bf2f(unsigned h) { return __uint_as_float(h << 16); }
__device__ __forceinline__ float bflo(unsigned w) { return __uint_as_float(w << 16); }
__device__ __forceinline__ float bfhi(unsigned w) { return __uint_as_float(w & 0xffff0000u); }
__device__ __forceinline__ float fast_rcp(float x) { return __builtin_amdgcn_rcpf(x); }
__device__ __forceinline__ float sigmoidf_(float x) { return fast_rcp(1.0f + __builtin_amdgcn_exp2f(-LOG2E * x)); }
__device__ __forceinline__ float siluf_(float x) { return x * sigmoidf_(x); }
__device__ __forceinline__ float gelu_tanh(float x) { const float u = (-2.0f * LOG2E * 0.7978845608028654f) * (x + 0.044715f * x * x * x); return x * fast_rcp(1.0f + __builtin_amdgcn_exp2f(u)); }
template <int CTRL> __device__ __forceinline__ float dpp_f(float v) { return __builtin_bit_cast(float, __builtin_amdgcn_update_dpp(0, __builtin_bit_cast(int, v), CTRL, 0xf, 0xf, true)); }
__device__ __forceinline__ float sum_x16(float v) { unsigned a = __builtin_bit_cast(unsigned, v), b = a; asm volatile("" : "+v"(b)); const auto r = __builtin_amdgcn_permlane16_swap(a, b, false, false); unsigned r0 = r[0], r1 = r[1]; asm volatile("" : "+v"(r0), "+v"(r1)); return __builtin_bit_cast(float, r0) + __builtin_bit_cast(float, r1); }
__device__ __forceinline__ float sum_x32(float v) { unsigned a = __builtin_bit_cast(unsigned, v), b = a; asm volatile("" : "+v"(b)); const auto r = __builtin_amdgcn_permlane32_swap(a, b, false, false); unsigned r0 = r[0], r1 = r[1]; asm volatile("" : "+v"(r0), "+v"(r1)); return __builtin_bit_cast(float, r0) + __builtin_bit_cast(float, r1); }
__device__ __forceinline__ float wave_sum(float v) {
    v += dpp_f<0xB1>(v); v += dpp_f<0x4E>(v); v += dpp_f<0x141>(v); v += dpp_f<0x140>(v);
    return sum_x32(sum_x16(v));
}
__device__ __forceinline__ int cond_of_row(int r) { return r < MP ? 4 : ((r - MP) >> 11); }

struct Args {
    const float* in[32];
    float* out;
    unsigned char* ws;
    int ph_lo, ph_hi;
};

typedef const __attribute__((address_space(4))) Args* ArgsP;
struct Ctx {
    float* out; unsigned char* ws; LAS unsigned char* lds;
    int tid, lane, wave, bid, G;
};
__device__ __forceinline__ unsigned char* wl_ptr(const Ctx& C, int l, size_t off) { return C.ws + WS_W + (size_t)l * WL_SIZE + off; }
__device__ __forceinline__ unsigned char* act_ptr(const Ctx& C, size_t off) { return C.ws + WS_ACT + off; }
__device__ __forceinline__ const float* mod_ptr(const Ctx& C, int l, int c, int sub, int which) { return (const float*)(C.ws + OFF_MOD) + ((size_t)(l * 5 + c) * NMOD + (sub * 3 + which) * D); }

struct TrItem { const float* W; bf16_t* WT; int ldw, ldt, drow0, dcol0, k0, n0; };
constexpr int I_G = 16 * 88, I_D = 44 * 32, I_IN = 16 * 72, I_BG = 16 * 96, I_A = 8 * 32, I_L = 8 * 32, I_O = 16 * 32;
constexpr int TR_PER_LAYER = 4 * I_G + 2 * I_D + I_IN + I_BG + I_A + 2 * I_L + I_O;
__device__ __forceinline__ TrItem p0_decode(ArgsP args, const Ctx& C, int it) {
    const int l = it / TR_PER_LAYER; int r = it % TR_PER_LAYER; TrItem t; t.dcol0 = 0;
    if (r < 2 * I_G) { const int gu = r >= I_G; r -= gu * I_G; const int kb = r / 88, n0 = (r % 88) * 32; t.W = args->in[11 + gu] + (size_t)l * D * DFF; t.ldw = DFF; t.WT = (bf16_t*)wl_ptr(C, l, WL_GU1); t.ldt = D; t.drow0 = 256 * (n0 >> 7) + 128 * gu + (n0 & 127); t.k0 = kb * 64; t.n0 = n0; return t; } r -= 2 * I_G;
    if (r < I_D) { const int kb = r / 32, nb = r % 32; t.W = args->in[13] + (size_t)l * DFF * D; t.ldw = D; t.WT = (bf16_t*)wl_ptr(C, l, WL_D1); t.ldt = DFF; t.drow0 = nb * 32; t.k0 = kb * 64; t.n0 = nb * 32; return t; } r -= I_D;
    if (r < 2 * I_G) { const int gu = r >= I_G; r -= gu * I_G; const int kb = r / 88, n0 = (r % 88) * 32; t.W = args->in[14 + gu] + (size_t)l * D * DFF; t.ldw = DFF; t.WT = (bf16_t*)wl_ptr(C, l, WL_GU2); t.ldt = D; t.drow0 = 256 * (n0 >> 7) + 128 * gu + (n0 & 127); t.k0 = kb * 64; t.n0 = n0; return t; } r -= 2 * I_G;
    if (r < I_D) { const int kb = r / 32, nb = r % 32; t.W = args->in[16] + (size_t)l * DFF * D; t.ldw = D; t.WT = (bf16_t*)wl_ptr(C, l, WL_D2); t.ldt = DFF; t.drow0 = nb * 32; t.k0 = kb * 64; t.n0 = nb * 32; return t; } r -= I_D;
    if (r < I_IN) { const int kb = r / 72, nb = r % 72; t.W = args->in[17] + (size_t)l * D * 2304; t.ldw = 2304; t.WT = (bf16_t*)wl_ptr(C, l, WL_IN); t.ldt = D; t.drow0 = nb * 32; t.k0 = kb * 64; t.n0 = nb * 32; return t; } r -= I_IN;
    if (r < I_BG) { const int kb = r / 96, nb = r % 96; t.W = args->in[18] + (size_t)l * D * 3072; t.ldw = 3072; t.WT = (bf16_t*)wl_ptr(C, l, WL_IN); t.ldt = D; t.drow0 = 2304 + nb * 32; t.k0 = kb * 64; t.n0 = nb * 32; return t; } r -= I_BG;
    if (r < I_A) { const int kb = r / 32, nb = r % 32; t.W = args->in[21] + (size_t)l * 512 * D; t.ldw = D; t.WT = (bf16_t*)wl_ptr(C, l, WL_A); t.ldt = 512; t.drow0 = nb * 32; t.k0 = kb * 64; t.n0 = nb * 32; return t; } r -= I_A;
    if (r < 2 * I_L) { const int dup = r >= I_L; r -= dup * I_L; const int kb = r / 32, nb = r % 32; t.W = args->in[29] + (size_t)l * 512 * D; t.ldw = D; t.WT = (bf16_t*)wl_ptr(C, l, WL_L2); t.ldt = D; t.drow0 = nb * 32; t.dcol0 = 512 * dup; t.k0 = kb * 64; t.n0 = nb * 32; return t; } r -= 2 * I_L;
    { const int kb = r / 32, nb = r % 32; t.W = args->in[31] + (size_t)l * D * D; t.ldw = D; t.WT = (bf16_t*)wl_ptr(C, l, WL_O); t.ldt = D; t.drow0 = nb * 32; t.k0 = kb * 64; t.n0 = nb * 32; return t; }
}
__device__ __forceinline__ void p0_tr_load(const TrItem& t, f32x4 (&r)[8], int lane) {
    const float* p = t.W + (size_t)(t.k0 + (lane >> 3)) * t.ldw + t.n0 + 4 * (lane & 7);
#pragma unroll
    for (int i = 0; i < 8; ++i) r[i] = *(const f32x4*)(p + (size_t)(8 * i) * t.ldw);
}
__device__ __forceinline__ void p0_tr_store(const TrItem& t, const f32x4 (&r)[8], LAS float* scr, int lane) {
#pragma unroll
    for (int i = 0; i < 8; ++i) { LAS float* p = scr + (8 * i + (lane >> 3)) * 33 + 4 * (lane & 7); p[0] = r[i].x; p[1] = r[i].y; p[2] = r[i].z; p[3] = r[i].w; }
    asm volatile("s_waitcnt lgkmcnt(0)" ::: "memory");
    const int c = lane & 7;
#pragma unroll
    for (int j = 0; j < 4; ++j) { const int n = (lane >> 3) + 8 * j; const LAS float* q = scr + (8 * c) * 33 + n;
        u32x4 o; o.x = cvt_pk_bf16(q[0 * 33], q[1 * 33]); o.y = cvt_pk_bf16(q[2 * 33], q[3 * 33]); o.z = cvt_pk_bf16(q[4 * 33], q[5 * 33]); o.w = cvt_pk_bf16(q[6 * 33], q[7 * 33]);
        *(u32x4*)(t.WT + (size_t)(t.drow0 + n) * t.ldt + t.dcol0 + t.k0 + 8 * c) = o; }
    asm volatile("s_waitcnt lgkmcnt(0)" ::: "memory");
}

__device__ __forceinline__ void p0_transposes(ArgsP args, const Ctx& C, LAS float* SCR, int it0, int it1, int gw, int NGW) {
    LAS float* scr = SCR + C.wave * (64 * 33);
    int it = it0 + gw; TrItem cur; f32x4 rc[8];
    if (it < it1) { cur = p0_decode(args, C, it); p0_tr_load(cur, rc, C.lane); }
    while (it < it1) {
        const int it2 = it + NGW; const bool more = it2 < it1; TrItem nxt = cur; f32x4 rn[8];
        if (more) { nxt = p0_decode(args, C, it2); p0_tr_load(nxt, rn, C.lane); }
        p0_tr_store(cur, rc, scr, C.lane);
        if (more) { cur = nxt;
#pragma unroll
            for (int i = 0; i < 8; ++i) rc[i] = rn[i]; }
        it = it2;
    }
}
__device__ __forceinline__ void p0_wf2_item(ArgsP args, const Ctx& C, const LAS float* TAB, LAS float* SCR, int r) {
    const int l = r >> 6, g = (r >> 4) & 3, n0 = (r & 15) * 64;
    const float* Wf = args->in[30] + (size_t)l * 512 * D + (size_t)(g * 128) * D + n0;
    for (int i = C.tid; i < 128 * 64; i += NTHREADS) SCR[i] = Wf[(size_t)(i >> 6) * D + (i & 63)];
    __syncthreads();
    const int trig = C.wave >> 2, c0 = 32 * (C.wave & 3), i32 = C.lane & 31, hk = C.lane >> 5, cc = c0 + i32, sh = trig ? 512 : 0;
    f32x16 acc0, acc1;
#pragma unroll
    for (int q = 0; q < 16; ++q) { acc0[q] = 0.f; acc1[q] = 0.f; }
#pragma unroll 8
    for (int kk = 0; kk < 64; ++kk) { const int q = 2 * kk + hk; const float a = TAB[((((cc * q) & 127) * 16) - sh) & 2047];
        acc0 = __builtin_amdgcn_mfma_f32_32x32x2f32(a, SCR[q * 64 + i32], acc0, 0, 0, 0); acc1 = __builtin_amdgcn_mfma_f32_32x32x2f32(a, SCR[q * 64 + 32 + i32], acc1, 0, 0, 0); }
    const float sc = trig ? -0.08838834764831845f : 0.08838834764831845f;
    bf16_t* d0 = (bf16_t*)wl_ptr(C, l, WL_F2) + (size_t)(n0 + i32) * D + sh + g * 128 + c0 + 4 * hk;
#pragma unroll
    for (int q4 = 0; q4 < 4; ++q4) { u32x2 o; o.x = cvt_pk_bf16(acc0[4 * q4] * sc, acc0[4 * q4 + 1] * sc); o.y = cvt_pk_bf16(acc0[4 * q4 + 2] * sc, acc0[4 * q4 + 3] * sc); *(u32x2*)(d0 + 8 * q4) = o;
        o.x = cvt_pk_bf16(acc1[4 * q4] * sc, acc1[4 * q4 + 1] * sc); o.y = cvt_pk_bf16(acc1[4 * q4 + 2] * sc, acc1[4 * q4 + 3] * sc); *(u32x2*)(d0 + (size_t)32 * D + 8 * q4) = o; }
    __syncthreads();
}
__device__ __forceinline__ void sw_layer(ArgsP args, const Ctx& C, int l, int gw, int NGW);
__device__ __forceinline__ void bg_layer1_transposes(ArgsP args, const Ctx& C) {
    const int nidle = (C.G > 192) ? C.G - 192 : C.G, me = (C.G > 192) ? C.bid - 192 : C.bid;
    if (me < 0) return;
    p0_transposes(args, C, (LAS float*)(C.lds + 32768), TR_PER_LAYER, 2 * TR_PER_LAYER, me * NWAVES + C.wave, nidle * NWAVES);
}
__device__ __forceinline__ void bg_layer1_wf2(ArgsP args, const Ctx& C) {
    const int nidle = (C.G > 192) ? C.G - 192 : C.G, me = (C.G > 192) ? C.bid - 192 : C.bid;
    if (me < 0) return;
    LAS float* TAB = (LAS float*)(C.lds + 20480);
    for (int i = C.tid; i < 2048; i += NTHREADS) TAB[i] = cospif((float)i * (1.0f / 1024.0f));
    __syncthreads();
    for (int r = 64 + me; r < 128; r += nidle) p0_wf2_item(args, C, TAB, (LAS float*)(C.lds + 32768), r);
    sw_layer(args, C, 1, me * NWAVES + C.wave, nidle * NWAVES);
}

__device__ __forceinline__ void p0_prologue(ArgsP args, const Ctx& C) {
    LAS float* SC = (LAS float*)C.lds;
    LAS float* TAB = (LAS float*)(C.lds + 20480);
    LAS float* SCR = (LAS float*)(C.lds + 32768);
    const float* c_in = args->in[2]; const float* cctx = args->in[6];
    for (int i = C.tid; i < 5 * 1024; i += NTHREADS) { const float v = (i < 4096) ? c_in[i] : cctx[i - 4096]; SC[i] = siluf_(v); }
    for (int i = C.tid; i < 2048; i += NTHREADS) TAB[i] = cospif((float)i * (1.0f / 1024.0f));
    __syncthreads();
    for (int it = C.bid; it < 288 + 64; it += C.G) {
        if (it < 288) {
            const int l = it / 144, j0 = (it % 144) * 64, lg = C.lane >> 4, kbase = C.wave * 128 + lg;
            const float* W = args->in[7] + (size_t)l * D * NMOD + (size_t)kbase * NMOD + j0 + 4 * (C.lane & 15);
            f32x4 a0 = {0.f, 0.f, 0.f, 0.f}, a1 = a0, a2 = a0, a3 = a0, a4 = a0;
#pragma unroll 16
            for (int i = 0; i < 32; ++i) { const f32x4 w = *(const f32x4*)(W + (size_t)(4 * i) * NMOD); const int k = kbase + 4 * i;
                a0 += w * SC[k]; a1 += w * SC[1024 + k]; a2 += w * SC[2048 + k]; a3 += w * SC[3072 + k]; a4 += w * SC[4096 + k]; }
#define P0_RED4(a) a.x = sum_x32(sum_x16(a.x)); a.y = sum_x32(sum_x16(a.y)); a.z = sum_x32(sum_x16(a.z)); a.w = sum_x32(sum_x16(a.w));
            P0_RED4(a0) P0_RED4(a1) P0_RED4(a2) P0_RED4(a3) P0_RED4(a4)
#undef P0_RED4
            LAS f32x4* R = (LAS f32x4*)SCR;
            if (C.lane < 16) { R[(C.wave * 5 + 0) * 16 + C.lane] = a0; R[(C.wave * 5 + 1) * 16 + C.lane] = a1; R[(C.wave * 5 + 2) * 16 + C.lane] = a2; R[(C.wave * 5 + 3) * 16 + C.lane] = a3; R[(C.wave * 5 + 4) * 16 + C.lane] = a4; }
            __syncthreads();
            if (C.tid < 320) { const int c = C.tid >> 6, j = C.tid & 63; float sum = args->in[8][(size_t)l * NMOD + j0 + j];
#pragma unroll
                for (int w = 0; w < 8; ++w) sum += SCR[(w * 5 + c) * 64 + j];
                ((float*)(C.ws + OFF_MOD))[(size_t)(l * 5 + c) * NMOD + j0 + j] = sum; }
            __syncthreads();
        } else {
            p0_wf2_item(args, C, TAB, SCR, it - 288);
        }
    }
    __syncthreads();
    p0_transposes(args, C, SCR, 0, TR_PER_LAYER, C.bid * NWAVES + C.wave, C.G * NWAVES);
    const int gt = C.bid * NTHREADS + C.tid, NGT = C.G * NTHREADS;
    for (int i = gt; i < 6 * M / 4; i += NGT) ((f32x4*)(C.ws + OFF_SSQ) + M / 4)[i] = (f32x4){0.f, 0.f, 0.f, 0.f};
    for (int i = gt; i < 2048 * 256; i += NGT) { const int pr = i >> 8, t0 = (i & 255) * 8, p = (pr <= 1024) ? pr : pr - 1024, sh = (pr > 1024) ? 512 : 0; const float s = 0.022097086912079608f;
        float v[8];
#pragma unroll
        for (int j = 0; j < 8; ++j) v[j] = TAB[((p * (t0 + j)) - sh) & 2047] * s;
        u32x4 o; o.x = cvt_pk_bf16(v[0], v[1]); o.y = cvt_pk_bf16(v[2], v[3]); o.z = cvt_pk_bf16(v[4], v[5]); o.w = cvt_pk_bf16(v[6], v[7]);
        *(u32x4*)((bf16_t*)(C.ws + WS_DFTL) + (size_t)pr * 2048 + t0) = o; }
    for (int i = gt; i < 256 * 32; i += NGT) { const int pr = i >> 5, t0 = (i & 31) * 8, p = (pr <= 128) ? pr : pr - 128, sh = (pr > 128) ? 512 : 0; const float s = 0.0625f;
        float v[8];
#pragma unroll
        for (int j = 0; j < 8; ++j) v[j] = TAB[((p * (t0 + j) * 8) - sh) & 2047] * s;
        u32x4 o; o.x = cvt_pk_bf16(v[0], v[1]); o.y = cvt_pk_bf16(v[2], v[3]); o.z = cvt_pk_bf16(v[4], v[5]); o.w = cvt_pk_bf16(v[6], v[7]);
        *(u32x4*)((bf16_t*)(C.ws + WS_DFTC) + (size_t)pr * 256 + t0) = o; }
    for (int i = gt; i < 1024; i += NGT) { const int pos = i >> 4, f = i & 15; const float inv = exp2f(-(float)f * (13.287712379549449f / 16.0f)); const float ang = (float)pos * inv; const float af = (float)((double)ang * 0.3183098861837907);
        ((float*)(C.ws + OFF_ROPE))[i] = cospif(af); ((float*)(C.ws + OFF_ROPE))[1024 + i] = sinpif(af); }
    for (int i = gt; i < 4 * 2 * 256 * 128; i += NGT) { ((bf16_t*)(C.ws + OFF_CK))[i] = f2bf(args->in[3][i]);
        const int d = i & 63, kvh = (i >> 6) & 1, t = (i >> 7) & 255, bl = i >> 15;
        ((bf16_t*)(C.ws + OFF_CVT))[((size_t)(bl * 2 + kvh) * 64 + d) * 256 + t] = f2bf(args->in[4][i]); }
    for (int i = gt; i < 2 * 2 * 8 * 128 * 64; i += NGT) { const int k = i & 63, n = (i >> 6) & 127, g = i >> 13;
        const float v = (n < 64) ? args->in[24][((size_t)g * 64 + k) * 64 + n] : args->in[26][((size_t)g * 64 + k) * 64 + (n - 64)]; ((bf16_t*)(C.ws + OFF_LWT))[i] = f2bf(v); }
}

__device__ __forceinline__ float* ssq_ptr(const Ctx& C, int idx) { return (float*)(C.ws + OFF_SSQ) + (size_t)idx * M; }
__device__ __forceinline__ const float* sw_ptr(const Ctx& C, int l, int sub, int c) { return (const float*)(C.ws + OFF_SW) + (size_t)((l * 3 + sub) * 5 + c) * 5632; }
__device__ __forceinline__ void sw_layer(ArgsP args, const Ctx& C, int l, int gw, int NGW) {
    LAS float* SH = (LAS float*)C.lds;
    __syncthreads();
    for (int i = C.tid; i < 15 * 1024; i += NTHREADS) { const int k = i & 1023, c = (i >> 10) % 5, sub = (i >> 10) / 5; SH[i] = mod_ptr(C, l, c, sub, 0)[k]; }
    __syncthreads();
    constexpr int RPL = 5632 + 5376 + 5632;
    for (int it = gw; it < RPL; it += NGW) {
        int n = it, sub = 0; size_t woff = WL_GU1;
        if (n >= 5632) { n -= 5632; sub = 1; woff = WL_IN; if (n >= 5376) { n -= 5376; sub = 2; woff = WL_GU2; } }
        const u32x4* wp = (const u32x4*)((const bf16_t*)wl_ptr(C, l, woff) + (size_t)n * D + 16 * C.lane);
        const u32x4 w0 = wp[0], w1 = wp[1];
        float wv[16] = {bflo(w0.x), bfhi(w0.x), bflo(w0.y), bfhi(w0.y), bflo(w0.z), bfhi(w0.z), bflo(w0.w), bfhi(w0.w), bflo(w1.x), bfhi(w1.x), bflo(w1.y), bfhi(w1.y), bflo(w1.z), bfhi(w1.z), bflo(w1.w), bfhi(w1.w)};
        float acc[5];
#pragma unroll
        for (int c = 0; c < 5; ++c) { const LAS f32x4* sp = (const LAS f32x4*)(SH + (sub * 5 + c) * 1024 + 16 * C.lane); float a = 0.f;
#pragma unroll
            for (int q = 0; q < 4; ++q) { const f32x4 sv = sp[q]; a += sv.x * wv[4 * q] + sv.y * wv[4 * q + 1] + sv.z * wv[4 * q + 2] + sv.w * wv[4 * q + 3]; }
            acc[c] = wave_sum(a); }
        if (C.lane < 5) { float* dst = (float*)(C.ws + OFF_SW) + (size_t)((l * 3 + sub) * 5 + C.lane) * 5632 + n;
            *dst = (C.lane == 0) ? acc[0] : (C.lane == 1) ? acc[1] : (C.lane == 2) ? acc[2] : (C.lane == 3) ? acc[3] : acc[4]; }
    }
}
__device__ __forceinline__ void p0b_phase(ArgsP args, const Ctx& C) {
    const int gw = C.bid * NWAVES + C.wave, NGW = C.G * NWAVES;
    { const float* nw = args->in[9]; bf16_t* XA = (bf16_t*)act_ptr(C, A_XN); float* ssq = ssq_ptr(C, 0);
      for (int r = gw; r < M; r += NGW) {
        const int c = cond_of_row(r); const float* sc = mod_ptr(C, 0, c, 0, 1);
        const f32x4* xr = (const f32x4*)((r < MP) ? args->in[0] + (size_t)r * D : args->in[1] + (size_t)(r - MP) * D) + C.lane;
        f32x4 v[4]; float s = 0.f;
#pragma unroll
        for (int j = 0; j < 4; ++j) { v[j] = xr[64 * j]; s += (v[j].x * v[j].x + v[j].y * v[j].y) + (v[j].z * v[j].z + v[j].w * v[j].w); }
        s = wave_sum(s); if (C.lane == 0) ssq[r] = s;
        u32x2* o = (u32x2*)(XA + (size_t)r * D) + C.lane;
#pragma unroll
        for (int j = 0; j < 4; ++j) { const int col = 4 * C.lane + 256 * j; const f32x4 w = *(const f32x4*)(nw + col), a = *(const f32x4*)(sc + col);
            const f32x4 y = v[j] * w * (a + 1.0f); u32x2 p; p.x = cvt_pk_bf16(y.x, y.y); p.y = cvt_pk_bf16(y.z, y.w); o[64 * j] = p; } } }
    sw_layer(args, C, 0, gw, NGW);
}
__device__ __forceinline__ void finalnorm_phase(ArgsP args, const Ctx& C) {
    const int gw = C.bid * NWAVES + C.wave, NGW = C.G * NWAVES;
    const float* nw = args->in[10]; const float* ssq = ssq_ptr(C, 6);
    for (int r = gw; r < M; r += NGW) {
        f32x4* xr = (f32x4*)(C.out + (size_t)r * D) + C.lane;
        const float rstd = __builtin_amdgcn_rsqf(ssq[r] * (1.0f / D) + EPS);
#pragma unroll
        for (int j = 0; j < 4; ++j) { const f32x4 w = *(const f32x4*)(nw + 4 * C.lane + 256 * j); xr[64 * j] = xr[64 * j] * rstd * w; }
    }
}

struct Unit { int pm, pn, z; const bf16_t* A; const bf16_t* B; };

struct StaticOrder {
    int nM, nN, nwg, G, c; const bf16_t* A; const bf16_t* B; int lda, ldb;
    __device__ void init(int Mr, int N, int G_, int c_, const bf16_t* A_, int lda_, const bf16_t* B_, int ldb_) { nM = Mr / 256; nN = N / 256; nwg = nM * nN; G = G_; c = c_; A = A_; B = B_; lda = lda_; ldb = ldb_; }
    __device__ bool next(int i, Unit& u) const {
        const long L = (long)i * G + c; if (L >= nwg) return false;
        int wgid = (int)L; { const int q = nwg / 8, r = nwg % 8, xcd = wgid % 8, off = wgid / 8; wgid = (xcd < r ? xcd * (q + 1) : r * (q + 1) + (xcd - r) * q) + off; }
        const int nig = 8 * nN, gid = wgid / nig, fm = gid * 8, gsz = (nM - fm) < 8 ? (nM - fm) : 8;
        u.pm = fm + ((wgid % nig) % gsz); u.pn = (wgid % nig) / gsz; u.z = 0;
        u.A = A + (size_t)u.pm * 256 * lda; u.B = B + (size_t)u.pn * 256 * ldb; return true;
    }
};
struct DftOrder {
    int nseq, nPm, L, G, c; const bf16_t* A; const bf16_t* XFT;
    __device__ bool next(int i, Unit& u) const {
        const int idx = i * G + c; if (idx >= nseq * nPm * 2) return false;
        u.z = idx / (nPm * 2); const int r = idx % (nPm * 2); u.pm = r >> 1; u.pn = r & 1;
        u.A = A + (size_t)u.pm * 256 * L; u.B = XFT + ((size_t)u.z * 512 + u.pn * 256) * L; return true;
    }
};

template <class Epi, class Sched>
__device__ __forceinline__ void gemm_simple(const Ctx& C, const Sched& S, const Epi& E, int lda, int ldb, int K) {
    const int wr = C.wave >> 2, wc = C.wave & 3, fr = C.lane & 15, fq = C.lane >> 4;
    Unit u;
    for (int ui = 0; S.next(ui, u); ++ui) {
        f32x4 acc[2][2][4][2];
#pragma unroll
        for (int a = 0; a < 2; ++a)
#pragma unroll
            for (int b = 0; b < 2; ++b)
#pragma unroll
                for (int m = 0; m < 4; ++m)
#pragma unroll
                    for (int n = 0; n < 2; ++n) acc[a][b][m][n] = (f32x4){0.f, 0.f, 0.f, 0.f};
        const bf16_t* pa = u.A + (size_t)(wr * 64 + fr) * lda + fq * 8;
        const bf16_t* pb = u.B + (size_t)(wc * 32 + fr) * ldb + fq * 8;
        for (int k0 = 0; k0 < K; k0 += 32) {
            bf16x8 At[2][4], Bt[2][2];
#pragma unroll
            for (int a = 0; a < 2; ++a)
#pragma unroll
                for (int m = 0; m < 4; ++m) At[a][m] = *(const bf16x8*)(pa + (size_t)(a * 128 + m * 16) * lda + k0);
#pragma unroll
            for (int b = 0; b < 2; ++b)
#pragma unroll
                for (int n = 0; n < 2; ++n) Bt[b][n] = *(const bf16x8*)(pb + (size_t)(b * 128 + n * 16) * ldb + k0);
#pragma unroll
            for (int a = 0; a < 2; ++a)
#pragma unroll
                for (int b = 0; b < 2; ++b)
#pragma unroll
                    for (int m = 0; m < 4; ++m)
#pragma unroll
                        for (int n = 0; n < 2; ++n) acc[a][b][m][n] = __builtin_amdgcn_mfma_f32_16x16x32_bf16(Bt[b][n], At[a][m], acc[a][b][m][n], 0, 0, 0);
        }
        E(acc, u, wr, wc, fr, fq);
    }
}

namespace pg8 {
#define PG8_LAS __attribute__((address_space(3)))
constexpr int BM = 256, BK = 64, HALF = 128, HTB = HALF * BK * 2  , STAGE_BYTES = 8 * HTB, NXCD = 8, WGM = 8;

__host__ __device__ __forceinline__ int lds_byte(int r, int c) { const int st = (r >> 4) * 2 + (c >> 5), rr = r & 15, cc = c & 31, ob = rr * 64 + cc * 2; return st * 1024 + (ob ^ (((ob >> 9) & 1) << 5)); }
__host__ __device__ __forceinline__ void stage_rc(int b, int& R, int& C) { const int st = b / 1024, sb = b % 1024, swz = sb ^ (((sb >> 9) & 1) << 5); R = (st >> 1) * 16 + swz / 64; C = (st & 1) * 32 + (swz % 64) / 2; }
__host__ __device__ __forceinline__ int perm32(int rho) { const int n = rho >> 4, i = rho & 15; return 8 * (i >> 2) + 4 * n + (i & 3); }
template <class Epi, class Sched, bool ALIGN_EPI = true, bool SP2 = true>
__device__ __forceinline__ void gemm_phase(PG8_LAS unsigned char* lds, const int tid, const Sched& S, const Epi& E, const int lda, const int ldb, const int K) {
    const int wid = __builtin_amdgcn_readfirstlane(tid >> 6), lane = tid & 63, wr = wid >> 2, wc = wid & 3, fr = lane & 15, fq = lane >> 4;
    const int nt = K / BK;
    unsigned voffA[2], voffB[2];
#pragma unroll
    for (int i = 0; i < 2; ++i) { int R, C; stage_rc(tid * 16 + i * 8192, R, C); const int Rb = Epi::PERM ? ((R & ~31) + perm32(R & 31)) : R;
        voffA[i] = (unsigned)(R * lda + C) * 2u; voffB[i] = (unsigned)(Rb * ldb + C) * 2u; }
    const size_t kstep = (size_t)(BK * 2);
    const size_t hstepA = (size_t)HALF * lda * 2, hstepB = (size_t)HALF * ldb * 2;
    const unsigned ldsw = (unsigned)wid * 1024u;
    const int aoff = lds_byte(wr * 64 + fr, fq * 8), boff = lds_byte(wc * 32 + fr, fq * 8);
#define PG8_SA(b, h) (((b) * 2 + (h)) * HTB)
#define PG8_SB(b, h) ((4 + (b) * 2 + (h)) * HTB)
#define PG8_STAGE(bufoff, gbase, voff) do { _Pragma("unroll") for (int _i = 0; _i < 2; ++_i) \
        __builtin_amdgcn_global_load_lds((const unsigned*)((const char*)(gbase) + (voff)[_i]), (PG8_LAS unsigned*)(lds + (bufoff) + ldsw + _i * 8192), 16, 0, 0); } while (0)
#define PG8_LDA(dst, b, h) do { _Pragma("unroll") for (int m = 0; m < 4; ++m) _Pragma("unroll") for (int k = 0; k < 2; ++k) dst[m][k] = *(const PG8_LAS bf16x8*)(lds + PG8_SA(b, h) + aoff + m * 2048 + k * 1024); } while (0)
#define PG8_LDB(dst, b, h) do { _Pragma("unroll") for (int n = 0; n < 2; ++n) _Pragma("unroll") for (int k = 0; k < 2; ++k) dst[n][k] = *(const PG8_LAS bf16x8*)(lds + PG8_SB(b, h) + boff + n * 2048 + k * 1024); } while (0)
#define PG8_MMA(ai, bj, At, Bt) do { __builtin_amdgcn_s_setprio(1); _Pragma("unroll") for (int m = 0; m < 4; ++m) _Pragma("unroll") for (int n = 0; n < 2; ++n) _Pragma("unroll") for (int k = 0; k < 2; ++k) \
        acc[ai][bj][m][n] = __builtin_amdgcn_mfma_f32_16x16x32_bf16(Bt[n][k], At[m][k], acc[ai][bj][m][n], 0, 0, 0); __builtin_amdgcn_s_setprio(0); } while (0)
#define PG8_WAIT_V(n) asm volatile("s_waitcnt vmcnt(" #n ")" ::: "memory")
#define PG8_WAIT_L(n) asm volatile("s_waitcnt lgkmcnt(" #n ")" ::: "memory")
#define PG8_BAR __builtin_amdgcn_s_barrier()
#define PG8_SCHED __builtin_amdgcn_sched_barrier(0)
    Unit cur, nxt; int ui = 0;
    if (!S.next(0, cur)) return;
    f32x4 acc[2][2][4][2];
#pragma unroll
    for (int a = 0; a < 2; ++a)
#pragma unroll
        for (int b = 0; b < 2; ++b)
#pragma unroll
            for (int m = 0; m < 4; ++m)
#pragma unroll
                for (int n = 0; n < 2; ++n) acc[a][b][m][n] = (f32x4){0.f, 0.f, 0.f, 0.f};
    bf16x8 At[4][2], B0[2][2], B1[2][2];
    const char* cA = (const char*)cur.A; const char* cB = (const char*)cur.B;
    if constexpr (SP2) {
        PG8_STAGE(PG8_SB(0, 0), cB, voffB); PG8_STAGE(PG8_SB(0, 1), cB + hstepB, voffB); PG8_STAGE(PG8_SA(0, 0), cA, voffA); PG8_STAGE(PG8_SA(0, 1), cA + hstepA, voffA);
        if (wr == 1) PG8_BAR;
        PG8_WAIT_V(2); PG8_BAR;
        PG8_STAGE(PG8_SB(1, 0), cB + kstep, voffB); PG8_STAGE(PG8_SA(1, 0), cA + kstep, voffA); PG8_STAGE(PG8_SB(1, 1), cB + hstepB + kstep, voffB);
        PG8_WAIT_V(6); PG8_BAR;
    } else {
        PG8_STAGE(PG8_SB(0, 0), cB, voffB); PG8_STAGE(PG8_SA(0, 0), cA, voffA); PG8_STAGE(PG8_SB(0, 1), cB + hstepB, voffB); PG8_STAGE(PG8_SA(0, 1), cA + hstepA, voffA);
        if (wr == 1) PG8_BAR;
        PG8_WAIT_V(4); PG8_BAR;
        PG8_STAGE(PG8_SB(1, 0), cB + kstep, voffB); PG8_STAGE(PG8_SA(1, 0), cA + kstep, voffA); PG8_STAGE(PG8_SB(1, 1), cB + hstepB + kstep, voffB);
        PG8_WAIT_V(6); PG8_BAR;
    }
    for (;;) {
        const bool has_next = S.next(ui + 1, nxt);
        const char* nA = has_next ? (const char*)nxt.A : cA; const char* nB = has_next ? (const char*)nxt.B : cB;
        for (int t = 0; t < nt; t += 2) {
            const bool last = (t == nt - 2);
            const char* a1 = cA + (size_t)(t + 1) * kstep;
            const char* a2 = last ? nA : cA + (size_t)(t + 2) * kstep; const char* b2 = last ? nB : cB + (size_t)(t + 2) * kstep;
            const char* a3 = a2 + kstep; const char* b3 = b2 + kstep;
            if constexpr (SP2) {
            PG8_LDB(B0, 0, 0); PG8_LDB(B1, 0, 1); PG8_SCHED; PG8_LDA(At, 0, 0); PG8_STAGE(PG8_SA(1, 1), a1 + hstepA, voffA);
            PG8_WAIT_V(8); PG8_WAIT_L(0); PG8_BAR; PG8_MMA(0, 0, At, B0); PG8_MMA(0, 1, At, B1); PG8_BAR; PG8_SCHED;
            PG8_LDA(At, 0, 1); PG8_STAGE(PG8_SB(0, 0), b2, voffB); PG8_STAGE(PG8_SB(0, 1), b2 + hstepB, voffB); PG8_STAGE(PG8_SA(0, 0), a2, voffA);
            PG8_WAIT_V(8); PG8_WAIT_L(0); PG8_BAR; PG8_MMA(1, 0, At, B0); PG8_MMA(1, 1, At, B1); PG8_BAR; PG8_SCHED;
            PG8_LDB(B0, 1, 0); PG8_LDB(B1, 1, 1); PG8_SCHED; PG8_LDA(At, 1, 0); PG8_STAGE(PG8_SA(0, 1), a2 + hstepA, voffA);
            PG8_WAIT_V(8); PG8_WAIT_L(0); PG8_BAR; PG8_MMA(0, 0, At, B0); PG8_MMA(0, 1, At, B1); PG8_BAR; PG8_SCHED;
            PG8_LDA(At, 1, 1); PG8_STAGE(PG8_SB(1, 0), b3, voffB); PG8_STAGE(PG8_SB(1, 1), b3 + hstepB, voffB); PG8_STAGE(PG8_SA(1, 0), a3, voffA);
            PG8_WAIT_V(8); PG8_WAIT_L(0); PG8_BAR; PG8_MMA(1, 0, At, B0); PG8_MMA(1, 1, At, B1); PG8_BAR; PG8_SCHED;
            } else {
            PG8_LDB(B0, 0, 0); PG8_SCHED; PG8_LDA(At, 0, 0); PG8_STAGE(PG8_SA(1, 1), a1 + hstepA, voffA);
            PG8_WAIT_L(8); PG8_BAR; PG8_WAIT_L(0); PG8_MMA(0, 0, At, B0); PG8_BAR; PG8_SCHED;
            PG8_LDB(B1, 0, 1); PG8_STAGE(PG8_SB(0, 0), b2, voffB);
            PG8_BAR; PG8_WAIT_L(0); PG8_MMA(0, 1, At, B1); PG8_BAR;
            PG8_LDA(At, 0, 1); PG8_STAGE(PG8_SA(0, 0), a2, voffA);
            PG8_BAR; PG8_WAIT_L(0); PG8_MMA(1, 0, At, B0); PG8_BAR; PG8_SCHED;
            PG8_STAGE(PG8_SB(0, 1), b2 + hstepB, voffB);
            PG8_WAIT_V(6); PG8_BAR; PG8_MMA(1, 1, At, B1); PG8_BAR;
            PG8_LDB(B0, 1, 0); PG8_SCHED; PG8_LDA(At, 1, 0); PG8_STAGE(PG8_SA(0, 1), a2 + hstepA, voffA);
            PG8_WAIT_L(8); PG8_BAR; PG8_WAIT_L(0); PG8_MMA(0, 0, At, B0); PG8_BAR; PG8_SCHED;
            PG8_LDB(B1, 1, 1); PG8_STAGE(PG8_SB(1, 0), b3, voffB);
            PG8_BAR; PG8_WAIT_L(0); PG8_MMA(0, 1, At, B1); PG8_BAR;
            PG8_LDA(At, 1, 1); PG8_STAGE(PG8_SA(1, 0), a3, voffA);
            PG8_BAR; PG8_WAIT_L(0); PG8_MMA(1, 0, At, B0); PG8_BAR; PG8_SCHED;
            PG8_STAGE(PG8_SB(1, 1), b3 + hstepB, voffB);
            PG8_WAIT_V(6); PG8_BAR; PG8_MMA(1, 1, At, B1); PG8_BAR;
            }
        }
        if constexpr (ALIGN_EPI) { if (wr == 0) PG8_BAR; }
        if constexpr (!Epi::AFTER_DRAIN) { E(acc, cur, wr, wc, fr, fq); }
        if (!has_next) break;
#pragma unroll
        for (int a = 0; a < 2; ++a)
#pragma unroll
            for (int b = 0; b < 2; ++b)
#pragma unroll
                for (int m = 0; m < 4; ++m)
#pragma unroll
                    for (int n = 0; n < 2; ++n) acc[a][b][m][n] = (f32x4){0.f, 0.f, 0.f, 0.f};
        cur = nxt; cA = nA; cB = nB; ++ui;
        if constexpr (ALIGN_EPI) { if (wr == 1) PG8_BAR; }
    }
    PG8_WAIT_V(0);
    if constexpr (!ALIGN_EPI) { if (wr == 0) PG8_BAR; }
    PG8_BAR;
    if constexpr (Epi::AFTER_DRAIN) { E.fused(acc, cur, wr, wc, fr, fq, lds, wid, lane); }
#undef PG8_SA
#undef PG8_SB
#undef PG8_STAGE
#undef PG8_LDA
#undef PG8_LDB
#undef PG8_MMA
#undef PG8_WAIT_V
#undef PG8_WAIT_L
#undef PG8_BAR
#undef PG8_SCHED
}
}

#ifndef USE_PG8
#define USE_PG8 1
#endif
#if USE_PG8
__device__ __forceinline__ int fresh_tid(const Ctx& C) { unsigned z_ = 0u; asm volatile("" : "+s"(z_)); return C.wave * 64 + (int)__builtin_amdgcn_mbcnt_hi(~0u, __builtin_amdgcn_mbcnt_lo(~0u, z_)); }
#define GEMM(C, S, E, lda, ldb, K) pg8::gemm_phase(C.lds, fresh_tid(C), S, E, lda, ldb, K)
#else
#define GEMM(C, S, E, lda, ldb, K) GEMM(C, S, E, lda, ldb, K)
#endif

#define EPI_LOOP_AM for (int ai = 0; ai < 2; ++ai) _Pragma("unroll") for (int m = 0; m < 4; ++m)
struct EpiGU {
    static constexpr bool PERM = true, AFTER_DRAIN = false;
    bf16_t* H; const float* ssq; const float* swb;
    __device__ __forceinline__ void operator()(const f32x4 (&acc)[2][2][4][2], const Unit& u, int wr, int wc, int fr, int fq) const {
        const float* sw = swb + (size_t)cond_of_row(u.pm * 256) * 5632 + u.pn * 256 + wc * 32 + fq * 8;
        f32x4 sg[2], su[2];
#pragma unroll
        for (int n = 0; n < 2; ++n) { sg[n] = *(const f32x4*)(sw + n * 4); su[n] = *(const f32x4*)(sw + 128 + n * 4); }
#pragma unroll
        EPI_LOOP_AM { const int row = u.pm * 256 + ai * 128 + wr * 64 + m * 16 + fr; const float rstd = __builtin_amdgcn_rsqf(ssq[row] * (1.0f / D) + EPS);
            u32x4 p;
            { const f32x4 g = acc[ai][0][m][0] * rstd + sg[0], up = acc[ai][1][m][0] * rstd + su[0]; p.x = cvt_pk_bf16(siluf_(g.x) * up.x, siluf_(g.y) * up.y); p.y = cvt_pk_bf16(siluf_(g.z) * up.z, siluf_(g.w) * up.w); }
            { const f32x4 g = acc[ai][0][m][1] * rstd + sg[1], up = acc[ai][1][m][1] * rstd + su[1]; p.z = cvt_pk_bf16(siluf_(g.x) * up.x, siluf_(g.y) * up.y); p.w = cvt_pk_bf16(siluf_(g.z) * up.z, siluf_(g.w) * up.w); }
            *(u32x4*)(H + (size_t)row * DFF + u.pn * 128 + wc * 32 + fq * 8) = p; }
    }
};
struct EpiRes {
    static constexpr bool PERM = true, AFTER_DRAIN = false;
    float* X; const float* Xin0; const float* Xin1; const float* modbase;
    bf16_t* XA; const float* nwn; float* ssqn;
    int l, sub, ln, subn; float coef;
    __device__ __forceinline__ void operator()(const f32x4 (&acc)[2][2][4][2], const Unit& u, int wr, int wc, int fr, int fq) const {
        const int c = cond_of_row(u.pm * 256), co = u.pn * 256 + wc * 32 + fq * 8;
        const float* gate = modbase + ((size_t)(l * 5 + c) * NMOD + (sub * 3 + 2) * D) + co;
        f32x4 g[2][2], wn[2][2];
#pragma unroll
        for (int bj = 0; bj < 2; ++bj)
#pragma unroll
            for (int n = 0; n < 2; ++n) { g[bj][n] = *(const f32x4*)(gate + bj * 128 + n * 4) * coef;
                if (ln >= 0) { const float* scn = modbase + ((size_t)(ln * 5 + c) * NMOD + (subn * 3 + 1) * D) + co + bj * 128 + n * 4; wn[bj][n] = *(const f32x4*)(nwn + co + bj * 128 + n * 4) * (*(const f32x4*)scn + 1.0f); }
                else wn[bj][n] = (f32x4){0.f, 0.f, 0.f, 0.f}; }
#pragma unroll
        EPI_LOOP_AM { const int row = u.pm * 256 + ai * 128 + wr * 64 + m * 16 + fr;
            float* xrow = X + (size_t)row * D + co; const float* irow = ((u.pm < 16) ? Xin0 + (size_t)row * D : Xin1 + (size_t)(row - MP) * D) + co;
            float ss = 0.f;
#pragma unroll
            for (int bj = 0; bj < 2; ++bj) {
                const f32x4 x0 = *(const f32x4*)(irow + bj * 128) + g[bj][0] * acc[ai][bj][m][0], x1 = *(const f32x4*)(irow + bj * 128 + 4) + g[bj][1] * acc[ai][bj][m][1];
                *(f32x4*)(xrow + bj * 128) = x0; *(f32x4*)(xrow + bj * 128 + 4) = x1;
                ss += ((x0.x * x0.x + x0.y * x0.y) + (x0.z * x0.z + x0.w * x0.w)) + ((x1.x * x1.x + x1.y * x1.y) + (x1.z * x1.z + x1.w * x1.w));
                if (ln >= 0) { const f32x4 y0 = x0 * wn[bj][0], y1 = x1 * wn[bj][1]; u32x4 p; p.x = cvt_pk_bf16(y0.x, y0.y); p.y = cvt_pk_bf16(y0.z, y0.w); p.z = cvt_pk_bf16(y1.x, y1.y); p.w = cvt_pk_bf16(y1.z, y1.w);
                    *(u32x4*)(XA + (size_t)row * D + co + bj * 128) = p; } }
            ss = sum_x32(sum_x16(ss));
            if (fq == 0) atomicAdd(ssqn + row, ss);
            asm volatile("" ::: "memory"); }
    }
};
struct EpiIn {
    static constexpr bool PERM = false, AFTER_DRAIN = false;
    bf16_t *Q, *Kb, *VT, *GY, *XFT, *G; float* XR; float* out; const float* rope; const float* bgate; int l; const float* ssq; const float* swb;
    __device__ __forceinline__ void operator()(f32x4 (&acc)[2][2][4][2], const Unit& u, int wr, int wc, int fr, int fq) const {
        const int row0 = u.pm * 256 + wr * 64 + fr; const bool latent = u.pm >= 16;
        { const float* sw = swb + (size_t)cond_of_row(u.pm * 256) * 5632 + u.pn * 256 + wc * 32 + fq * 4;
          f32x4 sv[2][2];
#pragma unroll
          for (int bj = 0; bj < 2; ++bj)
#pragma unroll
              for (int n = 0; n < 2; ++n) sv[bj][n] = *(const f32x4*)(sw + bj * 128 + n * 16);
#pragma unroll
          EPI_LOOP_AM { const float rstd = __builtin_amdgcn_rsqf(ssq[row0 + ai * 128 + m * 16] * (1.0f / D) + EPS);
#pragma unroll
              for (int bj = 0; bj < 2; ++bj)
#pragma unroll
                  for (int n = 0; n < 2; ++n) acc[ai][bj][m][n] = acc[ai][bj][m][n] * rstd + sv[bj][n]; } }
        if (u.pn <= 2) {
#pragma unroll
            for (int bj = 0; bj < 2; ++bj) {
                if (u.pn == 2 && bj == 1) {
#pragma unroll
                    EPI_LOOP_AM { const int row = row0 + ai * 128 + m * 16; int seqoff, L, t;
                        if (latent) { const int b = (row - MP) >> 11; t = (row - MP) & 2047; L = LS; seqoff = 16 * 128 * LC + b * 128 * LS; } else { const int b = row >> 8; t = row & 255; L = LC; seqoff = b * 128 * LC; }
#pragma unroll
                        for (int n = 0; n < 2; ++n) { const f32x4 v = acc[ai][1][m][n]; const int d128 = wc * 32 + n * 16 + fq * 4;
                            bf16_t* p = VT + seqoff + (size_t)d128 * L + t; p[0] = f2bf(v.x); p[L] = f2bf(v.y); p[2 * L] = f2bf(v.z); p[3 * L] = f2bf(v.w);
                            if (!latent) *(f32x4*)(out + OUT_CV + ((size_t)((row >> 8) * 2 + l) * 256 + t) * 128 + d128) = v; } }
                } else {
                    const bool isk = (u.pn == 2); const int axis = wc & 1;
#pragma unroll
                    EPI_LOOP_AM { const int row = row0 + ai * 128 + m * 16; f32x4 x1 = acc[ai][bj][m][0], x2 = acc[ai][bj][m][1];
                        if (isk && !latent) { float* o = out + OUT_CK + ((size_t)((row >> 8) * 2 + l) * 256 + (row & 255)) * 128 + wc * 32 + fq * 4; *(f32x4*)o = x1; *(f32x4*)(o + 16) = x2; }
                        if (latent) { const int t = (row - MP) & 2047, pos = axis ? (t & 63) : (t >> 6);
                            const f32x4 cs = *(const f32x4*)(rope + pos * 16 + fq * 4), sn = *(const f32x4*)(rope + 1024 + pos * 16 + fq * 4);
                            const f32x4 o1 = x1 * cs - x2 * sn, o2 = x1 * sn + x2 * cs; x1 = o1; x2 = o2; }
                        if (!isk) { x1 = x1 * QSCALE; x2 = x2 * QSCALE; }
                        bf16_t* o = isk ? (Kb + (size_t)row * 128 + wc * 32 + fq * 4) : (Q + (size_t)row * 512 + u.pn * 256 + bj * 128 + wc * 32 + fq * 4);
                        u32x2 p; p.x = cvt_pk_bf16(x1.x, x1.y); p.y = cvt_pk_bf16(x1.z, x1.w); *(u32x2*)o = p;
                        p.x = cvt_pk_bf16(x2.x, x2.y); p.y = cvt_pk_bf16(x2.z, x2.w); *(u32x2*)(o + 16) = p; }
                }
            }
        } else if (u.pn <= 4) {
#pragma unroll
            EPI_LOOP_AM { const int row = row0 + ai * 128 + m * 16;
#pragma unroll
                for (int bj = 0; bj < 2; ++bj)
#pragma unroll
                    for (int n = 0; n < 2; ++n) *(f32x4*)(XR + (size_t)row * 512 + (u.pn - 3) * 256 + bj * 128 + wc * 32 + n * 16 + fq * 4) = acc[ai][bj][m][n]; }
        } else if (u.pn <= 6) {
#pragma unroll
            EPI_LOOP_AM { const int row = row0 + ai * 128 + m * 16;
#pragma unroll
                for (int bj = 0; bj < 2; ++bj)
#pragma unroll
                    for (int n = 0; n < 2; ++n) { const f32x4 v = acc[ai][bj][m][n]; u32x2 p; p.x = cvt_pk_bf16(gelu_tanh(v.x), gelu_tanh(v.y)); p.y = cvt_pk_bf16(gelu_tanh(v.z), gelu_tanh(v.w));
                        *(u32x2*)(GY + (size_t)row * 512 + (u.pn - 5) * 256 + bj * 128 + wc * 32 + n * 16 + fq * 4) = p; } }
        } else if (u.pn <= 8) {
#pragma unroll
            EPI_LOOP_AM { const int row = row0 + ai * 128 + m * 16; size_t seqoff; int L, t;
                if (latent) { const int b = (row - MP) >> 11; t = (row - MP) & 2047; L = LS; seqoff = (size_t)16 * 512 * LC + (size_t)b * 512 * LS; } else { const int b = row >> 8; t = row & 255; L = LC; seqoff = (size_t)b * 512 * LC; }
#pragma unroll
                for (int bj = 0; bj < 2; ++bj)
#pragma unroll
                    for (int n = 0; n < 2; ++n) { const f32x4 v = acc[ai][bj][m][n]; bf16_t* p = XFT + seqoff + (size_t)((u.pn - 7) * 256 + bj * 128 + wc * 32 + n * 16 + fq * 4) * L + t;
                        p[0] = f2bf(v.x); p[L] = f2bf(v.y); p[2 * L] = f2bf(v.z); p[3 * L] = f2bf(v.w); } }
        } else {
#pragma unroll
            for (int bj = 0; bj < 2; ++bj)
#pragma unroll
                for (int n = 0; n < 2; ++n) { const int col = (u.pn - 9) * 256 + bj * 128 + wc * 32 + n * 16 + fq * 4; const f32x4 b = *(const f32x4*)(bgate + col);
#pragma unroll
                    EPI_LOOP_AM { const int row = row0 + ai * 128 + m * 16; const f32x4 v = acc[ai][bj][m][n] + b;
                        u32x2 p; p.x = cvt_pk_bf16(sigmoidf_(v.x), sigmoidf_(v.y)); p.y = cvt_pk_bf16(sigmoidf_(v.z), sigmoidf_(v.w)); *(u32x2*)(G + (size_t)row * 3072 + col) = p; } }
        }
    }
};
template <int MODE> struct EpiBranch {
    static constexpr bool PERM = true, AFTER_DRAIN = false;
    bf16_t* MG; const bf16_t* G; int br;
    __device__ __forceinline__ void operator()(const f32x4 (&acc)[2][2][4][2], const Unit& u, int wr, int wc, int fr, int fq) const {
#pragma unroll
        EPI_LOOP_AM { const int row = u.pm * 256 + ai * 128 + wr * 64 + m * 16 + fr;
#pragma unroll
            for (int bj = 0; bj < 2; ++bj) { const int col = u.pn * 256 + bj * 128 + wc * 32 + fq * 8;
                const u32x4 g = *(const u32x4*)(G + (size_t)row * 3072 + br * 1024 + col); f32x4 v0 = acc[ai][bj][m][0], v1 = acc[ai][bj][m][1];
                v0.x *= bflo(g.x); v0.y *= bfhi(g.x); v0.z *= bflo(g.y); v0.w *= bfhi(g.y); v1.x *= bflo(g.z); v1.y *= bfhi(g.z); v1.z *= bflo(g.w); v1.w *= bfhi(g.w);
                u32x4* p = (u32x4*)(MG + (size_t)row * D + col);
                if (MODE == 1) { const u32x4 o = *p; v0.x += bflo(o.x); v0.y += bfhi(o.x); v0.z += bflo(o.y); v0.w += bfhi(o.y); v1.x += bflo(o.z); v1.y += bfhi(o.z); v1.z += bflo(o.w); v1.w += bfhi(o.w); }
                u32x4 w; w.x = cvt_pk_bf16(v0.x, v0.y); w.y = cvt_pk_bf16(v0.z, v0.w); w.z = cvt_pk_bf16(v1.x, v1.y); w.w = cvt_pk_bf16(v1.z, v1.w); *p = w; }
            asm volatile("" ::: "memory"); }
    }
};
struct EpiDft {
    static constexpr bool PERM = true, AFTER_DRAIN = false;
    bf16_t* Z; int L, rowbase;
    __device__ __forceinline__ void operator()(const f32x4 (&acc)[2][2][4][2], const Unit& u, int wr, int wc, int fr, int fq) const {
        const int hl = L >> 1;
#pragma unroll
        EPI_LOOP_AM { const int rr = u.pm * 256 + ai * 128 + wr * 64 + m * 16 + fr; const bool sn = rr >= hl; const int p = sn ? rr - hl : rr;
            bf16_t* z0 = Z + (size_t)rowbase * D + u.pn * 256 + wc * 32 + fq * 8;
#pragma unroll
            for (int bj = 0; bj < 2; ++bj) { const f32x4 v0 = acc[ai][bj][m][0], v1 = acc[ai][bj][m][1]; u32x4 w; w.x = cvt_pk_bf16(v0.x, v0.y); w.y = cvt_pk_bf16(v0.z, v0.w); w.z = cvt_pk_bf16(v1.x, v1.y); w.w = cvt_pk_bf16(v1.z, v1.w); const int co = bj * 128;
                if (!sn) { *(u32x4*)(z0 + (size_t)p * D + co) = w; if (p) *(u32x4*)(z0 + (size_t)(L - p) * D + co) = w; }
                else if (p == 0) { *(u32x4*)(z0 + (size_t)hl * D + co) = w; const u32x4 zz = {0u, 0u, 0u, 0u}; *(u32x4*)(z0 + 512 + co) = zz; *(u32x4*)(z0 + (size_t)hl * D + 512 + co) = zz; }
                else { *(u32x4*)(z0 + (size_t)p * D + 512 + co) = w; u32x4 nw; nw.x = w.x ^ 0x80008000u; nw.y = w.y ^ 0x80008000u; nw.z = w.z ^ 0x80008000u; nw.w = w.w ^ 0x80008000u; *(u32x4*)(z0 + (size_t)(L - p) * D + 512 + co) = nw; } } }
    }
};

typedef short s16x4 __attribute__((ext_vector_type(4)));
#define MFMA32(a, b, c) __builtin_amdgcn_mfma_f32_32x32x16_bf16((a), (b), (c), 0, 0, 0)
constexpr int AT_KSTR = 144, AT_VSTR = 264, AT_KBYTES = 128 * AT_KSTR, AT_VBYTES = 64 * AT_VSTR, AT_BUF = AT_KBYTES + AT_VBYTES;
struct AttnSrc { const bf16_t* kp; const bf16_t* vp; int vstride; int kbase; };
__device__ __forceinline__ AttnSrc attn_src(int t, bool latent, int nband, int lo, int b, int l, int kvh, const bf16_t* Kb, const bf16_t* VT, const bf16_t* CK, const bf16_t* CVT) {
    AttnSrc s;
    if (!latent) { s.kp = Kb + (size_t)(b * LC + 128 * t) * 128 + kvh * 64; s.vp = VT + (size_t)b * 128 * LC + (size_t)(kvh * 64) * LC + 128 * t; s.vstride = LC; s.kbase = 0; }
    else if (t < nband) { const int kb = lo + 128 * t; s.kp = Kb + (size_t)(MP + b * LS + kb) * 128 + kvh * 64; s.vp = VT + (size_t)16 * 128 * LC + (size_t)b * 128 * LS + (size_t)(kvh * 64) * LS + kb; s.vstride = LS; s.kbase = kb; }
    else { const int c = t - nband; s.kp = CK + (size_t)((b * 2 + l) * 256 + 128 * c) * 128 + kvh * 64; s.vp = CVT + (size_t)((b * 2 + l) * 2 + kvh) * 64 * 256 + 128 * c; s.vstride = 256; s.kbase = 0; }
    return s;
}
__device__ __forceinline__ void attn_tile(const LAS unsigned char* kbp, const LAS unsigned char* vbp, const bf16x8 (&qf)[4], f32x16& O0, f32x16& O1, float& mrun, float& lsum, bool domask, int dk0, int q32, int half) {
    f32x16 S0, S1;
#pragma unroll
    for (int r = 0; r < 16; ++r) { S0[r] = 0.f; S1[r] = 0.f; }
#pragma unroll
    for (int ks = 0; ks < 4; ++ks) { const bf16x8 k0 = *(const LAS bf16x8*)(kbp + q32 * AT_KSTR + ks * 32 + half * 16), k1 = *(const LAS bf16x8*)(kbp + (32 + q32) * AT_KSTR + ks * 32 + half * 16);
        S0 = MFMA32(k0, qf[ks], S0); S1 = MFMA32(k1, qf[ks], S1); }
    if (domask) {
#pragma unroll
        for (int r = 0; r < 16; ++r) { const int d0 = dk0 + (r & 3) + 8 * (r >> 2) + 4 * half, d1 = d0 + 32;
            S0[r] = (d0 > 128 || d0 < -128) ? -1e30f : S0[r]; S1[r] = (d1 > 128 || d1 < -128) ? -1e30f : S1[r]; } }
    float mx = fmaxf(S0[0], S1[0]);
#pragma unroll
    for (int r = 1; r < 16; ++r) mx = fmaxf(mx, fmaxf(S0[r], S1[r]));
    mx = fmaxf(mx, __shfl_xor(mx, 32));
    const float mnew = fmaxf(mrun, mx), alpha = __builtin_amdgcn_exp2f(mrun - mnew); mrun = mnew;
    float ps = 0.f;
#pragma unroll
    for (int r = 0; r < 16; ++r) { S0[r] = __builtin_amdgcn_exp2f(S0[r] - mnew); S1[r] = __builtin_amdgcn_exp2f(S1[r] - mnew); ps += S0[r] + S1[r]; }
    lsum = lsum * alpha + ps;
#pragma unroll
    for (int r = 0; r < 16; ++r) { O0[r] *= alpha; O1[r] *= alpha; }
    bf16x8 pf[4];
#pragma unroll
    for (int s2 = 0; s2 < 2; ++s2) { u32x4 a, c2;
        a.x = cvt_pk_bf16(S0[8 * s2 + 0], S0[8 * s2 + 1]); a.y = cvt_pk_bf16(S0[8 * s2 + 2], S0[8 * s2 + 3]); a.z = cvt_pk_bf16(S0[8 * s2 + 4], S0[8 * s2 + 5]); a.w = cvt_pk_bf16(S0[8 * s2 + 6], S0[8 * s2 + 7]);
        c2.x = cvt_pk_bf16(S1[8 * s2 + 0], S1[8 * s2 + 1]); c2.y = cvt_pk_bf16(S1[8 * s2 + 2], S1[8 * s2 + 3]); c2.z = cvt_pk_bf16(S1[8 * s2 + 4], S1[8 * s2 + 5]); c2.w = cvt_pk_bf16(S1[8 * s2 + 6], S1[8 * s2 + 7]);
        pf[s2] = __builtin_bit_cast(bf16x8, a); pf[2 + s2] = __builtin_bit_cast(bf16x8, c2); }
#pragma unroll
    for (int s4 = 0; s4 < 4; ++s4) {
        const LAS unsigned char* v0p = vbp + q32 * AT_VSTR + s4 * 32 + half * 8; const LAS unsigned char* v1p = v0p + 32 * AT_VSTR;
        const s16x4 a0 = *(const LAS s16x4*)v0p, a1 = *(const LAS s16x4*)(v0p + 16), b0 = *(const LAS s16x4*)v1p, b1 = *(const LAS s16x4*)(v1p + 16);
        const bf16x8 vf0 = __builtin_shufflevector(a0, a1, 0, 1, 2, 3, 4, 5, 6, 7), vf1 = __builtin_shufflevector(b0, b1, 0, 1, 2, 3, 4, 5, 6, 7);
        O0 = MFMA32(vf0, pf[s4], O0); O1 = MFMA32(vf1, pf[s4], O1); }
}
__device__ __forceinline__ void attn_unit(ArgsP args, const Ctx& C, int l, int ui) {
    bf16_t* Q = (bf16_t*)act_ptr(C, A_Q); const bf16_t* Kb = (const bf16_t*)act_ptr(C, A_K); const bf16_t* VT = (const bf16_t*)act_ptr(C, A_VT);
    const bf16_t* CK = (const bf16_t*)(C.ws + OFF_CK); const bf16_t* CVT = (const bf16_t*)(C.ws + OFF_CVT);
    const int q32 = C.lane & 31, half = C.lane >> 5, w = C.wave;
    const int srow = C.tid >> 3, schunk = C.tid & 7;
    {
        const bool latent = ui < 256;
        int b, h, qb; if (latent) { b = ui >> 6; h = (ui >> 3) & 7; qb = ui & 7; } else { const int r = ui - 256; b = r >> 3; h = r & 7; qb = 0; }
        const int kvh = h >> 2, rowbase = latent ? (MP + b * LS + qb * 256) : b * LC;
        int lo = 0, nband = 2, nt = 2;
        if (latent) { lo = 256 * qb - 128; if (lo < 0) lo = 0; int hi = 256 * qb + 384; if (hi > LS) hi = LS; nband = (hi - lo) >> 7; nt = nband + 2; }
        const int qw_lo = qb * 256 + 32 * w, qpos = qw_lo + q32;
        bf16x8 qf[4];
        { const bf16_t* qp = Q + (size_t)(rowbase + 32 * w + q32) * 512 + h * 64 + 8 * half;
#pragma unroll
          for (int ks = 0; ks < 4; ++ks) qf[ks] = *(const bf16x8*)(qp + 16 * ks); }
        f32x16 O0, O1;
#pragma unroll
        for (int r = 0; r < 16; ++r) { O0[r] = 0.f; O1[r] = 0.f; }
        float mrun = args->in[20][l * 8 + h] * LOG2E, lsum = half ? 0.f : 1.0f;
        u32x4 kA0, kA1, vA0, vA1, kB0, kB1, vB0, vB1;
#define ATT_LOAD(k0, k1, v0, v1, tt) do { const AttnSrc s_ = attn_src((tt), latent, nband, lo, b, l, kvh, Kb, VT, CK, CVT); \
            k0 = *(const u32x4*)(s_.kp + (size_t)srow * 128 + schunk * 8); k1 = *(const u32x4*)(s_.kp + (size_t)(64 + srow) * 128 + schunk * 8); \
            v0 = *(const u32x4*)(s_.vp + (size_t)srow * s_.vstride + schunk * 8); v1 = *(const u32x4*)(s_.vp + (size_t)srow * s_.vstride + 64 + schunk * 8); } while (0)
#define ATT_WRITE(k0, k1, v0, v1, bufi) do { LAS unsigned char* kb_ = C.lds + (bufi) * AT_BUF; *(LAS u32x4*)(kb_ + srow * AT_KSTR + schunk * 16) = k0; *(LAS u32x4*)(kb_ + (64 + srow) * AT_KSTR + schunk * 16) = k1; \
            LAS u32x2* vd_ = (LAS u32x2*)(kb_ + AT_KBYTES + srow * AT_VSTR + schunk * 16); vd_[0] = (u32x2){v0.x, v0.y}; vd_[1] = (u32x2){v0.z, v0.w}; vd_[16] = (u32x2){v1.x, v1.y}; vd_[17] = (u32x2){v1.z, v1.w}; } while (0)
        ATT_LOAD(kA0, kA1, vA0, vA1, 0); ATT_WRITE(kA0, kA1, vA0, vA1, 0); if (nt > 1) ATT_LOAD(kA0, kA1, vA0, vA1, 1);
        __syncthreads();
#define ATT_STEP(t, kc0, kc1, vc0, vc1, kn0, kn1, vn0, vn1) do { const int buf = (t) & 1; \
            if ((t) + 2 < nt) ATT_LOAD(kn0, kn1, vn0, vn1, (t) + 2); \
            _Pragma("unroll") for (int sub_ = 0; sub_ < 2; ++sub_) { \
                bool skip = false, domask = false; const int kb = lo + 128 * (t) + 64 * sub_; \
                if (latent && (t) < nband) { skip = (kb > qw_lo + 31 + 128) || (kb + 63 < qw_lo - 128); domask = !((kb + 63 - qw_lo <= 128) && (qw_lo + 31 - kb <= 128)); } \
                if (!skip) attn_tile(C.lds + buf * AT_BUF + sub_ * 64 * AT_KSTR, C.lds + buf * AT_BUF + AT_KBYTES + sub_ * 128, qf, O0, O1, mrun, lsum, domask, kb - qpos, q32, half); } \
            if ((t) + 1 < nt) ATT_WRITE(kc0, kc1, vc0, vc1, buf ^ 1); \
            __syncthreads(); } while (0)
        for (int t = 0; t < nt; t += 2) { ATT_STEP(t, kA0, kA1, vA0, vA1, kB0, kB1, vB0, vB1); if (t + 1 < nt) ATT_STEP(t + 1, kB0, kB1, vB0, vB1, kA0, kA1, vA0, vA1); }
#undef ATT_STEP
#undef ATT_LOAD
#undef ATT_WRITE
        const float inv = fast_rcp(lsum + __shfl_xor(lsum, 32));
        bf16_t* op = Q + (size_t)(rowbase + 32 * w + q32) * 512 + h * 64 + 4 * half;
#pragma unroll
        for (int g = 0; g < 4; ++g) { u32x2 o; o.x = cvt_pk_bf16(O0[4 * g] * inv, O0[4 * g + 1] * inv); o.y = cvt_pk_bf16(O0[4 * g + 2] * inv, O0[4 * g + 3] * inv); *(u32x2*)(op + 8 * g) = o;
            o.x = cvt_pk_bf16(O1[4 * g] * inv, O1[4 * g + 1] * inv); o.y = cvt_pk_bf16(O1[4 * g + 2] * inv, O1[4 * g + 3] * inv); *(u32x2*)(op + 32 + 8 * g) = o; }
    }
}

constexpr int LRW_BYTES = 11008, LR_PH = 8 * LRW_BYTES, LR_CAR = LR_PH + 8192, LR_CONST = LR_CAR + 512, LR_END = LR_CONST + 768;
static_assert(LR_END <= 131072, "lru LDS map");
__device__ __forceinline__ void lru_load_rows(float (&xr)[19], const float* XRc, int trow0, int L) {
#pragma unroll
    for (int r = 0; r < 19; ++r) { const int t = trow0 + r; const bool ok = (t >= 0) && (t < L); const float v = XRc[(size_t)(ok ? t : 0) * 512]; xr[r] = ok ? v : 0.f; }
}
__device__ __forceinline__ void lru_item(ArgsP args, const Ctx& C, int l, int it) {
    const float* XR = (const float*)act_ptr(C, A_XR); const bf16_t* GY = (const bf16_t*)act_ptr(C, A_GY); bf16_t* REC = (bf16_t*)act_ptr(C, A_XN);
    const int w = C.wave, ch = C.lane, fr = C.lane & 15, fq = C.lane >> 4;
    LAS float* XF = (LAS float*)(C.lds + w * LRW_BYTES); LAS float* AA = XF + 16 * 68; LAS bf16_t* XCB = (LAS bf16_t*)(AA + 16 * 68);
    LAS float* PH = (LAS float*)(C.lds + LR_PH); LAS float* CAR = (LAS float*)(C.lds + LR_CAR); LAS float* CST = (LAS float*)(C.lds + LR_CONST);
    const int dir = it & 1, nb = (it >> 1) & 7, sq = it >> 4;
    const bool latent = sq < 4; const int b = latent ? sq : sq - 4, L = latent ? LS : LC, rowbase = latent ? MP + b * LS : b * LC;
    const int cgl = nb * 64 + ch, g = (l * 2 + dir) * 8 + nb;
    __syncthreads();
    if (C.tid < 64) { const int cg = (l * 2 + dir) * 512 + nb * 64 + C.tid; CST[C.tid] = args->in[25][cg]; CST[64 + C.tid] = args->in[27][cg]; CST[128 + C.tid] = -8.0f * log1pf(__expf(-args->in[28][cg]));
        CAR[C.tid] = latent ? args->in[5][((size_t)(b * 2 + l) * 2 + dir) * 512 + nb * 64 + C.tid] : 0.f; }
    bf16x8 wf[8][2];
    { const bf16_t* lw = (const bf16_t*)(C.ws + OFF_LWT) + (size_t)g * 128 * 64 + fr * 64 + 8 * fq;
#pragma unroll
      for (int nt = 0; nt < 8; ++nt)
#pragma unroll
          for (int kk = 0; kk < 2; ++kk) wf[nt][kk] = *(const bf16x8*)(lw + nt * 16 * 64 + 32 * kk); }
    const float cw0 = args->in[22][(l * 4 + 0) * 512 + cgl], cw1 = args->in[22][(l * 4 + 1) * 512 + cgl], cw2 = args->in[22][(l * 4 + 2) * 512 + cgl], cw3 = args->in[22][(l * 4 + 3) * 512 + cgl], cb = args->in[23][l * 512 + cgl];
    const float* XRc = XR + (size_t)rowbase * 512 + cgl;
    const int nch = L >> 7, e0 = dir ? 16 * (7 - w) : 16 * w;
    float xr[19];
    lru_load_rows(xr, XRc, (dir ? (L - 128) : 0) + e0 - 2, L);
    __syncthreads();
    float hfin = 0.f;
    for (int c = 0; c < nch; ++c) {
        const int t0 = dir ? (L - 128 * (c + 1)) : 128 * c, par = c & 1;
#pragma unroll
        for (int e = 0; e < 16; ++e) { const float xc = cb + cw0 * xr[e] + cw1 * xr[e + 1] + cw2 * xr[e + 2] + cw3 * xr[e + 3]; XF[e * 68 + ch] = xc; XCB[e * 72 + ch] = f2bf(xc); }
        asm volatile("" ::: "memory");
        float gy[16];
        { const bf16_t* gp = GY + (size_t)(rowbase + t0 + e0) * 512 + cgl;
#pragma unroll
          for (int j = 0; j < 16; ++j) gy[j] = bf2f(gp[(size_t)(dir ? 15 - j : j) * 512]); }
        if (c + 1 < nch) lru_load_rows(xr, XRc, (dir ? (L - 128 * (c + 2)) : 128 * (c + 1)) + e0 - 2, L);
        f32x4 acc[8];
#pragma unroll
        for (int nt = 0; nt < 8; ++nt) acc[nt] = (f32x4){0.f, 0.f, 0.f, 0.f};
#pragma unroll
        for (int kk = 0; kk < 2; ++kk) { const bf16x8 xf = *(const LAS bf16x8*)(XCB + fr * 72 + 8 * fq + 32 * kk);
#pragma unroll
            for (int nt = 0; nt < 8; ++nt) acc[nt] = __builtin_amdgcn_mfma_f32_16x16x32_bf16(wf[nt][kk], xf, acc[nt], 0, 0, 0); }
#pragma unroll
        for (int nt = 0; nt < 4; ++nt) { const int c0 = 16 * nt + 4 * fq; const f32x4 ba = *(const LAS f32x4*)(CST + c0), bi = *(const LAS f32x4*)(CST + 64 + c0), sp = *(const LAS f32x4*)(CST + 128 + c0);
            const f32x4 xcv = *(const LAS f32x4*)(XF + fr * 68 + c0); f32x4 av, bv;
#pragma unroll
            for (int i = 0; i < 4; ++i) { const float r = sigmoidf_(acc[nt][i] + ba[i]), ig = sigmoidf_(acc[nt + 4][i] + bi[i]); const float la = r * sp[i], a = __builtin_amdgcn_exp2f(LOG2E * la);
                const float om = 1.0f - a * a;
                av[i] = a; bv[i] = __builtin_amdgcn_sqrtf(fmaxf(om, 0.f)) * (ig * xcv[i]); }
            *(LAS f32x4*)(AA + fr * 68 + c0) = av; *(LAS f32x4*)(XF + fr * 68 + c0) = bv; }
        asm volatile("" ::: "memory");
        { float P = 1.f, H = 0.f;
#pragma unroll
          for (int j = 0; j < 16; ++j) { const int e = dir ? 15 - j : j; const float a = AA[e * 68 + ch], bb = XF[e * 68 + ch]; H = a * H + bb; P *= a; }
          PH[(par * 2 + 0) * 512 + w * 64 + ch] = P; PH[(par * 2 + 1) * 512 + w * 64 + ch] = H; }
        __syncthreads();
        float h = CAR[par * 64 + ch];
        for (int s2 = 0; s2 < w; ++s2) h = PH[(par * 2 + 0) * 512 + s2 * 64 + ch] * h + PH[(par * 2 + 1) * 512 + s2 * 64 + ch];
        { bf16_t* rp = REC + (size_t)(rowbase + t0 + e0) * D + dir * 512 + cgl;
#pragma unroll
          for (int j = 0; j < 16; ++j) { const int e = dir ? 15 - j : j; h = AA[e * 68 + ch] * h + XF[e * 68 + ch]; rp[(size_t)e * D] = f2bf(h * gy[j]); } }
        asm volatile("" ::: "memory");
        if (w == 7) { CAR[(par ^ 1) * 64 + ch] = h; hfin = h; }
    }
    if (!latent && w == 7) C.out[OUT_ST + ((size_t)(b * 2 + l) * 2 + dir) * 512 + cgl] = hfin;
}

#define XB_TMO      128
#define XB_XCNT(j)  (256  + 64 * (j))
#define XB_XSUB(j)  (1280 + 64 * (j))
#define XB_XGEN(j)  (2304 + 64 * (j))
#define XB_TOP      3328
#define XB_TOPGEN   3392
#define XCD_BAR_WORDS 3456
#define XB_SPIN_CAP (1u << 18)

__device__ __forceinline__ unsigned xb_ld(unsigned* p)              { return __hip_atomic_load(p, __ATOMIC_RELAXED, __HIP_MEMORY_SCOPE_AGENT); }
__device__ __forceinline__ unsigned xb_add(unsigned* p, unsigned v) { return __hip_atomic_fetch_add(p, v, __ATOMIC_RELAXED, __HIP_MEMORY_SCOPE_AGENT); }
__device__ __forceinline__ unsigned xb_xcc_id() { return (unsigned)__builtin_amdgcn_s_getreg((3 << 11) | 20) & 0xFu; }
#define XB_SPIN(cond, bar) do { unsigned _sp = 0; while (cond) { __builtin_amdgcn_s_sleep(1); \
    if ((++_sp & 255u) == 0u) { if (xb_ld(&(bar)[XB_TMO])) break; if (_sp > XB_SPIN_CAP) { atomicAdd(&(bar)[XB_TMO], 1u); break; } } } } while (0)

struct XcdBarrier {
    unsigned* bar; unsigned x;
    volatile LAS unsigned* st;
};

__device__ __forceinline__ XcdBarrier xcd_barrier_post(unsigned* bar, volatile LAS unsigned* st, int tid) {
    XcdBarrier b; b.bar = bar; b.x = xb_xcc_id(); b.st = st;
    if (tid == 0) (void)xb_add(&bar[XB_XCNT(b.x)], 1u);
    return b;
}
__device__ __forceinline__ void xcd_barrier_complete(unsigned* bar, unsigned x, unsigned& nloc, unsigned& nx) {
    const unsigned G = gridDim.x * gridDim.y * gridDim.z;
    unsigned sum, cnt, mine, sp = 0u;
    for (;;) {
        sum = 0u; cnt = 0u; mine = 0u;
#pragma unroll
        for (unsigned j = 0; j < 16; ++j) { const unsigned c = xb_ld(&bar[XB_XCNT(j)]); sum += c; cnt += (c > 0u) ? 1u : 0u; mine = (j == x) ? c : mine; }
        if (sum == G) break;
        __builtin_amdgcn_s_sleep(1);
        if ((++sp & 255u) == 0u) { if (xb_ld(&bar[XB_TMO])) break; if (sp > XB_SPIN_CAP) { atomicAdd(&bar[XB_TMO], 1u); break; } }
    }
    nloc = mine > 0u ? mine : 1u; nx = cnt > 0u ? cnt : 1u;
}

__device__ __forceinline__ void xcd_barrier(const XcdBarrier& b, int tid) {
    asm volatile("s_waitcnt vmcnt(0)" ::: "memory");
    __syncthreads();
    if (tid == 0) {
        unsigned* bar = b.bar;
        __builtin_amdgcn_s_waitcnt(0);
        unsigned nloc = b.st[0], nx = b.st[1];
        if (nloc == 0u) { xcd_barrier_complete(bar, b.x, nloc, nx); b.st[0] = nloc; b.st[1] = nx; }
        const unsigned old = xb_add(&bar[XB_XSUB(b.x)], 1u);
        const unsigned gen = old / nloc;
        if (old + 1u == (gen + 1u) * nloc) {
            __builtin_amdgcn_fence(__ATOMIC_RELEASE, "agent");
            asm volatile("s_waitcnt vmcnt(0)" ::: "memory");
            const unsigned og = xb_add(&bar[XB_TOP], 1u);
            const unsigned tg = og / nx;
            if (og + 1u == (tg + 1u) * nx) xb_add(&bar[XB_TOPGEN], 1u);
            else XB_SPIN(xb_ld(&bar[XB_TOPGEN]) == tg, bar);
            __builtin_amdgcn_fence(__ATOMIC_ACQUIRE, "agent");
            xb_add(&bar[XB_XGEN(b.x)], 1u);
            asm volatile("s_waitcnt vmcnt(0)" ::: "memory");
        } else {
            XB_SPIN(xb_ld(&bar[XB_XGEN(b.x)]) == gen, bar);
            __builtin_amdgcn_fence(__ATOMIC_ACQUIRE, "agent");
            asm volatile("s_waitcnt vmcnt(0)" ::: "memory");
        }
    }
    __syncthreads();
}

#ifndef PROBE_ITEM
#define PROBE_ITEM 0
#endif
#ifndef PROBE_STAT
#define PROBE_STAT 0
#endif
constexpr int CW_PROBE = 3700;
struct OneUnit { Unit u; __device__ bool next(int i, Unit& o) const { if (i) return false; o = u; return true; } };
constexpr int MX_DFTL = 64, MX_LRUL = 64, MX_ATTL = 256, MX_LRUC = 256, MX_ATTC = 128, MX_DFTC = 32;
constexpr int MX_N = MX_DFTL + MX_LRUL + MX_ATTL + MX_LRUC + MX_ATTC + MX_DFTC;
constexpr int CW_QUEUE = 3520;
__device__ __forceinline__ void mixer_phase(ArgsP args_in, const Ctx& C_in, int l_in) {
    for (;;) {
        ArgsP args = args_in; asm volatile("" : "+s"(args));
        int tid_ = C_in.tid; asm volatile("" : "+v"(tid_));
        int l = l_in; asm volatile("" : "+s"(l));
        Ctx C; C.out = args->out; C.ws = args->ws; C.lds = C_in.lds; C.tid = tid_; C.lane = tid_ & 63; C.wave = __builtin_amdgcn_readfirstlane(tid_ >> 6); C.bid = C_in.bid; C.G = C_in.G;
        volatile LAS int* qslot = (volatile LAS int*)(C.lds + 131072 + 64);
        unsigned* qhead = (unsigned*)(C.ws + WS_CTL) + CW_QUEUE + 64 * l;
        __syncthreads();
        if (C.tid == 0) qslot[0] = (int)__hip_atomic_fetch_add(qhead, 1u, __ATOMIC_RELAXED, __HIP_MEMORY_SCOPE_AGENT);
        __syncthreads();
        int idx = __builtin_amdgcn_readfirstlane(qslot[0]);
        if (idx >= MX_N) break;
        const unsigned long long pt0 = (PROBE_ITEM != 0) ? __builtin_amdgcn_s_memrealtime() : 0ull; int ptype = 0;
        if (idx < MX_DFTL) { const int z = idx >> 4, pm = (idx >> 1) & 7, pn = idx & 1;
            OneUnit S; S.u.pm = pm; S.u.pn = pn; S.u.z = z; S.u.A = (const bf16_t*)(C.ws + WS_DFTL) + (size_t)pm * 256 * LS; S.u.B = (const bf16_t*)act_ptr(C, A_XFT) + (size_t)16 * 512 * LC + ((size_t)z * 512 + pn * 256) * LS;
            EpiDft E{(bf16_t*)act_ptr(C, A_Z), LS, MP + z * LS}; GEMM(C, S, E, LS, LS, LS); ptype = 1; }
        else { idx -= MX_DFTL;
        if (idx < MX_LRUL) { lru_item(args, C, l, idx); ptype = 2; } else { idx -= MX_LRUL;
        if (idx < MX_ATTL) { attn_unit(args, C, l, idx); ptype = 3; } else { idx -= MX_ATTL;
        if (idx < MX_LRUC) { lru_item(args, C, l, 64 + idx); ptype = 4; } else { idx -= MX_LRUC;
        if (idx < MX_ATTC) { attn_unit(args, C, l, 256 + idx); ptype = 5; } else { idx -= MX_ATTC;
        { const int z = idx >> 1, pn = idx & 1; ptype = 6;
            OneUnit S; S.u.pm = 0; S.u.pn = pn; S.u.z = z; S.u.A = (const bf16_t*)(C.ws + WS_DFTC); S.u.B = (const bf16_t*)act_ptr(C, A_XFT) + ((size_t)z * 512 + pn * 256) * LC;
            EpiDft E{(bf16_t*)act_ptr(C, A_Z), LC, z * LC}; GEMM(C, S, E, LC, LC, LC); } } } } } }
        if (PROBE_ITEM != 0 && ptype == PROBE_ITEM && C.tid == 0) { const unsigned dt = (unsigned)(__builtin_amdgcn_s_memrealtime() - pt0); unsigned* pw = (unsigned*)(C.ws + WS_CTL) + CW_PROBE;
            if (PROBE_STAT == 0) atomicMax(pw, dt); else atomicAdd(pw, dt); }
    }
}

#ifndef PROBE_MASK
#define PROBE_MASK 0u
#endif
constexpr int N_PHASES = 19;
__device__ __forceinline__ void run_phase(ArgsP args, const Ctx& C, int ph) {
    if (ph == 0) { p0_prologue(args, C); return; }
    if (ph == 1) { p0b_phase(args, C); return; }
    if (ph == N_PHASES - 1) { finalnorm_phase(args, C); return; }
    const int l = (ph - 2) >> 3, s = (ph - 2) & 7;
    const float* MODB = (const float*)(C.ws + OFF_MOD);
    if (s == 0 || s == 6) { const int sub = s ? 2 : 0; StaticOrder S; S.init(M, 2 * DFF, C.G, C.bid, (const bf16_t*)act_ptr(C, A_XN), D, (const bf16_t*)wl_ptr(C, l, s ? WL_GU2 : WL_GU1), D);
        EpiGU E{(bf16_t*)act_ptr(C, A_G), ssq_ptr(C, l * 3 + sub), sw_ptr(C, l, sub, 0)}; GEMM(C, S, E, D, D, D); }
    else if (s == 1 || s == 7) { const int sub = (s == 1) ? 0 : 2; const bool first = (l == 0 && s == 1);
        int ln = l, subn = 1; if (s == 7) { ln = (l == 0) ? 1 : -1; subn = 0; }
        const int sidx = (ln < 0) ? 6 : ln * 3 + subn;
        StaticOrder S; S.init(M, D, C.G, C.bid, (const bf16_t*)act_ptr(C, A_G), DFF, (const bf16_t*)wl_ptr(C, l, s == 1 ? WL_D1 : WL_D2), DFF);
        EpiRes E{C.out, first ? args->in[0] : C.out, first ? args->in[1] : C.out + (size_t)MP * D, MODB,
                 (bf16_t*)act_ptr(C, A_XN), args->in[9] + (size_t)((ln < 0 ? 0 : ln) * 3 + subn) * D, ssq_ptr(C, sidx), l, sub, ln, subn, 0.5f};
        GEMM(C, S, E, DFF, DFF, DFF);
        if (first) bg_layer1_transposes(args, C); }
    else if (s == 2) { StaticOrder S; S.init(M, NIN, C.G, C.bid, (const bf16_t*)act_ptr(C, A_XN), D, (const bf16_t*)wl_ptr(C, l, WL_IN), D);
        EpiIn E{(bf16_t*)act_ptr(C, A_Q), (bf16_t*)act_ptr(C, A_K), (bf16_t*)act_ptr(C, A_VT), (bf16_t*)act_ptr(C, A_GY), (bf16_t*)act_ptr(C, A_XFT), (bf16_t*)act_ptr(C, A_G),
                (float*)act_ptr(C, A_XR), C.out, (const float*)(C.ws + OFF_ROPE), args->in[19] + (size_t)l * 3072, l, ssq_ptr(C, l * 3 + 1), sw_ptr(C, l, 1, 0)};
        GEMM(C, S, E, D, D, D); }
    else if (s == 3) { mixer_phase(args, C, l); }
    else if (s == 4) {
        bf16_t* MG = (bf16_t*)act_ptr(C, A_XR); const bf16_t* G = (const bf16_t*)act_ptr(C, A_G);
        { StaticOrder S; S.init(M, D, C.G, C.bid, (const bf16_t*)act_ptr(C, A_Q), 512, (const bf16_t*)wl_ptr(C, l, WL_A), 512); EpiBranch<0> E{MG, G, 0}; GEMM(C, S, E, 512, 512, 512); }
        { StaticOrder S; S.init(M, D, C.G, C.bid, (const bf16_t*)act_ptr(C, A_XN), D, (const bf16_t*)wl_ptr(C, l, WL_L2), D); EpiBranch<1> E{MG, G, 1}; GEMM(C, S, E, D, D, D); }
        { StaticOrder S; S.init(M, D, C.G, C.bid, (const bf16_t*)act_ptr(C, A_Z), D, (const bf16_t*)wl_ptr(C, l, WL_F2), D); EpiBranch<1> E{MG, G, 2}; GEMM(C, S, E, D, D, D); } }
    else if (s == 5) { StaticOrder S; S.init(M, D, C.G, C.bid, (const bf16_t*)act_ptr(C, A_XR), D, (const bf16_t*)wl_ptr(C, l, WL_O), D);
        EpiRes E{C.out, C.out, C.out + (size_t)MP * D, MODB, (bf16_t*)act_ptr(C, A_XN), args->in[9] + (size_t)(l * 3 + 2) * D, ssq_ptr(C, l * 3 + 2), l, 1, l, 2, 1.0f};
        GEMM(C, S, E, D, D, D);
        if (l == 0) bg_layer1_wf2(args, C); }
}

__global__ void __launch_bounds__(NTHREADS, 2) fwd_kernel(Args args_byval) {
    extern __shared__ __attribute__((aligned(16))) unsigned char lds_raw[];
    ArgsP args0 = (ArgsP)__builtin_amdgcn_kernarg_segment_ptr();
    const int lo = args0->ph_lo, hi = args0->ph_hi;
    volatile LAS unsigned* bst = (volatile LAS unsigned*)((LAS unsigned char*)lds_raw + 131072);
    const int wave0 = __builtin_amdgcn_readfirstlane(threadIdx.x >> 6);
#define TID_NOW() ({ unsigned z_ = 0u; asm volatile("" : "+s"(z_)); wave0 * 64 + (int)__builtin_amdgcn_mbcnt_hi(~0u, __builtin_amdgcn_mbcnt_lo(~0u, z_)); })
    { const int t = TID_NOW(); if (t < 2) bst[t] = 0u; }
    __syncthreads();
    (void)xcd_barrier_post((unsigned*)(args0->ws + WS_CTL), bst, TID_NOW());
    volatile LAS unsigned long long* tacc = (volatile LAS unsigned long long*)((LAS unsigned char*)lds_raw + 131072 + 128);
    if (PROBE_MASK != 0u && blockIdx.x == 0 && TID_NOW() == 0) { tacc[0] = __builtin_amdgcn_s_memrealtime(); tacc[1] = 0ull; }
    for (int ph = lo; ph < hi; ++ph) {
        ArgsP args = args0; asm volatile("" : "+s"(args));
        int tid = TID_NOW(); asm volatile("" : "+v"(tid));
        int bid = blockIdx.x; asm volatile("" : "+s"(bid));
        Ctx C; C.out = args->out; C.ws = args->ws; C.lds = (LAS unsigned char*)lds_raw;
        C.tid = tid; C.lane = tid & 63; C.wave = __builtin_amdgcn_readfirstlane(tid >> 6); C.bid = bid; C.G = gridDim.x;
        run_phase(args, C, ph);
        if (ph + 1 < hi) {
            { XcdBarrier xb; xb.bar = (unsigned*)(args->ws + WS_CTL); xb.x = xb_xcc_id(); xb.st = bst; xcd_barrier(xb, TID_NOW()); } }
        if (PROBE_MASK != 0u && blockIdx.x == 0 && TID_NOW() == 0) { const unsigned long long now = __builtin_amdgcn_s_memrealtime(); if ((PROBE_MASK >> ph) & 1u) tacc[1] = tacc[1] + (now - tacc[0]); tacc[0] = now; }
    }
    if (PROBE_ITEM != 0 && blockIdx.x == 0 && TID_NOW() == 0) { const unsigned v = __hip_atomic_load((unsigned*)(args0->ws + WS_CTL) + CW_PROBE, __ATOMIC_RELAXED, __HIP_MEMORY_SCOPE_AGENT); const unsigned long long want = PROBE_STAT ? v / 256u : v, t0 = __builtin_amdgcn_s_memrealtime(); while (__builtin_amdgcn_s_memrealtime() - t0 < want) __builtin_amdgcn_s_sleep(8); }
    if (PROBE_MASK != 0u && blockIdx.x == 0 && TID_NOW() == 0) { const unsigned long long t0 = tacc[0], want = tacc[1]; while (__builtin_amdgcn_s_memrealtime() - t0 < want) __builtin_amdgcn_s_sleep(8); }
#undef TID_NOW
}

extern "C" void kernel_launch(void* const* d_in, const int* in_sizes, int n_in, void* d_out, int out_size, void* d_ws, size_t ws_size, hipStream_t stream) {
    if (n_in != 32 || ws_size < WS_END) { fprintf(stderr, "kernel_launch: n_in %d ws %zu (need %zu)\n", n_in, ws_size, (size_t)WS_END); return; }
    static int grid = 0;
    if (grid == 0) {
        int dev = 0, cus = 0, per_cu = 0;
        if (hipGetDevice(&dev) != hipSuccess || hipDeviceGetAttribute(&cus, hipDeviceAttributeMultiprocessorCount, dev) != hipSuccess) { fprintf(stderr, "kernel_launch: device query failed\n"); grid = -1; return; }
        if (hipFuncSetAttribute((const void*)fwd_kernel, hipFuncAttributeMaxDynamicSharedMemorySize, LDS_BYTES) != hipSuccess) { fprintf(stderr, "hipFuncSetAttribute failed\n"); grid = -1; return; }
        if (hipOccupancyMaxActiveBlocksPerMultiprocessor(&per_cu, (const void*)fwd_kernel, NTHREADS, LDS_BYTES) != hipSuccess || per_cu < 1) { fprintf(stderr, "kernel_launch: occupancy query says %d blocks per CU\n", per_cu); grid = -1; return; }
        if (per_cu > 1) per_cu = 1;
        grid = cus * per_cu;
    }
    if (grid < 0) return;
    Args a{};
    for (int i = 0; i < 32; ++i) a.in[i] = (const float*)d_in[i];
    a.out = (float*)d_out; a.ws = (unsigned char*)d_ws;
    a.ph_lo = 0; a.ph_hi = N_PHASES;
    if (hipMemsetAsync((char*)d_ws + WS_CTL, 0, CTL_ZERO_BYTES, stream) != hipSuccess) { fprintf(stderr, "hipMemsetAsync failed\n"); return; }
    void* kargs[] = {&a};
    hipError_t e = hipLaunchCooperativeKernel((const void*)fwd_kernel, dim3(grid), dim3(NTHREADS), kargs, LDS_BYTES, stream);
    if (e != hipSuccess) fprintf(stderr, "cooperative launch failed: %s (grid %d)\n", hipGetErrorString(e), grid);
}
```

```cpp
#include <hip/hip_runtime.h>
#include <hip/hip_cooperative_groups.h>
#include <cstdint>
#include <cstdio>


#define LAS __attribute__((address_space(3)))
typedef unsigned short bf16_t;
typedef short bf16x8 __attribute__((ext_vector_type(8)));
typedef float f32x4 __attribute__((ext_vector_type(4)));
typedef float f32x2 __attribute__((ext_vector_type(2)));
typedef float f32x16 __attribute__((ext_vector_type(16)));
typedef unsigned u32x4 __attribute__((ext_vector_type(4)));
typedef unsigned u32x2 __attribute__((ext_vector_type(2)));

constexpr int D = 1024, MP = 4096, MS = 8192, M = MP + MS, DFF = 2816, DEPTH = 2;
constexpr int LC = 256, LS = 2048;
constexpr int NB_C = 16, NB_S = 4;
constexpr int NIN = 2304 + 3072;
constexpr int NMOD = 9216;
constexpr float EPS = 1e-6f;
constexpr float LOG2E = 1.4426950408889634f;
constexpr float QSCALE = 0.125f * LOG2E;

constexpr size_t MiB = 1u << 20;
constexpr size_t SZ_WGU = (size_t)2 * DFF * D * 2, SZ_WD = (size_t)D * DFF * 2, SZ_WIN = (size_t)NIN * D * 2;
constexpr size_t SZ_WA = (size_t)D * 512 * 2, SZ_W1K = (size_t)D * D * 2;
constexpr size_t WL_GU1 = 0, WL_D1 = WL_GU1 + SZ_WGU, WL_GU2 = WL_D1 + SZ_WD, WL_D2 = WL_GU2 + SZ_WGU, WL_IN = WL_D2 + SZ_WD,
                 WL_A = WL_IN + SZ_WIN, WL_L2 = WL_A + SZ_WA, WL_F2 = WL_L2 + SZ_W1K, WL_O = WL_F2 + SZ_W1K, WL_SIZE = WL_O + SZ_W1K;
constexpr size_t WS_CTL = 0;
constexpr size_t WS_MISC = 1 * MiB;
constexpr size_t OFF_MOD = WS_CTL + 65536;
constexpr size_t OFF_SSQ = OFF_MOD + (size_t)2 * 5 * NMOD * 4;
constexpr size_t CTL_ZERO_BYTES = 32768;
static_assert(OFF_SSQ + (size_t)7 * M * 4 - WS_CTL <= 1048576, "control region");
constexpr size_t OFF_ROPE = WS_MISC;
constexpr size_t OFF_CK = OFF_ROPE + 2 * 1024 * 4;
constexpr size_t OFF_CVT = OFF_CK + (size_t)4 * 2 * 256 * 128 * 2;
constexpr size_t OFF_LWT = OFF_CVT + (size_t)4 * 2 * 2 * 64 * 256 * 2;
constexpr size_t WS_DFTC = 3 * MiB;
constexpr size_t WS_DFTL = 4 * MiB;
constexpr size_t OFF_SW = 12 * MiB;
constexpr size_t WS_W = 20 * MiB;
constexpr size_t WS_ACT = WS_W + 2 * WL_SIZE;
constexpr size_t A_G = 0;
constexpr size_t A_XN = 72 * MiB;
constexpr size_t A_XR = 96 * MiB;
constexpr size_t A_GY = 120 * MiB;
constexpr size_t A_XFT = 132 * MiB;
constexpr size_t A_Q = 144 * MiB;
constexpr size_t A_K = 156 * MiB;
constexpr size_t A_VT = 159 * MiB;
constexpr size_t A_Z = 162 * MiB;
constexpr size_t A_END = 186 * MiB;
constexpr size_t WS_END = WS_ACT + A_END;

constexpr int OUT_YS = MP * D, OUT_CK = M * D, OUT_CV = OUT_CK + 16 * 2 * 256 * 128, OUT_ST = OUT_CV + 16 * 2 * 256 * 128;

constexpr int NTHREADS = 512, NWAVES = 8;
constexpr int LDS_BYTES = 147456;

typedef __bf16 bf16x2_t __attribute__((ext_vector_type(2)));
__device__ __forceinline__ unsigned cvt_pk_bf16(float lo, float hi) { f32x2 v = {lo, hi}; bf16x2_t b = __builtin_convertvector(v, bf16x2_t); return __builtin_bit_cast(unsigned, b); }
__device__ __forceinline__ bf16_t f2bf(float f) { return (bf16_t)(cvt_pk_bf16(f, 0.f) & 0xffffu); }
__device__ __forceinline__ float bf2f(unsigned h) { return __uint_as_float(h << 16); }
__device__ __forceinline__ float bflo(unsigned w) { return __uint_as_float(w << 16); }
__device__ __forceinline__ float bfhi(unsigned w) { return __uint_as_float(w & 0xffff0000u); }
__device__ __forceinline__ float fast_rcp(float x) { return __builtin_amdgcn_rcpf(x); }
__device__ __forceinline__ float sigmoidf_(float x) { return fast_rcp(1.0f + __builtin_amdgcn_exp2f(-LOG2E * x)); }
__device__ __forceinline__ float siluf_(float x) { return x * sigmoidf_(x); }
__device__ __forceinline__ float gelu_tanh(float x) { const float u = (-2.0f * LOG2E * 0.7978845608028654f) * (x + 0.044715f * x * x * x); return x * fast_rcp(1.0f + __builtin_amdgcn_exp2f(u)); }
template <int CTRL> __device__ __forceinline__ float dpp_f(float v) { return __builtin_bit_cast(float, __builtin_amdgcn_update_dpp(0, __builtin_bit_cast(int, v), CTRL, 0xf, 0xf, true)); }
__device__ __forceinline__ float sum_x16(float v) { unsigned a = __builtin_bit_cast(unsigned, v), b = a; asm volatile("" : "+v"(b)); const auto r = __builtin_amdgcn_permlane16_swap(a, b, false, false); unsigned r0 = r[0], r1 = r[1]; asm volatile("" : "+v"(r0), "+v"(r1)); return __builtin_bit_cast(float, r0) + __builtin_bit_cast(float, r1); }
__device__ __forceinline__ float sum_x32(float v) { unsigned a = __builtin_bit_cast(unsigned, v), b = a; asm volatile("" : "+v"(b)); const auto r = __builtin_amdgcn_permlane32_swap(a, b, false, false); unsigned r0 = r[0], r1 = r[1]; asm volatile("" : "+v"(r0), "+v"(r1)); return __builtin_bit_cast(float, r0) + __builtin_bit_cast(float, r1); }
__device__ __forceinline__ float wave_sum(float v) {
    v += dpp_f<0xB1>(v); v += dpp_f<0x4E>(v); v += dpp_f<0x141>(v); v += dpp_f<0x140>(v);
    return sum_x32(sum_x16(v));
}
__device__ __forceinline__ int cond_of_row(int r) { return r < MP ? 4 : ((r - MP) >> 11); }

struct Args {
    const float* in[32];
    float* out;
    unsigned char* ws;
    int ph_lo, ph_hi;
};

typedef const __attribute__((address_space(4))) Args* ArgsP;
struct Ctx {
    float* out; unsigned char* ws; LAS unsigned char* lds;
    int tid, lane, wave, bid, G;
};
__device__ __forceinline__ unsigned char* wl_ptr(const Ctx& C, int l, size_t off) { return C.ws + WS_W + (size_t)l * WL_SIZE + off; }
__device__ __forceinline__ unsigned char* act_ptr(const Ctx& C, size_t off) { return C.ws + WS_ACT + off; }
__device__ __forceinline__ const float* mod_ptr(const Ctx& C, int l, int c, int sub, int which) { return (const float*)(C.ws + OFF_MOD) + ((size_t)(l * 5 + c) * NMOD + (sub * 3 + which) * D); }

struct TrItem { const float* W; bf16_t* WT; int ldw, ldt, drow0, dcol0, k0, n0; };
constexpr int I_G = 16 * 88, I_D = 44 * 32, I_IN = 16 * 72, I_BG = 16 * 96, I_A = 8 * 32, I_L = 8 * 32, I_O = 16 * 32;
constexpr int TR_PER_LAYER = 4 * I_G + 2 * I_D + I_IN + I_BG + I_A + 2 * I_L + I_O;
__device__ __forceinline__ TrItem p0_decode(ArgsP args, const Ctx& C, int it) {
    const int l = it / TR_PER_LAYER; int r = it % TR_PER_LAYER; TrItem t; t.dcol0 = 0;
    if (r < 2 * I_G) { const int gu = r >= I_G; r -= gu * I_G; const int kb = r / 88, n0 = (r % 88) * 32; t.W = args->in[11 + gu] + (size_t)l * D * DFF; t.ldw = DFF; t.WT = (bf16_t*)wl_ptr(C, l, WL_GU1); t.ldt = D; t.drow0 = 256 * (n0 >> 7) + 128 * gu + (n0 & 127); t.k0 = kb * 64; t.n0 = n0; return t; } r -= 2 * I_G;
    if (r < I_D) { const int kb = r / 32, nb = r % 32; t.W = args->in[13] + (size_t)l * DFF * D; t.ldw = D; t.WT = (bf16_t*)wl_ptr(C, l, WL_D1); t.ldt = DFF; t.drow0 = nb * 32; t.k0 = kb * 64; t.n0 = nb * 32; return t; } r -= I_D;
    if (r < 2 * I_G) { const int gu = r >= I_G; r -= gu * I_G; const int kb = r / 88, n0 = (r % 88) * 32; t.W = args->in[14 + gu] + (size_t)l * D * DFF; t.ldw = DFF; t.WT = (bf16_t*)wl_ptr(C, l, WL_GU2); t.ldt = D; t.drow0 = 256 * (n0 >> 7) + 128 * gu + (n0 & 127); t.k0 = kb * 64; t.n0 = n0; return t; } r -= 2 * I_G;
    if (r < I_D) { const int kb = r / 32, nb = r % 32; t.W = args->in[16] + (size_t)l * DFF * D; t.ldw = D; t.WT = (bf16_t*)wl_ptr(C, l, WL_D2); t.ldt = DFF; t.drow0 = nb * 32; t.k0 = kb * 64; t.n0 = nb * 32; return t; } r -= I_D;
    if (r < I_IN) { const int kb = r / 72, nb = r % 72; t.W = args->in[17] + (size_t)l * D * 2304; t.ldw = 2304; t.WT = (bf16_t*)wl_ptr(C, l, WL_IN); t.ldt = D; t.drow0 = nb * 32; t.k0 = kb * 64; t.n0 = nb * 32; return t; } r -= I_IN;
    if (r < I_BG) { const int kb = r / 96, nb = r % 96; t.W = args->in[18] + (size_t)l * D * 3072; t.ldw = 3072; t.WT = (bf16_t*)wl_ptr(C, l, WL_IN); t.ldt = D; t.drow0 = 2304 + nb * 32; t.k0 = kb * 64; t.n0 = nb * 32; return t; } r -= I_BG;
    if (r < I_A) { const int kb = r / 32, nb = r % 32; t.W = args->in[21] + (size_t)l * 512 * D; t.ldw = D; t.WT = (bf16_t*)wl_ptr(C, l, WL_A); t.ldt = 512; t.drow0 = nb * 32; t.k0 = kb * 64; t.n0 = nb * 32; return t; } r -= I_A;
    if (r < 2 * I_L) { const int dup = r >= I_L; r -= dup * I_L; const int kb = r / 32, nb = r % 32; t.W = args->in[29] + (size_t)l * 512 * D; t.ldw = D; t.WT = (bf16_t*)wl_ptr(C, l, WL_L2); t.ldt = D; t.drow0 = nb * 32; t.dcol0 = 512 * dup; t.k0 = kb * 64; t.n0 = nb * 32; return t; } r -= 2 * I_L;
    { const int kb = r / 32, nb = r % 32; t.W = args->in[31] + (size_t)l * D * D; t.ldw = D; t.WT = (bf16_t*)wl_ptr(C, l, WL_O); t.ldt = D; t.drow0 = nb * 32; t.k0 = kb * 64; t.n0 = nb * 32; return t; }
}
__device__ __forceinline__ void p0_tr_load(const TrItem& t, f32x4 (&r)[8], int lane) {
    const float* p = t.W + (size_t)(t.k0 + (lane >> 3)) * t.ldw + t.n0 + 4 * (lane & 7);
#pragma unroll
    for (int i = 0; i < 8; ++i) r[i] = *(const f32x4*)(p + (size_t)(8 * i) * t.ldw);
}
__device__ __forceinline__ void p0_tr_store(const TrItem& t, const f32x4 (&r)[8], LAS float* scr, int lane) {
#pragma unroll
    for (int i = 0; i < 8; ++i) { LAS float* p = scr + (8 * i + (lane >> 3)) * 33 + 4 * (lane & 7); p[0] = r[i].x; p[1] = r[i].y; p[2] = r[i].z; p[3] = r[i].w; }
    asm volatile("s_waitcnt lgkmcnt(0)" ::: "memory");
    const int c = lane & 7;
#pragma unroll
    for (int j = 0; j < 4; ++j) { const int n = (lane >> 3) + 8 * j; const LAS float* q = scr + (8 * c) * 33 + n;
        u32x4 o; o.x = cvt_pk_bf16(q[0 * 33], q[1 * 33]); o.y = cvt_pk_bf16(q[2 * 33], q[3 * 33]); o.z = cvt_pk_bf16(q[4 * 33], q[5 * 33]); o.w = cvt_pk_bf16(q[6 * 33], q[7 * 33]);
        *(u32x4*)(t.WT + (size_t)(t.drow0 + n) * t.ldt + t.dcol0 + t.k0 + 8 * c) = o; }
    asm volatile("s_waitcnt lgkmcnt(0)" ::: "memory");
}

__device__ __forceinline__ void p0_transposes(ArgsP args, const Ctx& C, LAS float* SCR, int it0, int it1, int gw, int NGW) {
    LAS float* scr = SCR + C.wave * (64 * 33);
    int it = it0 + gw; TrItem cur; f32x4 rc[8];
    if (it < it1) { cur = p0_decode(args, C, it); p0_tr_load(cur, rc, C.lane); }
    while (it < it1) {
        const int it2 = it + NGW; const bool more = it2 < it1; TrItem nxt = cur; f32x4 rn[8];
        if (more) { nxt = p0_decode(args, C, it2); p0_tr_load(nxt, rn, C.lane); }
        p0_tr_store(cur, rc, scr, C.lane);
        if (more) { cur = nxt;
#pragma unroll
            for (int i = 0; i < 8; ++i) rc[i] = rn[i]; }
        it = it2;
    }
}
constexpr int BG_NA = TR_PER_LAYER - 2 * I_G, BG_NB = (5376 + 5632) / 8, BG_NC = 512, BG_ND = TR_PER_LAYER, BG_NE = (5632 + 5376 + 5632) / 8, BG_NF = 512;
static_assert(BG_NA % 32 == 0 && BG_ND % 32 == 0 && BG_NB % 8 == 0 && BG_NE % 8 == 0, "background batches");
constexpr int CW_BGQ = 4096, CW_DONE = 3632;
constexpr int BG_SCR = 61440;
__device__ __forceinline__ void bg_load_shifts(const Ctx& C, int l) {
    LAS float* SH = (LAS float*)C.lds;
    __syncthreads();
    for (int i = C.tid; i < 15 * 1024; i += NTHREADS) { const int k = i & 1023, c = (i >> 10) % 5, sub = (i >> 10) / 5; SH[i] = mod_ptr(C, l, c, sub, 0)[k]; }
    __syncthreads();
}
__device__ __forceinline__ void sw_rows(const Ctx& C, int l, int r0, int nr) {
    const LAS float* SH = (const LAS float*)C.lds;
    for (int it = r0; it < r0 + nr; ++it) {
        int n = it, sub = 0; size_t woff = WL_GU1;
        if (n >= 5632) { n -= 5632; sub = 1; woff = WL_IN; if (n >= 5376) { n -= 5376; sub = 2; woff = WL_GU2; } }
        const u32x4* wp = (const u32x4*)((const bf16_t*)wl_ptr(C, l, woff) + (size_t)n * D + 16 * C.lane);
        const u32x4 w0 = wp[0], w1 = wp[1];
        float wv[16] = {bflo(w0.x), bfhi(w0.x), bflo(w0.y), bfhi(w0.y), bflo(w0.z), bfhi(w0.z), bflo(w0.w), bfhi(w0.w), bflo(w1.x), bfhi(w1.x), bflo(w1.y), bfhi(w1.y), bflo(w1.z), bfhi(w1.z), bflo(w1.w), bfhi(w1.w)};
        float acc[5];
#pragma unroll
        for (int c = 0; c < 5; ++c) { const LAS f32x4* sp = (const LAS f32x4*)(SH + (sub * 5 + c) * 1024 + 16 * C.lane); float a = 0.f;
#pragma unroll
            for (int q = 0; q < 4; ++q) { const f32x4 sv = sp[q]; a += sv.x * wv[4 * q] + sv.y * wv[4 * q + 1] + sv.z * wv[4 * q + 2] + sv.w * wv[4 * q + 3]; }
            acc[c] = wave_sum(a); }
        if (C.lane < 5) { float* dst = (float*)(C.ws + OFF_SW) + (size_t)((l * 3 + sub) * 5 + C.lane) * 5632 + n;
            *dst = (C.lane == 0) ? acc[0] : (C.lane == 1) ? acc[1] : (C.lane == 2) ? acc[2] : (C.lane == 3) ? acc[3] : acc[4]; }
    }
}
__device__ __forceinline__ void wf2_item(ArgsP args, const Ctx& C, int l, int idx) {
    const int g = idx >> 7, n0 = ((idx >> 3) & 15) * 64, rt = idx & 7, trig = rt >> 2, c0 = 32 * (rt & 3), i32 = C.lane & 31, hk = C.lane >> 5, cc = c0 + i32;
    const float* Wf = args->in[30] + (size_t)l * 512 * D + (size_t)(g * 128) * D + n0 + i32;
    f32x16 acc0, acc1;
#pragma unroll
    for (int q = 0; q < 16; ++q) { acc0[q] = 0.f; acc1[q] = 0.f; }
#pragma unroll 8
    for (int kk = 0; kk < 64; ++kk) { const int q = 2 * kk + hk; const float ph = (float)((cc * q) & 127) * (1.0f / 128.0f); const float a = trig ? __builtin_amdgcn_sinf(ph) : __builtin_amdgcn_cosf(ph);
        const float b0 = Wf[(size_t)q * D], b1 = Wf[(size_t)q * D + 32];
        acc0 = __builtin_amdgcn_mfma_f32_32x32x2f32(a, b0, acc0, 0, 0, 0); acc1 = __builtin_amdgcn_mfma_f32_32x32x2f32(a, b1, acc1, 0, 0, 0); }
    const float sc = trig ? -0.08838834764831845f : 0.08838834764831845f;
    bf16_t* d0 = (bf16_t*)wl_ptr(C, l, WL_F2) + (size_t)(n0 + i32) * D + (trig ? 512 : 0) + g * 128 + c0 + 4 * hk;
#pragma unroll
    for (int q4 = 0; q4 < 4; ++q4) { u32x2 o; o.x = cvt_pk_bf16(acc0[4 * q4] * sc, acc0[4 * q4 + 1] * sc); o.y = cvt_pk_bf16(acc0[4 * q4 + 2] * sc, acc0[4 * q4 + 3] * sc); *(u32x2*)(d0 + 8 * q4) = o;
        o.x = cvt_pk_bf16(acc1[4 * q4] * sc, acc1[4 * q4 + 1] * sc); o.y = cvt_pk_bf16(acc1[4 * q4 + 2] * sc, acc1[4 * q4 + 3] * sc); *(u32x2*)(d0 + (size_t)32 * D + 8 * q4) = o; }
}
__device__ __forceinline__ void bg_run(ArgsP args, const Ctx& C, int seg, bool forced, int ph, int need) {
    unsigned* ctl = (unsigned*)(C.ws + WS_CTL);
    volatile LAS int* slot = (volatile LAS int*)(C.lds + 131072 + 192);
    const int count = ((seg == 0) ? BG_NA / 4 : (seg == 1) ? BG_NB : (seg == 2) ? BG_NC : (seg == 3) ? BG_ND / 4 : (seg == 4) ? BG_NE : BG_NF) / 8;
    for (;;) {
        __syncthreads();
        if (C.tid == 0) { int v = count;
            if (forced || (int)__hip_atomic_load(ctl + CW_DONE + ph, __ATOMIC_RELAXED, __HIP_MEMORY_SCOPE_AGENT) < need) v = (int)__hip_atomic_fetch_add(ctl + CW_BGQ + 64 * seg, 1u, __ATOMIC_RELAXED, __HIP_MEMORY_SCOPE_AGENT);
            slot[0] = v; }
        __syncthreads();
        const int bidx = __builtin_amdgcn_readfirstlane(slot[0]);
        if (bidx >= count) break;
        const int idx = bidx * 8 + C.wave;
        if (seg == 0) p0_transposes(args, C, (LAS float*)(C.lds + BG_SCR), 2 * I_G + 4 * idx, 2 * I_G + 4 * idx + 4, 0, 1);
        else if (seg == 3) p0_transposes(args, C, (LAS float*)(C.lds + BG_SCR), TR_PER_LAYER + 4 * idx, TR_PER_LAYER + 4 * idx + 4, 0, 1);
        else if (seg == 1) sw_rows(C, 0, 5632 + 8 * idx, 8);
        else if (seg == 4) sw_rows(C, 1, 8 * idx, 8);
        else wf2_item(args, C, seg == 2 ? 0 : 1, idx);
    }
}
__device__ __forceinline__ void bg_signal_done(const Ctx& C, int ph) { if (C.tid == 0) __hip_atomic_fetch_add((unsigned*)(C.ws + WS_CTL) + CW_DONE + ph, 1u, __ATOMIC_RELAXED, __HIP_MEMORY_SCOPE_AGENT); }

__device__ __forceinline__ void p0_prologue(ArgsP args, const Ctx& C) {
    LAS float* SC = (LAS float*)C.lds;
    LAS float* TAB = (LAS float*)(C.lds + 20480);
    LAS float* SCR = (LAS float*)(C.lds + 32768);
    const float* c_in = args->in[2]; const float* cctx = args->in[6];
    for (int i = C.tid; i < 5 * 1024; i += NTHREADS) { const float v = (i < 4096) ? c_in[i] : cctx[i - 4096]; SC[i] = siluf_(v); }
    for (int i = C.tid; i < 2048; i += NTHREADS) TAB[i] = __builtin_amdgcn_cosf((float)i * (1.0f / 2048.0f));
    __syncthreads();
    for (int it = C.bid; it < 288; it += C.G) {
        {
            const int l = it / 144, j0 = (it % 144) * 64, lg = C.lane >> 4, kbase = C.wave * 128 + lg;
            const float* W = args->in[7] + (size_t)l * D * NMOD + (size_t)kbase * NMOD + j0 + 4 * (C.lane & 15);
            f32x4 a0 = {0.f, 0.f, 0.f, 0.f}, a1 = a0, a2 = a0, a3 = a0, a4 = a0;
#pragma unroll 16
            for (int i = 0; i < 32; ++i) { const f32x4 w = *(const f32x4*)(W + (size_t)(4 * i) * NMOD); const int k = kbase + 4 * i;
                a0 += w * SC[k]; a1 += w * SC[1024 + k]; a2 += w * SC[2048 + k]; a3 += w * SC[3072 + k]; a4 += w * SC[4096 + k]; }
#define P0_RED4(a) a.x = sum_x32(sum_x16(a.x)); a.y = sum_x32(sum_x16(a.y)); a.z = sum_x32(sum_x16(a.z)); a.w = sum_x32(sum_x16(a.w));
            P0_RED4(a0) P0_RED4(a1) P0_RED4(a2) P0_RED4(a3) P0_RED4(a4)
#undef P0_RED4
            LAS f32x4* R = (LAS f32x4*)SCR;
            if (C.lane < 16) { R[(C.wave * 5 + 0) * 16 + C.lane] = a0; R[(C.wave * 5 + 1) * 16 + C.lane] = a1; R[(C.wave * 5 + 2) * 16 + C.lane] = a2; R[(C.wave * 5 + 3) * 16 + C.lane] = a3; R[(C.wave * 5 + 4) * 16 + C.lane] = a4; }
            __syncthreads();
            if (C.tid < 320) { const int c = C.tid >> 6, j = C.tid & 63; float sum = args->in[8][(size_t)l * NMOD + j0 + j];
#pragma unroll
                for (int w = 0; w < 8; ++w) sum += SCR[(w * 5 + c) * 64 + j];
                ((float*)(C.ws + OFF_MOD))[(size_t)(l * 5 + c) * NMOD + j0 + j] = sum; }
            __syncthreads();
        }
    }
    __syncthreads();
    p0_transposes(args, C, SCR, 0, 2 * I_G, C.bid * NWAVES + C.wave, C.G * NWAVES);
    const int gt = C.bid * NTHREADS + C.tid, NGT = C.G * NTHREADS;
    for (int i = gt; i < 6 * M / 4; i += NGT) ((f32x4*)(C.ws + OFF_SSQ) + M / 4)[i] = (f32x4){0.f, 0.f, 0.f, 0.f};
    for (int i = gt; i < 2048 * 256; i += NGT) { const int pr = i >> 8, t0 = (i & 255) * 8, p = (pr <= 1024) ? pr : pr - 1024, sh = (pr > 1024) ? 512 : 0; const float s = 0.022097086912079608f;
        float v[8];
#pragma unroll
        for (int j = 0; j < 8; ++j) v[j] = TAB[((p * (t0 + j)) - sh) & 2047] * s;
        u32x4 o; o.x = cvt_pk_bf16(v[0], v[1]); o.y = cvt_pk_bf16(v[2], v[3]); o.z = cvt_pk_bf16(v[4], v[5]); o.w = cvt_pk_bf16(v[6], v[7]);
        *(u32x4*)((bf16_t*)(C.ws + WS_DFTL) + (size_t)pr * 2048 + t0) = o; }
    for (int i = gt; i < 256 * 32; i += NGT) { const int pr = i >> 5, t0 = (i & 31) * 8, p = (pr <= 128) ? pr : pr - 128, sh = (pr > 128) ? 512 : 0; const float s = 0.0625f;
        float v[8];
#pragma unroll
        for (int j = 0; j < 8; ++j) v[j] = TAB[((p * (t0 + j) * 8) - sh) & 2047] * s;
        u32x4 o; o.x = cvt_pk_bf16(v[0], v[1]); o.y = cvt_pk_bf16(v[2], v[3]); o.z = cvt_pk_bf16(v[4], v[5]); o.w = cvt_pk_bf16(v[6], v[7]);
        *(u32x4*)((bf16_t*)(C.ws + WS_DFTC) + (size_t)pr * 256 + t0) = o; }
    for (int i = gt; i < 1024; i += NGT) { const int pos = i >> 4, f = i & 15; const float inv = __builtin_amdgcn_exp2f(-(float)f * (13.287712379549449f / 16.0f)); const float ang = (float)pos * inv;
        float tr = ang * 0.15915494309189535f; tr = tr - __builtin_floorf(tr);
        ((float*)(C.ws + OFF_ROPE))[i] = __builtin_amdgcn_cosf(tr); ((float*)(C.ws + OFF_ROPE))[1024 + i] = __builtin_amdgcn_sinf(tr); }
    for (int i = gt; i < 4 * 2 * 256 * 128; i += NGT) { ((bf16_t*)(C.ws + OFF_CK))[i] = f2bf(args->in[3][i]);
        const int d = i & 63, kvh = (i >> 6) & 1, t = (i >> 7) & 255, bl = i >> 15;
        ((bf16_t*)(C.ws + OFF_CVT))[((size_t)(bl * 2 + kvh) * 64 + d) * 256 + t] = f2bf(args->in[4][i]); }
    for (int i = gt; i < 2 * 2 * 8 * 128 * 64; i += NGT) { const int k = i & 63, n = (i >> 6) & 127, g = i >> 13;
        const float v = (n < 64) ? args->in[24][((size_t)g * 64 + k) * 64 + n] : args->in[26][((size_t)g * 64 + k) * 64 + (n - 64)]; ((bf16_t*)(C.ws + OFF_LWT))[i] = f2bf(v); }
}

__device__ __forceinline__ float* ssq_ptr(const Ctx& C, int idx) { return (float*)(C.ws + OFF_SSQ) + (size_t)idx * M; }
__device__ __forceinline__ const float* sw_ptr(const Ctx& C, int l, int sub, int c) { return (const float*)(C.ws + OFF_SW) + (size_t)((l * 3 + sub) * 5 + c) * 5632; }
__device__ __forceinline__ void p0b_phase(ArgsP args, const Ctx& C) {
    const int gw = C.bid * NWAVES + C.wave, NGW = C.G * NWAVES;
    { const float* nw = args->in[9]; bf16_t* XA = (bf16_t*)act_ptr(C, A_XN); float* ssq = ssq_ptr(C, 0);
      for (int r = gw; r < M; r += NGW) {
        const int c = cond_of_row(r); const float* sc = mod_ptr(C, 0, c, 0, 1);
        const f32x4* xr = (const f32x4*)((r < MP) ? args->in[0] + (size_t)r * D : args->in[1] + (size_t)(r - MP) * D) + C.lane;
        f32x4 v[4]; float s = 0.f;
#pragma unroll
        for (int j = 0; j < 4; ++j) { v[j] = xr[64 * j]; s += (v[j].x * v[j].x + v[j].y * v[j].y) + (v[j].z * v[j].z + v[j].w * v[j].w); }
        s = wave_sum(s); if (C.lane == 0) ssq[r] = s;
        u32x2* o = (u32x2*)(XA + (size_t)r * D) + C.lane;
#pragma unroll
        for (int j = 0; j < 4; ++j) { const int col = 4 * C.lane + 256 * j; const f32x4 w = *(const f32x4*)(nw + col), a = *(const f32x4*)(sc + col);
            const f32x4 y = v[j] * w * (a + 1.0f); u32x2 p; p.x = cvt_pk_bf16(y.x, y.y); p.y = cvt_pk_bf16(y.z, y.w); o[64 * j] = p; } } }
    bg_load_shifts(C, 0);
    for (int r0 = gw * 16; r0 < 5632; r0 += NGW * 16) sw_rows(C, 0, r0, 16);
}
__device__ __forceinline__ void finalnorm_phase(ArgsP args, const Ctx& C) {
    const int gw = C.bid * NWAVES + C.wave, NGW = C.G * NWAVES;
    const float* nw = args->in[10]; const float* ssq = ssq_ptr(C, 6);
    for (int r = gw; r < M; r += NGW) {
        f32x4* xr = (f32x4*)(C.out + (size_t)r * D) + C.lane;
        const float rstd = __builtin_amdgcn_rsqf(ssq[r] * (1.0f / D) + EPS);
#pragma unroll
        for (int j = 0; j < 4; ++j) { const f32x4 w = *(const f32x4*)(nw + 4 * C.lane + 256 * j); xr[64 * j] = xr[64 * j] * rstd * w; }
    }
}

struct Unit { int pm, pn, z; const bf16_t* A; const bf16_t* B; };

struct StaticOrder {
    int nM, nN, nwg, G, c; const bf16_t* A; const bf16_t* B; int lda, ldb;
    __device__ void init(int Mr, int N, int G_, int c_, const bf16_t* A_, int lda_, const bf16_t* B_, int ldb_) { nM = Mr / 256; nN = N / 256; nwg = nM * nN; G = G_; c = c_; A = A_; B = B_; lda = lda_; ldb = ldb_; }
    __device__ bool next(int i, Unit& u) const {
        const int L = i * G + c; if (L >= nwg) return false;
        int wgid = (int)L; { const int q = nwg / 8, r = nwg % 8, xcd = wgid % 8, off = wgid / 8; wgid = (xcd < r ? xcd * (q + 1) : r * (q + 1) + (xcd - r) * q) + off; }
        const int nig = 8 * nN, gid = wgid / nig, fm = gid * 8, gsz = (nM - fm) < 8 ? (nM - fm) : 8;
        u.pm = fm + ((wgid % nig) % gsz); u.pn = (wgid % nig) / gsz; u.z = 0;
        u.A = A + (size_t)u.pm * 256 * lda; u.B = B + (size_t)u.pn * 256 * ldb; return true;
    }
};
struct DftOrder {
    int nseq, nPm, L, G, c; const bf16_t* A; const bf16_t* XFT;
    __device__ bool next(int i, Unit& u) const {
        const int idx = i * G + c; if (idx >= nseq * nPm * 2) return false;
        u.z = idx / (nPm * 2); const int r = idx % (nPm * 2); u.pm = r >> 1; u.pn = r & 1;
        u.A = A + (size_t)u.pm * 256 * L; u.B = XFT + ((size_t)u.z * 512 + u.pn * 256) * L; return true;
    }
};

template <class Epi, class Sched>
__device__ __forceinline__ void gemm_simple(const Ctx& C, const Sched& S, const Epi& E, int lda, int ldb, int K) {
    const int wr = C.wave >> 2, wc = C.wave & 3, fr = C.lane & 15, fq = C.lane >> 4;
    Unit u;
    for (int ui = 0; S.next(ui, u); ++ui) {
        f32x4 acc[2][2][4][2];
#pragma unroll
        for (int a = 0; a < 2; ++a)
#pragma unroll
            for (int b = 0; b < 2; ++b)
#pragma unroll
                for (int m = 0; m < 4; ++m)
#pragma unroll
                    for (int n = 0; n < 2; ++n) acc[a][b][m][n] = (f32x4){0.f, 0.f, 0.f, 0.f};
        const bf16_t* pa = u.A + (size_t)(wr * 64 + fr) * lda + fq * 8;
        const bf16_t* pb = u.B + (size_t)(wc * 32 + fr) * ldb + fq * 8;
        for (int k0 = 0; k0 < K; k0 += 32) {
            bf16x8 At[2][4], Bt[2][2];
#pragma unroll
            for (int a = 0; a < 2; ++a)
#pragma unroll
                for (int m = 0; m < 4; ++m) At[a][m] = *(const bf16x8*)(pa + (size_t)(a * 128 + m * 16) * lda + k0);
#pragma unroll
            for (int b = 0; b < 2; ++b)
#pragma unroll
                for (int n = 0; n < 2; ++n) Bt[b][n] = *(const bf16x8*)(pb + (size_t)(b * 128 + n * 16) * ldb + k0);
#pragma unroll
            for (int a = 0; a < 2; ++a)
#pragma unroll
                for (int b = 0; b < 2; ++b)
#pragma unroll
                    for (int m = 0; m < 4; ++m)
#pragma unroll
                        for (int n = 0; n < 2; ++n) acc[a][b][m][n] = __builtin_amdgcn_mfma_f32_16x16x32_bf16(Bt[b][n], At[a][m], acc[a][b][m][n], 0, 0, 0);
        }
        E(acc, u, wr, wc, fr, fq);
    }
}

namespace pg8 {
#define PG8_LAS __attribute__((address_space(3)))
constexpr int BM = 256, BK = 64, HALF = 128, HTB = HALF * BK * 2  , STAGE_BYTES = 8 * HTB, NXCD = 8, WGM = 8;

__host__ __device__ __forceinline__ int lds_byte(int r, int c) { const int st = (r >> 4) * 2 + (c >> 5), rr = r & 15, cc = c & 31, ob = rr * 64 + cc * 2; return st * 1024 + (ob ^ (((ob >> 9) & 1) << 5)); }
__host__ __device__ __forceinline__ void stage_rc(int b, int& R, int& C) { const int st = b / 1024, sb = b % 1024, swz = sb ^ (((sb >> 9) & 1) << 5); R = (st >> 1) * 16 + swz / 64; C = (st & 1) * 32 + (swz % 64) / 2; }
__host__ __device__ __forceinline__ int perm32(int rho) { const int n = rho >> 4, i = rho & 15; return 8 * (i >> 2) + 4 * n + (i & 3); }
template <class Epi, class Sched, bool ALIGN_EPI = true, bool SP2 = true>
__device__ __forceinline__ void gemm_phase(PG8_LAS unsigned char* lds, const int tid, const Sched& S, const Epi& E, const int lda, const int ldb, const int K) {
    const int wid = __builtin_amdgcn_readfirstlane(tid >> 6), lane = tid & 63, wr = wid >> 2, wc = wid & 3, fr = lane & 15, fq = lane >> 4;
    const int nt = K / BK;
    unsigned voffA[2], voffB[2];
#pragma unroll
    for (int i = 0; i < 2; ++i) { int R, C; stage_rc(tid * 16 + i * 8192, R, C); const int Rb = Epi::PERM ? ((R & ~31) + perm32(R & 31)) : R;
        voffA[i] = (unsigned)(R * lda + C) * 2u; voffB[i] = (unsigned)(Rb * ldb + C) * 2u; }
    const size_t kstep = (size_t)(BK * 2);
    const size_t hstepA = (size_t)HALF * lda * 2, hstepB = (size_t)HALF * ldb * 2;
    const unsigned ldsw = (unsigned)wid * 1024u;
    const int aoff = lds_byte(wr * 64 + fr, fq * 8), boff = lds_byte(wc * 32 + fr, fq * 8);
#define PG8_SA(b, h) (((b) * 2 + (h)) * HTB)
#define PG8_SB(b, h) ((4 + (b) * 2 + (h)) * HTB)
#define PG8_STAGE(bufoff, gbase, voff) do { _Pragma("unroll") for (int _i = 0; _i < 2; ++_i) \
        __builtin_amdgcn_global_load_lds((const unsigned*)((const char*)(gbase) + (voff)[_i]), (PG8_LAS unsigned*)(lds + (bufoff) + ldsw + _i * 8192), 16, 0, 0); } while (0)
#define PG8_LDA(dst, b, h) do { _Pragma("unroll") for (int m = 0; m < 4; ++m) _Pragma("unroll") for (int k = 0; k < 2; ++k) dst[m][k] = *(const PG8_LAS bf16x8*)(lds + PG8_SA(b, h) + aoff + m * 2048 + k * 1024); } while (0)
#define PG8_LDB(dst, b, h) do { _Pragma("unroll") for (int n = 0; n < 2; ++n) _Pragma("unroll") for (int k = 0; k < 2; ++k) dst[n][k] = *(const PG8_LAS bf16x8*)(lds + PG8_SB(b, h) + boff + n * 2048 + k * 1024); } while (0)
#define PG8_MMA(ai, bj, At, Bt) do { __builtin_amdgcn_s_setprio(1); _Pragma("unroll") for (int m = 0; m < 4; ++m) _Pragma("unroll") for (int n = 0; n < 2; ++n) _Pragma("unroll") for (int k = 0; k < 2; ++k) \
        acc[ai][bj][m][n] = __builtin_amdgcn_mfma_f32_16x16x32_bf16(Bt[n][k], At[m][k], acc[ai][bj][m][n], 0, 0, 0); __builtin_amdgcn_s_setprio(0); } while (0)
#define PG8_WAIT_V(n) asm volatile("s_waitcnt vmcnt(" #n ")" ::: "memory")
#define PG8_WAIT_L(n) asm volatile("s_waitcnt lgkmcnt(" #n ")" ::: "memory")
#define PG8_BAR __builtin_amdgcn_s_barrier()
#define PG8_SCHED __builtin_amdgcn_sched_barrier(0)
    Unit cur, nxt; int ui = 0;
    if (!S.next(0, cur)) return;
    f32x4 acc[2][2][4][2];
#pragma unroll
    for (int a = 0; a < 2; ++a)
#pragma unroll
        for (int b = 0; b < 2; ++b)
#pragma unroll
            for (int m = 0; m < 4; ++m)
#pragma unroll
                for (int n = 0; n < 2; ++n) acc[a][b][m][n] = (f32x4){0.f, 0.f, 0.f, 0.f};
    bf16x8 At[4][2], B0[2][2], B1[2][2];
    const char* cA = (const char*)cur.A; const char* cB = (const char*)cur.B;
    if constexpr (SP2) {
        PG8_STAGE(PG8_SB(0, 0), cB, voffB); PG8_STAGE(PG8_SB(0, 1), cB + hstepB, voffB); PG8_STAGE(PG8_SA(0, 0), cA, voffA); PG8_STAGE(PG8_SA(0, 1), cA + hstepA, voffA);
        if (wr == 1) PG8_BAR;
        PG8_WAIT_V(2); PG8_BAR;
        PG8_STAGE(PG8_SB(1, 0), cB + kstep, voffB); PG8_STAGE(PG8_SA(1, 0), cA + kstep, voffA); PG8_STAGE(PG8_SB(1, 1), cB + hstepB + kstep, voffB);
        PG8_WAIT_V(6); PG8_BAR;
    } else {
        PG8_STAGE(PG8_SB(0, 0), cB, voffB); PG8_STAGE(PG8_SA(0, 0), cA, voffA); PG8_STAGE(PG8_SB(0, 1), cB + hstepB, voffB); PG8_STAGE(PG8_SA(0, 1), cA + hstepA, voffA);
        if (wr == 1) PG8_BAR;
        PG8_WAIT_V(4); PG8_BAR;
        PG8_STAGE(PG8_SB(1, 0), cB + kstep, voffB); PG8_STAGE(PG8_SA(1, 0), cA + kstep, voffA); PG8_STAGE(PG8_SB(1, 1), cB + hstepB + kstep, voffB);
        PG8_WAIT_V(6); PG8_BAR;
    }
    for (;;) {
        const bool has_next = S.next(ui + 1, nxt);
        const char* nA = has_next ? (const char*)nxt.A : cA; const char* nB = has_next ? (const char*)nxt.B : cB;
        for (int t = 0; t < nt; t += 2) {
            const bool last = (t == nt - 2);
            const char* a1 = cA + (size_t)(t + 1) * kstep;
            const char* a2 = last ? nA : cA + (size_t)(t + 2) * kstep; const char* b2 = last ? nB : cB + (size_t)(t + 2) * kstep;
            const char* a3 = a2 + kstep; const char* b3 = b2 + kstep;
            if constexpr (SP2) {
            PG8_LDB(B0, 0, 0); PG8_LDB(B1, 0, 1); PG8_SCHED; PG8_LDA(At, 0, 0); PG8_STAGE(PG8_SA(1, 1), a1 + hstepA, voffA);
            PG8_WAIT_V(8); PG8_WAIT_L(0); PG8_BAR; PG8_MMA(0, 0, At, B0); PG8_MMA(0, 1, At, B1); PG8_BAR; PG8_SCHED;
            PG8_LDA(At, 0, 1); PG8_STAGE(PG8_SB(0, 0), b2, voffB); PG8_STAGE(PG8_SB(0, 1), b2 + hstepB, voffB); PG8_STAGE(PG8_SA(0, 0), a2, voffA);
            PG8_WAIT_V(8); PG8_WAIT_L(0); PG8_BAR; PG8_MMA(1, 0, At, B0); PG8_MMA(1, 1, At, B1); PG8_BAR; PG8_SCHED;
            PG8_LDB(B0, 1, 0); PG8_LDB(B1, 1, 1); PG8_SCHED; PG8_LDA(At, 1, 0); PG8_STAGE(PG8_SA(0, 1), a2 + hstepA, voffA);
            PG8_WAIT_V(8); PG8_WAIT_L(0); PG8_BAR; PG8_MMA(0, 0, At, B0); PG8_MMA(0, 1, At, B1); PG8_BAR; PG8_SCHED;
            PG8_LDA(At, 1, 1); PG8_STAGE(PG8_SB(1, 0), b3, voffB); PG8_STAGE(PG8_SB(1, 1), b3 + hstepB, voffB); PG8_STAGE(PG8_SA(1, 0), a3, voffA);
            PG8_WAIT_V(8); PG8_WAIT_L(0); PG8_BAR; PG8_MMA(1, 0, At, B0); PG8_MMA(1, 1, At, B1); PG8_BAR; PG8_SCHED;
            } else {
            PG8_LDB(B0, 0, 0); PG8_SCHED; PG8_LDA(At, 0, 0); PG8_STAGE(PG8_SA(1, 1), a1 + hstepA, voffA);
            PG8_WAIT_L(8); PG8_BAR; PG8_WAIT_L(0); PG8_MMA(0, 0, At, B0); PG8_BAR; PG8_SCHED;
            PG8_LDB(B1, 0, 1); PG8_STAGE(PG8_SB(0, 0), b2, voffB);
            PG8_BAR; PG8_WAIT_L(0); PG8_MMA(0, 1, At, B1); PG8_BAR;
            PG8_LDA(At, 0, 1); PG8_STAGE(PG8_SA(0, 0), a2, voffA);
            PG8_BAR; PG8_WAIT_L(0); PG8_MMA(1, 0, At, B0); PG8_BAR; PG8_SCHED;
            PG8_STAGE(PG8_SB(0, 1), b2 + hstepB, voffB);
            PG8_WAIT_V(6); PG8_BAR; PG8_MMA(1, 1, At, B1); PG8_BAR;
            PG8_LDB(B0, 1, 0); PG8_SCHED; PG8_LDA(At, 1, 0); PG8_STAGE(PG8_SA(0, 1), a2 + hstepA, voffA);
            PG8_WAIT_L(8); PG8_BAR; PG8_WAIT_L(0); PG8_MMA(0, 0, At, B0); PG8_BAR; PG8_SCHED;
            PG8_LDB(B1, 1, 1); PG8_STAGE(PG8_SB(1, 0), b3, voffB);
            PG8_BAR; PG8_WAIT_L(0); PG8_MMA(0, 1, At, B1); PG8_BAR;
            PG8_LDA(At, 1, 1); PG8_STAGE(PG8_SA(1, 0), a3, voffA);
            PG8_BAR; PG8_WAIT_L(0); PG8_MMA(1, 0, At, B0); PG8_BAR; PG8_SCHED;
            PG8_STAGE(PG8_SB(1, 1), b3 + hstepB, voffB);
            PG8_WAIT_V(6); PG8_BAR; PG8_MMA(1, 1, At, B1); PG8_BAR;
            }
        }
        if constexpr (ALIGN_EPI) { if (wr == 0) PG8_BAR; }
        if constexpr (!Epi::AFTER_DRAIN) { E(acc, cur, wr, wc, fr, fq); }
        if (!has_next) break;
#pragma unroll
        for (int a = 0; a < 2; ++a)
#pragma unroll
            for (int b = 0; b < 2; ++b)
#pragma unroll
                for (int m = 0; m < 4; ++m)
#pragma unroll
                    for (int n = 0; n < 2; ++n) acc[a][b][m][n] = (f32x4){0.f, 0.f, 0.f, 0.f};
        cur = nxt; cA = nA; cB = nB; ++ui;
        if constexpr (ALIGN_EPI) { if (wr == 1) PG8_BAR; }
    }
    PG8_WAIT_V(0);
    if constexpr (!ALIGN_EPI) { if (wr == 0) PG8_BAR; }
    PG8_BAR;
    if constexpr (Epi::AFTER_DRAIN) { E.fused(acc, cur, wr, wc, fr, fq, lds, wid, lane); }
#undef PG8_SA
#undef PG8_SB
#undef PG8_STAGE
#undef PG8_LDA
#undef PG8_LDB
#undef PG8_MMA
#undef PG8_WAIT_V
#undef PG8_WAIT_L
#undef PG8_BAR
#undef PG8_SCHED
}
}

#ifndef USE_PG8
#define USE_PG8 1
#endif
#if USE_PG8
__device__ __forceinline__ int fresh_tid(const Ctx& C) { unsigned z_ = 0u; asm volatile("" : "+s"(z_)); return C.wave * 64 + (int)__builtin_amdgcn_mbcnt_hi(~0u, __builtin_amdgcn_mbcnt_lo(~0u, z_)); }
#define GEMM(C, S, E, lda, ldb, K) pg8::gemm_phase(C.lds, fresh_tid(C), S, E, lda, ldb, K)
#else
#define GEMM(C, S, E, lda, ldb, K) GEMM(C, S, E, lda, ldb, K)
#endif

#define EPI_LOOP_AM for (int ai = 0; ai < 2; ++ai) _Pragma("unroll") for (int m = 0; m < 4; ++m)
struct EpiGU {
    static constexpr bool PERM = true, AFTER_DRAIN = false;
    bf16_t* H; const float* ssq; const float* swb;
    __device__ __forceinline__ void operator()(const f32x4 (&acc)[2][2][4][2], const Unit& u, int wr, int wc, int fr, int fq) const {
        const float* sw = swb + (size_t)cond_of_row(u.pm * 256) * 5632 + u.pn * 256 + wc * 32 + fq * 8;
        f32x4 sg[2], su[2];
#pragma unroll
        for (int n = 0; n < 2; ++n) { sg[n] = *(const f32x4*)(sw + n * 4); su[n] = *(const f32x4*)(sw + 128 + n * 4); }
#pragma unroll
        EPI_LOOP_AM { const int row = u.pm * 256 + ai * 128 + wr * 64 + m * 16 + fr; const float rstd = __builtin_amdgcn_rsqf(ssq[row] * (1.0f / D) + EPS);
            u32x4 p;
            { const f32x4 g = acc[ai][0][m][0] * rstd + sg[0], up = acc[ai][1][m][0] * rstd + su[0]; p.x = cvt_pk_bf16(siluf_(g.x) * up.x, siluf_(g.y) * up.y); p.y = cvt_pk_bf16(siluf_(g.z) * up.z, siluf_(g.w) * up.w); }
            { const f32x4 g = acc[ai][0][m][1] * rstd + sg[1], up = acc[ai][1][m][1] * rstd + su[1]; p.z = cvt_pk_bf16(siluf_(g.x) * up.x, siluf_(g.y) * up.y); p.w = cvt_pk_bf16(siluf_(g.z) * up.z, siluf_(g.w) * up.w); }
            *(u32x4*)(H + (size_t)row * DFF + u.pn * 128 + wc * 32 + fq * 8) = p; }
    }
};
struct EpiRes {
    static constexpr bool PERM = true, AFTER_DRAIN = false;
    float* X; const float* Xin0; const float* Xin1; const float* modbase;
    bf16_t* XA; const float* nwn; float* ssqn;
    int l, sub, ln, subn; float coef;
    __device__ __forceinline__ void operator()(const f32x4 (&acc)[2][2][4][2], const Unit& u, int wr, int wc, int fr, int fq) const {
        const int c = cond_of_row(u.pm * 256), co = u.pn * 256 + wc * 32 + fq * 8;
        const float* gate = modbase + ((size_t)(l * 5 + c) * NMOD + (sub * 3 + 2) * D) + co;
        f32x4 g[2][2], wn[2][2];
#pragma unroll
        for (int bj = 0; bj < 2; ++bj)
#pragma unroll
            for (int n = 0; n < 2; ++n) { g[bj][n] = *(const f32x4*)(gate + bj * 128 + n * 4) * coef;
                if (ln >= 0) { const float* scn = modbase + ((size_t)(ln * 5 + c) * NMOD + (subn * 3 + 1) * D) + co + bj * 128 + n * 4; wn[bj][n] = *(const f32x4*)(nwn + co + bj * 128 + n * 4) * (*(const f32x4*)scn + 1.0f); }
                else wn[bj][n] = (f32x4){0.f, 0.f, 0.f, 0.f}; }
#pragma unroll
        EPI_LOOP_AM { const int row = u.pm * 256 + ai * 128 + wr * 64 + m * 16 + fr;
            float* xrow = X + (size_t)row * D + co; const float* irow = ((u.pm < 16) ? Xin0 + (size_t)row * D : Xin1 + (size_t)(row - MP) * D) + co;
            float ss = 0.f;
#pragma unroll
            for (int bj = 0; bj < 2; ++bj) {
                const f32x4 x0 = *(const f32x4*)(irow + bj * 128) + g[bj][0] * acc[ai][bj][m][0], x1 = *(const f32x4*)(irow + bj * 128 + 4) + g[bj][1] * acc[ai][bj][m][1];
                *(f32x4*)(xrow + bj * 128) = x0; *(f32x4*)(xrow + bj * 128 + 4) = x1;
                ss += ((x0.x * x0.x + x0.y * x0.y) + (x0.z * x0.z + x0.w * x0.w)) + ((x1.x * x1.x + x1.y * x1.y) + (x1.z * x1.z + x1.w * x1.w));
                if (ln >= 0) { const f32x4 y0 = x0 * wn[bj][0], y1 = x1 * wn[bj][1]; u32x4 p; p.x = cvt_pk_bf16(y0.x, y0.y); p.y = cvt_pk_bf16(y0.z, y0.w); p.z = cvt_pk_bf16(y1.x, y1.y); p.w = cvt_pk_bf16(y1.z, y1.w);
                    *(u32x4*)(XA + (size_t)row * D + co + bj * 128) = p; } }
            ss = sum_x32(sum_x16(ss));
            if (fq == 0) atomicAdd(ssqn + row, ss);
            asm volatile("" ::: "memory"); }
    }
};
struct EpiIn {
    static constexpr bool PERM = false, AFTER_DRAIN = false;
    bf16_t *Q, *Kb, *VT, *GY, *XFT, *G; float* XR; float* out; const float* rope; const float* bgate; int l; const float* ssq; const float* swb;
    __device__ __forceinline__ void operator()(f32x4 (&acc)[2][2][4][2], const Unit& u, int wr, int wc, int fr, int fq) const {
        const int row0 = u.pm * 256 + wr * 64 + fr; const bool latent = u.pm >= 16;
        { const float* sw = swb + (size_t)cond_of_row(u.pm * 256) * 5632 + u.pn * 256 + wc * 32 + fq * 4;
          f32x4 sv[2][2];
#pragma unroll
          for (int bj = 0; bj < 2; ++bj)
#pragma unroll
              for (int n = 0; n < 2; ++n) sv[bj][n] = *(const f32x4*)(sw + bj * 128 + n * 16);
#pragma unroll
          EPI_LOOP_AM { const float rstd = __builtin_amdgcn_rsqf(ssq[row0 + ai * 128 + m * 16] * (1.0f / D) + EPS);
#pragma unroll
              for (int bj = 0; bj < 2; ++bj)
#pragma unroll
                  for (int n = 0; n < 2; ++n) acc[ai][bj][m][n] = acc[ai][bj][m][n] * rstd + sv[bj][n]; } }
        if (u.pn <= 2) {
#pragma unroll
            for (int bj = 0; bj < 2; ++bj) {
                if (u.pn == 2 && bj == 1) {
#pragma unroll
                    EPI_LOOP_AM { const int row = row0 + ai * 128 + m * 16; int seqoff, L, t;
                        if (latent) { const int b = (row - MP) >> 11; t = (row - MP) & 2047; L = LS; seqoff = 16 * 128 * LC + b * 128 * LS; } else { const int b = row >> 8; t = row & 255; L = LC; seqoff = b * 128 * LC; }
#pragma unroll
                        for (int n = 0; n < 2; ++n) { const f32x4 v = acc[ai][1][m][n]; const int d128 = wc * 32 + n * 16 + fq * 4;
                            bf16_t* p = VT + seqoff + (size_t)d128 * L + t; p[0] = f2bf(v.x); p[L] = f2bf(v.y); p[2 * L] = f2bf(v.z); p[3 * L] = f2bf(v.w);
                            if (!latent) *(f32x4*)(out + OUT_CV + ((size_t)((row >> 8) * 2 + l) * 256 + t) * 128 + d128) = v; } }
                } else {
                    const bool isk = (u.pn == 2); const int axis = wc & 1;
#pragma unroll
                    EPI_LOOP_AM { const int row = row0 + ai * 128 + m * 16; f32x4 x1 = acc[ai][bj][m][0], x2 = acc[ai][bj][m][1];
                        if (isk && !latent) { float* o = out + OUT_CK + ((size_t)((row >> 8) * 2 + l) * 256 + (row & 255)) * 128 + wc * 32 + fq * 4; *(f32x4*)o = x1; *(f32x4*)(o + 16) = x2; }
                        if (latent) { const int t = (row - MP) & 2047, pos = axis ? (t & 63) : (t >> 6);
                            const f32x4 cs = *(const f32x4*)(rope + pos * 16 + fq * 4), sn = *(const f32x4*)(rope + 1024 + pos * 16 + fq * 4);
                            const f32x4 o1 = x1 * cs - x2 * sn, o2 = x1 * sn + x2 * cs; x1 = o1; x2 = o2; }
                        if (!isk) { x1 = x1 * QSCALE; x2 = x2 * QSCALE; }
                        bf16_t* o = isk ? (Kb + (size_t)row * 128 + wc * 32 + fq * 4) : (Q + (size_t)row * 512 + u.pn * 256 + bj * 128 + wc * 32 + fq * 4);
                        u32x2 p; p.x = cvt_pk_bf16(x1.x, x1.y); p.y = cvt_pk_bf16(x1.z, x1.w); *(u32x2*)o = p;
                        p.x = cvt_pk_bf16(x2.x, x2.y); p.y = cvt_pk_bf16(x2.z, x2.w); *(u32x2*)(o + 16) = p; }
                }
            }
        } else if (u.pn <= 4) {
#pragma unroll
            EPI_LOOP_AM { const int row = row0 + ai * 128 + m * 16;
#pragma unroll
                for (int bj = 0; bj < 2; ++bj)
#pragma unroll
                    for (int n = 0; n < 2; ++n) *(f32x4*)(XR + (size_t)row * 512 + (u.pn - 3) * 256 + bj * 128 + wc * 32 + n * 16 + fq * 4) = acc[ai][bj][m][n]; }
        } else if (u.pn <= 6) {
#pragma unroll
            EPI_LOOP_AM { const int row = row0 + ai * 128 + m * 16;
#pragma unroll
                for (int bj = 0; bj < 2; ++bj)
#pragma unroll
                    for (int n = 0; n < 2; ++n) { const f32x4 v = acc[ai][bj][m][n]; u32x2 p; p.x = cvt_pk_bf16(gelu_tanh(v.x), gelu_tanh(v.y)); p.y = cvt_pk_bf16(gelu_tanh(v.z), gelu_tanh(v.w));
                        *(u32x2*)(GY + (size_t)row * 512 + (u.pn - 5) * 256 + bj * 128 + wc * 32 + n * 16 + fq * 4) = p; } }
        } else if (u.pn <= 8) {
#pragma unroll
            EPI_LOOP_AM { const int row = row0 + ai * 128 + m * 16; size_t seqoff; int L, t;
                if (latent) { const int b = (row - MP) >> 11; t = (row - MP) & 2047; L = LS; seqoff = (size_t)16 * 512 * LC + (size_t)b * 512 * LS; } else { const int b = row >> 8; t = row & 255; L = LC; seqoff = (size_t)b * 512 * LC; }
#pragma unroll
                for (int bj = 0; bj < 2; ++bj)
#pragma unroll
                    for (int n = 0; n < 2; ++n) { const f32x4 v = acc[ai][bj][m][n]; bf16_t* p = XFT + seqoff + (size_t)((u.pn - 7) * 256 + bj * 128 + wc * 32 + n * 16 + fq * 4) * L + t;
                        p[0] = f2bf(v.x); p[L] = f2bf(v.y); p[2 * L] = f2bf(v.z); p[3 * L] = f2bf(v.w); } }
        } else {
#pragma unroll
            for (int bj = 0; bj < 2; ++bj)
#pragma unroll
                for (int n = 0; n < 2; ++n) { const int col = (u.pn - 9) * 256 + bj * 128 + wc * 32 + n * 16 + fq * 4; const f32x4 b = *(const f32x4*)(bgate + col);
#pragma unroll
                    EPI_LOOP_AM { const int row = row0 + ai * 128 + m * 16; const f32x4 v = acc[ai][bj][m][n] + b;
                        u32x2 p; p.x = cvt_pk_bf16(sigmoidf_(v.x), sigmoidf_(v.y)); p.y = cvt_pk_bf16(sigmoidf_(v.z), sigmoidf_(v.w)); *(u32x2*)(G + (size_t)row * 3072 + col) = p; } }
        }
    }
};
template <int MODE> struct EpiBranch {
    static constexpr bool PERM = true, AFTER_DRAIN = false;
    bf16_t* MG; const bf16_t* G; int br;
    __device__ __forceinline__ void operator()(const f32x4 (&acc)[2][2][4][2], const Unit& u, int wr, int wc, int fr, int fq) const {
#pragma unroll
        EPI_LOOP_AM { const int row = u.pm * 256 + ai * 128 + wr * 64 + m * 16 + fr;
#pragma unroll
            for (int bj = 0; bj < 2; ++bj) { const int col = u.pn * 256 + bj * 128 + wc * 32 + fq * 8;
                const u32x4 g = *(const u32x4*)(G + (size_t)row * 3072 + br * 1024 + col); f32x4 v0 = acc[ai][bj][m][0], v1 = acc[ai][bj][m][1];
                v0.x *= bflo(g.x); v0.y *= bfhi(g.x); v0.z *= bflo(g.y); v0.w *= bfhi(g.y); v1.x *= bflo(g.z); v1.y *= bfhi(g.z); v1.z *= bflo(g.w); v1.w *= bfhi(g.w);
                u32x4* p = (u32x4*)(MG + (size_t)row * D + col);
                if (MODE == 1) { const u32x4 o = *p; v0.x += bflo(o.x); v0.y += bfhi(o.x); v0.z += bflo(o.y); v0.w += bfhi(o.y); v1.x += bflo(o.z); v1.y += bfhi(o.z); v1.z += bflo(o.w); v1.w += bfhi(o.w); }
                u32x4 w; w.x = cvt_pk_bf16(v0.x, v0.y); w.y = cvt_pk_bf16(v0.z, v0.w); w.z = cvt_pk_bf16(v1.x, v1.y); w.w = cvt_pk_bf16(v1.z, v1.w); *p = w; }
            asm volatile("" ::: "memory"); }
    }
};
struct EpiDft {
    static constexpr bool PERM = true, AFTER_DRAIN = false;
    bf16_t* Z; int L, rowbase;
    __device__ __forceinline__ void operator()(const f32x4 (&acc)[2][2][4][2], const Unit& u, int wr, int wc, int fr, int fq) const {
        const int hl = L >> 1;
#pragma unroll
        EPI_LOOP_AM { const int rr = u.pm * 256 + ai * 128 + wr * 64 + m * 16 + fr; const bool sn = rr >= hl; const int p = sn ? rr - hl : rr;
            bf16_t* z0 = Z + (size_t)rowbase * D + u.pn * 256 + wc * 32 + fq * 8;
#pragma unroll
            for (int bj = 0; bj < 2; ++bj) { const f32x4 v0 = acc[ai][bj][m][0], v1 = acc[ai][bj][m][1]; u32x4 w; w.x = cvt_pk_bf16(v0.x, v0.y); w.y = cvt_pk_bf16(v0.z, v0.w); w.z = cvt_pk_bf16(v1.x, v1.y); w.w = cvt_pk_bf16(v1.z, v1.w); const int co = bj * 128;
                if (!sn) { *(u32x4*)(z0 + (size_t)p * D + co) = w; if (p) *(u32x4*)(z0 + (size_t)(L - p) * D + co) = w; }
                else if (p == 0) { *(u32x4*)(z0 + (size_t)hl * D + co) = w; const u32x4 zz = {0u, 0u, 0u, 0u}; *(u32x4*)(z0 + 512 + co) = zz; *(u32x4*)(z0 + (size_t)hl * D + 512 + co) = zz; }
                else { *(u32x4*)(z0 + (size_t)p * D + 512 + co) = w; u32x4 nw; nw.x = w.x ^ 0x80008000u; nw.y = w.y ^ 0x80008000u; nw.z = w.z ^ 0x80008000u; nw.w = w.w ^ 0x80008000u; *(u32x4*)(z0 + (size_t)(L - p) * D + 512 + co) = nw; } } }
    }
};

typedef short s16x4 __attribute__((ext_vector_type(4)));
#define MFMA32(a, b, c) __builtin_amdgcn_mfma_f32_32x32x16_bf16((a), (b), (c), 0, 0, 0)
constexpr int AT_KSTR = 144, AT_VSTR = 264, AT_KBYTES = 128 * AT_KSTR, AT_VBYTES = 64 * AT_VSTR, AT_BUF = AT_KBYTES + AT_VBYTES;
struct AttnSrc { const bf16_t* kp; const bf16_t* vp; int vstride; int kbase; };
__device__ __forceinline__ AttnSrc attn_src(int t, bool latent, int nband, int lo, int b, int l, int kvh, const bf16_t* Kb, const bf16_t* VT, const bf16_t* CK, const bf16_t* CVT) {
    AttnSrc s;
    if (!latent) { s.kp = Kb + (size_t)(b * LC + 128 * t) * 128 + kvh * 64; s.vp = VT + (size_t)b * 128 * LC + (size_t)(kvh * 64) * LC + 128 * t; s.vstride = LC; s.kbase = 0; }
    else if (t < nband) { const int kb = lo + 128 * t; s.kp = Kb + (size_t)(MP + b * LS + kb) * 128 + kvh * 64; s.vp = VT + (size_t)16 * 128 * LC + (size_t)b * 128 * LS + (size_t)(kvh * 64) * LS + kb; s.vstride = LS; s.kbase = kb; }
    else { const int c = t - nband; s.kp = CK + (size_t)((b * 2 + l) * 256 + 128 * c) * 128 + kvh * 64; s.vp = CVT + (size_t)((b * 2 + l) * 2 + kvh) * 64 * 256 + 128 * c; s.vstride = 256; s.kbase = 0; }
    return s;
}
__device__ __forceinline__ void attn_tile(const LAS unsigned char* kbp, const LAS unsigned char* vbp, const bf16x8 (&qf)[4], f32x16& O0, f32x16& O1, float& mrun, float& lsum, bool domask, int dk0, int q32, int half) {
    f32x16 S0, S1;
#pragma unroll
    for (int r = 0; r < 16; ++r) { S0[r] = 0.f; S1[r] = 0.f; }
#pragma unroll
    for (int ks = 0; ks < 4; ++ks) { const bf16x8 k0 = *(const LAS bf16x8*)(kbp + q32 * AT_KSTR + ks * 32 + half * 16), k1 = *(const LAS bf16x8*)(kbp + (32 + q32) * AT_KSTR + ks * 32 + half * 16);
        S0 = MFMA32(k0, qf[ks], S0); S1 = MFMA32(k1, qf[ks], S1); }
    if (domask) {
#pragma unroll
        for (int r = 0; r < 16; ++r) { const int d0 = dk0 + (r & 3) + 8 * (r >> 2) + 4 * half, d1 = d0 + 32;
            S0[r] = (d0 > 128 || d0 < -128) ? -1e30f : S0[r]; S1[r] = (d1 > 128 || d1 < -128) ? -1e30f : S1[r]; } }
    float mx = fmaxf(S0[0], S1[0]);
#pragma unroll
    for (int r = 1; r < 16; ++r) mx = fmaxf(mx, fmaxf(S0[r], S1[r]));
    mx = fmaxf(mx, __shfl_xor(mx, 32));
    const float mnew = fmaxf(mrun, mx), alpha = __builtin_amdgcn_exp2f(mrun - mnew); mrun = mnew;
    float ps = 0.f;
#pragma unroll
    for (int r = 0; r < 16; ++r) { S0[r] = __builtin_amdgcn_exp2f(S0[r] - mnew); S1[r] = __builtin_amdgcn_exp2f(S1[r] - mnew); ps += S0[r] + S1[r]; }
    lsum = lsum * alpha + ps;
#pragma unroll
    for (int r = 0; r < 16; ++r) { O0[r] *= alpha; O1[r] *= alpha; }
    bf16x8 pf[4];
#pragma unroll
    for (int s2 = 0; s2 < 2; ++s2) { u32x4 a, c2;
        a.x = cvt_pk_bf16(S0[8 * s2 + 0], S0[8 * s2 + 1]); a.y = cvt_pk_bf16(S0[8 * s2 + 2], S0[8 * s2 + 3]); a.z = cvt_pk_bf16(S0[8 * s2 + 4], S0[8 * s2 + 5]); a.w = cvt_pk_bf16(S0[8 * s2 + 6], S0[8 * s2 + 7]);
        c2.x = cvt_pk_bf16(S1[8 * s2 + 0], S1[8 * s2 + 1]); c2.y = cvt_pk_bf16(S1[8 * s2 + 2], S1[8 * s2 + 3]); c2.z = cvt_pk_bf16(S1[8 * s2 + 4], S1[8 * s2 + 5]); c2.w = cvt_pk_bf16(S1[8 * s2 + 6], S1[8 * s2 + 7]);
        pf[s2] = __builtin_bit_cast(bf16x8, a); pf[2 + s2] = __builtin_bit_cast(bf16x8, c2); }
#pragma unroll
    for (int s4 = 0; s4 < 4; ++s4) {
        const LAS unsigned char* v0p = vbp + q32 * AT_VSTR + s4 * 32 + half * 8; const LAS unsigned char* v1p = v0p + 32 * AT_VSTR;
        const s16x4 a0 = *(const LAS s16x4*)v0p, a1 = *(const LAS s16x4*)(v0p + 16), b0 = *(const LAS s16x4*)v1p, b1 = *(const LAS s16x4*)(v1p + 16);
        const bf16x8 vf0 = __builtin_shufflevector(a0, a1, 0, 1, 2, 3, 4, 5, 6, 7), vf1 = __builtin_shufflevector(b0, b1, 0, 1, 2, 3, 4, 5, 6, 7);
        O0 = MFMA32(vf0, pf[s4], O0); O1 = MFMA32(vf1, pf[s4], O1); }
}
__device__ __forceinline__ void attn_unit(ArgsP args, const Ctx& C, int l, int ui) {
    bf16_t* Q = (bf16_t*)act_ptr(C, A_Q); const bf16_t* Kb = (const bf16_t*)act_ptr(C, A_K); const bf16_t* VT = (const bf16_t*)act_ptr(C, A_VT);
    const bf16_t* CK = (const bf16_t*)(C.ws + OFF_CK); const bf16_t* CVT = (const bf16_t*)(C.ws + OFF_CVT);
    const int q32 = C.lane & 31, half = C.lane >> 5, w = C.wave;
    const int srow = C.tid >> 3, schunk = C.tid & 7;
    {
        const bool latent = ui < 256;
        int b, h, qb; if (latent) { b = ui >> 6; h = (ui >> 3) & 7; qb = ui & 7; } else { const int r = ui - 256; b = r >> 3; h = r & 7; qb = 0; }
        const int kvh = h >> 2, rowbase = latent ? (MP + b * LS + qb * 256) : b * LC;
        int lo = 0, nband = 2, nt = 2;
        if (latent) { lo = 256 * qb - 128; if (lo < 0) lo = 0; int hi = 256 * qb + 384; if (hi > LS) hi = LS; nband = (hi - lo) >> 7; nt = nband + 2; }
        const int qw_lo = qb * 256 + 32 * w, qpos = qw_lo + q32;
        bf16x8 qf[4];
        { const bf16_t* qp = Q + (size_t)(rowbase + 32 * w + q32) * 512 + h * 64 + 8 * half;
#pragma unroll
          for (int ks = 0; ks < 4; ++ks) qf[ks] = *(const bf16x8*)(qp + 16 * ks); }
        f32x16 O0, O1;
#pragma unroll
        for (int r = 0; r < 16; ++r) { O0[r] = 0.f; O1[r] = 0.f; }
        float mrun = args->in[20][l * 8 + h] * LOG2E, lsum = half ? 0.f : 1.0f;
        u32x4 kA0, kA1, vA0, vA1, kB0, kB1, vB0, vB1;
#define ATT_LOAD(k0, k1, v0, v1, tt) do { const AttnSrc s_ = attn_src((tt), latent, nband, lo, b, l, kvh, Kb, VT, CK, CVT); \
            k0 = *(const u32x4*)(s_.kp + (size_t)srow * 128 + schunk * 8); k1 = *(const u32x4*)(s_.kp + (size_t)(64 + srow) * 128 + schunk * 8); \
            v0 = *(const u32x4*)(s_.vp + (size_t)srow * s_.vstride + schunk * 8); v1 = *(const u32x4*)(s_.vp + (size_t)srow * s_.vstride + 64 + schunk * 8); } while (0)
#define ATT_WRITE(k0, k1, v0, v1, bufi) do { LAS unsigned char* kb_ = C.lds + (bufi) * AT_BUF; *(LAS u32x4*)(kb_ + srow * AT_KSTR + schunk * 16) = k0; *(LAS u32x4*)(kb_ + (64 + srow) * AT_KSTR + schunk * 16) = k1; \
            LAS u32x2* vd_ = (LAS u32x2*)(kb_ + AT_KBYTES + srow * AT_VSTR + schunk * 16); vd_[0] = (u32x2){v0.x, v0.y}; vd_[1] = (u32x2){v0.z, v0.w}; vd_[16] = (u32x2){v1.x, v1.y}; vd_[17] = (u32x2){v1.z, v1.w}; } while (0)
        ATT_LOAD(kA0, kA1, vA0, vA1, 0); ATT_WRITE(kA0, kA1, vA0, vA1, 0); if (nt > 1) ATT_LOAD(kA0, kA1, vA0, vA1, 1);
        __syncthreads();
#define ATT_STEP(t, kc0, kc1, vc0, vc1, kn0, kn1, vn0, vn1) do { const int buf = (t) & 1; \
            if ((t) + 2 < nt) ATT_LOAD(kn0, kn1, vn0, vn1, (t) + 2); \
            _Pragma("unroll") for (int sub_ = 0; sub_ < 2; ++sub_) { \
                bool skip = false, domask = false; const int kb = lo + 128 * (t) + 64 * sub_; \
                if (latent && (t) < nband) { skip = (kb > qw_lo + 31 + 128) || (kb + 63 < qw_lo - 128); domask = !((kb + 63 - qw_lo <= 128) && (qw_lo + 31 - kb <= 128)); } \
                if (!skip) attn_tile(C.lds + buf * AT_BUF + sub_ * 64 * AT_KSTR, C.lds + buf * AT_BUF + AT_KBYTES + sub_ * 128, qf, O0, O1, mrun, lsum, domask, kb - qpos, q32, half); } \
            if ((t) + 1 < nt) ATT_WRITE(kc0, kc1, vc0, vc1, buf ^ 1); \
            __syncthreads(); } while (0)
        for (int t = 0; t < nt; t += 2) { ATT_STEP(t, kA0, kA1, vA0, vA1, kB0, kB1, vB0, vB1); if (t + 1 < nt) ATT_STEP(t + 1, kB0, kB1, vB0, vB1, kA0, kA1, vA0, vA1); }
#undef ATT_STEP
#undef ATT_LOAD
#undef ATT_WRITE
        const float inv = fast_rcp(lsum + __shfl_xor(lsum, 32));
        bf16_t* op = Q + (size_t)(rowbase + 32 * w + q32) * 512 + h * 64 + 4 * half;
#pragma unroll
        for (int g = 0; g < 4; ++g) { u32x2 o; o.x = cvt_pk_bf16(O0[4 * g] * inv, O0[4 * g + 1] * inv); o.y = cvt_pk_bf16(O0[4 * g + 2] * inv, O0[4 * g + 3] * inv); *(u32x2*)(op + 8 * g) = o;
            o.x = cvt_pk_bf16(O1[4 * g] * inv, O1[4 * g + 1] * inv); o.y = cvt_pk_bf16(O1[4 * g + 2] * inv, O1[4 * g + 3] * inv); *(u32x2*)(op + 32 + 8 * g) = o; }
    }
}

constexpr int LRW_BYTES = 11008, LR_PH = 8 * LRW_BYTES, LR_CAR = LR_PH + 8192, LR_CONST = LR_CAR + 512, LR_END = LR_CONST + 768;
static_assert(LR_END <= 131072, "lru LDS map");
__device__ __forceinline__ void lru_load_rows(float (&xr)[19], const float* XRc, int trow0, int L) {
#pragma unroll
    for (int r = 0; r < 19; ++r) { const int t = trow0 + r; const bool ok = (t >= 0) && (t < L); const float v = XRc[(size_t)(ok ? t : 0) * 512]; xr[r] = ok ? v : 0.f; }
}
__device__ __forceinline__ void lru_item(ArgsP args, const Ctx& C, int l, int it) {
    const float* XR = (const float*)act_ptr(C, A_XR); const bf16_t* GY = (const bf16_t*)act_ptr(C, A_GY); bf16_t* REC = (bf16_t*)act_ptr(C, A_XN);
    const int w = C.wave, ch = C.lane, fr = C.lane & 15, fq = C.lane >> 4;
    LAS float* XF = (LAS float*)(C.lds + w * LRW_BYTES); LAS float* AA = XF + 16 * 68; LAS bf16_t* XCB = (LAS bf16_t*)(AA + 16 * 68);
    LAS float* PH = (LAS float*)(C.lds + LR_PH); LAS float* CAR = (LAS float*)(C.lds + LR_CAR); LAS float* CST = (LAS float*)(C.lds + LR_CONST);
    const int dir = it & 1, nb = (it >> 1) & 7, sq = it >> 4;
    const bool latent = sq < 4; const int b = latent ? sq : sq - 4, L = latent ? LS : LC, rowbase = latent ? MP + b * LS : b * LC;
    const int cgl = nb * 64 + ch, g = (l * 2 + dir) * 8 + nb;
    __syncthreads();
    if (C.tid < 64) { const int cg = (l * 2 + dir) * 512 + nb * 64 + C.tid; CST[C.tid] = args->in[25][cg]; CST[64 + C.tid] = args->in[27][cg]; CST[128 + C.tid] = (-8.0f * 0.6931471805599453f) * __builtin_amdgcn_logf(1.0f + __builtin_amdgcn_exp2f(-LOG2E * args->in[28][cg]));
        CAR[C.tid] = latent ? args->in[5][((size_t)(b * 2 + l) * 2 + dir) * 512 + nb * 64 + C.tid] : 0.f; }
    bf16x8 wf[8][2];
    { const bf16_t* lw = (const bf16_t*)(C.ws + OFF_LWT) + (size_t)g * 128 * 64 + fr * 64 + 8 * fq;
#pragma unroll
      for (int nt = 0; nt < 8; ++nt)
#pragma unroll
          for (int kk = 0; kk < 2; ++kk) wf[nt][kk] = *(const bf16x8*)(lw + nt * 16 * 64 + 32 * kk); }
    const float cw0 = args->in[22][(l * 4 + 0) * 512 + cgl], cw1 = args->in[22][(l * 4 + 1) * 512 + cgl], cw2 = args->in[22][(l * 4 + 2) * 512 + cgl], cw3 = args->in[22][(l * 4 + 3) * 512 + cgl], cb = args->in[23][l * 512 + cgl];
    const float* XRc = XR + (size_t)rowbase * 512 + cgl;
    const int nch = L >> 7, e0 = dir ? 16 * (7 - w) : 16 * w;
    float xr[19];
    lru_load_rows(xr, XRc, (dir ? (L - 128) : 0) + e0 - 2, L);
    __syncthreads();
    float hfin = 0.f;
    for (int c = 0; c < nch; ++c) {
        const int t0 = dir ? (L - 128 * (c + 1)) : 128 * c, par = c & 1;
#pragma unroll
        for (int e = 0; e < 16; ++e) { const float xc = cb + cw0 * xr[e] + cw1 * xr[e + 1] + cw2 * xr[e + 2] + cw3 * xr[e + 3]; XF[e * 68 + ch] = xc; XCB[e * 72 + ch] = f2bf(xc); }
        asm volatile("" ::: "memory");
        float gy[16];
        { const bf16_t* gp = GY + (size_t)(rowbase + t0 + e0) * 512 + cgl;
#pragma unroll
          for (int j = 0; j < 16; ++j) gy[j] = bf2f(gp[(size_t)(dir ? 15 - j : j) * 512]); }
        if (c + 1 < nch) lru_load_rows(xr, XRc, (dir ? (L - 128 * (c + 2)) : 128 * (c + 1)) + e0 - 2, L);
        f32x4 acc[8];
#pragma unroll
        for (int nt = 0; nt < 8; ++nt) acc[nt] = (f32x4){0.f, 0.f, 0.f, 0.f};
#pragma unroll
        for (int kk = 0; kk < 2; ++kk) { const bf16x8 xf = *(const LAS bf16x8*)(XCB + fr * 72 + 8 * fq + 32 * kk);
#pragma unroll
            for (int nt = 0; nt < 8; ++nt) acc[nt] = __builtin_amdgcn_mfma_f32_16x16x32_bf16(wf[nt][kk], xf, acc[nt], 0, 0, 0); }
#pragma unroll
        for (int nt = 0; nt < 4; ++nt) { const int c0 = 16 * nt + 4 * fq; const f32x4 ba = *(const LAS f32x4*)(CST + c0), bi = *(const LAS f32x4*)(CST + 64 + c0), sp = *(const LAS f32x4*)(CST + 128 + c0);
            const f32x4 xcv = *(const LAS f32x4*)(XF + fr * 68 + c0); f32x4 av, bv;
#pragma unroll
            for (int i = 0; i < 4; ++i) { const float r = sigmoidf_(acc[nt][i] + ba[i]), ig = sigmoidf_(acc[nt + 4][i] + bi[i]); const float la = r * sp[i], a = __builtin_amdgcn_exp2f(LOG2E * la);
                const float om = 1.0f - a * a;
                av[i] = a; bv[i] = __builtin_amdgcn_sqrtf(fmaxf(om, 0.f)) * (ig * xcv[i]); }
            *(LAS f32x4*)(AA + fr * 68 + c0) = av; *(LAS f32x4*)(XF + fr * 68 + c0) = bv; }
        asm volatile("" ::: "memory");
        { float P = 1.f, H = 0.f;
#pragma unroll
          for (int j = 0; j < 16; ++j) { const int e = dir ? 15 - j : j; const float a = AA[e * 68 + ch], bb = XF[e * 68 + ch]; H = a * H + bb; P *= a; }
          PH[(par * 2 + 0) * 512 + w * 64 + ch] = P; PH[(par * 2 + 1) * 512 + w * 64 + ch] = H; }
        __syncthreads();
        float h = CAR[par * 64 + ch];
        for (int s2 = 0; s2 < w; ++s2) h = PH[(par * 2 + 0) * 512 + s2 * 64 + ch] * h + PH[(par * 2 + 1) * 512 + s2 * 64 + ch];
        { bf16_t* rp = REC + (size_t)(rowbase + t0 + e0) * D + dir * 512 + cgl;
#pragma unroll
          for (int j = 0; j < 16; ++j) { const int e = dir ? 15 - j : j; h = AA[e * 68 + ch] * h + XF[e * 68 + ch]; rp[(size_t)e * D] = f2bf(h * gy[j]); } }
        asm volatile("" ::: "memory");
        if (w == 7) { CAR[(par ^ 1) * 64 + ch] = h; hfin = h; }
    }
    if (!latent && w == 7) C.out[OUT_ST + ((size_t)(b * 2 + l) * 2 + dir) * 512 + cgl] = hfin;
}

#define XB_TMO      128
#define XB_XCNT(j)  (256  + 64 * (j))
#define XB_XSUB(j)  (1280 + 64 * (j))
#define XB_XGEN(j)  (2304 + 64 * (j))
#define XB_TOP      3328
#define XB_TOPGEN   3392
#define XCD_BAR_WORDS 3456
#define XB_SPIN_CAP (1u << 18)

__device__ __forceinline__ unsigned xb_ld(unsigned* p)              { return __hip_atomic_load(p, __ATOMIC_RELAXED, __HIP_MEMORY_SCOPE_AGENT); }
__device__ __forceinline__ unsigned xb_add(unsigned* p, unsigned v) { return __hip_atomic_fetch_add(p, v, __ATOMIC_RELAXED, __HIP_MEMORY_SCOPE_AGENT); }
__device__ __forceinline__ unsigned xb_xcc_id() { return (unsigned)__builtin_amdgcn_s_getreg((3 << 11) | 20) & 0xFu; }
#define XB_SPIN(cond, bar) do { unsigned _sp = 0; while (cond) { __builtin_amdgcn_s_sleep(1); \
    if ((++_sp & 255u) == 0u) { if (xb_ld(&(bar)[XB_TMO])) break; if (_sp > XB_SPIN_CAP) { atomicAdd(&(bar)[XB_TMO], 1u); break; } } } } while (0)

struct XcdBarrier {
    unsigned* bar; unsigned x;
    volatile LAS unsigned* st;
};

__device__ __forceinline__ XcdBarrier xcd_barrier_post(unsigned* bar, volatile LAS unsigned* st, int tid) {
    XcdBarrier b; b.bar = bar; b.x = xb_xcc_id(); b.st = st;
    if (tid == 0) (void)xb_add(&bar[XB_XCNT(b.x)], 1u);
    return b;
}
__device__ __forceinline__ void xcd_barrier_complete(unsigned* bar, unsigned x, unsigned& nloc, unsigned& nx) {
    const unsigned G = gridDim.x * gridDim.y * gridDim.z;
    unsigned sum, cnt, mine, sp = 0u;
    for (;;) {
        sum = 0u; cnt = 0u; mine = 0u;
#pragma unroll
        for (unsigned j = 0; j < 16; ++j) { const unsigned c = xb_ld(&bar[XB_XCNT(j)]); sum += c; cnt += (c > 0u) ? 1u : 0u; mine = (j == x) ? c : mine; }
        if (sum == G) break;
        __builtin_amdgcn_s_sleep(1);
        if ((++sp & 255u) == 0u) { if (xb_ld(&bar[XB_TMO])) break; if (sp > XB_SPIN_CAP) { atomicAdd(&bar[XB_TMO], 1u); break; } }
    }
    nloc = mine > 0u ? mine : 1u; nx = cnt > 0u ? cnt : 1u;
}

__device__ __forceinline__ void xcd_barrier(const XcdBarrier& b, int tid) {
    asm volatile("s_waitcnt vmcnt(0)" ::: "memory");
    __syncthreads();
    if (tid == 0) {
        unsigned* bar = b.bar;
        __builtin_amdgcn_s_waitcnt(0);
        unsigned nloc = b.st[0], nx = b.st[1];
        if (nloc == 0u) { xcd_barrier_complete(bar, b.x, nloc, nx); b.st[0] = nloc; b.st[1] = nx; }
        const unsigned old = xb_add(&bar[XB_XSUB(b.x)], 1u);
        const unsigned gen = old / nloc;
        if (old + 1u == (gen + 1u) * nloc) {
            __builtin_amdgcn_fence(__ATOMIC_RELEASE, "agent");
            asm volatile("s_waitcnt vmcnt(0)" ::: "memory");
            const unsigned og = xb_add(&bar[XB_TOP], 1u);
            const unsigned tg = og / nx;
            if (og + 1u == (tg + 1u) * nx) xb_add(&bar[XB_TOPGEN], 1u);
            else XB_SPIN(xb_ld(&bar[XB_TOPGEN]) == tg, bar);
            __builtin_amdgcn_fence(__ATOMIC_ACQUIRE, "agent");
            xb_add(&bar[XB_XGEN(b.x)], 1u);
            asm volatile("s_waitcnt vmcnt(0)" ::: "memory");
        } else {
            XB_SPIN(xb_ld(&bar[XB_XGEN(b.x)]) == gen, bar);
            __builtin_amdgcn_fence(__ATOMIC_ACQUIRE, "agent");
            asm volatile("s_waitcnt vmcnt(0)" ::: "memory");
        }
    }
    __syncthreads();
}

#ifndef PROBE_ITEM
#define PROBE_ITEM 0
#endif
#ifndef PROBE_STAT
#define PROBE_STAT 0
#endif
constexpr int CW_PROBE = 3700;
struct OneUnit { Unit u; __device__ bool next(int i, Unit& o) const { if (i) return false; o = u; return true; } };
constexpr int MX_DFTL = 64, MX_LRUL = 64, MX_ATTL = 256, MX_LRUC = 256, MX_ATTC = 128, MX_DFTC = 32;
constexpr int MX_N = MX_DFTL + MX_LRUL + MX_ATTL + MX_LRUC + MX_ATTC + MX_DFTC;
constexpr int CW_QUEUE = 3520;
__device__ __forceinline__ void mixer_phase(ArgsP args_in, const Ctx& C_in, int l_in) {
    for (;;) {
        ArgsP args = args_in; asm volatile("" : "+s"(args));
        int tid_ = C_in.tid; asm volatile("" : "+v"(tid_));
        int l = l_in; asm volatile("" : "+s"(l));
        Ctx C; C.out = args->out; C.ws = args->ws; C.lds = C_in.lds; C.tid = tid_; C.lane = tid_ & 63; C.wave = __builtin_amdgcn_readfirstlane(tid_ >> 6); C.bid = C_in.bid; C.G = C_in.G;
        volatile LAS int* qslot = (volatile LAS int*)(C.lds + 131072 + 64);
        unsigned* qhead = (unsigned*)(C.ws + WS_CTL) + CW_QUEUE + 64 * l;
        __syncthreads();
        if (C.tid == 0) qslot[0] = (int)__hip_atomic_fetch_add(qhead, 1u, __ATOMIC_RELAXED, __HIP_MEMORY_SCOPE_AGENT);
        __syncthreads();
        int idx = __builtin_amdgcn_readfirstlane(qslot[0]);
        if (idx >= MX_N) break;
        const unsigned long long pt0 = (PROBE_ITEM != 0) ? __builtin_amdgcn_s_memrealtime() : 0ull; int ptype = 0;
        if (idx < MX_DFTL) { const int z = idx >> 4, pm = (idx >> 1) & 7, pn = idx & 1;
            OneUnit S; S.u.pm = pm; S.u.pn = pn; S.u.z = z; S.u.A = (const bf16_t*)(C.ws + WS_DFTL) + (size_t)pm * 256 * LS; S.u.B = (const bf16_t*)act_ptr(C, A_XFT) + (size_t)16 * 512 * LC + ((size_t)z * 512 + pn * 256) * LS;
            EpiDft E{(bf16_t*)act_ptr(C, A_Z), LS, MP + z * LS}; GEMM(C, S, E, LS, LS, LS); ptype = 1; }
        else { idx -= MX_DFTL;
        if (idx < MX_LRUL) { lru_item(args, C, l, idx); ptype = 2; } else { idx -= MX_LRUL;
        if (idx < MX_ATTL) { attn_unit(args, C, l, idx); ptype = 3; } else { idx -= MX_ATTL;
        if (idx < MX_LRUC) { lru_item(args, C, l, 64 + idx); ptype = 4; } else { idx -= MX_LRUC;
        if (idx < MX_ATTC) { attn_unit(args, C, l, 256 + idx); ptype = 5; } else { idx -= MX_ATTC;
        { const int z = idx >> 1, pn = idx & 1; ptype = 6;
            OneUnit S; S.u.pm = 0; S.u.pn = pn; S.u.z = z; S.u.A = (const bf16_t*)(C.ws + WS_DFTC); S.u.B = (const bf16_t*)act_ptr(C, A_XFT) + ((size_t)z * 512 + pn * 256) * LC;
            EpiDft E{(bf16_t*)act_ptr(C, A_Z), LC, z * LC}; GEMM(C, S, E, LC, LC, LC); } } } } } }
        if (PROBE_ITEM != 0 && ptype == PROBE_ITEM && C.tid == 0) { const unsigned dt = (unsigned)(__builtin_amdgcn_s_memrealtime() - pt0); unsigned* pw = (unsigned*)(C.ws + WS_CTL) + CW_PROBE;
            if (PROBE_STAT == 0) atomicMax(pw, dt); else atomicAdd(pw, dt); }
    }
}

#ifndef PROBE_MASK
#define PROBE_MASK 0u
#endif
constexpr int N_PHASES = 19;
__device__ __forceinline__ void run_phase(ArgsP args, const Ctx& C, int ph) {
    if (ph == 0) { p0_prologue(args, C); return; }
    if (ph == 1) { p0b_phase(args, C); return; }
    if (ph == N_PHASES - 1) { finalnorm_phase(args, C); return; }
    const int l = (ph - 2) >> 3, s = (ph - 2) & 7;
    const float* MODB = (const float*)(C.ws + OFF_MOD);
    if (s == 0 || s == 6) { const int sub = s ? 2 : 0; StaticOrder S; S.init(M, 2 * DFF, C.G, C.bid, (const bf16_t*)act_ptr(C, A_XN), D, (const bf16_t*)wl_ptr(C, l, s ? WL_GU2 : WL_GU1), D);
        EpiGU E{(bf16_t*)act_ptr(C, A_G), ssq_ptr(C, l * 3 + sub), sw_ptr(C, l, sub, 0)}; GEMM(C, S, E, D, D, D);
        if (l == 0 && s == 0) bg_run(args, C, 0, true, ph, 0);
        if (l == 0 && s == 6) { bg_load_shifts(C, 1); bg_run(args, C, 4, true, ph, 0); } }
    else if (s == 1 || s == 7) { const int sub = (s == 1) ? 0 : 2; const bool first = (l == 0 && s == 1);
        int ln = l, subn = 1; if (s == 7) { ln = (l == 0) ? 1 : -1; subn = 0; }
        const int sidx = (ln < 0) ? 6 : ln * 3 + subn;
        StaticOrder S; S.init(M, D, C.G, C.bid, (const bf16_t*)act_ptr(C, A_G), DFF, (const bf16_t*)wl_ptr(C, l, s == 1 ? WL_D1 : WL_D2), DFF);
        EpiRes E{C.out, first ? args->in[0] : C.out, first ? args->in[1] : C.out + (size_t)MP * D, MODB,
                 (bf16_t*)act_ptr(C, A_XN), args->in[9] + (size_t)((ln < 0 ? 0 : ln) * 3 + subn) * D, ssq_ptr(C, sidx), l, sub, ln, subn, 0.5f};
        GEMM(C, S, E, DFF, DFF, DFF);
        if (first) { bg_signal_done(C, ph); bg_load_shifts(C, 0); bg_run(args, C, 1, true, ph, 0); bg_run(args, C, 2, true, ph, 0); bg_run(args, C, 3, false, ph, C.G < 192 ? C.G : 192); }
        if (l == 0 && s == 7) bg_run(args, C, 5, true, ph, 0); }
    else if (s == 2) { StaticOrder S; S.init(M, NIN, C.G, C.bid, (const bf16_t*)act_ptr(C, A_XN), D, (const bf16_t*)wl_ptr(C, l, WL_IN), D);
        EpiIn E{(bf16_t*)act_ptr(C, A_Q), (bf16_t*)act_ptr(C, A_K), (bf16_t*)act_ptr(C, A_VT), (bf16_t*)act_ptr(C, A_GY), (bf16_t*)act_ptr(C, A_XFT), (bf16_t*)act_ptr(C, A_G),
                (float*)act_ptr(C, A_XR), C.out, (const float*)(C.ws + OFF_ROPE), args->in[19] + (size_t)l * 3072, l, ssq_ptr(C, l * 3 + 1), sw_ptr(C, l, 1, 0)};
        GEMM(C, S, E, D, D, D); }
    else if (s == 3) { mixer_phase(args, C, l); }
    else if (s == 4) {
        bf16_t* MG = (bf16_t*)act_ptr(C, A_XR); const bf16_t* G = (const bf16_t*)act_ptr(C, A_G);
        { StaticOrder S; S.init(M, D, C.G, C.bid, (const bf16_t*)act_ptr(C, A_Q), 512, (const bf16_t*)wl_ptr(C, l, WL_A), 512); EpiBranch<0> E{MG, G, 0}; GEMM(C, S, E, 512, 512, 512); }
        { StaticOrder S; S.init(M, D, C.G, C.bid, (const bf16_t*)act_ptr(C, A_XN), D, (const bf16_t*)wl_ptr(C, l, WL_L2), D); EpiBranch<1> E{MG, G, 1}; GEMM(C, S, E, D, D, D); }
        { StaticOrder S; S.init(M, D, C.G, C.bid, (const bf16_t*)act_ptr(C, A_Z), D, (const bf16_t*)wl_ptr(C, l, WL_F2), D); EpiBranch<1> E{MG, G, 2}; GEMM(C, S, E, D, D, D); }
        if (l == 0) { bg_signal_done(C, ph); bg_run(args, C, 3, false, ph, C.G < 192 ? C.G : 192); } }
    else if (s == 5) { StaticOrder S; S.init(M, D, C.G, C.bid, (const bf16_t*)act_ptr(C, A_XR), D, (const bf16_t*)wl_ptr(C, l, WL_O), D);
        EpiRes E{C.out, C.out, C.out + (size_t)MP * D, MODB, (bf16_t*)act_ptr(C, A_XN), args->in[9] + (size_t)(l * 3 + 2) * D, ssq_ptr(C, l * 3 + 2), l, 1, l, 2, 1.0f};
        GEMM(C, S, E, D, D, D);
        if (l == 0) bg_run(args, C, 3, true, ph, 0); }
}

__global__ void __launch_bounds__(NTHREADS, 2) fwd_kernel(Args args_byval) {
    extern __shared__ __attribute__((aligned(16))) unsigned char lds_raw[];
    ArgsP args0 = (ArgsP)__builtin_amdgcn_kernarg_segment_ptr();
    const int lo = args0->ph_lo, hi = args0->ph_hi;
    volatile LAS unsigned* bst = (volatile LAS unsigned*)((LAS unsigned char*)lds_raw + 131072);
    const int wave0 = __builtin_amdgcn_readfirstlane(threadIdx.x >> 6);
#define TID_NOW() ({ unsigned z_ = 0u; asm volatile("" : "+s"(z_)); wave0 * 64 + (int)__builtin_amdgcn_mbcnt_hi(~0u, __builtin_amdgcn_mbcnt_lo(~0u, z_)); })
    { const int t = TID_NOW(); if (t < 2) bst[t] = 0u; }
    __syncthreads();
    (void)xcd_barrier_post((unsigned*)(args0->ws + WS_CTL), bst, TID_NOW());
    volatile LAS unsigned long long* tacc = (volatile LAS unsigned long long*)((LAS unsigned char*)lds_raw + 131072 + 128);
    if (PROBE_MASK != 0u && blockIdx.x == 0 && TID_NOW() == 0) { tacc[0] = __builtin_amdgcn_s_memrealtime(); tacc[1] = 0ull; }
    for (int ph = lo; ph < hi; ++ph) {
        ArgsP args = args0; asm volatile("" : "+s"(args));
        int tid = TID_NOW(); asm volatile("" : "+v"(tid));
        int bid = blockIdx.x; asm volatile("" : "+s"(bid));
        Ctx C; C.out = args->out; C.ws = args->ws; C.lds = (LAS unsigned char*)lds_raw;
        C.tid = tid; C.lane = tid & 63; C.wave = __builtin_amdgcn_readfirstlane(tid >> 6); C.bid = bid; C.G = gridDim.x;
        run_phase(args, C, ph);
        if (ph + 1 < hi) {
            { XcdBarrier xb; xb.bar = (unsigned*)(args->ws + WS_CTL); xb.x = xb_xcc_id(); xb.st = bst; xcd_barrier(xb, TID_NOW()); } }
        if (PROBE_MASK != 0u && blockIdx.x == 0 && TID_NOW() == 0) { const unsigned long long now = __builtin_amdgcn_s_memrealtime(); if ((PROBE_MASK >> ph) & 1u) tacc[1] = tacc[1] + (now - tacc[0]); tacc[0] = now; }
    }
    if (PROBE_ITEM != 0 && blockIdx.x == 0 && TID_NOW() == 0) { const unsigned v = __hip_atomic_load((unsigned*)(args0->ws + WS_CTL) + CW_PROBE, __ATOMIC_RELAXED, __HIP_MEMORY_SCOPE_AGENT); const unsigned long long want = PROBE_STAT ? v / 256u : v, t0 = __builtin_amdgcn_s_memrealtime(); while (__builtin_amdgcn_s_memrealtime() - t0 < want) __builtin_amdgcn_s_sleep(8); }
    if (PROBE_MASK != 0u && blockIdx.x == 0 && TID_NOW() == 0) { const unsigned long long t0 = tacc[0], want = tacc[1]; while (__builtin_amdgcn_s_memrealtime() - t0 < want) __builtin_amdgcn_s_sleep(8); }
#undef TID_NOW
}

extern "C" void kernel_launch(void* const* d_in, const int* in_sizes, int n_in, void* d_out, int out_size, void* d_ws, size_t ws_size, hipStream_t stream) {
    if (n_in != 32 || ws_size < WS_END) { fprintf(stderr, "kernel_launch: n_in %d ws %zu (need %zu)\n", n_in, ws_size, (size_t)WS_END); return; }
    static int grid = 0;
    if (grid == 0) {
        int dev = 0, cus = 0, per_cu = 0;
        if (hipGetDevice(&dev) != hipSuccess || hipDeviceGetAttribute(&cus, hipDeviceAttributeMultiprocessorCount, dev) != hipSuccess) { fprintf(stderr, "kernel_launch: device query failed\n"); grid = -1; return; }
        if (hipFuncSetAttribute((const void*)fwd_kernel, hipFuncAttributeMaxDynamicSharedMemorySize, LDS_BYTES) != hipSuccess) { fprintf(stderr, "hipFuncSetAttribute failed\n"); grid = -1; return; }
        if (hipOccupancyMaxActiveBlocksPerMultiprocessor(&per_cu, (const void*)fwd_kernel, NTHREADS, LDS_BYTES) != hipSuccess || per_cu < 1) { fprintf(stderr, "kernel_launch: occupancy query says %d blocks per CU\n", per_cu); grid = -1; return; }
        if (per_cu > 1) per_cu = 1;
        grid = cus * per_cu;
    }
    if (grid < 0) return;
    Args a{};
    for (int i = 0; i < 32; ++i) a.in[i] = (const float*)d_in[i];
    a.out = (float*)d_out; a.ws = (unsigned char*)d_ws;
    a.ph_lo = 0; a.ph_hi = N_PHASES;
    if (hipMemsetAsync((char*)d_ws + WS_CTL, 0, CTL_ZERO_BYTES, stream) != hipSuccess) { fprintf(stderr, "hipMemsetAsync failed\n"); return; }
    void* kargs[] = {&a};
    hipError_t e = hipLaunchCooperativeKernel((const void*)fwd_kernel, dim3(grid), dim3(NTHREADS), kargs, LDS_BYTES, stream);
    if (e != hipSuccess) fprintf(stderr, "cooperative launch failed: %s (grid %d)\n", hipGetErrorString(e), grid);
}
```

```cpp
#include <hip/hip_runtime.h>
#include <hip/hip_cooperative_groups.h>
#include <cstdint>
#include <cstdio>


#define LAS __attribute__((address_space(3)))
typedef unsigned short bf16_t;
typedef short bf16x8 __attribute__((ext_vector_type(8)));
typedef float f32x4 __attribute__((ext_vector_type(4)));
typedef float f32x2 __attribute__((ext_vector_type(2)));
typedef float f32x16 __attribute__((ext_vector_type(16)));
typedef unsigned u32x4 __attribute__((ext_vector_type(4)));
typedef unsigned u32x2 __attribute__((ext_vector_type(2)));

constexpr int D = 1024, MP = 4096, MS = 8192, M = MP + MS, DFF = 2816, DEPTH = 2;
constexpr int LC = 256, LS = 2048;
constexpr int NB_C = 16, NB_S = 4;
constexpr int NIN = 2304 + 3072;
constexpr int NMOD = 9216;
constexpr float EPS = 1e-6f;
constexpr float LOG2E = 1.4426950408889634f;
constexpr float QSCALE = 0.125f * LOG2E;

constexpr size_t MiB = 1u << 20;
constexpr size_t SZ_WGU = (size_t)2 * DFF * D * 2, SZ_WD = (size_t)D * DFF * 2, SZ_WIN = (size_t)NIN * D * 2;
constexpr size_t SZ_WA = (size_t)D * 512 * 2, SZ_W1K = (size_t)D * D * 2;
constexpr size_t WL_GU1 = 0, WL_D1 = WL_GU1 + SZ_WGU, WL_GU2 = WL_D1 + SZ_WD, WL_D2 = WL_GU2 + SZ_WGU, WL_IN = WL_D2 + SZ_WD,
                 WL_A = WL_IN + SZ_WIN, WL_L2 = WL_A + SZ_WA, WL_F2 = WL_L2 + SZ_W1K, WL_O = WL_F2 + SZ_W1K, WL_SIZE = WL_O + SZ_W1K;
constexpr size_t WS_CTL = 0;
constexpr size_t WS_MISC = 1 * MiB;
constexpr size_t OFF_MOD = WS_CTL + 65536;
constexpr size_t OFF_SSQ = OFF_MOD + (size_t)2 * 5 * NMOD * 4;
constexpr size_t CTL_ZERO_BYTES = 32768;
static_assert(OFF_SSQ + (size_t)7 * M * 4 - WS_CTL <= 1048576, "control region");
constexpr size_t OFF_ROPE = WS_MISC;
constexpr size_t OFF_CK = OFF_ROPE + 2 * 1024 * 4;
constexpr size_t OFF_CVT = OFF_CK + (size_t)4 * 2 * 256 * 128 * 2;
constexpr size_t OFF_LWT = OFF_CVT + (size_t)4 * 2 * 2 * 64 * 256 * 2;
constexpr size_t WS_DFTC = 3 * MiB;
constexpr size_t WS_DFTL = 4 * MiB;
constexpr size_t OFF_SW = 12 * MiB;
constexpr size_t WS_W = 20 * MiB;
constexpr size_t WS_ACT = WS_W + 2 * WL_SIZE;
constexpr size_t A_G = 0;
constexpr size_t A_XN = 72 * MiB;
constexpr size_t A_XR = 96 * MiB;
constexpr size_t A_GY = 120 * MiB;
constexpr size_t A_XFT = 132 * MiB;
constexpr size_t A_Q = 144 * MiB;
constexpr size_t A_K = 156 * MiB;
constexpr size_t A_VT = 159 * MiB;
constexpr size_t A_Z = 162 * MiB;
constexpr size_t A_END = 186 * MiB;
constexpr size_t WS_END = WS_ACT + A_END;

constexpr int OUT_YS = MP * D, OUT_CK = M * D, OUT_CV = OUT_CK + 16 * 2 * 256 * 128, OUT_ST = OUT_CV + 16 * 2 * 256 * 128;

constexpr int NTHREADS = 512, NWAVES = 8;
constexpr int LDS_BYTES = 147456;

typedef __bf16 bf16x2_t __attribute__((ext_vector_type(2)));
__device__ __forceinline__ unsigned cvt_pk_bf16(float lo, float hi) { f32x2 v = {lo, hi}; bf16x2_t b = __builtin_convertvector(v, bf16x2_t); return __builtin_bit_cast(unsigned, b); }
__device__ __forceinline__ bf16_t f2bf(float f) { return (bf16_t)(cvt_pk_bf16(f, 0.f) & 0xffffu); }
__device__ __forceinline__ float bf2f(unsigned h) { return __uint_as_float(h << 16); }
__device__ __forceinline__ float bflo(unsigned w) { return __uint_as_float(w << 16); }
__device__ __forceinline__ float bfhi(unsigned w) { return __uint_as_float(w & 0xffff0000u); }
__device__ __forceinline__ float fast_rcp(float x) { return __builtin_amdgcn_rcpf(x); }
__device__ __forceinline__ float sigmoidf_(float x) { return fast_rcp(1.0f + __builtin_amdgcn_exp2f(-LOG2E * x)); }
__device__ __forceinline__ float siluf_(float x) { return x * sigmoidf_(x); }
__device__ __forceinline__ float gelu_tanh(float x) { const float u = (-2.0f * LOG2E * 0.7978845608028654f) * (x + 0.044715f * x * x * x); return x * fast_rcp(1.0f + __builtin_amdgcn_exp2f(u)); }
template <int CTRL> __device__ __forceinline__ float dpp_f(float v) { return __builtin_bit_cast(float, __builtin_amdgcn_update_dpp(0, __builtin_bit_cast(int, v), CTRL, 0xf, 0xf, true)); }
__device__ __forceinline__ float sum_x16(float v) { unsigned a = __builtin_bit_cast(unsigned, v), b = a; asm volatile("" : "+v"(b)); const auto r = __builtin_amdgcn_permlane16_swap(a, b, false, false); unsigned r0 = r[0], r1 = r[1]; asm volatile("" : "+v"(r0), "+v"(r1)); return __builtin_bit_cast(float, r0) + __builtin_bit_cast(float, r1); }
__device__ __forceinline__ float sum_x32(float v) { unsigned a = __builtin_bit_cast(unsigned, v), b = a; asm volatile("" : "+v"(b)); const auto r = __builtin_amdgcn_permlane32_swap(a, b, false, false); unsigned r0 = r[0], r1 = r[1]; asm volatile("" : "+v"(r0), "+v"(r1)); return __builtin_bit_cast(float, r0) + __builtin_bit_cast(float, r1); }
__device__ __forceinline__ float wave_sum(float v) {
    v += dpp_f<0xB1>(v); v += dpp_f<0x4E>(v); v += dpp_f<0x141>(v); v += dpp_f<0x140>(v);
    return sum_x32(sum_x16(v));
}
__device__ __forceinline__ int cond_of_row(int r) { return r < MP ? 4 : ((r - MP) >> 11); }

struct Args {
    const float* in[32];
    float* out;
    unsigned char* ws;
    int ph_lo, ph_hi;
};

typedef const __attribute__((address_space(4))) Args* ArgsP;
struct Ctx {
    float* out; unsigned char* ws; LAS unsigned char* lds;
    int tid, lane, wave, bid, G;
};
__device__ __forceinline__ unsigned char* wl_ptr(const Ctx& C, int l, size_t off) { return C.ws + WS_W + (size_t)l * WL_SIZE + off; }
__device__ __forceinline__ unsigned char* act_ptr(const Ctx& C, size_t off) { return C.ws + WS_ACT + off; }
__device__ __forceinline__ const float* mod_ptr(const Ctx& C, int l, int c, int sub, int which) { return (const float*)(C.ws + OFF_MOD) + ((size_t)(l * 5 + c) * NMOD + (sub * 3 + which) * D); }

struct TrItem { const float* W; bf16_t* WT; int ldw, ldt, drow0, dcol0, k0, n0; };
constexpr int I_G = 16 * 88, I_D = 44 * 32, I_IN = 16 * 72, I_BG = 16 * 96, I_A = 8 * 32, I_L = 8 * 32, I_O = 16 * 32;
constexpr int TR_PER_LAYER = 4 * I_G + 2 * I_D + I_IN + I_BG + I_A + 2 * I_L + I_O;
__device__ __forceinline__ TrItem p0_decode(ArgsP args, const Ctx& C, int it) {
    const int l = it / TR_PER_LAYER; int r = it % TR_PER_LAYER; TrItem t; t.dcol0 = 0;
    if (r < 2 * I_G) { const int gu = r >= I_G; r -= gu * I_G; const int kb = r / 88, n0 = (r % 88) * 32; t.W = args->in[11 + gu] + (size_t)l * D * DFF; t.ldw = DFF; t.WT = (bf16_t*)wl_ptr(C, l, WL_GU1); t.ldt = D; t.drow0 = 256 * (n0 >> 7) + 128 * gu + (n0 & 127); t.k0 = kb * 64; t.n0 = n0; return t; } r -= 2 * I_G;
    if (r < I_D) { const int kb = r / 32, nb = r % 32; t.W = args->in[13] + (size_t)l * DFF * D; t.ldw = D; t.WT = (bf16_t*)wl_ptr(C, l, WL_D1); t.ldt = DFF; t.drow0 = nb * 32; t.k0 = kb * 64; t.n0 = nb * 32; return t; } r -= I_D;
    if (r < 2 * I_G) { const int gu = r >= I_G; r -= gu * I_G; const int kb = r / 88, n0 = (r % 88) * 32; t.W = args->in[14 + gu] + (size_t)l * D * DFF; t.ldw = DFF; t.WT = (bf16_t*)wl_ptr(C, l, WL_GU2); t.ldt = D; t.drow0 = 256 * (n0 >> 7) + 128 * gu + (n0 & 127); t.k0 = kb * 64; t.n0 = n0; return t; } r -= 2 * I_G;
    if (r < I_D) { const int kb = r / 32, nb = r % 32; t.W = args->in[16] + (size_t)l * DFF * D; t.ldw = D; t.WT = (bf16_t*)wl_ptr(C, l, WL_D2); t.ldt = DFF; t.drow0 = nb * 32; t.k0 = kb * 64; t.n0 = nb * 32; return t; } r -= I_D;
    if (r < I_IN) { const int kb = r / 72, nb = r % 72; t.W = args->in[17] + (size_t)l * D * 2304; t.ldw = 2304; t.WT = (bf16_t*)wl_ptr(C, l, WL_IN); t.ldt = D; t.drow0 = nb * 32; t.k0 = kb * 64; t.n0 = nb * 32; return t; } r -= I_IN;
    if (r < I_BG) { const int kb = r / 96, nb = r % 96; t.W = args->in[18] + (size_t)l * D * 3072; t.ldw = 3072; t.WT = (bf16_t*)wl_ptr(C, l, WL_IN); t.ldt = D; t.drow0 = 2304 + nb * 32; t.k0 = kb * 64; t.n0 = nb * 32; return t; } r -= I_BG;
    if (r < I_A) { const int kb = r / 32, nb = r % 32; t.W = args->in[21] + (size_t)l * 512 * D; t.ldw = D; t.WT = (bf16_t*)wl_ptr(C, l, WL_A); t.ldt = 512; t.drow0 = nb * 32; t.k0 = kb * 64; t.n0 = nb * 32; return t; } r -= I_A;
    if (r < 2 * I_L) { const int dup = r >= I_L; r -= dup * I_L; const int kb = r / 32, nb = r % 32; t.W = args->in[29] + (size_t)l * 512 * D; t.ldw = D; t.WT = (bf16_t*)wl_ptr(C, l, WL_L2); t.ldt = D; t.drow0 = nb * 32; t.dcol0 = 512 * dup; t.k0 = kb * 64; t.n0 = nb * 32; return t; } r -= 2 * I_L;
    { const int kb = r / 32, nb = r % 32; t.W = args->in[31] + (size_t)l * D * D; t.ldw = D; t.WT = (bf16_t*)wl_ptr(C, l, WL_O); t.ldt = D; t.drow0 = nb * 32; t.k0 = kb * 64; t.n0 = nb * 32; return t; }
}
__device__ __forceinline__ void p0_tr_load(const TrItem& t, f32x4 (&r)[8], int lane) {
    const float* p = t.W + (size_t)(t.k0 + (lane >> 3)) * t.ldw + t.n0 + 4 * (lane & 7);
#pragma unroll
    for (int i = 0; i < 8; ++i) r[i] = *(const f32x4*)(p + (size_t)(8 * i) * t.ldw);
}
__device__ __forceinline__ void p0_tr_store(const TrItem& t, const f32x4 (&r)[8], LAS float* scr, int lane) {
#pragma unroll
    for (int i = 0; i < 8; ++i) { LAS float* p = scr + (8 * i + (lane >> 3)) * 33 + 4 * (lane & 7); p[0] = r[i].x; p[1] = r[i].y; p[2] = r[i].z; p[3] = r[i].w; }
    asm volatile("s_waitcnt lgkmcnt(0)" ::: "memory");
    const int c = lane & 7;
#pragma unroll
    for (int j = 0; j < 4; ++j) { const int n = (lane >> 3) + 8 * j; const LAS float* q = scr + (8 * c) * 33 + n;
        u32x4 o; o.x = cvt_pk_bf16(q[0 * 33], q[1 * 33]); o.y = cvt_pk_bf16(q[2 * 33], q[3 * 33]); o.z = cvt_pk_bf16(q[4 * 33], q[5 * 33]); o.w = cvt_pk_bf16(q[6 * 33], q[7 * 33]);
        *(u32x4*)(t.WT + (size_t)(t.drow0 + n) * t.ldt + t.dcol0 + t.k0 + 8 * c) = o; }
    asm volatile("s_waitcnt lgkmcnt(0)" ::: "memory");
}

__device__ __forceinline__ void p0_transposes(ArgsP args, const Ctx& C, LAS float* SCR, int it0, int it1, int gw, int NGW) {
    LAS float* scr = SCR + C.wave * (64 * 33);
    int it = it0 + gw; TrItem cur; f32x4 rc[8];
    if (it < it1) { cur = p0_decode(args, C, it); p0_tr_load(cur, rc, C.lane); }
    while (it < it1) {
        const int it2 = it + NGW; const bool more = it2 < it1; TrItem nxt = cur; f32x4 rn[8];
        if (more) { nxt = p0_decode(args, C, it2); p0_tr_load(nxt, rn, C.lane); }
        p0_tr_store(cur, rc, scr, C.lane);
        if (more) { cur = nxt;
#pragma unroll
            for (int i = 0; i < 8; ++i) rc[i] = rn[i]; }
        it = it2;
    }
}
constexpr int BG_NA = TR_PER_LAYER - 2 * I_G, BG_NB = (5376 + 5632) / 8, BG_NC = 512, BG_ND = TR_PER_LAYER, BG_NE = (5632 + 5376 + 5632) / 8, BG_NF = 512;
static_assert(BG_NA % 32 == 0 && BG_ND % 32 == 0 && BG_NB % 8 == 0 && BG_NE % 8 == 0, "background batches");
constexpr int CW_BGQ = 4096, CW_DONE = 3632;
constexpr int BG_SCR = 61440;
__device__ __forceinline__ void bg_load_shifts(const Ctx& C, int l) {
    LAS float* SH = (LAS float*)C.lds;
    __syncthreads();
    for (int i = C.tid; i < 15 * 1024; i += NTHREADS) { const int k = i & 1023, c = (i >> 10) % 5, sub = (i >> 10) / 5; SH[i] = mod_ptr(C, l, c, sub, 0)[k]; }
    __syncthreads();
}
__device__ __forceinline__ void sw_rows(const Ctx& C, int l, int r0, int nr) {
    const LAS float* SH = (const LAS float*)C.lds;
    for (int it = r0; it < r0 + nr; ++it) {
        int n = it, sub = 0; size_t woff = WL_GU1;
        if (n >= 5632) { n -= 5632; sub = 1; woff = WL_IN; if (n >= 5376) { n -= 5376; sub = 2; woff = WL_GU2; } }
        const u32x4* wp = (const u32x4*)((const bf16_t*)wl_ptr(C, l, woff) + (size_t)n * D + 16 * C.lane);
        const u32x4 w0 = wp[0], w1 = wp[1];
        float wv[16] = {bflo(w0.x), bfhi(w0.x), bflo(w0.y), bfhi(w0.y), bflo(w0.z), bfhi(w0.z), bflo(w0.w), bfhi(w0.w), bflo(w1.x), bfhi(w1.x), bflo(w1.y), bfhi(w1.y), bflo(w1.z), bfhi(w1.z), bflo(w1.w), bfhi(w1.w)};
        float acc[5];
#pragma unroll
        for (int c = 0; c < 5; ++c) { const LAS f32x4* sp = (const LAS f32x4*)(SH + (sub * 5 + c) * 1024 + 16 * C.lane); float a = 0.f;
#pragma unroll
            for (int q = 0; q < 4; ++q) { const f32x4 sv = sp[q]; a += sv.x * wv[4 * q] + sv.y * wv[4 * q + 1] + sv.z * wv[4 * q + 2] + sv.w * wv[4 * q + 3]; }
            acc[c] = wave_sum(a); }
        if (C.lane < 5) { float* dst = (float*)(C.ws + OFF_SW) + (size_t)((l * 3 + sub) * 5 + C.lane) * 5632 + n;
            *dst = (C.lane == 0) ? acc[0] : (C.lane == 1) ? acc[1] : (C.lane == 2) ? acc[2] : (C.lane == 3) ? acc[3] : acc[4]; }
    }
}
__device__ __forceinline__ void wf2_item(ArgsP args, const Ctx& C, int l, int idx) {
    const int g = idx >> 7, n0 = ((idx >> 3) & 15) * 64, rt = idx & 7, trig = rt >> 2, c0 = 32 * (rt & 3), i32 = C.lane & 31, hk = C.lane >> 5, cc = c0 + i32;
    const float* Wf = args->in[30] + (size_t)l * 512 * D + (size_t)(g * 128) * D + n0 + i32;
    f32x16 acc0, acc1;
#pragma unroll
    for (int q = 0; q < 16; ++q) { acc0[q] = 0.f; acc1[q] = 0.f; }
#pragma unroll 8
    for (int kk = 0; kk < 64; ++kk) { const int q = 2 * kk + hk; const float ph = (float)((cc * q) & 127) * (1.0f / 128.0f); const float a = trig ? __builtin_amdgcn_sinf(ph) : __builtin_amdgcn_cosf(ph);
        const float b0 = Wf[(size_t)q * D], b1 = Wf[(size_t)q * D + 32];
        acc0 = __builtin_amdgcn_mfma_f32_32x32x2f32(a, b0, acc0, 0, 0, 0); acc1 = __builtin_amdgcn_mfma_f32_32x32x2f32(a, b1, acc1, 0, 0, 0); }
    const float sc = trig ? -0.08838834764831845f : 0.08838834764831845f;
    bf16_t* d0 = (bf16_t*)wl_ptr(C, l, WL_F2) + (size_t)(n0 + i32) * D + (trig ? 512 : 0) + g * 128 + c0 + 4 * hk;
#pragma unroll
    for (int q4 = 0; q4 < 4; ++q4) { u32x2 o; o.x = cvt_pk_bf16(acc0[4 * q4] * sc, acc0[4 * q4 + 1] * sc); o.y = cvt_pk_bf16(acc0[4 * q4 + 2] * sc, acc0[4 * q4 + 3] * sc); *(u32x2*)(d0 + 8 * q4) = o;
        o.x = cvt_pk_bf16(acc1[4 * q4] * sc, acc1[4 * q4 + 1] * sc); o.y = cvt_pk_bf16(acc1[4 * q4 + 2] * sc, acc1[4 * q4 + 3] * sc); *(u32x2*)(d0 + (size_t)32 * D + 8 * q4) = o; }
}
__device__ __forceinline__ void bg_run(ArgsP args, const Ctx& C, int seg, bool forced, int ph, int need) {
    unsigned* ctl = (unsigned*)(C.ws + WS_CTL);
    volatile LAS int* slot = (volatile LAS int*)(C.lds + 131072 + 192);
    const int count = ((seg == 0) ? BG_NA / 4 : (seg == 1) ? BG_NB : (seg == 2) ? BG_NC : (seg == 3) ? BG_ND / 4 : (seg == 4) ? BG_NE : BG_NF) / 8;
    for (;;) {
        __syncthreads();
        if (C.tid == 0) { int v = count;
            if (forced || (int)__hip_atomic_load(ctl + CW_DONE + ph, __ATOMIC_RELAXED, __HIP_MEMORY_SCOPE_AGENT) < need) v = (int)__hip_atomic_fetch_add(ctl + CW_BGQ + 64 * seg, 1u, __ATOMIC_RELAXED, __HIP_MEMORY_SCOPE_AGENT);
            slot[0] = v; }
        __syncthreads();
        const int bidx = __builtin_amdgcn_readfirstlane(slot[0]);
        if (bidx >= count) break;
        const int idx = bidx * 8 + C.wave;
        if (seg == 0) p0_transposes(args, C, (LAS float*)(C.lds + BG_SCR), 2 * I_G + 4 * idx, 2 * I_G + 4 * idx + 4, 0, 1);
        else if (seg == 3) p0_transposes(args, C, (LAS float*)(C.lds + BG_SCR), TR_PER_LAYER + 4 * idx, TR_PER_LAYER + 4 * idx + 4, 0, 1);
        else if (seg == 1) sw_rows(C, 0, 5632 + 8 * idx, 8);
        else if (seg == 4) sw_rows(C, 1, 8 * idx, 8);
        else wf2_item(args, C, seg == 2 ? 0 : 1, idx);
    }
}
__device__ __forceinline__ void bg_signal_done(const Ctx& C, int ph) { if (C.tid == 0) __hip_atomic_fetch_add((unsigned*)(C.ws + WS_CTL) + CW_DONE + ph, 1u, __ATOMIC_RELAXED, __HIP_MEMORY_SCOPE_AGENT); }

__device__ __forceinline__ void p0_prologue(ArgsP args, const Ctx& C) {
    LAS float* SC = (LAS float*)C.lds;
    LAS float* TAB = (LAS float*)(C.lds + 20480);
    LAS float* SCR = (LAS float*)(C.lds + 32768);
    const float* c_in = args->in[2]; const float* cctx = args->in[6];
    for (int i = C.tid; i < 5 * 1024; i += NTHREADS) { const float v = (i < 4096) ? c_in[i] : cctx[i - 4096]; SC[i] = siluf_(v); }
    for (int i = C.tid; i < 2048; i += NTHREADS) TAB[i] = __builtin_amdgcn_cosf((float)i * (1.0f / 2048.0f));
    __syncthreads();
    for (int it = C.bid; it < 288; it += C.G) {
        {
            const int l = it / 144, j0 = (it % 144) * 64, lg = C.lane >> 4, kbase = C.wave * 128 + lg;
            const float* W = args->in[7] + (size_t)l * D * NMOD + (size_t)kbase * NMOD + j0 + 4 * (C.lane & 15);
            f32x4 a0 = {0.f, 0.f, 0.f, 0.f}, a1 = a0, a2 = a0, a3 = a0, a4 = a0;
#pragma unroll 16
            for (int i = 0; i < 32; ++i) { const f32x4 w = *(const f32x4*)(W + (size_t)(4 * i) * NMOD); const int k = kbase + 4 * i;
                a0 += w * SC[k]; a1 += w * SC[1024 + k]; a2 += w * SC[2048 + k]; a3 += w * SC[3072 + k]; a4 += w * SC[4096 + k]; }
#define P0_RED4(a) a.x = sum_x32(sum_x16(a.x)); a.y = sum_x32(sum_x16(a.y)); a.z = sum_x32(sum_x16(a.z)); a.w = sum_x32(sum_x16(a.w));
            P0_RED4(a0) P0_RED4(a1) P0_RED4(a2) P0_RED4(a3) P0_RED4(a4)
#undef P0_RED4
            LAS f32x4* R = (LAS f32x4*)SCR;
            if (C.lane < 16) { R[(C.wave * 5 + 0) * 16 + C.lane] = a0; R[(C.wave * 5 + 1) * 16 + C.lane] = a1; R[(C.wave * 5 + 2) * 16 + C.lane] = a2; R[(C.wave * 5 + 3) * 16 + C.lane] = a3; R[(C.wave * 5 + 4) * 16 + C.lane] = a4; }
            __syncthreads();
            if (C.tid < 320) { const int c = C.tid >> 6, j = C.tid & 63; float sum = args->in[8][(size_t)l * NMOD + j0 + j];
#pragma unroll
                for (int w = 0; w < 8; ++w) sum += SCR[(w * 5 + c) * 64 + j];
                ((float*)(C.ws + OFF_MOD))[(size_t)(l * 5 + c) * NMOD + j0 + j] = sum; }
            __syncthreads();
        }
    }
    __syncthreads();
    p0_transposes(args, C, SCR, 0, 2 * I_G, C.bid * NWAVES + C.wave, C.G * NWAVES);
    const int gt = C.bid * NTHREADS + C.tid, NGT = C.G * NTHREADS;
    for (int i = gt; i < 6 * M / 4; i += NGT) ((f32x4*)(C.ws + OFF_SSQ) + M / 4)[i] = (f32x4){0.f, 0.f, 0.f, 0.f};
    for (int i = gt; i < 2048 * 256; i += NGT) { const int pr = i >> 8, t0 = (i & 255) * 8, p = (pr <= 1024) ? pr : pr - 1024, sh = (pr > 1024) ? 512 : 0; const float s = 0.022097086912079608f;
        float v[8];
#pragma unroll
        for (int j = 0; j < 8; ++j) v[j] = TAB[((p * (t0 + j)) - sh) & 2047] * s;
        u32x4 o; o.x = cvt_pk_bf16(v[0], v[1]); o.y = cvt_pk_bf16(v[2], v[3]); o.z = cvt_pk_bf16(v[4], v[5]); o.w = cvt_pk_bf16(v[6], v[7]);
        *(u32x4*)((bf16_t*)(C.ws + WS_DFTL) + (size_t)pr * 2048 + t0) = o; }
    for (int i = gt; i < 256 * 32; i += NGT) { const int pr = i >> 5, t0 = (i & 31) * 8, p = (pr <= 128) ? pr : pr - 128, sh = (pr > 128) ? 512 : 0; const float s = 0.0625f;
        float v[8];
#pragma unroll
        for (int j = 0; j < 8; ++j) v[j] = TAB[((p * (t0 + j) * 8) - sh) & 2047] * s;
        u32x4 o; o.x = cvt_pk_bf16(v[0], v[1]); o.y = cvt_pk_bf16(v[2], v[3]); o.z = cvt_pk_bf16(v[4], v[5]); o.w = cvt_pk_bf16(v[6], v[7]);
        *(u32x4*)((bf16_t*)(C.ws + WS_DFTC) + (size_t)pr * 256 + t0) = o; }
    for (int i = gt; i < 1024; i += NGT) { const int pos = i >> 4, f = i & 15; const float inv = __builtin_amdgcn_exp2f(-(float)f * (13.287712379549449f / 16.0f)); const float ang = (float)pos * inv;
        float tr = ang * 0.15915494309189535f; tr = tr - __builtin_floorf(tr);
        ((float*)(C.ws + OFF_ROPE))[i] = __builtin_amdgcn_cosf(tr); ((float*)(C.ws + OFF_ROPE))[1024 + i] = __builtin_amdgcn_sinf(tr); }
    for (int i = gt; i < 4 * 2 * 256 * 128; i += NGT) { ((bf16_t*)(C.ws + OFF_CK))[i] = f2bf(args->in[3][i]);
        const int d = i & 63, kvh = (i >> 6) & 1, t = (i >> 7) & 255, bl = i >> 15;
        ((bf16_t*)(C.ws + OFF_CVT))[((size_t)(bl * 2 + kvh) * 64 + d) * 256 + t] = f2bf(args->in[4][i]); }
    for (int i = gt; i < 2 * 2 * 8 * 128 * 64; i += NGT) { const int k = i & 63, n = (i >> 6) & 127, g = i >> 13;
        const float v = (n < 64) ? args->in[24][((size_t)g * 64 + k) * 64 + n] : args->in[26][((size_t)g * 64 + k) * 64 + (n - 64)]; ((bf16_t*)(C.ws + OFF_LWT))[i] = f2bf(v); }
}

__device__ __forceinline__ float* ssq_ptr(const Ctx& C, int idx) { return (float*)(C.ws + OFF_SSQ) + (size_t)idx * M; }
__device__ __forceinline__ const float* sw_ptr(const Ctx& C, int l, int sub, int c) { return (const float*)(C.ws + OFF_SW) + (size_t)((l * 3 + sub) * 5 + c) * 5632; }
__device__ __forceinline__ void p0b_phase(ArgsP args, const Ctx& C) {
    const int gw = C.bid * NWAVES + C.wave, NGW = C.G * NWAVES;
    { const float* nw = args->in[9]; bf16_t* XA = (bf16_t*)act_ptr(C, A_XN); float* ssq = ssq_ptr(C, 0);
      f32x4 v[4], vn[4];
      if (gw < M) { const f32x4* xr = (const f32x4*)((gw < MP) ? args->in[0] + (size_t)gw * D : args->in[1] + (size_t)(gw - MP) * D) + C.lane;
#pragma unroll
          for (int j = 0; j < 4; ++j) v[j] = xr[64 * j]; }
      for (int r = gw; r < M; r += NGW) {
        const int rn = r + NGW;
        if (rn < M) { const f32x4* xr = (const f32x4*)((rn < MP) ? args->in[0] + (size_t)rn * D : args->in[1] + (size_t)(rn - MP) * D) + C.lane;
#pragma unroll
            for (int j = 0; j < 4; ++j) vn[j] = xr[64 * j]; }
        const int c = cond_of_row(r); const float* sc = mod_ptr(C, 0, c, 0, 1);
        float s = 0.f;
#pragma unroll
        for (int j = 0; j < 4; ++j) s += (v[j].x * v[j].x + v[j].y * v[j].y) + (v[j].z * v[j].z + v[j].w * v[j].w);
        s = wave_sum(s); if (C.lane == 0) ssq[r] = s;
        u32x2* o = (u32x2*)(XA + (size_t)r * D) + C.lane;
#pragma unroll
        for (int j = 0; j < 4; ++j) { const int col = 4 * C.lane + 256 * j; const f32x4 w = *(const f32x4*)(nw + col), a = *(const f32x4*)(sc + col);
            const f32x4 y = v[j] * w * (a + 1.0f); u32x2 p; p.x = cvt_pk_bf16(y.x, y.y); p.y = cvt_pk_bf16(y.z, y.w); o[64 * j] = p; }
#pragma unroll
        for (int j = 0; j < 4; ++j) v[j] = vn[j]; } }
    bg_load_shifts(C, 0);
    for (int r0 = gw * 4; r0 < 5632; r0 += NGW * 4) sw_rows(C, 0, r0, 4);
}
__device__ __forceinline__ void finalnorm_phase(ArgsP args, const Ctx& C) {
    const int gw = C.bid * NWAVES + C.wave, NGW = C.G * NWAVES;
    const float* nw = args->in[10]; const float* ssq = ssq_ptr(C, 6);
    for (int r = gw; r < M; r += NGW) {
        f32x4* xr = (f32x4*)(C.out + (size_t)r * D) + C.lane;
        const float rstd = __builtin_amdgcn_rsqf(ssq[r] * (1.0f / D) + EPS);
#pragma unroll
        for (int j = 0; j < 4; ++j) { const f32x4 w = *(const f32x4*)(nw + 4 * C.lane + 256 * j); xr[64 * j] = xr[64 * j] * rstd * w; }
    }
}

struct Unit { int pm, pn, z; const bf16_t* A; const bf16_t* B; };

struct StaticOrder {
    int nM, nN, nwg, G, c; const bf16_t* A; const bf16_t* B; int lda, ldb;
    __device__ void init(int Mr, int N, int G_, int c_, const bf16_t* A_, int lda_, const bf16_t* B_, int ldb_) { nM = Mr / 256; nN = N / 256; nwg = nM * nN; G = G_; c = c_; A = A_; B = B_; lda = lda_; ldb = ldb_; }
    __device__ bool next(int i, Unit& u) const {
        const int L = i * G + c; if (L >= nwg) return false;
        int wgid = (int)L; { const int q = nwg / 8, r = nwg % 8, xcd = wgid % 8, off = wgid / 8; wgid = (xcd < r ? xcd * (q + 1) : r * (q + 1) + (xcd - r) * q) + off; }
        const int nig = 8 * nN, gid = wgid / nig, fm = gid * 8, gsz = (nM - fm) < 8 ? (nM - fm) : 8;
        u.pm = fm + ((wgid % nig) % gsz); u.pn = (wgid % nig) / gsz; u.z = 0;
        u.A = A + (size_t)u.pm * 256 * lda; u.B = B + (size_t)u.pn * 256 * ldb; return true;
    }
};
struct DftOrder {
    int nseq, nPm, L, G, c; const bf16_t* A; const bf16_t* XFT;
    __device__ bool next(int i, Unit& u) const {
        const int idx = i * G + c; if (idx >= nseq * nPm * 2) return false;
        u.z = idx / (nPm * 2); const int r = idx % (nPm * 2); u.pm = r >> 1; u.pn = r & 1;
        u.A = A + (size_t)u.pm * 256 * L; u.B = XFT + ((size_t)u.z * 512 + u.pn * 256) * L; return true;
    }
};

template <class Epi, class Sched>
__device__ __forceinline__ void gemm_simple(const Ctx& C, const Sched& S, const Epi& E, int lda, int ldb, int K) {
    const int wr = C.wave >> 2, wc = C.wave & 3, fr = C.lane & 15, fq = C.lane >> 4;
    Unit u;
    for (int ui = 0; S.next(ui, u); ++ui) {
        f32x4 acc[2][2][4][2];
#pragma unroll
        for (int a = 0; a < 2; ++a)
#pragma unroll
            for (int b = 0; b < 2; ++b)
#pragma unroll
                for (int m = 0; m < 4; ++m)
#pragma unroll
                    for (int n = 0; n < 2; ++n) acc[a][b][m][n] = (f32x4){0.f, 0.f, 0.f, 0.f};
        const bf16_t* pa = u.A + (size_t)(wr * 64 + fr) * lda + fq * 8;
        const bf16_t* pb = u.B + (size_t)(wc * 32 + fr) * ldb + fq * 8;
        for (int k0 = 0; k0 < K; k0 += 32) {
            bf16x8 At[2][4], Bt[2][2];
#pragma unroll
            for (int a = 0; a < 2; ++a)
#pragma unroll
                for (int m = 0; m < 4; ++m) At[a][m] = *(const bf16x8*)(pa + (size_t)(a * 128 + m * 16) * lda + k0);
#pragma unroll
            for (int b = 0; b < 2; ++b)
#pragma unroll
                for (int n = 0; n < 2; ++n) Bt[b][n] = *(const bf16x8*)(pb + (size_t)(b * 128 + n * 16) * ldb + k0);
#pragma unroll
            for (int a = 0; a < 2; ++a)
#pragma unroll
                for (int b = 0; b < 2; ++b)
#pragma unroll
                    for (int m = 0; m < 4; ++m)
#pragma unroll
                        for (int n = 0; n < 2; ++n) acc[a][b][m][n] = __builtin_amdgcn_mfma_f32_16x16x32_bf16(Bt[b][n], At[a][m], acc[a][b][m][n], 0, 0, 0);
        }
        E(acc, u, wr, wc, fr, fq);
    }
}

namespace pg8 {
#define PG8_LAS __attribute__((address_space(3)))
constexpr int BM = 256, BK = 64, HALF = 128, HTB = HALF * BK * 2  , STAGE_BYTES = 8 * HTB, NXCD = 8, WGM = 8;

__host__ __device__ __forceinline__ int lds_byte(int r, int c) { const int st = (r >> 4) * 2 + (c >> 5), rr = r & 15, cc = c & 31, ob = rr * 64 + cc * 2; return st * 1024 + (ob ^ (((ob >> 9) & 1) << 5)); }
__host__ __device__ __forceinline__ void stage_rc(int b, int& R, int& C) { const int st = b / 1024, sb = b % 1024, swz = sb ^ (((sb >> 9) & 1) << 5); R = (st >> 1) * 16 + swz / 64; C = (st & 1) * 32 + (swz % 64) / 2; }
__host__ __device__ __forceinline__ int perm32(int rho) { const int n = rho >> 4, i = rho & 15; return 8 * (i >> 2) + 4 * n + (i & 3); }
template <class Epi, class Sched, bool ALIGN_EPI = true, bool SP2 = true>
__device__ __forceinline__ void gemm_phase(PG8_LAS unsigned char* lds, const int tid, const Sched& S, const Epi& E, const int lda, const int ldb, const int K) {
    const int wid = __builtin_amdgcn_readfirstlane(tid >> 6), lane = tid & 63, wr = wid >> 2, wc = wid & 3, fr = lane & 15, fq = lane >> 4;
    const int nt = K / BK;
    unsigned voffA[2], voffB[2];
#pragma unroll
    for (int i = 0; i < 2; ++i) { int R, C; stage_rc(tid * 16 + i * 8192, R, C); const int Rb = Epi::PERM ? ((R & ~31) + perm32(R & 31)) : R;
        voffA[i] = (unsigned)(R * lda + C) * 2u; voffB[i] = (unsigned)(Rb * ldb + C) * 2u; }
    const size_t kstep = (size_t)(BK * 2);
    const size_t hstepA = (size_t)HALF * lda * 2, hstepB = (size_t)HALF * ldb * 2;
    const unsigned ldsw = (unsigned)wid * 1024u;
    const int aoff = lds_byte(wr * 64 + fr, fq * 8), boff = lds_byte(wc * 32 + fr, fq * 8);
#define PG8_SA(b, h) (((b) * 2 + (h)) * HTB)
#define PG8_SB(b, h) ((4 + (b) * 2 + (h)) * HTB)
#define PG8_STAGE(bufoff, gbase, voff) do { _Pragma("unroll") for (int _i = 0; _i < 2; ++_i) \
        __builtin_amdgcn_global_load_lds((const unsigned*)((const char*)(gbase) + (voff)[_i]), (PG8_LAS unsigned*)(lds + (bufoff) + ldsw + _i * 8192), 16, 0, 0); } while (0)
#define PG8_LDA(dst, b, h) do { _Pragma("unroll") for (int m = 0; m < 4; ++m) _Pragma("unroll") for (int k = 0; k < 2; ++k) dst[m][k] = *(const PG8_LAS bf16x8*)(lds + PG8_SA(b, h) + aoff + m * 2048 + k * 1024); } while (0)
#define PG8_LDB(dst, b, h) do { _Pragma("unroll") for (int n = 0; n < 2; ++n) _Pragma("unroll") for (int k = 0; k < 2; ++k) dst[n][k] = *(const PG8_LAS bf16x8*)(lds + PG8_SB(b, h) + boff + n * 2048 + k * 1024); } while (0)
#define PG8_MMA(ai, bj, At, Bt) do { __builtin_amdgcn_s_setprio(1); _Pragma("unroll") for (int m = 0; m < 4; ++m) _Pragma("unroll") for (int n = 0; n < 2; ++n) _Pragma("unroll") for (int k = 0; k < 2; ++k) \
        acc[ai][bj][m][n] = __builtin_amdgcn_mfma_f32_16x16x32_bf16(Bt[n][k], At[m][k], acc[ai][bj][m][n], 0, 0, 0); __builtin_amdgcn_s_setprio(0); } while (0)
#define PG8_WAIT_V(n) asm volatile("s_waitcnt vmcnt(" #n ")" ::: "memory")
#define PG8_WAIT_L(n) asm volatile("s_waitcnt lgkmcnt(" #n ")" ::: "memory")
#define PG8_BAR __builtin_amdgcn_s_barrier()
#define PG8_SCHED __builtin_amdgcn_sched_barrier(0)
    Unit cur, nxt; int ui = 0;
    if (!S.next(0, cur)) return;
    f32x4 acc[2][2][4][2];
#pragma unroll
    for (int a = 0; a < 2; ++a)
#pragma unroll
        for (int b = 0; b < 2; ++b)
#pragma unroll
            for (int m = 0; m < 4; ++m)
#pragma unroll
                for (int n = 0; n < 2; ++n) acc[a][b][m][n] = (f32x4){0.f, 0.f, 0.f, 0.f};
    bf16x8 At[4][2], B0[2][2], B1[2][2];
    const char* cA = (const char*)cur.A; const char* cB = (const char*)cur.B;
    if constexpr (SP2) {
        PG8_STAGE(PG8_SB(0, 0), cB, voffB); PG8_STAGE(PG8_SB(0, 1), cB + hstepB, voffB); PG8_STAGE(PG8_SA(0, 0), cA, voffA); PG8_STAGE(PG8_SA(0, 1), cA + hstepA, voffA);
        if (wr == 1) PG8_BAR;
        PG8_WAIT_V(2); PG8_BAR;
        PG8_STAGE(PG8_SB(1, 0), cB + kstep, voffB); PG8_STAGE(PG8_SA(1, 0), cA + kstep, voffA); PG8_STAGE(PG8_SB(1, 1), cB + hstepB + kstep, voffB);
        PG8_WAIT_V(6); PG8_BAR;
    } else {
        PG8_STAGE(PG8_SB(0, 0), cB, voffB); PG8_STAGE(PG8_SA(0, 0), cA, voffA); PG8_STAGE(PG8_SB(0, 1), cB + hstepB, voffB); PG8_STAGE(PG8_SA(0, 1), cA + hstepA, voffA);
        if (wr == 1) PG8_BAR;
        PG8_WAIT_V(4); PG8_BAR;
        PG8_STAGE(PG8_SB(1, 0), cB + kstep, voffB); PG8_STAGE(PG8_SA(1, 0), cA + kstep, voffA); PG8_STAGE(PG8_SB(1, 1), cB + hstepB + kstep, voffB);
        PG8_WAIT_V(6); PG8_BAR;
    }
    for (;;) {
        const bool has_next = S.next(ui + 1, nxt);
        const char* nA = has_next ? (const char*)nxt.A : cA; const char* nB = has_next ? (const char*)nxt.B : cB;
        for (int t = 0; t < nt; t += 2) {
            const bool last = (t == nt - 2);
            const char* a1 = cA + (size_t)(t + 1) * kstep;
            const char* a2 = last ? nA : cA + (size_t)(t + 2) * kstep; const char* b2 = last ? nB : cB + (size_t)(t + 2) * kstep;
            const char* a3 = a2 + kstep; const char* b3 = b2 + kstep;
            if constexpr (SP2) {
            PG8_LDB(B0, 0, 0); PG8_LDB(B1, 0, 1); PG8_SCHED; PG8_LDA(At, 0, 0); PG8_STAGE(PG8_SA(1, 1), a1 + hstepA, voffA);
            PG8_WAIT_V(8); PG8_WAIT_L(0); PG8_BAR; PG8_MMA(0, 0, At, B0); PG8_MMA(0, 1, At, B1); PG8_BAR; PG8_SCHED;
            PG8_LDA(At, 0, 1); PG8_STAGE(PG8_SB(0, 0), b2, voffB); PG8_STAGE(PG8_SB(0, 1), b2 + hstepB, voffB); PG8_STAGE(PG8_SA(0, 0), a2, voffA);
            PG8_WAIT_V(8); PG8_WAIT_L(0); PG8_BAR; PG8_MMA(1, 0, At, B0); PG8_MMA(1, 1, At, B1); PG8_BAR; PG8_SCHED;
            PG8_LDB(B0, 1, 0); PG8_LDB(B1, 1, 1); PG8_SCHED; PG8_LDA(At, 1, 0); PG8_STAGE(PG8_SA(0, 1), a2 + hstepA, voffA);
            PG8_WAIT_V(8); PG8_WAIT_L(0); PG8_BAR; PG8_MMA(0, 0, At, B0); PG8_MMA(0, 1, At, B1); PG8_BAR; PG8_SCHED;
            PG8_LDA(At, 1, 1); PG8_STAGE(PG8_SB(1, 0), b3, voffB); PG8_STAGE(PG8_SB(1, 1), b3 + hstepB, voffB); PG8_STAGE(PG8_SA(1, 0), a3, voffA);
            PG8_WAIT_V(8); PG8_WAIT_L(0); PG8_BAR; PG8_MMA(1, 0, At, B0); PG8_MMA(1, 1, At, B1); PG8_BAR; PG8_SCHED;
            } else {
            PG8_LDB(B0, 0, 0); PG8_SCHED; PG8_LDA(At, 0, 0); PG8_STAGE(PG8_SA(1, 1), a1 + hstepA, voffA);
            PG8_WAIT_L(8); PG8_BAR; PG8_WAIT_L(0); PG8_MMA(0, 0, At, B0); PG8_BAR; PG8_SCHED;
            PG8_LDB(B1, 0, 1); PG8_STAGE(PG8_SB(0, 0), b2, voffB);
            PG8_BAR; PG8_WAIT_L(0); PG8_MMA(0, 1, At, B1); PG8_BAR;
            PG8_LDA(At, 0, 1); PG8_STAGE(PG8_SA(0, 0), a2, voffA);
            PG8_BAR; PG8_WAIT_L(0); PG8_MMA(1, 0, At, B0); PG8_BAR; PG8_SCHED;
            PG8_STAGE(PG8_SB(0, 1), b2 + hstepB, voffB);
            PG8_WAIT_V(6); PG8_BAR; PG8_MMA(1, 1, At, B1); PG8_BAR;
            PG8_LDB(B0, 1, 0); PG8_SCHED; PG8_LDA(At, 1, 0); PG8_STAGE(PG8_SA(0, 1), a2 + hstepA, voffA);
            PG8_WAIT_L(8); PG8_BAR; PG8_WAIT_L(0); PG8_MMA(0, 0, At, B0); PG8_BAR; PG8_SCHED;
            PG8_LDB(B1, 1, 1); PG8_STAGE(PG8_SB(1, 0), b3, voffB);
            PG8_BAR; PG8_WAIT_L(0); PG8_MMA(0, 1, At, B1); PG8_BAR;
            PG8_LDA(At, 1, 1); PG8_STAGE(PG8_SA(1, 0), a3, voffA);
            PG8_BAR; PG8_WAIT_L(0); PG8_MMA(1, 0, At, B0); PG8_BAR; PG8_SCHED;
            PG8_STAGE(PG8_SB(1, 1), b3 + hstepB, voffB);
            PG8_WAIT_V(6); PG8_BAR; PG8_MMA(1, 1, At, B1); PG8_BAR;
            }
        }
        if constexpr (ALIGN_EPI) { if (wr == 0) PG8_BAR; }
        if constexpr (!Epi::AFTER_DRAIN) { E(acc, cur, wr, wc, fr, fq); }
        if (!has_next) break;
#pragma unroll
        for (int a = 0; a < 2; ++a)
#pragma unroll
            for (int b = 0; b < 2; ++b)
#pragma unroll
                for (int m = 0; m < 4; ++m)
#pragma unroll
                    for (int n = 0; n < 2; ++n) acc[a][b][m][n] = (f32x4){0.f, 0.f, 0.f, 0.f};
        cur = nxt; cA = nA; cB = nB; ++ui;
        if constexpr (ALIGN_EPI) { if (wr == 1) PG8_BAR; }
    }
    PG8_WAIT_V(0);
    if constexpr (!ALIGN_EPI) { if (wr == 0) PG8_BAR; }
    PG8_BAR;
    if constexpr (Epi::AFTER_DRAIN) { E.fused(acc, cur, wr, wc, fr, fq, lds, wid, lane); }
#undef PG8_SA
#undef PG8_SB
#undef PG8_STAGE
#undef PG8_LDA
#undef PG8_LDB
#undef PG8_MMA
#undef PG8_WAIT_V
#undef PG8_WAIT_L
#undef PG8_BAR
#undef PG8_SCHED
}
}

#ifndef USE_PG8
#define USE_PG8 1
#endif
#if USE_PG8
__device__ __forceinline__ int fresh_tid(const Ctx& C) { unsigned z_ = 0u; asm volatile("" : "+s"(z_)); return C.wave * 64 + (int)__builtin_amdgcn_mbcnt_hi(~0u, __builtin_amdgcn_mbcnt_lo(~0u, z_)); }
#define GEMM(C, S, E, lda, ldb, K) pg8::gemm_phase(C.lds, fresh_tid(C), S, E, lda, ldb, K)
#else
#define GEMM(C, S, E, lda, ldb, K) GEMM(C, S, E, lda, ldb, K)
#endif

#define EPI_LOOP_AM for (int ai = 0; ai < 2; ++ai) _Pragma("unroll") for (int m = 0; m < 4; ++m)
struct EpiGU {
    static constexpr bool PERM = true, AFTER_DRAIN = false;
    bf16_t* H; const float* ssq; const float* swb;
    __device__ __forceinline__ void operator()(const f32x4 (&acc)[2][2][4][2], const Unit& u, int wr, int wc, int fr, int fq) const {
        const float* sw = swb + (size_t)cond_of_row(u.pm * 256) * 5632 + u.pn * 256 + wc * 32 + fq * 8;
        f32x4 sg[2], su[2];
#pragma unroll
        for (int n = 0; n < 2; ++n) { sg[n] = *(const f32x4*)(sw + n * 4); su[n] = *(const f32x4*)(sw + 128 + n * 4); }
#pragma unroll
        EPI_LOOP_AM { const int row = u.pm * 256 + ai * 128 + wr * 64 + m * 16 + fr; const float rstd = __builtin_amdgcn_rsqf(ssq[row] * (1.0f / D) + EPS);
            u32x4 p;
            { const f32x4 g = acc[ai][0][m][0] * rstd + sg[0], up = acc[ai][1][m][0] * rstd + su[0]; p.x = cvt_pk_bf16(siluf_(g.x) * up.x, siluf_(g.y) * up.y); p.y = cvt_pk_bf16(siluf_(g.z) * up.z, siluf_(g.w) * up.w); }
            { const f32x4 g = acc[ai][0][m][1] * rstd + sg[1], up = acc[ai][1][m][1] * rstd + su[1]; p.z = cvt_pk_bf16(siluf_(g.x) * up.x, siluf_(g.y) * up.y); p.w = cvt_pk_bf16(siluf_(g.z) * up.z, siluf_(g.w) * up.w); }
            *(u32x4*)(H + (size_t)row * DFF + u.pn * 128 + wc * 32 + fq * 8) = p; }
    }
};
struct EpiRes {
    static constexpr bool PERM = true, AFTER_DRAIN = false;
    float* X; const float* Xin0; const float* Xin1; const float* modbase;
    bf16_t* XA; const float* nwn; float* ssqn;
    int l, sub, ln, subn; float coef;
    __device__ __forceinline__ void operator()(const f32x4 (&acc)[2][2][4][2], const Unit& u, int wr, int wc, int fr, int fq) const {
        const int c = cond_of_row(u.pm * 256), co = u.pn * 256 + wc * 32 + fq * 8;
        const float* gate = modbase + ((size_t)(l * 5 + c) * NMOD + (sub * 3 + 2) * D) + co;
        f32x4 g[2][2], wn[2][2];
#pragma unroll
        for (int bj = 0; bj < 2; ++bj)
#pragma unroll
            for (int n = 0; n < 2; ++n) { g[bj][n] = *(const f32x4*)(gate + bj * 128 + n * 4) * coef;
                if (ln >= 0) { const float* scn = modbase + ((size_t)(ln * 5 + c) * NMOD + (subn * 3 + 1) * D) + co + bj * 128 + n * 4; wn[bj][n] = *(const f32x4*)(nwn + co + bj * 128 + n * 4) * (*(const f32x4*)scn + 1.0f); }
                else wn[bj][n] = (f32x4){0.f, 0.f, 0.f, 0.f}; }
#pragma unroll
        EPI_LOOP_AM { const int row = u.pm * 256 + ai * 128 + wr * 64 + m * 16 + fr;
            float* xrow = X + (size_t)row * D + co; const float* irow = ((u.pm < 16) ? Xin0 + (size_t)row * D : Xin1 + (size_t)(row - MP) * D) + co;
            float ss = 0.f;
#pragma unroll
            for (int bj = 0; bj < 2; ++bj) {
                const f32x4 x0 = *(const f32x4*)(irow + bj * 128) + g[bj][0] * acc[ai][bj][m][0], x1 = *(const f32x4*)(irow + bj * 128 + 4) + g[bj][1] * acc[ai][bj][m][1];
                *(f32x4*)(xrow + bj * 128) = x0; *(f32x4*)(xrow + bj * 128 + 4) = x1;
                ss += ((x0.x * x0.x + x0.y * x0.y) + (x0.z * x0.z + x0.w * x0.w)) + ((x1.x * x1.x + x1.y * x1.y) + (x1.z * x1.z + x1.w * x1.w));
                if (ln >= 0) { const f32x4 y0 = x0 * wn[bj][0], y1 = x1 * wn[bj][1]; u32x4 p; p.x = cvt_pk_bf16(y0.x, y0.y); p.y = cvt_pk_bf16(y0.z, y0.w); p.z = cvt_pk_bf16(y1.x, y1.y); p.w = cvt_pk_bf16(y1.z, y1.w);
                    *(u32x4*)(XA + (size_t)row * D + co + bj * 128) = p; } }
            ss = sum_x32(sum_x16(ss));
            if (fq == 0) atomicAdd(ssqn + row, ss);
            asm volatile("" ::: "memory"); }
    }
};
struct EpiIn {
    static constexpr bool PERM = false, AFTER_DRAIN = false;
    bf16_t *Q, *Kb, *VT, *GY, *XFT, *G; float* XR; float* out; const float* rope; const float* bgate; int l; const float* ssq; const float* swb;
    __device__ __forceinline__ void operator()(f32x4 (&acc)[2][2][4][2], const Unit& u, int wr, int wc, int fr, int fq) const {
        const int row0 = u.pm * 256 + wr * 64 + fr; const bool latent = u.pm >= 16;
        { const float* sw = swb + (size_t)cond_of_row(u.pm * 256) * 5632 + u.pn * 256 + wc * 32 + fq * 4;
          f32x4 sv[2][2];
#pragma unroll
          for (int bj = 0; bj < 2; ++bj)
#pragma unroll
              for (int n = 0; n < 2; ++n) sv[bj][n] = *(const f32x4*)(sw + bj * 128 + n * 16);
#pragma unroll
          EPI_LOOP_AM { const float rstd = __builtin_amdgcn_rsqf(ssq[row0 + ai * 128 + m * 16] * (1.0f / D) + EPS);
#pragma unroll
              for (int bj = 0; bj < 2; ++bj)
#pragma unroll
                  for (int n = 0; n < 2; ++n) acc[ai][bj][m][n] = acc[ai][bj][m][n] * rstd + sv[bj][n]; } }
        if (u.pn <= 2) {
#pragma unroll
            for (int bj = 0; bj < 2; ++bj) {
                if (u.pn == 2 && bj == 1) {
#pragma unroll
                    EPI_LOOP_AM { const int row = row0 + ai * 128 + m * 16; int seqoff, L, t;
                        if (latent) { const int b = (row - MP) >> 11; t = (row - MP) & 2047; L = LS; seqoff = 16 * 128 * LC + b * 128 * LS; } else { const int b = row >> 8; t = row & 255; L = LC; seqoff = b * 128 * LC; }
#pragma unroll
                        for (int n = 0; n < 2; ++n) { const f32x4 v = acc[ai][1][m][n]; const int d128 = wc * 32 + n * 16 + fq * 4;
                            bf16_t* p = VT + seqoff + (size_t)d128 * L + t; p[0] = f2bf(v.x); p[L] = f2bf(v.y); p[2 * L] = f2bf(v.z); p[3 * L] = f2bf(v.w);
                            if (!latent) *(f32x4*)(out + OUT_CV + ((size_t)((row >> 8) * 2 + l) * 256 + t) * 128 + d128) = v; } }
                } else {
                    const bool isk = (u.pn == 2); const int axis = wc & 1;
#pragma unroll
                    EPI_LOOP_AM { const int row = row0 + ai * 128 + m * 16; f32x4 x1 = acc[ai][bj][m][0], x2 = acc[ai][bj][m][1];
                        if (isk && !latent) { float* o = out + OUT_CK + ((size_t)((row >> 8) * 2 + l) * 256 + (row & 255)) * 128 + wc * 32 + fq * 4; *(f32x4*)o = x1; *(f32x4*)(o + 16) = x2; }
                        if (latent) { const int t = (row - MP) & 2047, pos = axis ? (t & 63) : (t >> 6);
                            const f32x4 cs = *(const f32x4*)(rope + pos * 16 + fq * 4), sn = *(const f32x4*)(rope + 1024 + pos * 16 + fq * 4);
                            const f32x4 o1 = x1 * cs - x2 * sn, o2 = x1 * sn + x2 * cs; x1 = o1; x2 = o2; }
                        if (!isk) { x1 = x1 * QSCALE; x2 = x2 * QSCALE; }
                        bf16_t* o = isk ? (Kb + (size_t)row * 128 + wc * 32 + fq * 4) : (Q + (size_t)row * 512 + u.pn * 256 + bj * 128 + wc * 32 + fq * 4);
                        u32x2 p; p.x = cvt_pk_bf16(x1.x, x1.y); p.y = cvt_pk_bf16(x1.z, x1.w); *(u32x2*)o = p;
                        p.x = cvt_pk_bf16(x2.x, x2.y); p.y = cvt_pk_bf16(x2.z, x2.w); *(u32x2*)(o + 16) = p; }
                }
            }
        } else if (u.pn <= 4) {
#pragma unroll
            EPI_LOOP_AM { const int row = row0 + ai * 128 + m * 16;
#pragma unroll
                for (int bj = 0; bj < 2; ++bj)
#pragma unroll
                    for (int n = 0; n < 2; ++n) *(f32x4*)(XR + (size_t)row * 512 + (u.pn - 3) * 256 + bj * 128 + wc * 32 + n * 16 + fq * 4) = acc[ai][bj][m][n]; }
        } else if (u.pn <= 6) {
#pragma unroll
            EPI_LOOP_AM { const int row = row0 + ai * 128 + m * 16;
#pragma unroll
                for (int bj = 0; bj < 2; ++bj)
#pragma unroll
                    for (int n = 0; n < 2; ++n) { const f32x4 v = acc[ai][bj][m][n]; u32x2 p; p.x = cvt_pk_bf16(gelu_tanh(v.x), gelu_tanh(v.y)); p.y = cvt_pk_bf16(gelu_tanh(v.z), gelu_tanh(v.w));
                        *(u32x2*)(GY + (size_t)row * 512 + (u.pn - 5) * 256 + bj * 128 + wc * 32 + n * 16 + fq * 4) = p; } }
        } else if (u.pn <= 8) {
#pragma unroll
            EPI_LOOP_AM { const int row = row0 + ai * 128 + m * 16; size_t seqoff; int L, t;
                if (latent) { const int b = (row - MP) >> 11; t = (row - MP) & 2047; L = LS; seqoff = (size_t)16 * 512 * LC + (size_t)b * 512 * LS; } else { const int b = row >> 8; t = row & 255; L = LC; seqoff = (size_t)b * 512 * LC; }
#pragma unroll
                for (int bj = 0; bj < 2; ++bj)
#pragma unroll
                    for (int n = 0; n < 2; ++n) { const f32x4 v = acc[ai][bj][m][n]; bf16_t* p = XFT + seqoff + (size_t)((u.pn - 7) * 256 + bj * 128 + wc * 32 + n * 16 + fq * 4) * L + t;
                        p[0] = f2bf(v.x); p[L] = f2bf(v.y); p[2 * L] = f2bf(v.z); p[3 * L] = f2bf(v.w); } }
        } else {
#pragma unroll
            for (int bj = 0; bj < 2; ++bj)
#pragma unroll
                for (int n = 0; n < 2; ++n) { const int col = (u.pn - 9) * 256 + bj * 128 + wc * 32 + n * 16 + fq * 4; const f32x4 b = *(const f32x4*)(bgate + col);
#pragma unroll
                    EPI_LOOP_AM { const int row = row0 + ai * 128 + m * 16; const f32x4 v = acc[ai][bj][m][n] + b;
                        u32x2 p; p.x = cvt_pk_bf16(sigmoidf_(v.x), sigmoidf_(v.y)); p.y = cvt_pk_bf16(sigmoidf_(v.z), sigmoidf_(v.w)); *(u32x2*)(G + (size_t)row * 3072 + col) = p; } }
        }
    }
};
template <int MODE> struct EpiBranch {
    static constexpr bool PERM = true, AFTER_DRAIN = false;
    bf16_t* MG; const bf16_t* G; int br;
    __device__ __forceinline__ void operator()(const f32x4 (&acc)[2][2][4][2], const Unit& u, int wr, int wc, int fr, int fq) const {
#pragma unroll
        EPI_LOOP_AM { const int row = u.pm * 256 + ai * 128 + wr * 64 + m * 16 + fr;
#pragma unroll
            for (int bj = 0; bj < 2; ++bj) { const int col = u.pn * 256 + bj * 128 + wc * 32 + fq * 8;
                const u32x4 g = *(const u32x4*)(G + (size_t)row * 3072 + br * 1024 + col); f32x4 v0 = acc[ai][bj][m][0], v1 = acc[ai][bj][m][1];
                v0.x *= bflo(g.x); v0.y *= bfhi(g.x); v0.z *= bflo(g.y); v0.w *= bfhi(g.y); v1.x *= bflo(g.z); v1.y *= bfhi(g.z); v1.z *= bflo(g.w); v1.w *= bfhi(g.w);
                u32x4* p = (u32x4*)(MG + (size_t)row * D + col);
                if (MODE == 1) { const u32x4 o = *p; v0.x += bflo(o.x); v0.y += bfhi(o.x); v0.z += bflo(o.y); v0.w += bfhi(o.y); v1.x += bflo(o.z); v1.y += bfhi(o.z); v1.z += bflo(o.w); v1.w += bfhi(o.w); }
                u32x4 w; w.x = cvt_pk_bf16(v0.x, v0.y); w.y = cvt_pk_bf16(v0.z, v0.w); w.z = cvt_pk_bf16(v1.x, v1.y); w.w = cvt_pk_bf16(v1.z, v1.w); *p = w; }
            asm volatile("" ::: "memory"); }
    }
};
struct EpiDft {
    static constexpr bool PERM = true, AFTER_DRAIN = false;
    bf16_t* Z; int L, rowbase;
    __device__ __forceinline__ void operator()(const f32x4 (&acc)[2][2][4][2], const Unit& u, int wr, int wc, int fr, int fq) const {
        const int hl = L >> 1;
#pragma unroll
        EPI_LOOP_AM { const int rr = u.pm * 256 + ai * 128 + wr * 64 + m * 16 + fr; const bool sn = rr >= hl; const int p = sn ? rr - hl : rr;
            bf16_t* z0 = Z + (size_t)rowbase * D + u.pn * 256 + wc * 32 + fq * 8;
#pragma unroll
            for (int bj = 0; bj < 2; ++bj) { const f32x4 v0 = acc[ai][bj][m][0], v1 = acc[ai][bj][m][1]; u32x4 w; w.x = cvt_pk_bf16(v0.x, v0.y); w.y = cvt_pk_bf16(v0.z, v0.w); w.z = cvt_pk_bf16(v1.x, v1.y); w.w = cvt_pk_bf16(v1.z, v1.w); const int co = bj * 128;
                if (!sn) { *(u32x4*)(z0 + (size_t)p * D + co) = w; if (p) *(u32x4*)(z0 + (size_t)(L - p) * D + co) = w; }
                else if (p == 0) { *(u32x4*)(z0 + (size_t)hl * D + co) = w; const u32x4 zz = {0u, 0u, 0u, 0u}; *(u32x4*)(z0 + 512 + co) = zz; *(u32x4*)(z0 + (size_t)hl * D + 512 + co) = zz; }
                else { *(u32x4*)(z0 + (size_t)p * D + 512 + co) = w; u32x4 nw; nw.x = w.x ^ 0x80008000u; nw.y = w.y ^ 0x80008000u; nw.z = w.z ^ 0x80008000u; nw.w = w.w ^ 0x80008000u; *(u32x4*)(z0 + (size_t)(L - p) * D + 512 + co) = nw; } } }
    }
};

typedef short s16x4 __attribute__((ext_vector_type(4)));
#define MFMA32(a, b, c) __builtin_amdgcn_mfma_f32_32x32x16_bf16((a), (b), (c), 0, 0, 0)
constexpr int AT_KSTR = 144, AT_VSTR = 264, AT_KBYTES = 128 * AT_KSTR, AT_VBYTES = 64 * AT_VSTR, AT_BUF = AT_KBYTES + AT_VBYTES;
struct AttnSrc { const bf16_t* kp; const bf16_t* vp; int vstride; int kbase; };
__device__ __forceinline__ AttnSrc attn_src(int t, bool latent, int nband, int lo, int b, int l, int kvh, const bf16_t* Kb, const bf16_t* VT, const bf16_t* CK, const bf16_t* CVT) {
    AttnSrc s;
    if (!latent) { s.kp = Kb + (size_t)(b * LC + 128 * t) * 128 + kvh * 64; s.vp = VT + (size_t)b * 128 * LC + (size_t)(kvh * 64) * LC + 128 * t; s.vstride = LC; s.kbase = 0; }
    else if (t < nband) { const int kb = lo + 128 * t; s.kp = Kb + (size_t)(MP + b * LS + kb) * 128 + kvh * 64; s.vp = VT + (size_t)16 * 128 * LC + (size_t)b * 128 * LS + (size_t)(kvh * 64) * LS + kb; s.vstride = LS; s.kbase = kb; }
    else { const int c = t - nband; s.kp = CK + (size_t)((b * 2 + l) * 256 + 128 * c) * 128 + kvh * 64; s.vp = CVT + (size_t)((b * 2 + l) * 2 + kvh) * 64 * 256 + 128 * c; s.vstride = 256; s.kbase = 0; }
    return s;
}
__device__ __forceinline__ void attn_tile(const LAS unsigned char* kbp, const LAS unsigned char* vbp, const bf16x8 (&qf)[4], f32x16& O0, f32x16& O1, float& mrun, float& lsum, bool domask, int dk0, int q32, int half) {
    f32x16 S0, S1;
#pragma unroll
    for (int r = 0; r < 16; ++r) { S0[r] = 0.f; S1[r] = 0.f; }
    bf16x8 kf[4][2];
#pragma unroll
    for (int ks = 0; ks < 4; ++ks) { kf[ks][0] = *(const LAS bf16x8*)(kbp + q32 * AT_KSTR + ks * 32 + half * 16); kf[ks][1] = *(const LAS bf16x8*)(kbp + (32 + q32) * AT_KSTR + ks * 32 + half * 16); }
#pragma unroll
    for (int ks = 0; ks < 4; ++ks) { S0 = MFMA32(kf[ks][0], qf[ks], S0); S1 = MFMA32(kf[ks][1], qf[ks], S1); }
    s16x4 vr[4][4];
#pragma unroll
    for (int s4 = 0; s4 < 4; ++s4) { const LAS unsigned char* v0p = vbp + q32 * AT_VSTR + s4 * 32 + half * 8; const LAS unsigned char* v1p = v0p + 32 * AT_VSTR;
        vr[s4][0] = *(const LAS s16x4*)v0p; vr[s4][1] = *(const LAS s16x4*)(v0p + 16); vr[s4][2] = *(const LAS s16x4*)v1p; vr[s4][3] = *(const LAS s16x4*)(v1p + 16); }
    if (domask) {
#pragma unroll
        for (int r = 0; r < 16; ++r) { const int d0 = dk0 + (r & 3) + 8 * (r >> 2) + 4 * half, d1 = d0 + 32;
            S0[r] = (d0 > 128 || d0 < -128) ? -1e30f : S0[r]; S1[r] = (d1 > 128 || d1 < -128) ? -1e30f : S1[r]; } }
    float mx = fmaxf(S0[0], S1[0]);
#pragma unroll
    for (int r = 1; r < 16; ++r) mx = fmaxf(mx, fmaxf(S0[r], S1[r]));
    mx = fmaxf(mx, __shfl_xor(mx, 32));
    const float mnew = fmaxf(mrun, mx), alpha = __builtin_amdgcn_exp2f(mrun - mnew); mrun = mnew;
    float ps = 0.f;
#pragma unroll
    for (int r = 0; r < 16; ++r) { S0[r] = __builtin_amdgcn_exp2f(S0[r] - mnew); S1[r] = __builtin_amdgcn_exp2f(S1[r] - mnew); ps += S0[r] + S1[r]; }
    lsum = lsum * alpha + ps;
#pragma unroll
    for (int r = 0; r < 16; ++r) { O0[r] *= alpha; O1[r] *= alpha; }
    bf16x8 pf[4];
#pragma unroll
    for (int s2 = 0; s2 < 2; ++s2) { u32x4 a, c2;
        a.x = cvt_pk_bf16(S0[8 * s2 + 0], S0[8 * s2 + 1]); a.y = cvt_pk_bf16(S0[8 * s2 + 2], S0[8 * s2 + 3]); a.z = cvt_pk_bf16(S0[8 * s2 + 4], S0[8 * s2 + 5]); a.w = cvt_pk_bf16(S0[8 * s2 + 6], S0[8 * s2 + 7]);
        c2.x = cvt_pk_bf16(S1[8 * s2 + 0], S1[8 * s2 + 1]); c2.y = cvt_pk_bf16(S1[8 * s2 + 2], S1[8 * s2 + 3]); c2.z = cvt_pk_bf16(S1[8 * s2 + 4], S1[8 * s2 + 5]); c2.w = cvt_pk_bf16(S1[8 * s2 + 6], S1[8 * s2 + 7]);
        pf[s2] = __builtin_bit_cast(bf16x8, a); pf[2 + s2] = __builtin_bit_cast(bf16x8, c2); }
#pragma unroll
    for (int s4 = 0; s4 < 4; ++s4) {
        const bf16x8 vf0 = __builtin_shufflevector(vr[s4][0], vr[s4][1], 0, 1, 2, 3, 4, 5, 6, 7), vf1 = __builtin_shufflevector(vr[s4][2], vr[s4][3], 0, 1, 2, 3, 4, 5, 6, 7);
        O0 = MFMA32(vf0, pf[s4], O0); O1 = MFMA32(vf1, pf[s4], O1); }
}
__device__ __forceinline__ void attn_unit(ArgsP args, const Ctx& C, int l, int ui) {
    bf16_t* Q = (bf16_t*)act_ptr(C, A_Q); const bf16_t* Kb = (const bf16_t*)act_ptr(C, A_K); const bf16_t* VT = (const bf16_t*)act_ptr(C, A_VT);
    const bf16_t* CK = (const bf16_t*)(C.ws + OFF_CK); const bf16_t* CVT = (const bf16_t*)(C.ws + OFF_CVT);
    const int q32 = C.lane & 31, half = C.lane >> 5, w = C.wave;
    const int srow = C.tid >> 3, schunk = C.tid & 7;
    {
        const bool latent = ui < 256;
        int b, h, qb; if (latent) { b = ui >> 6; h = (ui >> 3) & 7; qb = ui & 7; } else { const int r = ui - 256; b = r >> 3; h = r & 7; qb = 0; }
        const int kvh = h >> 2, rowbase = latent ? (MP + b * LS + qb * 256) : b * LC;
        int lo = 0, nband = 2, nt = 2;
        if (latent) { lo = 256 * qb - 128; if (lo < 0) lo = 0; int hi = 256 * qb + 384; if (hi > LS) hi = LS; nband = (hi - lo) >> 7; nt = nband + 2; }
        const int qw_lo = qb * 256 + 32 * w, qpos = qw_lo + q32;
        bf16x8 qf[4];
        { const bf16_t* qp = Q + (size_t)(rowbase + 32 * w + q32) * 512 + h * 64 + 8 * half;
#pragma unroll
          for (int ks = 0; ks < 4; ++ks) qf[ks] = *(const bf16x8*)(qp + 16 * ks); }
        f32x16 O0, O1;
#pragma unroll
        for (int r = 0; r < 16; ++r) { O0[r] = 0.f; O1[r] = 0.f; }
        float mrun = args->in[20][l * 8 + h] * LOG2E, lsum = half ? 0.f : 1.0f;
        u32x4 kA0, kA1, vA0, vA1, kB0, kB1, vB0, vB1;
#define ATT_LOAD(k0, k1, v0, v1, tt) do { const AttnSrc s_ = attn_src((tt), latent, nband, lo, b, l, kvh, Kb, VT, CK, CVT); \
            k0 = *(const u32x4*)(s_.kp + (size_t)srow * 128 + schunk * 8); k1 = *(const u32x4*)(s_.kp + (size_t)(64 + srow) * 128 + schunk * 8); \
            v0 = *(const u32x4*)(s_.vp + (size_t)srow * s_.vstride + schunk * 8); v1 = *(const u32x4*)(s_.vp + (size_t)srow * s_.vstride + 64 + schunk * 8); } while (0)
#define ATT_WRITE(k0, k1, v0, v1, bufi) do { LAS unsigned char* kb_ = C.lds + (bufi) * AT_BUF; *(LAS u32x4*)(kb_ + srow * AT_KSTR + schunk * 16) = k0; *(LAS u32x4*)(kb_ + (64 + srow) * AT_KSTR + schunk * 16) = k1; \
            LAS u32x2* vd_ = (LAS u32x2*)(kb_ + AT_KBYTES + srow * AT_VSTR + schunk * 16); vd_[0] = (u32x2){v0.x, v0.y}; vd_[1] = (u32x2){v0.z, v0.w}; vd_[16] = (u32x2){v1.x, v1.y}; vd_[17] = (u32x2){v1.z, v1.w}; } while (0)
        ATT_LOAD(kA0, kA1, vA0, vA1, 0); ATT_WRITE(kA0, kA1, vA0, vA1, 0); if (nt > 1) ATT_LOAD(kA0, kA1, vA0, vA1, 1);
        __syncthreads();
#define ATT_STEP(t, kc0, kc1, vc0, vc1, kn0, kn1, vn0, vn1) do { const int buf = (t) & 1; \
            if ((t) + 2 < nt) ATT_LOAD(kn0, kn1, vn0, vn1, (t) + 2); \
            _Pragma("unroll") for (int sub_ = 0; sub_ < 2; ++sub_) { \
                bool skip = false, domask = false; const int kb = lo + 128 * (t) + 64 * sub_; \
                if (latent && (t) < nband) { skip = (kb > qw_lo + 31 + 128) || (kb + 63 < qw_lo - 128); domask = !((kb + 63 - qw_lo <= 128) && (qw_lo + 31 - kb <= 128)); } \
                if (!skip) attn_tile(C.lds + buf * AT_BUF + sub_ * 64 * AT_KSTR, C.lds + buf * AT_BUF + AT_KBYTES + sub_ * 128, qf, O0, O1, mrun, lsum, domask, kb - qpos, q32, half); } \
            if ((t) + 1 < nt) ATT_WRITE(kc0, kc1, vc0, vc1, buf ^ 1); \
            __syncthreads(); } while (0)
        for (int t = 0; t < nt; t += 2) { ATT_STEP(t, kA0, kA1, vA0, vA1, kB0, kB1, vB0, vB1); if (t + 1 < nt) ATT_STEP(t + 1, kB0, kB1, vB0, vB1, kA0, kA1, vA0, vA1); }
#undef ATT_STEP
#undef ATT_LOAD
#undef ATT_WRITE
        const float inv = fast_rcp(lsum + __shfl_xor(lsum, 32));
        bf16_t* op = Q + (size_t)(rowbase + 32 * w + q32) * 512 + h * 64 + 4 * half;
#pragma unroll
        for (int g = 0; g < 4; ++g) { u32x2 o; o.x = cvt_pk_bf16(O0[4 * g] * inv, O0[4 * g + 1] * inv); o.y = cvt_pk_bf16(O0[4 * g + 2] * inv, O0[4 * g + 3] * inv); *(u32x2*)(op + 8 * g) = o;
            o.x = cvt_pk_bf16(O1[4 * g] * inv, O1[4 * g + 1] * inv); o.y = cvt_pk_bf16(O1[4 * g + 2] * inv, O1[4 * g + 3] * inv); *(u32x2*)(op + 32 + 8 * g) = o; }
    }
}

constexpr int LRW_BYTES = 11008, LR_PH = 8 * LRW_BYTES, LR_CAR = LR_PH + 8192, LR_CONST = LR_CAR + 512, LR_END = LR_CONST + 768;
static_assert(LR_END <= 131072, "lru LDS map");
__device__ __forceinline__ void lru_load_rows(float (&xr)[19], const float* XRc, int trow0, int L) {
#pragma unroll
    for (int r = 0; r < 19; ++r) { const int t = trow0 + r; const bool ok = (t >= 0) && (t < L); xr[r] = XRc[(size_t)(ok ? t : 0) * 512]; }
    asm volatile("" ::: "memory");
#pragma unroll
    for (int r = 0; r < 19; ++r) { const int t = trow0 + r; xr[r] *= ((t >= 0) && (t < L)) ? 1.0f : 0.0f; }
}
__device__ __forceinline__ void lru_item(ArgsP args, const Ctx& C, int l, int it) {
    const float* XR = (const float*)act_ptr(C, A_XR); const bf16_t* GY = (const bf16_t*)act_ptr(C, A_GY); bf16_t* REC = (bf16_t*)act_ptr(C, A_XN);
    const int w = C.wave, ch = C.lane, fr = C.lane & 15, fq = C.lane >> 4;
    LAS float* XF = (LAS float*)(C.lds + w * LRW_BYTES); LAS float* AA = XF + 16 * 68; LAS bf16_t* XCB = (LAS bf16_t*)(AA + 16 * 68);
    LAS float* PH = (LAS float*)(C.lds + LR_PH); LAS float* CAR = (LAS float*)(C.lds + LR_CAR); LAS float* CST = (LAS float*)(C.lds + LR_CONST);
    const int dir = it & 1, nb = (it >> 1) & 7, sq = it >> 4;
    const bool latent = sq < 4; const int b = latent ? sq : sq - 4, L = latent ? LS : LC, rowbase = latent ? MP + b * LS : b * LC;
    const int cgl = nb * 64 + ch, g = (l * 2 + dir) * 8 + nb;
    __syncthreads();
    if (C.tid < 64) { const int cg = (l * 2 + dir) * 512 + nb * 64 + C.tid; CST[C.tid] = args->in[25][cg]; CST[64 + C.tid] = args->in[27][cg]; CST[128 + C.tid] = (-8.0f * 0.6931471805599453f) * __builtin_amdgcn_logf(1.0f + __builtin_amdgcn_exp2f(-LOG2E * args->in[28][cg]));
        CAR[C.tid] = latent ? args->in[5][((size_t)(b * 2 + l) * 2 + dir) * 512 + nb * 64 + C.tid] : 0.f; }
    bf16x8 wf[8][2];
    { const bf16_t* lw = (const bf16_t*)(C.ws + OFF_LWT) + (size_t)g * 128 * 64 + fr * 64 + 8 * fq;
#pragma unroll
      for (int nt = 0; nt < 8; ++nt)
#pragma unroll
          for (int kk = 0; kk < 2; ++kk) wf[nt][kk] = *(const bf16x8*)(lw + nt * 16 * 64 + 32 * kk); }
    const float cw0 = args->in[22][(l * 4 + 0) * 512 + cgl], cw1 = args->in[22][(l * 4 + 1) * 512 + cgl], cw2 = args->in[22][(l * 4 + 2) * 512 + cgl], cw3 = args->in[22][(l * 4 + 3) * 512 + cgl], cb = args->in[23][l * 512 + cgl];
    const float* XRc = XR + (size_t)rowbase * 512 + cgl;
    const int nch = L >> 7, e0 = dir ? 16 * (7 - w) : 16 * w;
    float xr[19];
    lru_load_rows(xr, XRc, (dir ? (L - 128) : 0) + e0 - 2, L);
    __syncthreads();
    float hfin = 0.f;
    for (int c = 0; c < nch; ++c) {
        const int t0 = dir ? (L - 128 * (c + 1)) : 128 * c, par = c & 1;
#pragma unroll
        for (int e = 0; e < 16; ++e) { const float xc = cb + cw0 * xr[e] + cw1 * xr[e + 1] + cw2 * xr[e + 2] + cw3 * xr[e + 3]; XF[e * 68 + ch] = xc; XCB[e * 72 + ch] = f2bf(xc); }
        asm volatile("" ::: "memory");
        float gy[16];
        { const bf16_t* gp = GY + (size_t)(rowbase + t0 + e0) * 512 + cgl;
#pragma unroll
          for (int j = 0; j < 16; ++j) gy[j] = bf2f(gp[(size_t)(dir ? 15 - j : j) * 512]); }
        if (c + 1 < nch) lru_load_rows(xr, XRc, (dir ? (L - 128 * (c + 2)) : 128 * (c + 1)) + e0 - 2, L);
        f32x4 acc[8];
#pragma unroll
        for (int nt = 0; nt < 8; ++nt) acc[nt] = (f32x4){0.f, 0.f, 0.f, 0.f};
#pragma unroll
        for (int kk = 0; kk < 2; ++kk) { const bf16x8 xf = *(const LAS bf16x8*)(XCB + fr * 72 + 8 * fq + 32 * kk);
#pragma unroll
            for (int nt = 0; nt < 8; ++nt) acc[nt] = __builtin_amdgcn_mfma_f32_16x16x32_bf16(wf[nt][kk], xf, acc[nt], 0, 0, 0); }
#pragma unroll
        for (int nt = 0; nt < 4; ++nt) { const int c0 = 16 * nt + 4 * fq; const f32x4 ba = *(const LAS f32x4*)(CST + c0), bi = *(const LAS f32x4*)(CST + 64 + c0), sp = *(const LAS f32x4*)(CST + 128 + c0);
            const f32x4 xcv = *(const LAS f32x4*)(XF + fr * 68 + c0); f32x4 av, bv;
#pragma unroll
            for (int i = 0; i < 4; ++i) { const float r = sigmoidf_(acc[nt][i] + ba[i]), ig = sigmoidf_(acc[nt + 4][i] + bi[i]); const float la = r * sp[i], a = __builtin_amdgcn_exp2f(LOG2E * la);
                const float om = 1.0f - a * a;
                av[i] = a; bv[i] = __builtin_amdgcn_sqrtf(fmaxf(om, 0.f)) * (ig * xcv[i]); }
            *(LAS f32x4*)(AA + fr * 68 + c0) = av; *(LAS f32x4*)(XF + fr * 68 + c0) = bv; }
        asm volatile("" ::: "memory");
        { float P = 1.f, H = 0.f;
#pragma unroll
          for (int j = 0; j < 16; ++j) { const int e = dir ? 15 - j : j; const float a = AA[e * 68 + ch], bb = XF[e * 68 + ch]; H = a * H + bb; P *= a; }
          PH[(par * 2 + 0) * 512 + w * 64 + ch] = P; PH[(par * 2 + 1) * 512 + w * 64 + ch] = H; }
        __syncthreads();
        float h = CAR[par * 64 + ch];
        for (int s2 = 0; s2 < w; ++s2) h = PH[(par * 2 + 0) * 512 + s2 * 64 + ch] * h + PH[(par * 2 + 1) * 512 + s2 * 64 + ch];
        { bf16_t* rp = REC + (size_t)(rowbase + t0 + e0) * D + dir * 512 + cgl;
#pragma unroll
          for (int j = 0; j < 16; ++j) { const int e = dir ? 15 - j : j; h = AA[e * 68 + ch] * h + XF[e * 68 + ch]; rp[(size_t)e * D] = f2bf(h * gy[j]); } }
        asm volatile("" ::: "memory");
        if (w == 7) { CAR[(par ^ 1) * 64 + ch] = h; hfin = h; }
    }
    if (!latent && w == 7) C.out[OUT_ST + ((size_t)(b * 2 + l) * 2 + dir) * 512 + cgl] = hfin;
}

#define XB_TMO      128
#define XB_XCNT(j)  (256  + 64 * (j))
#define XB_XSUB(j)  (1280 + 64 * (j))
#define XB_XGEN(j)  (2304 + 64 * (j))
#define XB_TOP      3328
#define XB_TOPGEN   3392
#define XCD_BAR_WORDS 3456
#define XB_SPIN_CAP (1u << 18)

__device__ __forceinline__ unsigned xb_ld(unsigned* p)              { return __hip_atomic_load(p, __ATOMIC_RELAXED, __HIP_MEMORY_SCOPE_AGENT); }
__device__ __forceinline__ unsigned xb_add(unsigned* p, unsigned v) { return __hip_atomic_fetch_add(p, v, __ATOMIC_RELAXED, __HIP_MEMORY_SCOPE_AGENT); }
__device__ __forceinline__ unsigned xb_xcc_id() { return (unsigned)__builtin_amdgcn_s_getreg((3 << 11) | 20) & 0xFu; }
#define XB_SPIN(cond, bar) do { unsigned _sp = 0; while (cond) { __builtin_amdgcn_s_sleep(1); \
    if ((++_sp & 255u) == 0u) { if (xb_ld(&(bar)[XB_TMO])) break; if (_sp > XB_SPIN_CAP) { atomicAdd(&(bar)[XB_TMO], 1u); break; } } } } while (0)

struct XcdBarrier {
    unsigned* bar; unsigned x;
    volatile LAS unsigned* st;
};

__device__ __forceinline__ XcdBarrier xcd_barrier_post(unsigned* bar, volatile LAS unsigned* st, int tid) {
    XcdBarrier b; b.bar = bar; b.x = xb_xcc_id(); b.st = st;
    if (tid == 0) (void)xb_add(&bar[XB_XCNT(b.x)], 1u);
    return b;
}
__device__ __forceinline__ void xcd_barrier_complete(unsigned* bar, unsigned x, unsigned& nloc, unsigned& nx) {
    const unsigned G = gridDim.x * gridDim.y * gridDim.z;
    unsigned sum, cnt, mine, sp = 0u;
    for (;;) {
        sum = 0u; cnt = 0u; mine = 0u;
#pragma unroll
        for (unsigned j = 0; j < 16; ++j) { const unsigned c = xb_ld(&bar[XB_XCNT(j)]); sum += c; cnt += (c > 0u) ? 1u : 0u; mine = (j == x) ? c : mine; }
        if (sum == G) break;
        __builtin_amdgcn_s_sleep(1);
        if ((++sp & 255u) == 0u) { if (xb_ld(&bar[XB_TMO])) break; if (sp > XB_SPIN_CAP) { atomicAdd(&bar[XB_TMO], 1u); break; } }
    }
    nloc = mine > 0u ? mine : 1u; nx = cnt > 0u ? cnt : 1u;
}

__device__ __forceinline__ void xcd_barrier(const XcdBarrier& b, int tid) {
    asm volatile("s_waitcnt vmcnt(0)" ::: "memory");
    __syncthreads();
    if (tid == 0) {
        unsigned* bar = b.bar;
        __builtin_amdgcn_s_waitcnt(0);
        unsigned nloc = b.st[0], nx = b.st[1];
        if (nloc == 0u) { xcd_barrier_complete(bar, b.x, nloc, nx); b.st[0] = nloc; b.st[1] = nx; }
        const unsigned old = xb_add(&bar[XB_XSUB(b.x)], 1u);
        const unsigned gen = old / nloc;
        if (old + 1u == (gen + 1u) * nloc) {
            __builtin_amdgcn_fence(__ATOMIC_RELEASE, "agent");
            asm volatile("s_waitcnt vmcnt(0)" ::: "memory");
            const unsigned og = xb_add(&bar[XB_TOP], 1u);
            const unsigned tg = og / nx;
            if (og + 1u == (tg + 1u) * nx) xb_add(&bar[XB_TOPGEN], 1u);
            else XB_SPIN(xb_ld(&bar[XB_TOPGEN]) == tg, bar);
            __builtin_amdgcn_fence(__ATOMIC_ACQUIRE, "agent");
            xb_add(&bar[XB_XGEN(b.x)], 1u);
            asm volatile("s_waitcnt vmcnt(0)" ::: "memory");
        } else {
            XB_SPIN(xb_ld(&bar[XB_XGEN(b.x)]) == gen, bar);
            __builtin_amdgcn_fence(__ATOMIC_ACQUIRE, "agent");
            asm volatile("s_waitcnt vmcnt(0)" ::: "memory");
        }
    }
    __syncthreads();
}

#ifndef PROBE_ITEM
#define PROBE_ITEM 0
#endif
#ifndef PROBE_STAT
#define PROBE_STAT 0
#endif
constexpr int CW_PROBE = 3700;
struct OneUnit { Unit u; __device__ bool next(int i, Unit& o) const { if (i) return false; o = u; return true; } };
constexpr int MX_DFTL = 64, MX_LRUL = 64, MX_ATTL = 256, MX_LRUC = 256, MX_ATTC = 128, MX_DFTC = 32;
constexpr int MX_N = MX_DFTL + MX_LRUL + MX_ATTL + MX_LRUC + MX_ATTC + MX_DFTC;
constexpr int CW_QUEUE = 3520;
__device__ __forceinline__ void mixer_phase(ArgsP args_in, const Ctx& C_in, int l_in) {
    for (;;) {
        ArgsP args = args_in; asm volatile("" : "+s"(args));
        int tid_ = C_in.tid; asm volatile("" : "+v"(tid_));
        int l = l_in; asm volatile("" : "+s"(l));
        Ctx C; C.out = args->out; C.ws = args->ws; C.lds = C_in.lds; C.tid = tid_; C.lane = tid_ & 63; C.wave = __builtin_amdgcn_readfirstlane(tid_ >> 6); C.bid = C_in.bid; C.G = C_in.G;
        volatile LAS int* qslot = (volatile LAS int*)(C.lds + 131072 + 64);
        unsigned* qhead = (unsigned*)(C.ws + WS_CTL) + CW_QUEUE + 64 * l;
        __syncthreads();
        if (C.tid == 0) qslot[0] = (int)__hip_atomic_fetch_add(qhead, 1u, __ATOMIC_RELAXED, __HIP_MEMORY_SCOPE_AGENT);
        __syncthreads();
        int idx = __builtin_amdgcn_readfirstlane(qslot[0]);
        if (idx >= MX_N) break;
        const unsigned long long pt0 = (PROBE_ITEM != 0) ? __builtin_amdgcn_s_memrealtime() : 0ull; int ptype = 0;
        if (idx < MX_DFTL) { const int z = idx >> 4, pm = (idx >> 1) & 7, pn = idx & 1;
            OneUnit S; S.u.pm = pm; S.u.pn = pn; S.u.z = z; S.u.A = (const bf16_t*)(C.ws + WS_DFTL) + (size_t)pm * 256 * LS; S.u.B = (const bf16_t*)act_ptr(C, A_XFT) + (size_t)16 * 512 * LC + ((size_t)z * 512 + pn * 256) * LS;
            EpiDft E{(bf16_t*)act_ptr(C, A_Z), LS, MP + z * LS}; GEMM(C, S, E, LS, LS, LS); ptype = 1; }
        else { idx -= MX_DFTL;
        if (idx < MX_LRUL) { lru_item(args, C, l, idx); ptype = 2; } else { idx -= MX_LRUL;
        if (idx < MX_ATTL) { attn_unit(args, C, l, idx); ptype = 3; } else { idx -= MX_ATTL;
        if (idx < MX_LRUC) { lru_item(args, C, l, 64 + idx); ptype = 4; } else { idx -= MX_LRUC;
        if (idx < MX_ATTC) { attn_unit(args, C, l, 256 + idx); ptype = 5; } else { idx -= MX_ATTC;
        { const int z = idx >> 1, pn = idx & 1; ptype = 6;
            OneUnit S; S.u.pm = 0; S.u.pn = pn; S.u.z = z; S.u.A = (const bf16_t*)(C.ws + WS_DFTC); S.u.B = (const bf16_t*)act_ptr(C, A_XFT) + ((size_t)z * 512 + pn * 256) * LC;
            EpiDft E{(bf16_t*)act_ptr(C, A_Z), LC, z * LC}; GEMM(C, S, E, LC, LC, LC); } } } } } }
        if (PROBE_ITEM != 0 && ptype == PROBE_ITEM && C.tid == 0) { const unsigned dt = (unsigned)(__builtin_amdgcn_s_memrealtime() - pt0); unsigned* pw = (unsigned*)(C.ws + WS_CTL) + CW_PROBE;
            if (PROBE_STAT == 0) atomicMax(pw, dt); else atomicAdd(pw, dt); }
    }
}

#ifndef PROBE_MASK
#define PROBE_MASK 0u
#endif
constexpr int N_PHASES = 19;
__device__ __forceinline__ void run_phase(ArgsP args, const Ctx& C, int ph) {
    if (ph == 0) { p0_prologue(args, C); return; }
    if (ph == 1) { p0b_phase(args, C); return; }
    if (ph == N_PHASES - 1) { finalnorm_phase(args, C); return; }
    const int l = (ph - 2) >> 3, s = (ph - 2) & 7;
    const float* MODB = (const float*)(C.ws + OFF_MOD);
    if (s == 0 || s == 6) { const int sub = s ? 2 : 0; StaticOrder S; S.init(M, 2 * DFF, C.G, C.bid, (const bf16_t*)act_ptr(C, A_XN), D, (const bf16_t*)wl_ptr(C, l, s ? WL_GU2 : WL_GU1), D);
        EpiGU E{(bf16_t*)act_ptr(C, A_G), ssq_ptr(C, l * 3 + sub), sw_ptr(C, l, sub, 0)}; GEMM(C, S, E, D, D, D);
        if (l == 0 && s == 0) bg_run(args, C, 0, true, ph, 0);
        if (l == 0 && s == 6) { bg_load_shifts(C, 1); bg_run(args, C, 4, true, ph, 0); } }
    else if (s == 1 || s == 7) { const int sub = (s == 1) ? 0 : 2; const bool first = (l == 0 && s == 1);
        int ln = l, subn = 1; if (s == 7) { ln = (l == 0) ? 1 : -1; subn = 0; }
        const int sidx = (ln < 0) ? 6 : ln * 3 + subn;
        StaticOrder S; S.init(M, D, C.G, C.bid, (const bf16_t*)act_ptr(C, A_G), DFF, (const bf16_t*)wl_ptr(C, l, s == 1 ? WL_D1 : WL_D2), DFF);
        EpiRes E{C.out, first ? args->in[0] : C.out, first ? args->in[1] : C.out + (size_t)MP * D, MODB,
                 (bf16_t*)act_ptr(C, A_XN), args->in[9] + (size_t)((ln < 0 ? 0 : ln) * 3 + subn) * D, ssq_ptr(C, sidx), l, sub, ln, subn, 0.5f};
        GEMM(C, S, E, DFF, DFF, DFF);
        if (first) { bg_signal_done(C, ph); bg_load_shifts(C, 0); bg_run(args, C, 1, true, ph, 0); bg_run(args, C, 2, true, ph, 0); bg_run(args, C, 3, false, ph, C.G < 192 ? C.G : 192); }
        if (l == 0 && s == 7) bg_run(args, C, 5, true, ph, 0); }
    else if (s == 2) { StaticOrder S; S.init(M, NIN, C.G, C.bid, (const bf16_t*)act_ptr(C, A_XN), D, (const bf16_t*)wl_ptr(C, l, WL_IN), D);
        EpiIn E{(bf16_t*)act_ptr(C, A_Q), (bf16_t*)act_ptr(C, A_K), (bf16_t*)act_ptr(C, A_VT), (bf16_t*)act_ptr(C, A_GY), (bf16_t*)act_ptr(C, A_XFT), (bf16_t*)act_ptr(C, A_G),
                (float*)act_ptr(C, A_XR), C.out, (const float*)(C.ws + OFF_ROPE), args->in[19] + (size_t)l * 3072, l, ssq_ptr(C, l * 3 + 1), sw_ptr(C, l, 1, 0)};
        GEMM(C, S, E, D, D, D); }
    else if (s == 3) { mixer_phase(args, C, l); }
    else if (s == 4) {
        bf16_t* MG = (bf16_t*)act_ptr(C, A_XR); const bf16_t* G = (const bf16_t*)act_ptr(C, A_G);
        { StaticOrder S; S.init(M, D, C.G, C.bid, (const bf16_t*)act_ptr(C, A_Q), 512, (const bf16_t*)wl_ptr(C, l, WL_A), 512); EpiBranch<0> E{MG, G, 0}; GEMM(C, S, E, 512, 512, 512); }
        { StaticOrder S; S.init(M, D, C.G, C.bid, (const bf16_t*)act_ptr(C, A_XN), D, (const bf16_t*)wl_ptr(C, l, WL_L2), D); EpiBranch<1> E{MG, G, 1}; GEMM(C, S, E, D, D, D); }
        { StaticOrder S; S.init(M, D, C.G, C.bid, (const bf16_t*)act_ptr(C, A_Z), D, (const bf16_t*)wl_ptr(C, l, WL_F2), D); EpiBranch<1> E{MG, G, 2}; GEMM(C, S, E, D, D, D); }
        if (l == 0) { bg_signal_done(C, ph); bg_run(args, C, 3, false, ph, C.G < 192 ? C.G : 192); } }
    else if (s == 5) { StaticOrder S; S.init(M, D, C.G, C.bid, (const bf16_t*)act_ptr(C, A_XR), D, (const bf16_t*)wl_ptr(C, l, WL_O), D);
        EpiRes E{C.out, C.out, C.out + (size_t)MP * D, MODB, (bf16_t*)act_ptr(C, A_XN), args->in[9] + (size_t)(l * 3 + 2) * D, ssq_ptr(C, l * 3 + 2), l, 1, l, 2, 1.0f};
        GEMM(C, S, E, D, D, D);
        if (l == 0) bg_run(args, C, 3, true, ph, 0); }
}

__global__ void __launch_bounds__(NTHREADS, 2) fwd_kernel(Args args_byval) {
    extern __shared__ __attribute__((aligned(16))) unsigned char lds_raw[];
    ArgsP args0 = (ArgsP)__builtin_amdgcn_kernarg_segment_ptr();
    const int lo = args0->ph_lo, hi = args0->ph_hi;
    volatile LAS unsigned* bst = (volatile LAS unsigned*)((LAS unsigned char*)lds_raw + 131072);
    const int wave0 = __builtin_amdgcn_readfirstlane(threadIdx.x >> 6);
#define TID_NOW() ({ unsigned z_ = 0u; asm volatile("" : "+s"(z_)); wave0 * 64 + (int)__builtin_amdgcn_mbcnt_hi(~0u, __builtin_amdgcn_mbcnt_lo(~0u, z_)); })
    { const int t = TID_NOW(); if (t < 2) bst[t] = 0u; }
    __syncthreads();
    (void)xcd_barrier_post((unsigned*)(args0->ws + WS_CTL), bst, TID_NOW());
    volatile LAS unsigned long long* tacc = (volatile LAS unsigned long long*)((LAS unsigned char*)lds_raw + 131072 + 128);
    if (PROBE_MASK != 0u && blockIdx.x == 0 && TID_NOW() == 0) { tacc[0] = __builtin_amdgcn_s_memrealtime(); tacc[1] = 0ull; }
    for (int ph = lo; ph < hi; ++ph) {
        ArgsP args = args0; asm volatile("" : "+s"(args));
        int tid = TID_NOW(); asm volatile("" : "+v"(tid));
        int bid = blockIdx.x; asm volatile("" : "+s"(bid));
        Ctx C; C.out = args->out; C.ws = args->ws; C.lds = (LAS unsigned char*)lds_raw;
        C.tid = tid; C.lane = tid & 63; C.wave = __builtin_amdgcn_readfirstlane(tid >> 6); C.bid = bid; C.G = gridDim.x;
        run_phase(args, C, ph);
        if (ph + 1 < hi) {
            { XcdBarrier xb; xb.bar = (unsigned*)(args->ws + WS_CTL); xb.x = xb_xcc_id(); xb.st = bst; xcd_barrier(xb, TID_NOW()); } }
        if (PROBE_MASK != 0u && blockIdx.x == 0 && TID_NOW() == 0) { const unsigned long long now = __builtin_amdgcn_s_memrealtime(); if ((PROBE_MASK >> ph) & 1u) tacc[1] = tacc[1] + (now - tacc[0]); tacc[0] = now; }
    }
    if (PROBE_ITEM != 0 && blockIdx.x == 0 && TID_NOW() == 0) { const unsigned v = __hip_atomic_load((unsigned*)(args0->ws + WS_CTL) + CW_PROBE, __ATOMIC_RELAXED, __HIP_MEMORY_SCOPE_AGENT); const unsigned long long want = PROBE_STAT ? v / 256u : v, t0 = __builtin_amdgcn_s_memrealtime(); while (__builtin_amdgcn_s_memrealtime() - t0 < want) __builtin_amdgcn_s_sleep(8); }
    if (PROBE_MASK != 0u && blockIdx.x == 0 && TID_NOW() == 0) { const unsigned long long t0 = tacc[0], want = tacc[1]; while (__builtin_amdgcn_s_memrealtime() - t0 < want) __builtin_amdgcn_s_sleep(8); }
#undef TID_NOW
}

extern "C" void kernel_launch(void* const* d_in, const int* in_sizes, int n_in, void* d_out, int out_size, void* d_ws, size_t ws_size, hipStream_t stream) {
    if (n_in != 32 || ws_size < WS_END) { fprintf(stderr, "kernel_launch: n_in %d ws %zu (need %zu)\n", n_in, ws_size, (size_t)WS_END); return; }
    static int grid = 0;
    if (grid == 0) {
        int dev = 0, cus = 0, per_cu = 0;
        if (hipGetDevice(&dev) != hipSuccess || hipDeviceGetAttribute(&cus, hipDeviceAttributeMultiprocessorCount, dev) != hipSuccess) { fprintf(stderr, "kernel_launch: device query failed\n"); grid = -1; return; }
        if (hipFuncSetAttribute((const void*)fwd_kernel, hipFuncAttributeMaxDynamicSharedMemorySize, LDS_BYTES) != hipSuccess) { fprintf(stderr, "hipFuncSetAttribute failed\n"); grid = -1; return; }
        if (hipOccupancyMaxActiveBlocksPerMultiprocessor(&per_cu, (const void*)fwd_kernel, NTHREADS, LDS_BYTES) != hipSuccess || per_cu < 1) { fprintf(stderr, "kernel_launch: occupancy query says %d blocks per CU\n", per_cu); grid = -1; return; }
        if (per_cu > 1) per_cu = 1;
        grid = cus * per_cu;
    }
    if (grid < 0) return;
    Args a{};
    for (int i = 0; i < 32; ++i) a.in[i] = (const float*)d_in[i];
    a.out = (float*)d_out; a.ws = (unsigned char*)d_ws;
    a.ph_lo = 0; a.ph_hi = N_PHASES;
    if (hipMemsetAsync((char*)d_ws + WS_CTL, 0, CTL_ZERO_BYTES, stream) != hipSuccess) { fprintf(stderr, "hipMemsetAsync failed\n"); return; }
    void* kargs[] = {&a};
    hipError_t e = hipLaunchCooperativeKernel((const void*)fwd_kernel, dim3(grid), dim3(NTHREADS), kargs, LDS_BYTES, stream);
    if (e != hipSuccess) fprintf(stderr, "cooperative launch failed: %s (grid %d)\n", hipGetErrorString(e), grid);
}
```

```cpp
#include <hip/hip_runtime.h>
#include <hip/hip_cooperative_groups.h>
#include <cstdint>
#include <cstdio>


#define LAS __attribute__((address_space(3)))
typedef unsigned short bf16_t;
typedef short bf16x8 __attribute__((ext_vector_type(8)));
typedef float f32x4 __attribute__((ext_vector_type(4)));
typedef float f32x2 __attribute__((ext_vector_type(2)));
typedef float f32x16 __attribute__((ext_vector_type(16)));
typedef unsigned u32x4 __attribute__((ext_vector_type(4)));
typedef unsigned u32x2 __attribute__((ext_vector_type(2)));

constexpr int D = 1024, MP = 4096, MS = 8192, M = MP + MS, DFF = 2816, DEPTH = 2;
constexpr int LC = 256, LS = 2048;
constexpr int NB_C = 16, NB_S = 4;
constexpr int NIN = 2304 + 3072;
constexpr int NMOD = 9216;
constexpr float EPS = 1e-6f;
constexpr float LOG2E = 1.4426950408889634f;
constexpr float QSCALE = 0.125f * LOG2E;

constexpr size_t MiB = 1u << 20;
constexpr size_t SZ_WGU = (size_t)2 * DFF * D * 2, SZ_WD = (size_t)D * DFF * 2, SZ_WIN = (size_t)NIN * D * 2;
constexpr size_t SZ_WA = (size_t)D * 512 * 2, SZ_W1K = (size_t)D * D * 2;
constexpr size_t WL_GU1 = 0, WL_D1 = WL_GU1 + SZ_WGU, WL_GU2 = WL_D1 + SZ_WD, WL_D2 = WL_GU2 + SZ_WGU, WL_IN = WL_D2 + SZ_WD,
                 WL_A = WL_IN + SZ_WIN, WL_L2 = WL_A + SZ_WA, WL_F2 = WL_L2 + SZ_W1K, WL_O = WL_F2 + SZ_W1K, WL_SIZE = WL_O + SZ_W1K;
constexpr size_t WS_CTL = 0;
constexpr size_t WS_MISC = 1 * MiB;
constexpr size_t OFF_MOD = WS_CTL + 65536;
constexpr size_t OFF_SSQ = OFF_MOD + (size_t)2 * 5 * NMOD * 4;
constexpr size_t CTL_ZERO_BYTES = 32768;
static_assert(OFF_SSQ + (size_t)7 * M * 4 - WS_CTL <= 1048576, "control region");
constexpr size_t OFF_ROPE = WS_MISC;
constexpr size_t OFF_CK = OFF_ROPE + 2 * 1024 * 4;
constexpr size_t OFF_CVT = OFF_CK + (size_t)4 * 2 * 256 * 128 * 2;
constexpr size_t OFF_LWT = OFF_CVT + (size_t)4 * 2 * 2 * 64 * 256 * 2;
constexpr size_t WS_DFTC = 3 * MiB;
constexpr size_t WS_DFTL = 4 * MiB;
constexpr size_t OFF_SW = 12 * MiB;
constexpr size_t WS_W = 20 * MiB;
constexpr size_t WS_ACT = WS_W + 2 * WL_SIZE;
constexpr size_t A_G = 0;
constexpr size_t A_XN = 72 * MiB;
constexpr size_t A_XR = 96 * MiB;
constexpr size_t A_GY = 120 * MiB;
constexpr size_t A_XFT = 132 * MiB;
constexpr size_t A_Q = 144 * MiB;
constexpr size_t A_K = 156 * MiB;
constexpr size_t A_VT = 159 * MiB;
constexpr size_t A_Z = 162 * MiB;
constexpr size_t A_END = 186 * MiB;
constexpr size_t WS_END = WS_ACT + A_END;

constexpr int OUT_YS = MP * D, OUT_CK = M * D, OUT_CV = OUT_CK + 16 * 2 * 256 * 128, OUT_ST = OUT_CV + 16 * 2 * 256 * 128;

constexpr int NTHREADS = 512, NWAVES = 8;
constexpr int LDS_BYTES = 147456;

typedef __bf16 bf16x2_t __attribute__((ext_vector_type(2)));
__device__ __forceinline__ unsigned cvt_pk_bf16(float lo, float hi) { f32x2 v = {lo, hi}; bf16x2_t b = __builtin_convertvector(v, bf16x2_t); return __builtin_bit_cast(unsigned, b); }
__device__ __forceinline__ bf16_t f2bf(float f) { return (bf16_t)(cvt_pk_bf16(f, 0.f) & 0xffffu); }
__device__ __forceinline__ float bf2f(unsigned h) { return __uint_as_float(h << 16); }
__device__ __forceinline__ float bflo(unsigned w) { return __uint_as_float(w << 16); }
__device__ __forceinline__ float bfhi(unsigned w) { return __uint_as_float(w & 0xffff0000u); }
__device__ __forceinline__ float fast_rcp(float x) { return __builtin_amdgcn_rcpf(x); }
__device__ __forceinline__ float sigmoidf_(float x) { return fast_rcp(1.0f + __builtin_amdgcn_exp2f(-LOG2E * x)); }
__device__ __forceinline__ float siluf_(float x) { return x * sigmoidf_(x); }
__device__ __forceinline__ float gelu_tanh(float x) { const float u = (-2.0f * LOG2E * 0.7978845608028654f) * (x + 0.044715f * x * x * x); return x * fast_rcp(1.0f + __builtin_amdgcn_exp2f(u)); }
template <int CTRL> __device__ __forceinline__ float dpp_f(float v) { return __builtin_bit_cast(float, __builtin_amdgcn_update_dpp(0, __builtin_bit_cast(int, v), CTRL, 0xf, 0xf, true)); }
__device__ __forceinline__ float sum_x16(float v) { unsigned a = __builtin_bit_cast(unsigned, v), b = a; asm volatile("" : "+v"(b)); const auto r = __builtin_amdgcn_permlane16_swap(a, b, false, false); unsigned r0 = r[0], r1 = r[1]; asm volatile("" : "+v"(r0), "+v"(r1)); return __builtin_bit_cast(float, r0) + __builtin_bit_cast(float, r1); }
__device__ __forceinline__ float sum_x32(float v) { unsigned a = __builtin_bit_cast(unsigned, v), b = a; asm volatile("" : "+v"(b)); const auto r = __builtin_amdgcn_permlane32_swap(a, b, false, false); unsigned r0 = r[0], r1 = r[1]; asm volatile("" : "+v"(r0), "+v"(r1)); return __builtin_bit_cast(float, r0) + __builtin_bit_cast(float, r1); }
__device__ __forceinline__ float wave_sum(float v) {
    v += dpp_f<0xB1>(v); v += dpp_f<0x4E>(v); v += dpp_f<0x141>(v); v += dpp_f<0x140>(v);
    return sum_x32(sum_x16(v));
}
__device__ __forceinline__ int cond_of_row(int r) { return r < MP ? 4 : ((r - MP) >> 11); }

struct Args {
    const float* in[32];
    float* out;
    unsigned char* ws;
    int ph_lo, ph_hi;
};

typedef const __attribute__((address_space(4))) Args* ArgsP;
struct Ctx {
    float* out; unsigned char* ws; LAS unsigned char* lds;
    int tid, lane, wave, bid, G;
};
__device__ __forceinline__ unsigned char* wl_ptr(const Ctx& C, int l, size_t off) { return C.ws + WS_W + (size_t)l * WL_SIZE + off; }
__device__ __forceinline__ unsigned char* act_ptr(const Ctx& C, size_t off) { return C.ws + WS_ACT + off; }
__device__ __forceinline__ const float* mod_ptr(const Ctx& C, int l, int c, int sub, int which) { return (const float*)(C.ws + OFF_MOD) + ((size_t)(l * 5 + c) * NMOD + (sub * 3 + which) * D); }

struct TrItem { const float* W; bf16_t* WT; int ldw, ldt, drow0, dcol0, k0, n0; };
constexpr int I_G = 16 * 88, I_D = 44 * 32, I_IN = 16 * 72, I_BG = 16 * 96, I_A = 8 * 32, I_L = 8 * 32, I_O = 16 * 32;
constexpr int TR_PER_LAYER = 4 * I_G + 2 * I_D + I_IN + I_BG + I_A + 2 * I_L + I_O;
__device__ __forceinline__ TrItem p0_decode(ArgsP args, const Ctx& C, int it) {
    const int l = it / TR_PER_LAYER; int r = it % TR_PER_LAYER; TrItem t; t.dcol0 = 0;
    if (r < 2 * I_G) { const int gu = r >= I_G; r -= gu * I_G; const int kb = r / 88, n0 = (r % 88) * 32; t.W = args->in[11 + gu] + (size_t)l * D * DFF; t.ldw = DFF; t.WT = (bf16_t*)wl_ptr(C, l, WL_GU1); t.ldt = D; t.drow0 = 256 * (n0 >> 7) + 128 * gu + (n0 & 127); t.k0 = kb * 64; t.n0 = n0; return t; } r -= 2 * I_G;
    if (r < I_D) { const int kb = r / 32, nb = r % 32; t.W = args->in[13] + (size_t)l * DFF * D; t.ldw = D; t.WT = (bf16_t*)wl_ptr(C, l, WL_D1); t.ldt = DFF; t.drow0 = nb * 32; t.k0 = kb * 64; t.n0 = nb * 32; return t; } r -= I_D;
    if (r < 2 * I_G) { const int gu = r >= I_G; r -= gu * I_G; const int kb = r / 88, n0 = (r % 88) * 32; t.W = args->in[14 + gu] + (size_t)l * D * DFF; t.ldw = DFF; t.WT = (bf16_t*)wl_ptr(C, l, WL_GU2); t.ldt = D; t.drow0 = 256 * (n0 >> 7) + 128 * gu + (n0 & 127); t.k0 = kb * 64; t.n0 = n0; return t; } r -= 2 * I_G;
    if (r < I_D) { const int kb = r / 32, nb = r % 32; t.W = args->in[16] + (size_t)l * DFF * D; t.ldw = D; t.WT = (bf16_t*)wl_ptr(C, l, WL_D2); t.ldt = DFF; t.drow0 = nb * 32; t.k0 = kb * 64; t.n0 = nb * 32; return t; } r -= I_D;
    if (r < I_IN) { const int kb = r / 72, nb = r % 72; t.W = args->in[17] + (size_t)l * D * 2304; t.ldw = 2304; t.WT = (bf16_t*)wl_ptr(C, l, WL_IN); t.ldt = D; t.drow0 = nb * 32; t.k0 = kb * 64; t.n0 = nb * 32; return t; } r -= I_IN;
    if (r < I_BG) { const int kb = r / 96, nb = r % 96; t.W = args->in[18] + (size_t)l * D * 3072; t.ldw = 3072; t.WT = (bf16_t*)wl_ptr(C, l, WL_IN); t.ldt = D; t.drow0 = 2304 + nb * 32; t.k0 = kb * 64; t.n0 = nb * 32; return t; } r -= I_BG;
    if (r < I_A) { const int kb = r / 32, nb = r % 32; t.W = args->in[21] + (size_t)l * 512 * D; t.ldw = D; t.WT = (bf16_t*)wl_ptr(C, l, WL_A); t.ldt = 512; t.drow0 = nb * 32; t.k0 = kb * 64; t.n0 = nb * 32; return t; } r -= I_A;
    if (r < 2 * I_L) { const int dup = r >= I_L; r -= dup * I_L; const int kb = r / 32, nb = r % 32; t.W = args->in[29] + (size_t)l * 512 * D; t.ldw = D; t.WT = (bf16_t*)wl_ptr(C, l, WL_L2); t.ldt = D; t.drow0 = nb * 32; t.dcol0 = 512 * dup; t.k0 = kb * 64; t.n0 = nb * 32; return t; } r -= 2 * I_L;
    { const int kb = r / 32, nb = r % 32; t.W = args->in[31] + (size_t)l * D * D; t.ldw = D; t.WT = (bf16_t*)wl_ptr(C, l, WL_O); t.ldt = D; t.drow0 = nb * 32; t.k0 = kb * 64; t.n0 = nb * 32; return t; }
}
__device__ __forceinline__ void p0_tr_load(const TrItem& t, f32x4 (&r)[8], int lane) {
    const float* p = t.W + (size_t)(t.k0 + (lane >> 3)) * t.ldw + t.n0 + 4 * (lane & 7);
#pragma unroll
    for (int i = 0; i < 8; ++i) r[i] = __builtin_nontemporal_load((const f32x4*)(p + (size_t)(8 * i) * t.ldw));
}
__device__ __forceinline__ void p0_tr_store(const TrItem& t, const f32x4 (&r)[8], LAS float* scr, int lane) {
#pragma unroll
    for (int i = 0; i < 8; ++i) { LAS float* p = scr + (8 * i + (lane >> 3)) * 33 + 4 * (lane & 7); p[0] = r[i].x; p[1] = r[i].y; p[2] = r[i].z; p[3] = r[i].w; }
    asm volatile("s_waitcnt lgkmcnt(0)" ::: "memory");
    const int c = lane & 7;
#pragma unroll
    for (int j = 0; j < 4; ++j) { const int n = (lane >> 3) + 8 * j; const LAS float* q = scr + (8 * c) * 33 + n;
        u32x4 o; o.x = cvt_pk_bf16(q[0 * 33], q[1 * 33]); o.y = cvt_pk_bf16(q[2 * 33], q[3 * 33]); o.z = cvt_pk_bf16(q[4 * 33], q[5 * 33]); o.w = cvt_pk_bf16(q[6 * 33], q[7 * 33]);
        *(u32x4*)(t.WT + (size_t)(t.drow0 + n) * t.ldt + t.dcol0 + t.k0 + 8 * c) = o; }
    asm volatile("s_waitcnt lgkmcnt(0)" ::: "memory");
}

__device__ __forceinline__ void p0_transposes(ArgsP args, const Ctx& C, LAS float* SCR, int it0, int it1, int gw, int NGW) {
    LAS float* scr = SCR + C.wave * (64 * 33);
    int it = it0 + gw; TrItem cur; f32x4 rc[8];
    if (it < it1) { cur = p0_decode(args, C, it); p0_tr_load(cur, rc, C.lane); }
    while (it < it1) {
        const int it2 = it + NGW; const bool more = it2 < it1; TrItem nxt = cur; f32x4 rn[8];
        if (more) { nxt = p0_decode(args, C, it2); p0_tr_load(nxt, rn, C.lane); }
        p0_tr_store(cur, rc, scr, C.lane);
        if (more) { cur = nxt;
#pragma unroll
            for (int i = 0; i < 8; ++i) rc[i] = rn[i]; }
        it = it2;
    }
}
constexpr int BG_SCR = 61440;
__device__ __forceinline__ void bg_load_shifts(const Ctx& C, int l) {
    LAS float* SH = (LAS float*)C.lds;
    __syncthreads();
    { float v[30];
#pragma unroll
      for (int j = 0; j < 30; ++j) { const int vec = j >> 1, c = vec % 5, sub = vec / 5, k = C.tid + 512 * (j & 1); v[j] = mod_ptr(C, l, c, sub, 0)[k]; }
      __builtin_amdgcn_sched_barrier(0);
#pragma unroll
      for (int j = 0; j < 30; ++j) { const int vec = j >> 1, k = C.tid + 512 * (j & 1); SH[vec * 1024 + ((((k >> 2) & 3) * 64 + (k >> 4)) << 2) + (k & 3)] = v[j]; } }
    __syncthreads();
}
__device__ __forceinline__ void sw_rows(const Ctx& C, int l, int r0, int nr) {
    const LAS float* SH = (const LAS float*)C.lds;
    u32x4 w0[4], w1[4]; int nn[4], ss[4];
#pragma unroll
    for (int i = 0; i < 4; ++i) { const int it = (i < nr) ? r0 + i : r0; int n = it, sub = 0; size_t woff = WL_GU1;
        if (n >= 5632) { n -= 5632; sub = 1; woff = WL_IN; if (n >= 5376) { n -= 5376; sub = 2; woff = WL_GU2; } }
        const u32x4* wp = (const u32x4*)((const bf16_t*)wl_ptr(C, l, woff) + (size_t)n * D + 16 * C.lane); w0[i] = wp[0]; w1[i] = wp[1]; nn[i] = n; ss[i] = sub; }
#pragma unroll
    for (int i = 0; i < 4; ++i) { if (i < nr) {
        const float wv[16] = {bflo(w0[i].x), bfhi(w0[i].x), bflo(w0[i].y), bfhi(w0[i].y), bflo(w0[i].z), bfhi(w0[i].z), bflo(w0[i].w), bfhi(w0[i].w), bflo(w1[i].x), bfhi(w1[i].x), bflo(w1[i].y), bfhi(w1[i].y), bflo(w1[i].z), bfhi(w1[i].z), bflo(w1[i].w), bfhi(w1[i].w)};
        float acc[5];
#pragma unroll
        for (int c = 0; c < 5; ++c) { const LAS f32x4* sp = (const LAS f32x4*)(SH + (ss[i] * 5 + c) * 1024) + C.lane; float a = 0.f;
#pragma unroll
            for (int q = 0; q < 4; ++q) { const f32x4 sv = sp[q * 64]; a += sv.x * wv[4 * q] + sv.y * wv[4 * q + 1] + sv.z * wv[4 * q + 2] + sv.w * wv[4 * q + 3]; }
            acc[c] = wave_sum(a); }
        if (C.lane < 5) { float* dst = (float*)(C.ws + OFF_SW) + (size_t)((l * 3 + ss[i]) * 5 + C.lane) * 5632 + nn[i];
            *dst = (C.lane == 0) ? acc[0] : (C.lane == 1) ? acc[1] : (C.lane == 2) ? acc[2] : (C.lane == 3) ? acc[3] : acc[4]; } } }
}
__device__ __forceinline__ void wf2_item(ArgsP args, const Ctx& C, int l, int idx) {
    const int g = idx >> 7, n0 = ((idx >> 3) & 15) * 64, rt = idx & 7, trig = rt >> 2, c0 = 32 * (rt & 3), i32 = C.lane & 31, hk = C.lane >> 5, cc = c0 + i32;
    const float* Wf = args->in[30] + (size_t)l * 512 * D + (size_t)(g * 128) * D + n0 + i32;
    f32x16 acc0, acc1;
#pragma unroll
    for (int q = 0; q < 16; ++q) { acc0[q] = 0.f; acc1[q] = 0.f; }
    for (int k0 = 0; k0 < 64; k0 += 16) { float b0[16], b1[16];
#pragma unroll
        for (int j = 0; j < 16; ++j) { const int q = 2 * (k0 + j) + hk; b0[j] = Wf[(size_t)q * D]; b1[j] = Wf[(size_t)q * D + 32]; }
#pragma unroll
        for (int j = 0; j < 16; ++j) { const int q = 2 * (k0 + j) + hk; const float ph = (float)((cc * q) & 127) * (1.0f / 128.0f); const float a = trig ? __builtin_amdgcn_sinf(ph) : __builtin_amdgcn_cosf(ph);
            acc0 = __builtin_amdgcn_mfma_f32_32x32x2f32(a, b0[j], acc0, 0, 0, 0); acc1 = __builtin_amdgcn_mfma_f32_32x32x2f32(a, b1[j], acc1, 0, 0, 0); } }
    const float sc = trig ? -0.08838834764831845f : 0.08838834764831845f;
    bf16_t* d0 = (bf16_t*)wl_ptr(C, l, WL_F2) + (size_t)(n0 + i32) * D + (trig ? 512 : 0) + g * 128 + c0 + 4 * hk;
#pragma unroll
    for (int q4 = 0; q4 < 4; ++q4) { u32x2 o; o.x = cvt_pk_bf16(acc0[4 * q4] * sc, acc0[4 * q4 + 1] * sc); o.y = cvt_pk_bf16(acc0[4 * q4 + 2] * sc, acc0[4 * q4 + 3] * sc); *(u32x2*)(d0 + 8 * q4) = o;
        o.x = cvt_pk_bf16(acc1[4 * q4] * sc, acc1[4 * q4 + 1] * sc); o.y = cvt_pk_bf16(acc1[4 * q4 + 2] * sc, acc1[4 * q4 + 3] * sc); *(u32x2*)(d0 + (size_t)32 * D + 8 * q4) = o; }
}
__device__ __forceinline__ void bg_transposes(ArgsP args, const Ctx& C, int it0, int it1) {
    const int skip = (C.G > 64) ? 32 : 0; if (C.bid < skip) return;
    p0_transposes(args, C, (LAS float*)(C.lds + BG_SCR), it0, it1, (C.bid - skip) * NWAVES + C.wave, (C.G - skip) * NWAVES);
}
__device__ __forceinline__ void bg_sw_rows(const Ctx& C, int l, int r0, int r1, int skip) {
    if (C.bid < skip) return;
    bg_load_shifts(C, l);
    const int gw = (C.bid - skip) * NWAVES + C.wave, NGW = (C.G - skip) * NWAVES;
    for (int r = r0 + gw * 4; r < r1; r += NGW * 4) sw_rows(C, l, r, (r1 - r) < 4 ? (r1 - r) : 4);
}
__device__ __forceinline__ void bg_wf2(ArgsP args, const Ctx& C, int l, int skip) {
    if (C.bid < skip) return; const int nb = C.G - skip; for (int i = C.wave * nb + (C.bid - skip); i < 512; i += NWAVES * nb) wf2_item(args, C, l, i); }

__device__ __forceinline__ void p0_tables(const Ctx& C, const LAS float* TAB) {
    const int gt = C.bid * NTHREADS + C.tid, NGT = C.G * NTHREADS;
    for (int i = gt; i < 6 * M / 4; i += NGT) ((f32x4*)(C.ws + OFF_SSQ) + M / 4)[i] = (f32x4){0.f, 0.f, 0.f, 0.f};
    for (int i = gt; i < 2048 * 256; i += NGT) { const int pr = i >> 8, t0 = (i & 255) * 8, p = (pr <= 1024) ? pr : pr - 1024, sh = (pr > 1024) ? 512 : 0; const float s = 0.022097086912079608f;
        float v[8];
#pragma unroll
        for (int j = 0; j < 8; ++j) v[j] = TAB[((p * (t0 + j)) - sh) & 2047] * s;
        u32x4 o; o.x = cvt_pk_bf16(v[0], v[1]); o.y = cvt_pk_bf16(v[2], v[3]); o.z = cvt_pk_bf16(v[4], v[5]); o.w = cvt_pk_bf16(v[6], v[7]);
        *(u32x4*)((bf16_t*)(C.ws + WS_DFTL) + (size_t)pr * 2048 + t0) = o; }
    for (int i = gt; i < 256 * 32; i += NGT) { const int pr = i >> 5, t0 = (i & 31) * 8, p = (pr <= 128) ? pr : pr - 128, sh = (pr > 128) ? 512 : 0; const float s = 0.0625f;
        float v[8];
#pragma unroll
        for (int j = 0; j < 8; ++j) v[j] = TAB[((p * (t0 + j) * 8) - sh) & 2047] * s;
        u32x4 o; o.x = cvt_pk_bf16(v[0], v[1]); o.y = cvt_pk_bf16(v[2], v[3]); o.z = cvt_pk_bf16(v[4], v[5]); o.w = cvt_pk_bf16(v[6], v[7]);
        *(u32x4*)((bf16_t*)(C.ws + WS_DFTC) + (size_t)pr * 256 + t0) = o; }
    for (int i = gt; i < 1024; i += NGT) { const int pos = i >> 4, f = i & 15; const float inv = __builtin_amdgcn_exp2f(-(float)f * (13.287712379549449f / 16.0f)); const float ang = (float)pos * inv;
        float tr = ang * 0.15915494309189535f; tr = tr - __builtin_floorf(tr);
        ((float*)(C.ws + OFF_ROPE))[i] = __builtin_amdgcn_cosf(tr); ((float*)(C.ws + OFF_ROPE))[1024 + i] = __builtin_amdgcn_sinf(tr); }
}
__device__ __forceinline__ void mod_item(ArgsP args, const Ctx& C, int it, const LAS float* SC, LAS float* SCR, const LAS float* TAB, bool tables_now) {
            const int l = it / 144, j0 = (it % 144) * 64, lg = C.lane >> 4, kbase = C.wave * 128 + lg;
            const float* W = args->in[7] + (size_t)l * D * NMOD + (size_t)kbase * NMOD + j0 + 4 * (C.lane & 15);
            f32x4 a0 = {0.f, 0.f, 0.f, 0.f}, a1 = a0, a2 = a0, a3 = a0, a4 = a0;
            f32x4 wv[32];
#pragma unroll
            for (int i = 0; i < 32; ++i) wv[i] = __builtin_nontemporal_load((const f32x4*)(W + (size_t)(4 * i) * NMOD));
            __builtin_amdgcn_sched_barrier(0);
            if (tables_now) { p0_tables(C, TAB); __builtin_amdgcn_sched_barrier(0); }
#pragma unroll
            for (int i = 0; i < 32; ++i) { const f32x4 w = wv[i]; const int k = kbase + 4 * i;
                a0 += w * SC[k]; a1 += w * SC[1024 + k]; a2 += w * SC[2048 + k]; a3 += w * SC[3072 + k]; a4 += w * SC[4096 + k]; }
#define P0_RED4(a) a.x = sum_x32(sum_x16(a.x)); a.y = sum_x32(sum_x16(a.y)); a.z = sum_x32(sum_x16(a.z)); a.w = sum_x32(sum_x16(a.w));
            P0_RED4(a0) P0_RED4(a1) P0_RED4(a2) P0_RED4(a3) P0_RED4(a4)
#undef P0_RED4
            LAS f32x4* R = (LAS f32x4*)SCR;
            if (C.lane < 16) { R[(C.wave * 5 + 0) * 16 + C.lane] = a0; R[(C.wave * 5 + 1) * 16 + C.lane] = a1; R[(C.wave * 5 + 2) * 16 + C.lane] = a2; R[(C.wave * 5 + 3) * 16 + C.lane] = a3; R[(C.wave * 5 + 4) * 16 + C.lane] = a4; }
            __syncthreads();
            if (C.tid < 320) { const int c = C.tid >> 6, j = C.tid & 63; float sum = args->in[8][(size_t)l * NMOD + j0 + j];
#pragma unroll
                for (int w = 0; w < 8; ++w) sum += SCR[(w * 5 + c) * 64 + j];
                ((float*)(C.ws + OFF_MOD))[(size_t)(l * 5 + c) * NMOD + j0 + j] = sum; }
            __syncthreads();
}
__device__ __forceinline__ void p0_prologue(ArgsP args, const Ctx& C) {
    LAS float* SC = (LAS float*)C.lds;
    LAS float* TAB = (LAS float*)(C.lds + 20480);
    LAS float* SCR = (LAS float*)(C.lds + 32768);
    const float* c_in = args->in[2]; const float* cctx = args->in[6];
    { float cv[10];
#pragma unroll
      for (int j = 0; j < 8; ++j) cv[j] = c_in[C.tid + j * NTHREADS];
#pragma unroll
      for (int j = 8; j < 10; ++j) cv[j] = cctx[C.tid + (j - 8) * NTHREADS];
      __builtin_amdgcn_sched_barrier(0);
#pragma unroll
      for (int j = 0; j < 10; ++j) SC[C.tid + j * NTHREADS] = siluf_(cv[j]); }
    for (int i = C.tid; i < 2048; i += NTHREADS) TAB[i] = __builtin_amdgcn_cosf((float)i * (1.0f / 2048.0f));
    __syncthreads();
    bool tables_done = false;
    for (int it = C.bid; it < 144; it += C.G) { mod_item(args, C, it, SC, SCR, TAB, !tables_done); tables_done = true; }
    if (!tables_done) p0_tables(C, TAB);
    __syncthreads();
    p0_transposes(args, C, SCR, 0, 2 * I_G, C.bid * NWAVES + C.wave, C.G * NWAVES);
    const int gt = C.bid * NTHREADS + C.tid, NGT = C.G * NTHREADS;
    { constexpr int NC = 4 * 2 * 256 * 128, NL = 2 * 2 * 8 * 128 * 64;
      for (int i0 = gt; i0 < NC; i0 += 2 * NGT) { const int i1 = (i0 + NGT < NC) ? i0 + NGT : i0;
        const float ka = args->in[3][i0], va = args->in[4][i0], kb = args->in[3][i1], vb = args->in[4][i1];
        __builtin_amdgcn_sched_barrier(0);
#pragma unroll
        for (int h = 0; h < 2; ++h) { const int i = h ? i1 : i0; const int d = i & 63, kvh = (i >> 6) & 1, t = (i >> 7) & 255, bl = i >> 15;
            ((bf16_t*)(C.ws + OFF_CK))[i] = f2bf(h ? kb : ka); ((bf16_t*)(C.ws + OFF_CVT))[((size_t)(bl * 2 + kvh) * 64 + d) * 256 + t] = f2bf(h ? vb : va); } }
      for (int i0 = gt; i0 < NL; i0 += 2 * NGT) { const int i1 = (i0 + NGT < NL) ? i0 + NGT : i0; float v[2];
#pragma unroll
        for (int h = 0; h < 2; ++h) { const int i = h ? i1 : i0; const int k = i & 63, n = (i >> 6) & 127, g = i >> 13;
            const float* src = (n < 64) ? args->in[24] + ((size_t)g * 64 + k) * 64 + n : args->in[26] + ((size_t)g * 64 + k) * 64 + (n - 64); v[h] = *src; }
        __builtin_amdgcn_sched_barrier(0);
        ((bf16_t*)(C.ws + OFF_LWT))[i0] = f2bf(v[0]); ((bf16_t*)(C.ws + OFF_LWT))[i1] = f2bf(v[1]); } }
}

__device__ __forceinline__ float* ssq_ptr(const Ctx& C, int idx) { return (float*)(C.ws + OFF_SSQ) + (size_t)idx * M; }
__device__ __forceinline__ const float* sw_ptr(const Ctx& C, int l, int sub, int c) { return (const float*)(C.ws + OFF_SW) + (size_t)((l * 3 + sub) * 5 + c) * 5632; }
__device__ __forceinline__ void p0b_phase(ArgsP args, const Ctx& C) {
    const int gw = C.bid * NWAVES + C.wave, NGW = C.G * NWAVES;
    { const float* nw = args->in[9]; bf16_t* XA = (bf16_t*)act_ptr(C, A_XN); float* ssq = ssq_ptr(C, 0);
      f32x4 v[4], wa[4], wb[4], vn[4], wan[4], wbn[4];
#define P0B_LOAD(r_, v_, wa_, wb_) do { const f32x4* xr_ = (const f32x4*)(((r_) < MP) ? args->in[0] + (size_t)(r_) * D : args->in[1] + (size_t)((r_) - MP) * D) + C.lane; const float* sc_ = mod_ptr(C, 0, cond_of_row(r_), 0, 1); \
          _Pragma("unroll") for (int j = 0; j < 4; ++j) v_[j] = __builtin_nontemporal_load(xr_ + 64 * j); \
          _Pragma("unroll") for (int j = 0; j < 4; ++j) { const int col_ = 4 * C.lane + 256 * j; wa_[j] = *(const f32x4*)(nw + col_); wb_[j] = *(const f32x4*)(sc_ + col_); } } while (0)
      if (gw < M) P0B_LOAD(gw, v, wa, wb);
      for (int r = gw; r < M; r += NGW) {
        const int rn = r + NGW;
        if (rn < M) P0B_LOAD(rn, vn, wan, wbn);
        __builtin_amdgcn_sched_barrier(0);
        float s = 0.f;
#pragma unroll
        for (int j = 0; j < 4; ++j) s += (v[j].x * v[j].x + v[j].y * v[j].y) + (v[j].z * v[j].z + v[j].w * v[j].w);
        s = wave_sum(s); if (C.lane == 0) ssq[r] = s;
        u32x2* o = (u32x2*)(XA + (size_t)r * D) + C.lane;
#pragma unroll
        for (int j = 0; j < 4; ++j) { const f32x4 y = v[j] * wa[j] * (wb[j] + 1.0f); u32x2 p; p.x = cvt_pk_bf16(y.x, y.y); p.y = cvt_pk_bf16(y.z, y.w); o[64 * j] = p; }
#pragma unroll
        for (int j = 0; j < 4; ++j) { v[j] = vn[j]; wa[j] = wan[j]; wb[j] = wbn[j]; } }
#undef P0B_LOAD
    }
    bg_load_shifts(C, 0);
    for (int r0 = gw * 4; r0 < 5632; r0 += NGW * 4) sw_rows(C, 0, r0, 4);
}
__device__ __forceinline__ void finalnorm_phase(ArgsP args, const Ctx& C) {
    const int gw = C.bid * NWAVES + C.wave, NGW = C.G * NWAVES;
    const float* nw = args->in[10]; const float* ssq = ssq_ptr(C, 6);
    f32x4 w[4], x[4], xn[4]; float q = 0.f, qn = 0.f;
#pragma unroll
    for (int j = 0; j < 4; ++j) w[j] = *(const f32x4*)(nw + 4 * C.lane + 256 * j);
    if (gw < M) { const f32x4* xr = (const f32x4*)(C.out + (size_t)gw * D) + C.lane; q = ssq[gw];
#pragma unroll
        for (int j = 0; j < 4; ++j) x[j] = xr[64 * j]; }
    for (int r = gw; r < M; r += NGW) {
        const int rn = r + NGW;
        if (rn < M) { const f32x4* xr = (const f32x4*)(C.out + (size_t)rn * D) + C.lane; qn = ssq[rn];
#pragma unroll
            for (int j = 0; j < 4; ++j) xn[j] = xr[64 * j]; }
        __builtin_amdgcn_sched_barrier(0);
        f32x4* xo = (f32x4*)(C.out + (size_t)r * D) + C.lane;
        const float rstd = __builtin_amdgcn_rsqf(q * (1.0f / D) + EPS);
#pragma unroll
        for (int j = 0; j < 4; ++j) xo[64 * j] = x[j] * rstd * w[j];
        q = qn;
#pragma unroll
        for (int j = 0; j < 4; ++j) x[j] = xn[j];
    }
}

struct Unit { int pm, pn, z; const bf16_t* A; const bf16_t* B; };

struct StaticOrder {
    int nM, nN, nwg, G, c; const bf16_t* A; const bf16_t* B; int lda, ldb;
    __device__ void init(int Mr, int N, int G_, int c_, const bf16_t* A_, int lda_, const bf16_t* B_, int ldb_) { nM = Mr / 256; nN = N / 256; nwg = nM * nN; G = G_; c = c_; A = A_; B = B_; lda = lda_; ldb = ldb_; }
    __device__ bool next(int i, Unit& u) const {
        const int L = i * G + c; if (L >= nwg) return false;
        int wgid = (int)L; { const int q = nwg / 8, r = nwg % 8, xcd = wgid % 8, off = wgid / 8; wgid = (xcd < r ? xcd * (q + 1) : r * (q + 1) + (xcd - r) * q) + off; }
        const int nig = 8 * nN, gid = wgid / nig, fm = gid * 8, gsz = (nM - fm) < 8 ? (nM - fm) : 8;
        u.pm = fm + ((wgid % nig) % gsz); u.pn = (wgid % nig) / gsz; u.z = 0;
        u.A = A + (size_t)u.pm * 256 * lda; u.B = B + (size_t)u.pn * 256 * ldb; return true;
    }
};
struct DftOrder {
    int nseq, nPm, L, G, c; const bf16_t* A; const bf16_t* XFT;
    __device__ bool next(int i, Unit& u) const {
        const int idx = i * G + c; if (idx >= nseq * nPm * 2) return false;
        u.z = idx / (nPm * 2); const int r = idx % (nPm * 2); u.pm = r >> 1; u.pn = r & 1;
        u.A = A + (size_t)u.pm * 256 * L; u.B = XFT + ((size_t)u.z * 512 + u.pn * 256) * L; return true;
    }
};

template <class Epi, class Sched>
__device__ __forceinline__ void gemm_simple(const Ctx& C, const Sched& S, const Epi& E, int lda, int ldb, int K) {
    const int wr = C.wave >> 2, wc = C.wave & 3, fr = C.lane & 15, fq = C.lane >> 4;
    Unit u;
    for (int ui = 0; S.next(ui, u); ++ui) {
        f32x4 acc[2][2][4][2];
#pragma unroll
        for (int a = 0; a < 2; ++a)
#pragma unroll
            for (int b = 0; b < 2; ++b)
#pragma unroll
                for (int m = 0; m < 4; ++m)
#pragma unroll
                    for (int n = 0; n < 2; ++n) acc[a][b][m][n] = (f32x4){0.f, 0.f, 0.f, 0.f};
        const bf16_t* pa = u.A + (size_t)(wr * 64 + fr) * lda + fq * 8;
        const bf16_t* pb = u.B + (size_t)(wc * 32 + fr) * ldb + fq * 8;
        for (int k0 = 0; k0 < K; k0 += 32) {
            bf16x8 At[2][4], Bt[2][2];
#pragma unroll
            for (int a = 0; a < 2; ++a)
#pragma unroll
                for (int m = 0; m < 4; ++m) At[a][m] = *(const bf16x8*)(pa + (size_t)(a * 128 + m * 16) * lda + k0);
#pragma unroll
            for (int b = 0; b < 2; ++b)
#pragma unroll
                for (int n = 0; n < 2; ++n) Bt[b][n] = *(const bf16x8*)(pb + (size_t)(b * 128 + n * 16) * ldb + k0);
#pragma unroll
            for (int a = 0; a < 2; ++a)
#pragma unroll
                for (int b = 0; b < 2; ++b)
#pragma unroll
                    for (int m = 0; m < 4; ++m)
#pragma unroll
                        for (int n = 0; n < 2; ++n) acc[a][b][m][n] = __builtin_amdgcn_mfma_f32_16x16x32_bf16(Bt[b][n], At[a][m], acc[a][b][m][n], 0, 0, 0);
        }
        E(acc, u, wr, wc, fr, fq);
    }
}

#ifndef PROBE_MASK
#define PROBE_MASK 0u
#endif
#ifndef PROBE_SEL
#define PROBE_SEL 0
#endif
#ifndef PROBE_BLOCK
#define PROBE_BLOCK 0
#endif
namespace pg8 {
#define PG8_LAS __attribute__((address_space(3)))
constexpr int BM = 256, BK = 64, HALF = 128, HTB = HALF * BK * 2  , STAGE_BYTES = 8 * HTB, NXCD = 8, WGM = 8;

__host__ __device__ __forceinline__ int lds_byte(int r, int c) { const int st = (r >> 4) * 2 + (c >> 5), rr = r & 15, cc = c & 31, ob = rr * 64 + cc * 2; return st * 1024 + (ob ^ (((ob >> 9) & 1) << 5)); }
__host__ __device__ __forceinline__ void stage_rc(int b, int& R, int& C) { const int st = b / 1024, sb = b % 1024, swz = sb ^ (((sb >> 9) & 1) << 5); R = (st >> 1) * 16 + swz / 64; C = (st & 1) * 32 + (swz % 64) / 2; }
__host__ __device__ __forceinline__ int perm32(int rho) { const int n = rho >> 4, i = rho & 15; return 8 * (i >> 2) + 4 * n + (i & 3); }
template <class Epi, class Sched, bool ALIGN_EPI = true, bool SP2 = true, int MF = 4>
__device__ __forceinline__ void gemm_phase(PG8_LAS unsigned char* lds, const int tid, const Sched& S, const Epi& E, const int lda, const int ldb, const int K) {
    const int wid = __builtin_amdgcn_readfirstlane(tid >> 6), lane = tid & 63, wr = wid >> 2, wc = wid & 3, fr = lane & 15, fq = lane >> 4;
    const int nt = K / BK;
    unsigned voffA[2], voffB[2];
#pragma unroll
    for (int i = 0; i < 2; ++i) { int R, C; stage_rc(tid * 16 + i * 8192, R, C); const int Rb = Epi::PERM ? ((R & ~31) + perm32(R & 31)) : R;
        voffA[i] = (unsigned)(R * lda + C) * 2u; voffB[i] = (unsigned)(Rb * ldb + C) * 2u; }
    const size_t kstep = (size_t)(BK * 2);
    const size_t hstepA = (size_t)(32 * MF) * lda * 2, hstepB = (size_t)HALF * ldb * 2;
    const unsigned ldsw = (unsigned)wid * 1024u;
    const int aoff = lds_byte(wr * (16 * MF) + fr, fq * 8), boff = lds_byte(wc * 32 + fr, fq * 8);
#define PG8_SA(b, h) (((b) * 2 + (h)) * HTB)
#define PG8_SB(b, h) ((4 + (b) * 2 + (h)) * HTB)
#define PG8_STAGE(bufoff, gbase, voff) do { _Pragma("unroll") for (int _i = 0; _i < 2; ++_i) \
        __builtin_amdgcn_global_load_lds((const unsigned*)((const char*)(gbase) + (voff)[_i]), (PG8_LAS unsigned*)(lds + (bufoff) + ldsw + _i * 8192), 16, 0, 0); } while (0)
#define PG8_LDA(dst, b, h) do { _Pragma("unroll") for (int m = 0; m < MF; ++m) _Pragma("unroll") for (int k = 0; k < 2; ++k) dst[m][k] = *(const PG8_LAS bf16x8*)(lds + PG8_SA(b, h) + aoff + m * 2048 + k * 1024); } while (0)
#define PG8_LDB(dst, b, h) do { _Pragma("unroll") for (int n = 0; n < 2; ++n) _Pragma("unroll") for (int k = 0; k < 2; ++k) dst[n][k] = *(const PG8_LAS bf16x8*)(lds + PG8_SB(b, h) + boff + n * 2048 + k * 1024); } while (0)
#define PG8_MMA(ai, bj, At, Bt) do { __builtin_amdgcn_s_setprio(1); _Pragma("unroll") for (int m = 0; m < MF; ++m) _Pragma("unroll") for (int n = 0; n < 2; ++n) _Pragma("unroll") for (int k = 0; k < 2; ++k) \
        acc[ai][bj][m][n] = __builtin_amdgcn_mfma_f32_16x16x32_bf16(Bt[n][k], At[m][k], acc[ai][bj][m][n], 0, 0, 0); __builtin_amdgcn_s_setprio(0); } while (0)
#define PG8_WAIT_V(n) asm volatile("s_waitcnt vmcnt(" #n ")" ::: "memory")
#define PG8_WAIT_L(n) asm volatile("s_waitcnt lgkmcnt(" #n ")" ::: "memory")
#define PG8_BAR __builtin_amdgcn_s_barrier()
#define PG8_SCHED __builtin_amdgcn_sched_barrier(0)
#define PG8_TS_BEGIN(sel) do { if (PROBE_SEL == (sel) && wid == 0 && lane == 0) { volatile PG8_LAS unsigned long long* ta_ = (volatile PG8_LAS unsigned long long*)(lds + 131072 + 128); ta_[4] = __builtin_amdgcn_s_memrealtime(); } } while (0)
#define PG8_TS_END(sel) do { if (PROBE_SEL == (sel) && wid == 0 && lane == 0) { volatile PG8_LAS unsigned long long* ta_ = (volatile PG8_LAS unsigned long long*)(lds + 131072 + 128); ta_[2] = ta_[2] + (__builtin_amdgcn_s_memrealtime() - ta_[4]); } } while (0)
    Unit cur, nxt; int ui = 0;
    if (!S.next(0, cur)) return;
    f32x4 acc[2][2][MF][2];
#pragma unroll
    for (int a = 0; a < 2; ++a)
#pragma unroll
        for (int b = 0; b < 2; ++b)
#pragma unroll
            for (int m = 0; m < MF; ++m)
#pragma unroll
                for (int n = 0; n < 2; ++n) acc[a][b][m][n] = (f32x4){0.f, 0.f, 0.f, 0.f};
    bf16x8 At[MF][2], B0[2][2], B1[2][2];
    const char* cA = (const char*)cur.A; const char* cB = (const char*)cur.B;
    if constexpr (SP2) {
        PG8_STAGE(PG8_SB(0, 0), cB, voffB); PG8_STAGE(PG8_SB(0, 1), cB + hstepB, voffB); PG8_STAGE(PG8_SA(0, 0), cA, voffA); PG8_STAGE(PG8_SA(0, 1), cA + hstepA, voffA);
        if (wr == 1) PG8_BAR;
        PG8_WAIT_V(2); PG8_BAR;
        PG8_STAGE(PG8_SB(1, 0), cB + kstep, voffB); PG8_STAGE(PG8_SA(1, 0), cA + kstep, voffA); PG8_STAGE(PG8_SB(1, 1), cB + hstepB + kstep, voffB);
        PG8_WAIT_V(6); PG8_BAR;
    } else {
        PG8_STAGE(PG8_SB(0, 0), cB, voffB); PG8_STAGE(PG8_SA(0, 0), cA, voffA); PG8_STAGE(PG8_SB(0, 1), cB + hstepB, voffB); PG8_STAGE(PG8_SA(0, 1), cA + hstepA, voffA);
        if (wr == 1) PG8_BAR;
        PG8_WAIT_V(4); PG8_BAR;
        PG8_STAGE(PG8_SB(1, 0), cB + kstep, voffB); PG8_STAGE(PG8_SA(1, 0), cA + kstep, voffA); PG8_STAGE(PG8_SB(1, 1), cB + hstepB + kstep, voffB);
        PG8_WAIT_V(6); PG8_BAR;
    }
    for (;;) {
        const bool has_next = S.next(ui + 1, nxt);
        const char* nA = has_next ? (const char*)nxt.A : cA; const char* nB = has_next ? (const char*)nxt.B : cB;
        PG8_TS_BEGIN(3);
        for (int t = 0; t < nt; t += 2) {
            const bool last = (t == nt - 2);
            const char* a1 = cA + (size_t)(t + 1) * kstep;
            const char* a2 = last ? nA : cA + (size_t)(t + 2) * kstep; const char* b2 = last ? nB : cB + (size_t)(t + 2) * kstep;
            const char* a3 = a2 + kstep; const char* b3 = b2 + kstep;
            if constexpr (SP2) {
            PG8_LDB(B0, 0, 0); PG8_LDB(B1, 0, 1); PG8_SCHED; PG8_LDA(At, 0, 0); PG8_STAGE(PG8_SA(1, 1), a1 + hstepA, voffA);
            PG8_WAIT_V(8); PG8_WAIT_L(0); PG8_BAR; PG8_MMA(0, 0, At, B0); PG8_MMA(0, 1, At, B1); PG8_BAR; PG8_SCHED;
            PG8_LDA(At, 0, 1); PG8_STAGE(PG8_SB(0, 0), b2, voffB); PG8_STAGE(PG8_SB(0, 1), b2 + hstepB, voffB); PG8_STAGE(PG8_SA(0, 0), a2, voffA);
            PG8_WAIT_V(8); PG8_WAIT_L(0); PG8_BAR; PG8_MMA(1, 0, At, B0); PG8_MMA(1, 1, At, B1); PG8_BAR; PG8_SCHED;
            PG8_LDB(B0, 1, 0); PG8_LDB(B1, 1, 1); PG8_SCHED; PG8_LDA(At, 1, 0); PG8_STAGE(PG8_SA(0, 1), a2 + hstepA, voffA);
            PG8_WAIT_V(8); PG8_WAIT_L(0); PG8_BAR; PG8_MMA(0, 0, At, B0); PG8_MMA(0, 1, At, B1); PG8_BAR; PG8_SCHED;
            PG8_LDA(At, 1, 1); PG8_STAGE(PG8_SB(1, 0), b3, voffB); PG8_STAGE(PG8_SB(1, 1), b3 + hstepB, voffB); PG8_STAGE(PG8_SA(1, 0), a3, voffA);
            PG8_WAIT_V(8); PG8_WAIT_L(0); PG8_BAR; PG8_MMA(1, 0, At, B0); PG8_MMA(1, 1, At, B1); PG8_BAR; PG8_SCHED;
            } else {
            PG8_LDB(B0, 0, 0); PG8_SCHED; PG8_LDA(At, 0, 0); PG8_STAGE(PG8_SA(1, 1), a1 + hstepA, voffA);
            PG8_WAIT_L(8); PG8_BAR; PG8_WAIT_L(0); PG8_MMA(0, 0, At, B0); PG8_BAR; PG8_SCHED;
            PG8_LDB(B1, 0, 1); PG8_STAGE(PG8_SB(0, 0), b2, voffB);
            PG8_BAR; PG8_WAIT_L(0); PG8_MMA(0, 1, At, B1); PG8_BAR;
            PG8_LDA(At, 0, 1); PG8_STAGE(PG8_SA(0, 0), a2, voffA);
            PG8_BAR; PG8_WAIT_L(0); PG8_MMA(1, 0, At, B0); PG8_BAR; PG8_SCHED;
            PG8_STAGE(PG8_SB(0, 1), b2 + hstepB, voffB);
            PG8_WAIT_V(6); PG8_BAR; PG8_MMA(1, 1, At, B1); PG8_BAR;
            PG8_LDB(B0, 1, 0); PG8_SCHED; PG8_LDA(At, 1, 0); PG8_STAGE(PG8_SA(0, 1), a2 + hstepA, voffA);
            PG8_WAIT_L(8); PG8_BAR; PG8_WAIT_L(0); PG8_MMA(0, 0, At, B0); PG8_BAR; PG8_SCHED;
            PG8_LDB(B1, 1, 1); PG8_STAGE(PG8_SB(1, 0), b3, voffB);
            PG8_BAR; PG8_WAIT_L(0); PG8_MMA(0, 1, At, B1); PG8_BAR;
            PG8_LDA(At, 1, 1); PG8_STAGE(PG8_SA(1, 0), a3, voffA);
            PG8_BAR; PG8_WAIT_L(0); PG8_MMA(1, 0, At, B0); PG8_BAR; PG8_SCHED;
            PG8_STAGE(PG8_SB(1, 1), b3 + hstepB, voffB);
            PG8_WAIT_V(6); PG8_BAR; PG8_MMA(1, 1, At, B1); PG8_BAR;
            }
        }
        if constexpr (ALIGN_EPI) { if (wr == 0) PG8_BAR; }
        PG8_TS_END(3); PG8_TS_BEGIN(1);
        if constexpr (!Epi::AFTER_DRAIN) { E(acc, cur, wr, wc, fr, fq); }
        PG8_TS_END(1);
        if (!has_next) break;
#pragma unroll
        for (int a = 0; a < 2; ++a)
#pragma unroll
            for (int b = 0; b < 2; ++b)
#pragma unroll
                for (int m = 0; m < MF; ++m)
#pragma unroll
                    for (int n = 0; n < 2; ++n) acc[a][b][m][n] = (f32x4){0.f, 0.f, 0.f, 0.f};
        cur = nxt; cA = nA; cB = nB; ++ui;
        if constexpr (ALIGN_EPI) { if (wr == 1) PG8_BAR; }
    }
    PG8_WAIT_V(0);
    if constexpr (!ALIGN_EPI) { if (wr == 0) PG8_BAR; }
    PG8_BAR;
    if constexpr (Epi::AFTER_DRAIN) { E.fused(acc, cur, wr, wc, fr, fq, lds, wid, lane); }
#undef PG8_SA
#undef PG8_SB
#undef PG8_STAGE
#undef PG8_LDA
#undef PG8_LDB
#undef PG8_MMA
#undef PG8_WAIT_V
#undef PG8_WAIT_L
#undef PG8_BAR
#undef PG8_SCHED
#undef PG8_TS_BEGIN
#undef PG8_TS_END
}
struct SegUnit { const bf16_t* A; const bf16_t* B; int pm, pn, z, sh, nt, seg; };
template <int MF, class Epi, class Sched>
__device__ __forceinline__ void gemm_phase_seg(PG8_LAS unsigned char* lds, const int tid, const Sched& S, const Epi& E) {
    const int wid = __builtin_amdgcn_readfirstlane(tid >> 6), lane = tid & 63, wr = wid >> 2, wc = wid & 3, fr = lane & 15, fq = lane >> 4;
    unsigned Rv, Rbv, C2v;
    { int R, C; stage_rc(tid * 16, R, C); Rv = (unsigned)R; Rbv = (unsigned)(Epi::PERM ? ((R & ~31) + perm32(R & 31)) : R); C2v = (unsigned)C * 2u; }
    const size_t kstep = (size_t)(BK * 2);
    const unsigned ldsw = (unsigned)wid * 1024u;
    const int aoff = lds_byte(wr * (16 * MF) + fr, fq * 8), boff = lds_byte(wc * 32 + fr, fq * 8);
#define PG8_SA(b, h) (((b) * 2 + (h)) * HTB)
#define PG8_SB(b, h) ((4 + (b) * 2 + (h)) * HTB)
#define PG8_STAGE(bufoff, gbase, Rarr, sh_) do { const unsigned o_ = ((Rarr) << (sh_)) + C2v; _Pragma("unroll") for (int _i = 0; _i < 2; ++_i) \
        __builtin_amdgcn_global_load_lds((const unsigned*)((const char*)(gbase) + ((size_t)_i * ((size_t)64 << (sh_))) + o_), (PG8_LAS unsigned*)(lds + (bufoff) + ldsw + _i * 8192), 16, 0, 0); } while (0)
#define PG8_LDA(dst, b, h) do { _Pragma("unroll") for (int m = 0; m < MF; ++m) _Pragma("unroll") for (int k = 0; k < 2; ++k) dst[m][k] = *(const PG8_LAS bf16x8*)(lds + PG8_SA(b, h) + aoff + m * 2048 + k * 1024); } while (0)
#define PG8_LDB(dst, b, h) do { _Pragma("unroll") for (int n = 0; n < 2; ++n) _Pragma("unroll") for (int k = 0; k < 2; ++k) dst[n][k] = *(const PG8_LAS bf16x8*)(lds + PG8_SB(b, h) + boff + n * 2048 + k * 1024); } while (0)
#define PG8_MMA(ai, bj, At, Bt) do { __builtin_amdgcn_s_setprio(1); _Pragma("unroll") for (int m = 0; m < MF; ++m) _Pragma("unroll") for (int n = 0; n < 2; ++n) _Pragma("unroll") for (int k = 0; k < 2; ++k) \
        acc[ai][bj][m][n] = __builtin_amdgcn_mfma_f32_16x16x32_bf16(Bt[n][k], At[m][k], acc[ai][bj][m][n], 0, 0, 0); __builtin_amdgcn_s_setprio(0); } while (0)
#define PG8_WAIT_V(n) asm volatile("s_waitcnt vmcnt(" #n ")" ::: "memory")
#define PG8_WAIT_L(n) asm volatile("s_waitcnt lgkmcnt(" #n ")" ::: "memory")
#define PG8_BAR __builtin_amdgcn_s_barrier()
#define PG8_SCHED __builtin_amdgcn_sched_barrier(0)
    SegUnit cur, nxt; int ui = 0;
    if (!S.next(0, cur)) return;
    f32x4 acc[2][2][MF][2];
#pragma unroll
    for (int a = 0; a < 2; ++a)
#pragma unroll
        for (int b = 0; b < 2; ++b)
#pragma unroll
            for (int m = 0; m < MF; ++m)
#pragma unroll
                for (int n = 0; n < 2; ++n) acc[a][b][m][n] = (f32x4){0.f, 0.f, 0.f, 0.f};
    bf16x8 At[MF][2], B0[2][2], B1[2][2];
    const char* cA = (const char*)cur.A; const char* cB = (const char*)cur.B;
    { const int sh = cur.sh; const size_t hs = (size_t)128 << sh, hsa = (size_t)(32 * MF) << sh;
      PG8_STAGE(PG8_SB(0, 0), cB, Rbv, sh); PG8_STAGE(PG8_SB(0, 1), cB + hs, Rbv, sh); PG8_STAGE(PG8_SA(0, 0), cA, Rv, sh); PG8_STAGE(PG8_SA(0, 1), cA + hsa, Rv, sh);
      if (wr == 1) PG8_BAR;
      PG8_WAIT_V(2); PG8_BAR;
      PG8_STAGE(PG8_SB(1, 0), cB + kstep, Rbv, sh); PG8_STAGE(PG8_SA(1, 0), cA + kstep, Rv, sh); PG8_STAGE(PG8_SB(1, 1), cB + hs + kstep, Rbv, sh);
      PG8_WAIT_V(6); PG8_BAR; }
    for (;;) {
        const bool has_next = S.next(ui + 1, nxt);
        const char* nA = has_next ? (const char*)nxt.A : cA; const char* nB = has_next ? (const char*)nxt.B : cB;
        const int shc = cur.sh, shn = has_next ? nxt.sh : cur.sh, nt = cur.nt; const size_t hsca = (size_t)(32 * MF) << shc;
        for (int t = 0; t < nt; t += 2) {
            const bool last = (t == nt - 2);
            const char* a1 = cA + (size_t)(t + 1) * kstep;
            const char* a2 = last ? nA : cA + (size_t)(t + 2) * kstep; const char* b2 = last ? nB : cB + (size_t)(t + 2) * kstep;
            const char* a3 = a2 + kstep; const char* b3 = b2 + kstep;
            const int sh2 = last ? shn : shc; const size_t hs2 = (size_t)128 << sh2, hs2a = (size_t)(32 * MF) << sh2;
            PG8_LDB(B0, 0, 0); PG8_LDB(B1, 0, 1); PG8_SCHED; PG8_LDA(At, 0, 0); PG8_STAGE(PG8_SA(1, 1), a1 + hsca, Rv, shc);
            PG8_WAIT_V(8); PG8_WAIT_L(0); PG8_BAR; PG8_MMA(0, 0, At, B0); PG8_MMA(0, 1, At, B1); PG8_BAR; PG8_SCHED;
            PG8_LDA(At, 0, 1); PG8_STAGE(PG8_SB(0, 0), b2, Rbv, sh2); PG8_STAGE(PG8_SB(0, 1), b2 + hs2, Rbv, sh2); PG8_STAGE(PG8_SA(0, 0), a2, Rv, sh2);
            PG8_WAIT_V(8); PG8_WAIT_L(0); PG8_BAR; PG8_MMA(1, 0, At, B0); PG8_MMA(1, 1, At, B1); PG8_BAR; PG8_SCHED;
            PG8_LDB(B0, 1, 0); PG8_LDB(B1, 1, 1); PG8_SCHED; PG8_LDA(At, 1, 0); PG8_STAGE(PG8_SA(0, 1), a2 + hs2a, Rv, sh2);
            PG8_WAIT_V(8); PG8_WAIT_L(0); PG8_BAR; PG8_MMA(0, 0, At, B0); PG8_MMA(0, 1, At, B1); PG8_BAR; PG8_SCHED;
            PG8_LDA(At, 1, 1); PG8_STAGE(PG8_SB(1, 0), b3, Rbv, sh2); PG8_STAGE(PG8_SB(1, 1), b3 + hs2, Rbv, sh2); PG8_STAGE(PG8_SA(1, 0), a3, Rv, sh2);
            PG8_WAIT_V(8); PG8_WAIT_L(0); PG8_BAR; PG8_MMA(1, 0, At, B0); PG8_MMA(1, 1, At, B1); PG8_BAR; PG8_SCHED;
        }
        const bool fin = (cur.seg == 2);
        if (fin) { if (wr == 0) PG8_BAR; E(acc, cur, wr, wc, fr, fq); }
        else E.between(acc, cur, wr, wc, fr, fq);
        if (!has_next) break;
        if (fin) {
#pragma unroll
            for (int a = 0; a < 2; ++a)
#pragma unroll
                for (int b = 0; b < 2; ++b)
#pragma unroll
                    for (int m = 0; m < MF; ++m)
#pragma unroll
                        for (int n = 0; n < 2; ++n) acc[a][b][m][n] = (f32x4){0.f, 0.f, 0.f, 0.f};
        }
        cur = nxt; cA = nA; cB = nB; ++ui;
        if (fin) { if (wr == 1) PG8_BAR; }
    }
    PG8_WAIT_V(0);
    PG8_BAR;
#undef PG8_SA
#undef PG8_SB
#undef PG8_STAGE
#undef PG8_LDA
#undef PG8_LDB
#undef PG8_MMA
#undef PG8_WAIT_V
#undef PG8_WAIT_L
#undef PG8_BAR
#undef PG8_SCHED
}
}

#ifndef USE_PG8
#define USE_PG8 1
#endif
#if USE_PG8
__device__ __forceinline__ int fresh_tid(const Ctx& C) { unsigned z_ = 0u; asm volatile("" : "+s"(z_)); return C.wave * 64 + (int)__builtin_amdgcn_mbcnt_hi(~0u, __builtin_amdgcn_mbcnt_lo(~0u, z_)); }
#define GEMM(C, S, E, lda, ldb, K) pg8::gemm_phase(C.lds, fresh_tid(C), S, E, lda, ldb, K)
#else
#define GEMM(C, S, E, lda, ldb, K) GEMM(C, S, E, lda, ldb, K)
#endif

#define EPI_LOOP_AM for (int ai = 0; ai < 2; ++ai) _Pragma("unroll") for (int m = 0; m < 4; ++m)
struct EpiGU {
    static constexpr bool PERM = true, AFTER_DRAIN = false;
    bf16_t* H; const float* ssq; const float* swb;
    __device__ __forceinline__ void operator()(const f32x4 (&acc)[2][2][4][2], const Unit& u, int wr, int wc, int fr, int fq) const {
        const float* sw = swb + (size_t)cond_of_row(u.pm * 256) * 5632 + u.pn * 256 + wc * 32 + fq * 8;
        f32x4 sg[2], su[2]; float sq[2][4];
#pragma unroll
        for (int n = 0; n < 2; ++n) { sg[n] = *(const f32x4*)(sw + n * 4); su[n] = *(const f32x4*)(sw + 128 + n * 4); }
#pragma unroll
        EPI_LOOP_AM sq[ai][m] = ssq[u.pm * 256 + ai * 128 + wr * 64 + m * 16 + fr];
        __builtin_amdgcn_sched_barrier(0);
#pragma unroll
        EPI_LOOP_AM { const int row = u.pm * 256 + ai * 128 + wr * 64 + m * 16 + fr; const float rstd = __builtin_amdgcn_rsqf(sq[ai][m] * (1.0f / D) + EPS);
            u32x4 p;
            { const f32x4 g = acc[ai][0][m][0] * rstd + sg[0], up = acc[ai][1][m][0] * rstd + su[0]; p.x = cvt_pk_bf16(siluf_(g.x) * up.x, siluf_(g.y) * up.y); p.y = cvt_pk_bf16(siluf_(g.z) * up.z, siluf_(g.w) * up.w); }
            { const f32x4 g = acc[ai][0][m][1] * rstd + sg[1], up = acc[ai][1][m][1] * rstd + su[1]; p.z = cvt_pk_bf16(siluf_(g.x) * up.x, siluf_(g.y) * up.y); p.w = cvt_pk_bf16(siluf_(g.z) * up.z, siluf_(g.w) * up.w); }
            *(u32x4*)(H + (size_t)row * DFF + u.pn * 128 + wc * 32 + fq * 8) = p; }
    }
};
struct EpiRes {
    static constexpr bool PERM = true, AFTER_DRAIN = false;
    float* X; const float* Xin0; const float* Xin1; const float* modbase;
    bf16_t* XA; const float* nwn; float* ssqn;
    int l, sub, ln, subn; float coef;
    __device__ __forceinline__ void operator()(const f32x4 (&acc)[2][2][4][2], const Unit& u, int wr, int wc, int fr, int fq) const {
        const int c = cond_of_row(u.pm * 256), co = u.pn * 256 + wc * 32 + fq * 8;
        const float* gate = modbase + ((size_t)(l * 5 + c) * NMOD + (sub * 3 + 2) * D) + co;
        f32x4 g[2][2], wn[2][2];
#pragma unroll
        for (int bj = 0; bj < 2; ++bj)
#pragma unroll
            for (int n = 0; n < 2; ++n) { g[bj][n] = *(const f32x4*)(gate + bj * 128 + n * 4) * coef;
                if (ln >= 0) { const float* scn = modbase + ((size_t)(ln * 5 + c) * NMOD + (subn * 3 + 1) * D) + co + bj * 128 + n * 4; wn[bj][n] = *(const f32x4*)(nwn + co + bj * 128 + n * 4) * (*(const f32x4*)scn + 1.0f); }
                else wn[bj][n] = (f32x4){0.f, 0.f, 0.f, 0.f}; }
#pragma unroll
        EPI_LOOP_AM { const int row = u.pm * 256 + ai * 128 + wr * 64 + m * 16 + fr;
            float* xrow = X + (size_t)row * D + co; const float* irow = ((u.pm < 16) ? Xin0 + (size_t)row * D : Xin1 + (size_t)(row - MP) * D) + co;
            float ss = 0.f;
#pragma unroll
            for (int bj = 0; bj < 2; ++bj) {
                const f32x4 x0 = *(const f32x4*)(irow + bj * 128) + g[bj][0] * acc[ai][bj][m][0], x1 = *(const f32x4*)(irow + bj * 128 + 4) + g[bj][1] * acc[ai][bj][m][1];
                *(f32x4*)(xrow + bj * 128) = x0; *(f32x4*)(xrow + bj * 128 + 4) = x1;
                ss += ((x0.x * x0.x + x0.y * x0.y) + (x0.z * x0.z + x0.w * x0.w)) + ((x1.x * x1.x + x1.y * x1.y) + (x1.z * x1.z + x1.w * x1.w));
                if (ln >= 0) { const f32x4 y0 = x0 * wn[bj][0], y1 = x1 * wn[bj][1]; u32x4 p; p.x = cvt_pk_bf16(y0.x, y0.y); p.y = cvt_pk_bf16(y0.z, y0.w); p.z = cvt_pk_bf16(y1.x, y1.y); p.w = cvt_pk_bf16(y1.z, y1.w);
                    *(u32x4*)(XA + (size_t)row * D + co + bj * 128) = p; } }
            ss = sum_x32(sum_x16(ss));
            if (fq == 0) atomicAdd(ssqn + row, ss);
            asm volatile("" ::: "memory"); }
    }
};
struct Tile192Order {
    const bf16_t* A; const bf16_t* B; int lda, ldb, bid;
    __device__ bool next(int i, Unit& u) const { if (i) return false; u.pm = 8 * (bid >> 5) + (bid & 7); u.pn = (bid >> 3) & 3; u.z = 0; u.A = A + (size_t)u.pm * 192 * lda; u.B = B + (size_t)u.pn * 256 * ldb; return true; }
};
constexpr int CW_FIN = 3800;
struct EpiRes192 {
    static constexpr bool PERM = true, AFTER_DRAIN = false;
    float* X; const float* Xin0; const float* Xin1; const float* modbase;
    bf16_t* XA; const float* nwn; float* ssqn; unsigned* fcnt;
    int l, sub, ln, subn; float coef;
    __device__ __forceinline__ void operator()(f32x4 (&acc)[2][2][3][2], const Unit& u, int wr, int wc, int fr, int fq) const {
        asm volatile("" ::: "memory");
        const bool fin = ln < 0; const float selF = fin ? 0.0f : 1.0f;
        const int co = u.pn * 256 + wc * 32 + fq * 8, rg0 = u.pm * 192 + wr * 48;
        f32x4 xin[6][4], g[4], wn[4];
#define R192_LOADX(gi) do { const int row_ = rg0 + ((gi) / 3) * 96 + ((gi) % 3) * 16 + fr; const float* ir_ = ((row_ < MP) ? Xin0 + (size_t)row_ * D : Xin1 + (size_t)(row_ - MP) * D) + co; \
            xin[gi][0] = *(const f32x4*)ir_; xin[gi][1] = *(const f32x4*)(ir_ + 4); xin[gi][2] = *(const f32x4*)(ir_ + 128); xin[gi][3] = *(const f32x4*)(ir_ + 132); } while (0)
#define R192_LOADMOD(c_) do { const float* gate_ = modbase + ((size_t)(l * 5 + (c_)) * NMOD + (sub * 3 + 2) * D) + co; const float* scn_ = modbase + ((size_t)((ln < 0 ? 0 : ln) * 5 + (c_)) * NMOD + (subn * 3 + 1) * D) + co; \
            _Pragma("unroll") for (int q_ = 0; q_ < 4; ++q_) { const int o_ = (q_ >> 1) * 128 + (q_ & 1) * 4; g[q_] = *(const f32x4*)(gate_ + o_) * coef; \
                wn[q_] = *(const f32x4*)(nwn + co + o_) * (*(const f32x4*)(scn_ + o_) * selF + 1.0f); } } while (0)
        int ccur = cond_of_row(rg0);
        R192_LOADX(0); R192_LOADX(1); R192_LOADX(2);
        R192_LOADMOD(ccur);
#pragma unroll
        for (int gi = 0; gi < 6; ++gi) { const int ai = gi / 3, m = gi % 3, rg = rg0 + ai * 96 + m * 16, row = rg + fr, c = cond_of_row(rg);
            if (c != ccur) { ccur = c; R192_LOADMOD(c); }
            float* xrow = X + (size_t)row * D + co;
            float ss = 0.f;
#pragma unroll
            for (int bj = 0; bj < 2; ++bj) {
                const f32x4 x0 = xin[gi][2 * bj] + g[2 * bj] * acc[ai][bj][m][0], x1 = xin[gi][2 * bj + 1] + g[2 * bj + 1] * acc[ai][bj][m][1];
                ss += ((x0.x * x0.x + x0.y * x0.y) + (x0.z * x0.z + x0.w * x0.w)) + ((x1.x * x1.x + x1.y * x1.y) + (x1.z * x1.z + x1.w * x1.w));
                if (fin) { acc[ai][bj][m][0] = x0; acc[ai][bj][m][1] = x1; }
                else { *(f32x4*)(xrow + bj * 128) = x0; *(f32x4*)(xrow + bj * 128 + 4) = x1;
                    const f32x4 y0 = x0 * wn[2 * bj], y1 = x1 * wn[2 * bj + 1]; u32x4 p; p.x = cvt_pk_bf16(y0.x, y0.y); p.y = cvt_pk_bf16(y0.z, y0.w); p.z = cvt_pk_bf16(y1.x, y1.y); p.w = cvt_pk_bf16(y1.z, y1.w);
                    *(u32x4*)(XA + (size_t)row * D + co + bj * 128) = p; } }
            ss = sum_x32(sum_x16(ss));
            if (fq == 0) atomicAdd(ssqn + row, ss);
            if (gi + 3 < 6) R192_LOADX((gi + 3) % 6); }
#undef R192_LOADX
#undef R192_LOADMOD
        if (fin) {
            asm volatile("s_waitcnt vmcnt(0)" ::: "memory");
            __syncthreads();
            if (wr == 0 && wc == 0 && fr == 0 && fq == 0) {
                unsigned* cp = fcnt + u.pm;
                __hip_atomic_fetch_add(cp, 1u, __ATOMIC_RELEASE, __HIP_MEMORY_SCOPE_AGENT);
                unsigned spins = 0u;
                while (__hip_atomic_load(cp, __ATOMIC_RELAXED, __HIP_MEMORY_SCOPE_AGENT) < 4u) { __builtin_amdgcn_s_sleep(1); if (++spins > (1u << 24)) break; }
                __builtin_amdgcn_fence(__ATOMIC_ACQUIRE, "agent");
            }
            __syncthreads();
            float rs[6];
#pragma unroll
            for (int gi = 0; gi < 6; ++gi) rs[gi] = __hip_atomic_load(ssqn + rg0 + (gi / 3) * 96 + (gi % 3) * 16 + fr, __ATOMIC_RELAXED, __HIP_MEMORY_SCOPE_AGENT);
            __builtin_amdgcn_sched_barrier(0);
#pragma unroll
            for (int gi = 0; gi < 6; ++gi) { const int ai = gi / 3, m = gi % 3, row = rg0 + ai * 96 + m * 16 + fr; float* xrow = X + (size_t)row * D + co;
                const float rstd = __builtin_amdgcn_rsqf(rs[gi] * (1.0f / D) + EPS);
#pragma unroll
                for (int bj = 0; bj < 2; ++bj) { *(f32x4*)(xrow + bj * 128) = acc[ai][bj][m][0] * rstd * wn[2 * bj]; *(f32x4*)(xrow + bj * 128 + 4) = acc[ai][bj][m][1] * rstd * wn[2 * bj + 1]; } }
        }
    }
};
template <int MODE> struct EpiBranch192 {
    static constexpr bool PERM = true, AFTER_DRAIN = false;
    bf16_t* MG; const bf16_t* G; int br;
    __device__ __forceinline__ void operator()(const f32x4 (&acc)[2][2][3][2], const Unit& u, int wr, int wc, int fr, int fq) const {
        asm volatile("" ::: "memory");
#pragma unroll
        for (int ai = 0; ai < 2; ++ai)
#pragma unroll
            for (int m = 0; m < 3; ++m) { const int row = u.pm * 192 + ai * 96 + wr * 48 + m * 16 + fr;
#pragma unroll
                for (int bj = 0; bj < 2; ++bj) { const int col = u.pn * 256 + bj * 128 + wc * 32 + fq * 8;
                    const u32x4 g = *(const u32x4*)(G + (size_t)row * 3072 + br * 1024 + col); f32x4 v0 = acc[ai][bj][m][0], v1 = acc[ai][bj][m][1];
                    v0.x *= bflo(g.x); v0.y *= bfhi(g.x); v0.z *= bflo(g.y); v0.w *= bfhi(g.y); v1.x *= bflo(g.z); v1.y *= bfhi(g.z); v1.z *= bflo(g.w); v1.w *= bfhi(g.w);
                    u32x4* p = (u32x4*)(MG + (size_t)row * D + col);
                    if (MODE == 1) { const u32x4 o = *p; v0.x += bflo(o.x); v0.y += bfhi(o.x); v0.z += bflo(o.y); v0.w += bfhi(o.y); v1.x += bflo(o.z); v1.y += bfhi(o.z); v1.z += bflo(o.w); v1.w += bfhi(o.w); }
                    u32x4 w; w.x = cvt_pk_bf16(v0.x, v0.y); w.y = cvt_pk_bf16(v0.z, v0.w); w.z = cvt_pk_bf16(v1.x, v1.y); w.w = cvt_pk_bf16(v1.z, v1.w); *p = w; }
                asm volatile("" ::: "memory"); }
    }
};
#define GEMM192(C, S, E, lda, ldb, K) pg8::gemm_phase<decltype(E), decltype(S), true, true, 3>(C.lds, fresh_tid(C), S, E, lda, ldb, K)
struct EpiIn {
    static constexpr bool PERM = false, AFTER_DRAIN = false;
    bf16_t *Q, *Kb, *VT, *GY, *XFT, *G; float* XR; float* out; const float* bgate; const LAS float* rope; int l; const float* ssq; const float* swb;
    __device__ __forceinline__ void operator()(f32x4 (&acc)[2][2][4][2], const Unit& u, int wr, int wc, int fr, int fq) const {
        const int row0 = u.pm * 256 + wr * 64 + fr; const bool latent = u.pm >= 16;
        { const float* sw = swb + (size_t)cond_of_row(u.pm * 256) * 5632 + u.pn * 256 + wc * 32 + fq * 4;
          f32x4 sv[2][2];
#pragma unroll
          for (int bj = 0; bj < 2; ++bj)
#pragma unroll
              for (int n = 0; n < 2; ++n) sv[bj][n] = *(const f32x4*)(sw + bj * 128 + n * 16);
          float sq[2][4];
#pragma unroll
          EPI_LOOP_AM sq[ai][m] = ssq[row0 + ai * 128 + m * 16];
          __builtin_amdgcn_sched_barrier(0);
#pragma unroll
          EPI_LOOP_AM { const float rstd = __builtin_amdgcn_rsqf(sq[ai][m] * (1.0f / D) + EPS);
#pragma unroll
              for (int bj = 0; bj < 2; ++bj)
#pragma unroll
                  for (int n = 0; n < 2; ++n) acc[ai][bj][m][n] = acc[ai][bj][m][n] * rstd + sv[bj][n]; } }
        if (u.pn <= 2) {
#pragma unroll
            for (int bj = 0; bj < 2; ++bj) {
                if (u.pn == 2 && bj == 1) {
#pragma unroll
                    EPI_LOOP_AM { const int row = row0 + ai * 128 + m * 16; int seqoff, L, t;
                        if (latent) { const int b = (row - MP) >> 11; t = (row - MP) & 2047; L = LS; seqoff = 16 * 128 * LC + b * 128 * LS; } else { const int b = row >> 8; t = row & 255; L = LC; seqoff = b * 128 * LC; }
#pragma unroll
                        for (int n = 0; n < 2; ++n) { const f32x4 v = acc[ai][1][m][n]; const int d128 = wc * 32 + n * 16 + fq * 4;
                            bf16_t* p = VT + seqoff + (size_t)d128 * L + t; p[0] = f2bf(v.x); p[L] = f2bf(v.y); p[2 * L] = f2bf(v.z); p[3 * L] = f2bf(v.w);
                            if (!latent) *(f32x4*)(out + OUT_CV + ((size_t)((row >> 8) * 2 + l) * 256 + t) * 128 + d128) = v; } }
                } else {
                    const bool isk = (u.pn == 2); const int axis = wc & 1;
#pragma unroll
                    EPI_LOOP_AM { const int row = row0 + ai * 128 + m * 16; f32x4 x1 = acc[ai][bj][m][0], x2 = acc[ai][bj][m][1];
                        if (isk && !latent) { float* o = out + OUT_CK + ((size_t)((row >> 8) * 2 + l) * 256 + (row & 255)) * 128 + wc * 32 + fq * 4; *(f32x4*)o = x1; *(f32x4*)(o + 16) = x2; }
                        if (latent) { const int t = (row - MP) & 2047, pos = axis ? (t & 63) : (t >> 6);
                            const f32x4 cs = *(const LAS f32x4*)(rope + pos * 16 + fq * 4), sn = *(const LAS f32x4*)(rope + 1024 + pos * 16 + fq * 4);
                            const f32x4 o1 = x1 * cs - x2 * sn, o2 = x1 * sn + x2 * cs; x1 = o1; x2 = o2; }
                        if (!isk) { x1 = x1 * QSCALE; x2 = x2 * QSCALE; }
                        bf16_t* o = isk ? (Kb + (size_t)row * 128 + wc * 32 + fq * 4) : (Q + (size_t)row * 512 + u.pn * 256 + bj * 128 + wc * 32 + fq * 4);
                        u32x2 p; p.x = cvt_pk_bf16(x1.x, x1.y); p.y = cvt_pk_bf16(x1.z, x1.w); *(u32x2*)o = p;
                        p.x = cvt_pk_bf16(x2.x, x2.y); p.y = cvt_pk_bf16(x2.z, x2.w); *(u32x2*)(o + 16) = p; }
                }
            }
        } else if (u.pn <= 4) {
#pragma unroll
            EPI_LOOP_AM { const int row = row0 + ai * 128 + m * 16;
#pragma unroll
                for (int bj = 0; bj < 2; ++bj)
#pragma unroll
                    for (int n = 0; n < 2; ++n) *(f32x4*)(XR + (size_t)row * 512 + (u.pn - 3) * 256 + bj * 128 + wc * 32 + n * 16 + fq * 4) = acc[ai][bj][m][n]; }
        } else if (u.pn <= 6) {
#pragma unroll
            EPI_LOOP_AM { const int row = row0 + ai * 128 + m * 16;
#pragma unroll
                for (int bj = 0; bj < 2; ++bj)
#pragma unroll
                    for (int n = 0; n < 2; ++n) { const f32x4 v = acc[ai][bj][m][n]; u32x2 p; p.x = cvt_pk_bf16(gelu_tanh(v.x), gelu_tanh(v.y)); p.y = cvt_pk_bf16(gelu_tanh(v.z), gelu_tanh(v.w));
                        *(u32x2*)(GY + (size_t)row * 512 + (u.pn - 5) * 256 + bj * 128 + wc * 32 + n * 16 + fq * 4) = p; } }
        } else if (u.pn <= 8) {
#pragma unroll
            EPI_LOOP_AM { const int row = row0 + ai * 128 + m * 16; size_t seqoff; int L, t;
                if (latent) { const int b = (row - MP) >> 11; t = (row - MP) & 2047; L = LS; seqoff = (size_t)16 * 512 * LC + (size_t)b * 512 * LS; } else { const int b = row >> 8; t = row & 255; L = LC; seqoff = (size_t)b * 512 * LC; }
#pragma unroll
                for (int bj = 0; bj < 2; ++bj)
#pragma unroll
                    for (int n = 0; n < 2; ++n) { const f32x4 v = acc[ai][bj][m][n]; bf16_t* p = XFT + seqoff + (size_t)((u.pn - 7) * 256 + bj * 128 + wc * 32 + n * 16 + fq * 4) * L + t;
                        p[0] = f2bf(v.x); p[L] = f2bf(v.y); p[2 * L] = f2bf(v.z); p[3 * L] = f2bf(v.w); } }
        } else {
            f32x4 bb[2][2];
#pragma unroll
            for (int bj = 0; bj < 2; ++bj)
#pragma unroll
                for (int n = 0; n < 2; ++n) bb[bj][n] = *(const f32x4*)(bgate + (u.pn - 9) * 256 + bj * 128 + wc * 32 + n * 16 + fq * 4);
            __builtin_amdgcn_sched_barrier(0);
#pragma unroll
            for (int bj = 0; bj < 2; ++bj)
#pragma unroll
                for (int n = 0; n < 2; ++n) { const int col = (u.pn - 9) * 256 + bj * 128 + wc * 32 + n * 16 + fq * 4; const f32x4 b = bb[bj][n];
#pragma unroll
                    EPI_LOOP_AM { const int row = row0 + ai * 128 + m * 16; const f32x4 v = acc[ai][bj][m][n] + b;
                        u32x2 p; p.x = cvt_pk_bf16(sigmoidf_(v.x), sigmoidf_(v.y)); p.y = cvt_pk_bf16(sigmoidf_(v.z), sigmoidf_(v.w)); *(u32x2*)(G + (size_t)row * 3072 + col) = p; } }
        }
    }
};
template <int MODE> struct EpiBranch {
    static constexpr bool PERM = true, AFTER_DRAIN = false;
    bf16_t* MG; const bf16_t* G; int br;
    __device__ __forceinline__ void operator()(const f32x4 (&acc)[2][2][4][2], const Unit& u, int wr, int wc, int fr, int fq) const {
#pragma unroll
        EPI_LOOP_AM { const int row = u.pm * 256 + ai * 128 + wr * 64 + m * 16 + fr;
#pragma unroll
            for (int bj = 0; bj < 2; ++bj) { const int col = u.pn * 256 + bj * 128 + wc * 32 + fq * 8;
                const u32x4 g = *(const u32x4*)(G + (size_t)row * 3072 + br * 1024 + col); f32x4 v0 = acc[ai][bj][m][0], v1 = acc[ai][bj][m][1];
                v0.x *= bflo(g.x); v0.y *= bfhi(g.x); v0.z *= bflo(g.y); v0.w *= bfhi(g.y); v1.x *= bflo(g.z); v1.y *= bfhi(g.z); v1.z *= bflo(g.w); v1.w *= bfhi(g.w);
                u32x4* p = (u32x4*)(MG + (size_t)row * D + col);
                if (MODE == 1) { const u32x4 o = *p; v0.x += bflo(o.x); v0.y += bfhi(o.x); v0.z += bflo(o.y); v0.w += bfhi(o.y); v1.x += bflo(o.z); v1.y += bfhi(o.z); v1.z += bflo(o.w); v1.w += bfhi(o.w); }
                u32x4 w; w.x = cvt_pk_bf16(v0.x, v0.y); w.y = cvt_pk_bf16(v0.z, v0.w); w.z = cvt_pk_bf16(v1.x, v1.y); w.w = cvt_pk_bf16(v1.z, v1.w); *p = w; }
            asm volatile("" ::: "memory"); }
    }
};
struct EpiBranchSeg192 {
    static constexpr bool PERM = true, AFTER_DRAIN = false;
    bf16_t* MG; const bf16_t* G;
    __device__ __forceinline__ void bases(const pg8::SegUnit& u, int wr, int wc, int fr, int fq, unsigned& og, unsigned& om) const {
        const unsigned row = (unsigned)(u.pm * 192 + wr * 48 + fr), col = (unsigned)(u.pn * 256 + wc * 32 + fq * 8);
        og = row * 3072u + col; om = row * (unsigned)D + col; asm volatile("" : "+v"(og), "+v"(om));
    }
    __device__ __forceinline__ void between(f32x4 (&acc)[2][2][3][2], const pg8::SegUnit& u, int wr, int wc, int fr, int fq) const {
        asm volatile("" ::: "memory");
        unsigned og, om; bases(u, wr, wc, fr, fq, og, om);
        const bf16_t* gp = G + og + u.seg * 1024;
#pragma unroll
        for (int ai = 0; ai < 2; ++ai) {
            u32x4 gnv[3][2], gdv[3][2];
#pragma unroll
            for (int m = 0; m < 3; ++m)
#pragma unroll
                for (int bj = 0; bj < 2; ++bj) { const bf16_t* p = gp + (size_t)(ai * 96 + m * 16) * 3072 + bj * 128; gnv[m][bj] = *(const u32x4*)p; gdv[m][bj] = *(const u32x4*)(p + 1024); }
            __builtin_amdgcn_sched_barrier(0);
#pragma unroll
            for (int m = 0; m < 3; ++m) {
#pragma unroll
                for (int bj = 0; bj < 2; ++bj) { const u32x4 gn = gnv[m][bj], gd = gdv[m][bj];
                    f32x4 r0, r1;
                    r0.x = bflo(gn.x) * fast_rcp(fmaxf(bflo(gd.x), 1e-30f)); r0.y = bfhi(gn.x) * fast_rcp(fmaxf(bfhi(gd.x), 1e-30f)); r0.z = bflo(gn.y) * fast_rcp(fmaxf(bflo(gd.y), 1e-30f)); r0.w = bfhi(gn.y) * fast_rcp(fmaxf(bfhi(gd.y), 1e-30f));
                    r1.x = bflo(gn.z) * fast_rcp(fmaxf(bflo(gd.z), 1e-30f)); r1.y = bfhi(gn.z) * fast_rcp(fmaxf(bfhi(gd.z), 1e-30f)); r1.z = bflo(gn.w) * fast_rcp(fmaxf(bflo(gd.w), 1e-30f)); r1.w = bfhi(gn.w) * fast_rcp(fmaxf(bfhi(gd.w), 1e-30f));
                    acc[ai][bj][m][0] = acc[ai][bj][m][0] * r0; acc[ai][bj][m][1] = acc[ai][bj][m][1] * r1; } }
            asm volatile("" ::: "memory"); }
    }
    __device__ __forceinline__ void operator()(const f32x4 (&acc)[2][2][3][2], const pg8::SegUnit& u, int wr, int wc, int fr, int fq) const {
        asm volatile("" ::: "memory");
        unsigned og, om; bases(u, wr, wc, fr, fq, og, om);
        const bf16_t* gp = G + og + 2048; bf16_t* mp = MG + om;
        u32x4 gv[2][3][2];
#pragma unroll
        for (int ai = 0; ai < 2; ++ai)
#pragma unroll
            for (int m = 0; m < 3; ++m)
#pragma unroll
                for (int bj = 0; bj < 2; ++bj) gv[ai][m][bj] = *(const u32x4*)(gp + (size_t)(ai * 96 + m * 16) * 3072 + bj * 128);
        __builtin_amdgcn_sched_barrier(0);
#pragma unroll
        for (int ai = 0; ai < 2; ++ai)
#pragma unroll
            for (int m = 0; m < 3; ++m) {
#pragma unroll
                for (int bj = 0; bj < 2; ++bj) {
                    const u32x4 g = gv[ai][m][bj]; f32x4 v0 = acc[ai][bj][m][0], v1 = acc[ai][bj][m][1];
                    v0.x *= bflo(g.x); v0.y *= bfhi(g.x); v0.z *= bflo(g.y); v0.w *= bfhi(g.y); v1.x *= bflo(g.z); v1.y *= bfhi(g.z); v1.z *= bflo(g.w); v1.w *= bfhi(g.w);
                    u32x4 w; w.x = cvt_pk_bf16(v0.x, v0.y); w.y = cvt_pk_bf16(v0.z, v0.w); w.z = cvt_pk_bf16(v1.x, v1.y); w.w = cvt_pk_bf16(v1.z, v1.w); *(u32x4*)(mp + (size_t)(ai * 96 + m * 16) * D + bj * 128) = w; }
                asm volatile("" ::: "memory"); }
    }
};
struct BranchOrder192 {
    const bf16_t *A0, *A1, *A2, *B0, *B1, *B2; int bid, G;
    __device__ bool next(int i, pg8::SegUnit& u) const {
        const int L = (i / 3) * G + bid; if (L >= 256) return false;
        const int sg = i % 3; u.pm = 8 * (L >> 5) + (L & 7); u.pn = (L >> 3) & 3; u.z = 0; u.seg = sg;
        if (sg == 0) { u.A = A0 + (size_t)u.pm * 192 * 512; u.B = B0 + (size_t)u.pn * 256 * 512; u.sh = 10; u.nt = 8; }
        else if (sg == 1) { u.A = A1 + (size_t)u.pm * 192 * D; u.B = B1 + (size_t)u.pn * 256 * D; u.sh = 11; u.nt = 16; }
        else { u.A = A2 + (size_t)u.pm * 192 * D; u.B = B2 + (size_t)u.pn * 256 * D; u.sh = 11; u.nt = 16; }
        return true;
    }
};
struct EpiDft {
    static constexpr bool PERM = true, AFTER_DRAIN = false;
    bf16_t* Z; int L, rowbase;
    __device__ __forceinline__ void operator()(const f32x4 (&acc)[2][2][4][2], const Unit& u, int wr, int wc, int fr, int fq) const {
        const int hl = L >> 1;
#pragma unroll
        EPI_LOOP_AM { const int rr = u.pm * 256 + ai * 128 + wr * 64 + m * 16 + fr; const bool sn = rr >= hl; const int p = sn ? rr - hl : rr;
            bf16_t* z0 = Z + (size_t)rowbase * D + u.pn * 256 + wc * 32 + fq * 8;
#pragma unroll
            for (int bj = 0; bj < 2; ++bj) { const f32x4 v0 = acc[ai][bj][m][0], v1 = acc[ai][bj][m][1]; u32x4 w; w.x = cvt_pk_bf16(v0.x, v0.y); w.y = cvt_pk_bf16(v0.z, v0.w); w.z = cvt_pk_bf16(v1.x, v1.y); w.w = cvt_pk_bf16(v1.z, v1.w); const int co = bj * 128;
                if (!sn) { *(u32x4*)(z0 + (size_t)p * D + co) = w; if (p) *(u32x4*)(z0 + (size_t)(L - p) * D + co) = w; }
                else if (p == 0) { *(u32x4*)(z0 + (size_t)hl * D + co) = w; const u32x4 zz = {0u, 0u, 0u, 0u}; *(u32x4*)(z0 + 512 + co) = zz; *(u32x4*)(z0 + (size_t)hl * D + 512 + co) = zz; }
                else { *(u32x4*)(z0 + (size_t)p * D + 512 + co) = w; u32x4 nw; nw.x = w.x ^ 0x80008000u; nw.y = w.y ^ 0x80008000u; nw.z = w.z ^ 0x80008000u; nw.w = w.w ^ 0x80008000u; *(u32x4*)(z0 + (size_t)(L - p) * D + 512 + co) = nw; } } }
    }
};

typedef short s16x4 __attribute__((ext_vector_type(4)));
#define MFMA32(a, b, c) __builtin_amdgcn_mfma_f32_32x32x16_bf16((a), (b), (c), 0, 0, 0)
constexpr int AT_KSTR = 144, AT_VSTR = 264, AT_KBYTES = 128 * AT_KSTR, AT_VBYTES = 64 * AT_VSTR, AT_BUF = AT_KBYTES + AT_VBYTES;
struct AttnSrc { const bf16_t* kp; const bf16_t* vp; int vstride; int kbase; };
__device__ __forceinline__ AttnSrc attn_src(int t, bool latent, int nband, int lo, int b, int l, int kvh, const bf16_t* Kb, const bf16_t* VT, const bf16_t* CK, const bf16_t* CVT) {
    AttnSrc s;
    if (!latent) { s.kp = Kb + (size_t)(b * LC + 128 * t) * 128 + kvh * 64; s.vp = VT + (size_t)b * 128 * LC + (size_t)(kvh * 64) * LC + 128 * t; s.vstride = LC; s.kbase = 0; }
    else if (t < nband) { const int kb = lo + 128 * t; s.kp = Kb + (size_t)(MP + b * LS + kb) * 128 + kvh * 64; s.vp = VT + (size_t)16 * 128 * LC + (size_t)b * 128 * LS + (size_t)(kvh * 64) * LS + kb; s.vstride = LS; s.kbase = kb; }
    else { const int c = t - nband; s.kp = CK + (size_t)((b * 2 + l) * 256 + 128 * c) * 128 + kvh * 64; s.vp = CVT + (size_t)((b * 2 + l) * 2 + kvh) * 64 * 256 + 128 * c; s.vstride = 256; s.kbase = 0; }
    return s;
}
__device__ __forceinline__ void attn_tile(const LAS unsigned char* kbp, const LAS unsigned char* vbp, const bf16x8 (&qf)[4], f32x16& O0, f32x16& O1, float& mrun, float& lsum, bool domask, int dk0, int q32, int half) {
    f32x16 S0, S1;
#pragma unroll
    for (int r = 0; r < 16; ++r) { S0[r] = 0.f; S1[r] = 0.f; }
    bf16x8 kf[4][2];
#pragma unroll
    for (int ks = 0; ks < 4; ++ks) { kf[ks][0] = *(const LAS bf16x8*)(kbp + q32 * AT_KSTR + ks * 32 + half * 16); kf[ks][1] = *(const LAS bf16x8*)(kbp + (32 + q32) * AT_KSTR + ks * 32 + half * 16); }
#pragma unroll
    for (int ks = 0; ks < 4; ++ks) { S0 = MFMA32(kf[ks][0], qf[ks], S0); S1 = MFMA32(kf[ks][1], qf[ks], S1); }
    s16x4 vr[4][4];
#pragma unroll
    for (int s4 = 0; s4 < 4; ++s4) { const LAS unsigned char* v0p = vbp + q32 * AT_VSTR + s4 * 32 + half * 8; const LAS unsigned char* v1p = v0p + 32 * AT_VSTR;
        vr[s4][0] = *(const LAS s16x4*)v0p; vr[s4][1] = *(const LAS s16x4*)(v0p + 16); vr[s4][2] = *(const LAS s16x4*)v1p; vr[s4][3] = *(const LAS s16x4*)(v1p + 16); }
    if (domask) {
#pragma unroll
        for (int r = 0; r < 16; ++r) { const int d0 = dk0 + (r & 3) + 8 * (r >> 2) + 4 * half, d1 = d0 + 32;
            S0[r] = (d0 > 128 || d0 < -128) ? -1e30f : S0[r]; S1[r] = (d1 > 128 || d1 < -128) ? -1e30f : S1[r]; } }
    float mx = fmaxf(S0[0], S1[0]);
#pragma unroll
    for (int r = 1; r < 16; ++r) mx = fmaxf(mx, fmaxf(S0[r], S1[r]));
    mx = fmaxf(mx, __shfl_xor(mx, 32));
    const float mnew = fmaxf(mrun, mx), alpha = __builtin_amdgcn_exp2f(mrun - mnew); mrun = mnew;
    float ps = 0.f;
#pragma unroll
    for (int r = 0; r < 16; ++r) { S0[r] = __builtin_amdgcn_exp2f(S0[r] - mnew); S1[r] = __builtin_amdgcn_exp2f(S1[r] - mnew); ps += S0[r] + S1[r]; }
    lsum = lsum * alpha + ps;
#pragma unroll
    for (int r = 0; r < 16; ++r) { O0[r] *= alpha; O1[r] *= alpha; }
    bf16x8 pf[4];
#pragma unroll
    for (int s2 = 0; s2 < 2; ++s2) { u32x4 a, c2;
        a.x = cvt_pk_bf16(S0[8 * s2 + 0], S0[8 * s2 + 1]); a.y = cvt_pk_bf16(S0[8 * s2 + 2], S0[8 * s2 + 3]); a.z = cvt_pk_bf16(S0[8 * s2 + 4], S0[8 * s2 + 5]); a.w = cvt_pk_bf16(S0[8 * s2 + 6], S0[8 * s2 + 7]);
        c2.x = cvt_pk_bf16(S1[8 * s2 + 0], S1[8 * s2 + 1]); c2.y = cvt_pk_bf16(S1[8 * s2 + 2], S1[8 * s2 + 3]); c2.z = cvt_pk_bf16(S1[8 * s2 + 4], S1[8 * s2 + 5]); c2.w = cvt_pk_bf16(S1[8 * s2 + 6], S1[8 * s2 + 7]);
        pf[s2] = __builtin_bit_cast(bf16x8, a); pf[2 + s2] = __builtin_bit_cast(bf16x8, c2); }
#pragma unroll
    for (int s4 = 0; s4 < 4; ++s4) {
        const bf16x8 vf0 = __builtin_shufflevector(vr[s4][0], vr[s4][1], 0, 1, 2, 3, 4, 5, 6, 7), vf1 = __builtin_shufflevector(vr[s4][2], vr[s4][3], 0, 1, 2, 3, 4, 5, 6, 7);
        O0 = MFMA32(vf0, pf[s4], O0); O1 = MFMA32(vf1, pf[s4], O1); }
}
__device__ __forceinline__ void attn_unit(ArgsP args, const Ctx& C, int l, int ui) {
    bf16_t* Q = (bf16_t*)act_ptr(C, A_Q); const bf16_t* Kb = (const bf16_t*)act_ptr(C, A_K); const bf16_t* VT = (const bf16_t*)act_ptr(C, A_VT);
    const bf16_t* CK = (const bf16_t*)(C.ws + OFF_CK); const bf16_t* CVT = (const bf16_t*)(C.ws + OFF_CVT);
    const int q32 = C.lane & 31, half = C.lane >> 5, w = C.wave;
    const int srow = C.tid >> 3, schunk = C.tid & 7;
    {
        const bool latent = ui < 256;
        int b, h, qb; if (latent) { b = ui >> 6; h = (ui >> 3) & 7; qb = ui & 7; } else { const int r = ui - 256; b = r >> 3; h = r & 7; qb = 0; }
        const int kvh = h >> 2, rowbase = latent ? (MP + b * LS + qb * 256) : b * LC;
        int lo = 0, nband = 2, nt = 2;
        if (latent) { lo = 256 * qb - 128; if (lo < 0) lo = 0; int hi = 256 * qb + 384; if (hi > LS) hi = LS; nband = (hi - lo) >> 7; nt = nband + 2; }
        const int qw_lo = qb * 256 + 32 * w, qpos = qw_lo + q32;
        bf16x8 qf[4];
        { const bf16_t* qp = Q + (size_t)(rowbase + 32 * w + q32) * 512 + h * 64 + 8 * half;
#pragma unroll
          for (int ks = 0; ks < 4; ++ks) qf[ks] = *(const bf16x8*)(qp + 16 * ks); }
        f32x16 O0, O1;
#pragma unroll
        for (int r = 0; r < 16; ++r) { O0[r] = 0.f; O1[r] = 0.f; }
        float mrun = args->in[20][l * 8 + h] * LOG2E, lsum = half ? 0.f : 1.0f;
        u32x4 kA0, kA1, vA0, vA1, kB0, kB1, vB0, vB1;
#define ATT_LOAD(k0, k1, v0, v1, tt) do { const AttnSrc s_ = attn_src((tt), latent, nband, lo, b, l, kvh, Kb, VT, CK, CVT); \
            k0 = *(const u32x4*)(s_.kp + (size_t)srow * 128 + schunk * 8); k1 = *(const u32x4*)(s_.kp + (size_t)(64 + srow) * 128 + schunk * 8); \
            v0 = *(const u32x4*)(s_.vp + (size_t)srow * s_.vstride + schunk * 8); v1 = *(const u32x4*)(s_.vp + (size_t)srow * s_.vstride + 64 + schunk * 8); } while (0)
#define ATT_WRITE(k0, k1, v0, v1, bufi) do { LAS unsigned char* kb_ = C.lds + (bufi) * AT_BUF; *(LAS u32x4*)(kb_ + srow * AT_KSTR + schunk * 16) = k0; *(LAS u32x4*)(kb_ + (64 + srow) * AT_KSTR + schunk * 16) = k1; \
            LAS u32x2* vd_ = (LAS u32x2*)(kb_ + AT_KBYTES + srow * AT_VSTR + schunk * 16); vd_[0] = (u32x2){v0.x, v0.y}; vd_[1] = (u32x2){v0.z, v0.w}; vd_[16] = (u32x2){v1.x, v1.y}; vd_[17] = (u32x2){v1.z, v1.w}; } while (0)
        ATT_LOAD(kA0, kA1, vA0, vA1, 0); ATT_WRITE(kA0, kA1, vA0, vA1, 0); if (nt > 1) ATT_LOAD(kA0, kA1, vA0, vA1, 1);
        __syncthreads();
#define ATT_STEP(t, kc0, kc1, vc0, vc1, kn0, kn1, vn0, vn1) do { const int buf = (t) & 1; \
            if ((t) + 2 < nt) ATT_LOAD(kn0, kn1, vn0, vn1, (t) + 2); \
            _Pragma("unroll") for (int sub_ = 0; sub_ < 2; ++sub_) { \
                bool skip = false, domask = false; const int kb = lo + 128 * (t) + 64 * sub_; \
                if (latent && (t) < nband) { skip = (kb > qw_lo + 31 + 128) || (kb + 63 < qw_lo - 128); domask = !((kb + 63 - qw_lo <= 128) && (qw_lo + 31 - kb <= 128)); } \
                if (!skip) attn_tile(C.lds + buf * AT_BUF + sub_ * 64 * AT_KSTR, C.lds + buf * AT_BUF + AT_KBYTES + sub_ * 128, qf, O0, O1, mrun, lsum, domask, kb - qpos, q32, half); } \
            if ((t) + 1 < nt) ATT_WRITE(kc0, kc1, vc0, vc1, buf ^ 1); \
            __syncthreads(); } while (0)
        for (int t = 0; t < nt; t += 2) { ATT_STEP(t, kA0, kA1, vA0, vA1, kB0, kB1, vB0, vB1); if (t + 1 < nt) ATT_STEP(t + 1, kB0, kB1, vB0, vB1, kA0, kA1, vA0, vA1); }
#undef ATT_STEP
#undef ATT_LOAD
#undef ATT_WRITE
        const float inv = fast_rcp(lsum + __shfl_xor(lsum, 32));
        bf16_t* op = Q + (size_t)(rowbase + 32 * w + q32) * 512 + h * 64 + 4 * half;
#pragma unroll
        for (int g = 0; g < 4; ++g) { u32x2 o; o.x = cvt_pk_bf16(O0[4 * g] * inv, O0[4 * g + 1] * inv); o.y = cvt_pk_bf16(O0[4 * g + 2] * inv, O0[4 * g + 3] * inv); *(u32x2*)(op + 8 * g) = o;
            o.x = cvt_pk_bf16(O1[4 * g] * inv, O1[4 * g + 1] * inv); o.y = cvt_pk_bf16(O1[4 * g + 2] * inv, O1[4 * g + 3] * inv); *(u32x2*)(op + 32 + 8 * g) = o; }
    }
}

constexpr int LRW_BYTES = 11008, LR_PH = 8 * LRW_BYTES, LR_CAR = LR_PH + 8192, LR_CONST = LR_CAR + 512, LR_END = LR_CONST + 768;
static_assert(LR_END <= 131072, "lru LDS map");
__device__ __forceinline__ void lru_load_rows(float (&xr)[19], const float* XRc, int trow0, int L) {
#pragma unroll
    for (int r = 0; r < 19; ++r) { const int t = trow0 + r; const bool ok = (t >= 0) && (t < L); xr[r] = XRc[(size_t)(ok ? t : 0) * 512]; }
    asm volatile("" ::: "memory");
#pragma unroll
    for (int r = 0; r < 19; ++r) { const int t = trow0 + r; xr[r] *= ((t >= 0) && (t < L)) ? 1.0f : 0.0f; }
}
__device__ __forceinline__ void lru_item(ArgsP args, const Ctx& C, int l, int it) {
    const float* XR = (const float*)act_ptr(C, A_XR); const bf16_t* GY = (const bf16_t*)act_ptr(C, A_GY); bf16_t* REC = (bf16_t*)act_ptr(C, A_XN);
    const int w = C.wave, ch = C.lane, fr = C.lane & 15, fq = C.lane >> 4;
    LAS float* XF = (LAS float*)(C.lds + w * LRW_BYTES); LAS float* AA = XF + 16 * 68; LAS bf16_t* XCB = (LAS bf16_t*)(AA + 16 * 68);
    LAS float* PH = (LAS float*)(C.lds + LR_PH); LAS float* CAR = (LAS float*)(C.lds + LR_CAR); LAS float* CST = (LAS float*)(C.lds + LR_CONST);
    const int dir = it & 1, nb = (it >> 1) & 7, sq = it >> 4;
    const bool latent = sq < 4; const int b = latent ? sq : sq - 4, L = latent ? LS : LC, rowbase = latent ? MP + b * LS : b * LC;
    const int cgl = nb * 64 + ch, g = (l * 2 + dir) * 8 + nb;
    __syncthreads();
    if (C.tid < 64) { const int cg = (l * 2 + dir) * 512 + nb * 64 + C.tid; CST[C.tid] = args->in[25][cg]; CST[64 + C.tid] = args->in[27][cg]; CST[128 + C.tid] = (-8.0f * 0.6931471805599453f) * __builtin_amdgcn_logf(1.0f + __builtin_amdgcn_exp2f(-LOG2E * args->in[28][cg]));
        CAR[C.tid] = latent ? args->in[5][((size_t)(b * 2 + l) * 2 + dir) * 512 + nb * 64 + C.tid] : 0.f; }
    bf16x8 wf[8][2];
    { const bf16_t* lw = (const bf16_t*)(C.ws + OFF_LWT) + (size_t)g * 128 * 64 + fr * 64 + 8 * fq;
#pragma unroll
      for (int nt = 0; nt < 8; ++nt)
#pragma unroll
          for (int kk = 0; kk < 2; ++kk) wf[nt][kk] = *(const bf16x8*)(lw + nt * 16 * 64 + 32 * kk); }
    const float cw0 = args->in[22][(l * 4 + 0) * 512 + cgl], cw1 = args->in[22][(l * 4 + 1) * 512 + cgl], cw2 = args->in[22][(l * 4 + 2) * 512 + cgl], cw3 = args->in[22][(l * 4 + 3) * 512 + cgl], cb = args->in[23][l * 512 + cgl];
    const float* XRc = XR + (size_t)rowbase * 512 + cgl;
    const int nch = L >> 7, e0 = dir ? 16 * (7 - w) : 16 * w;
    float xr[19];
    lru_load_rows(xr, XRc, (dir ? (L - 128) : 0) + e0 - 2, L);
    __syncthreads();
    float hfin = 0.f;
    for (int c = 0; c < nch; ++c) {
        const int t0 = dir ? (L - 128 * (c + 1)) : 128 * c, par = c & 1;
#pragma unroll
        for (int e = 0; e < 16; ++e) { const float xc = cb + cw0 * xr[e] + cw1 * xr[e + 1] + cw2 * xr[e + 2] + cw3 * xr[e + 3]; XF[e * 68 + ch] = xc; XCB[e * 72 + ch] = f2bf(xc); }
        asm volatile("" ::: "memory");
        float gy[16];
        { const bf16_t* gp = GY + (size_t)(rowbase + t0 + e0) * 512 + cgl;
#pragma unroll
          for (int j = 0; j < 16; ++j) gy[j] = bf2f(gp[(size_t)(dir ? 15 - j : j) * 512]); }
        if (c + 1 < nch) lru_load_rows(xr, XRc, (dir ? (L - 128 * (c + 2)) : 128 * (c + 1)) + e0 - 2, L);
        f32x4 acc[8];
#pragma unroll
        for (int nt = 0; nt < 8; ++nt) acc[nt] = (f32x4){0.f, 0.f, 0.f, 0.f};
#pragma unroll
        for (int kk = 0; kk < 2; ++kk) { const bf16x8 xf = *(const LAS bf16x8*)(XCB + fr * 72 + 8 * fq + 32 * kk);
#pragma unroll
            for (int nt = 0; nt < 8; ++nt) acc[nt] = __builtin_amdgcn_mfma_f32_16x16x32_bf16(wf[nt][kk], xf, acc[nt], 0, 0, 0); }
#pragma unroll
        for (int nt = 0; nt < 4; ++nt) { const int c0 = 16 * nt + 4 * fq; const f32x4 ba = *(const LAS f32x4*)(CST + c0), bi = *(const LAS f32x4*)(CST + 64 + c0), sp = *(const LAS f32x4*)(CST + 128 + c0);
            const f32x4 xcv = *(const LAS f32x4*)(XF + fr * 68 + c0); f32x4 av, bv;
#pragma unroll
            for (int i = 0; i < 4; ++i) { const float r = sigmoidf_(acc[nt][i] + ba[i]), ig = sigmoidf_(acc[nt + 4][i] + bi[i]); const float la = r * sp[i], a = __builtin_amdgcn_exp2f(LOG2E * la);
                const float om = 1.0f - a * a;
                av[i] = a; bv[i] = __builtin_amdgcn_sqrtf(fmaxf(om, 0.f)) * (ig * xcv[i]); }
            *(LAS f32x4*)(AA + fr * 68 + c0) = av; *(LAS f32x4*)(XF + fr * 68 + c0) = bv; }
        asm volatile("" ::: "memory");
        { float P = 1.f, H = 0.f;
#pragma unroll
          for (int j = 0; j < 16; ++j) { const int e = dir ? 15 - j : j; const float a = AA[e * 68 + ch], bb = XF[e * 68 + ch]; H = a * H + bb; P *= a; }
          PH[(par * 2 + 0) * 512 + w * 64 + ch] = P; PH[(par * 2 + 1) * 512 + w * 64 + ch] = H; }
        __syncthreads();
        float h = CAR[par * 64 + ch];
        for (int s2 = 0; s2 < w; ++s2) h = PH[(par * 2 + 0) * 512 + s2 * 64 + ch] * h + PH[(par * 2 + 1) * 512 + s2 * 64 + ch];
        { bf16_t* rp = REC + (size_t)(rowbase + t0 + e0) * D + dir * 512 + cgl;
#pragma unroll
          for (int j = 0; j < 16; ++j) { const int e = dir ? 15 - j : j; h = AA[e * 68 + ch] * h + XF[e * 68 + ch]; rp[(size_t)e * D] = f2bf(h * gy[j]); } }
        asm volatile("" ::: "memory");
        if (w == 7) { CAR[(par ^ 1) * 64 + ch] = h; hfin = h; }
    }
    if (!latent && w == 7) C.out[OUT_ST + ((size_t)(b * 2 + l) * 2 + dir) * 512 + cgl] = hfin;
}

#define XB_TMO      128
#define XB_XCNT(j)  (256  + 64 * (j))
#define XB_XSUB(j)  (1280 + 64 * (j))
#define XB_XGEN(j)  (2304 + 64 * (j))
#define XB_TOP      3328
#define XB_TOPGEN   3392
#define XCD_BAR_WORDS 3456
#define XB_SPIN_CAP (1u << 18)

__device__ __forceinline__ unsigned xb_ld(unsigned* p)              { return __hip_atomic_load(p, __ATOMIC_RELAXED, __HIP_MEMORY_SCOPE_AGENT); }
__device__ __forceinline__ unsigned xb_add(unsigned* p, unsigned v) { return __hip_atomic_fetch_add(p, v, __ATOMIC_RELAXED, __HIP_MEMORY_SCOPE_AGENT); }
__device__ __forceinline__ unsigned xb_xcc_id() { return (unsigned)__builtin_amdgcn_s_getreg((3 << 11) | 20) & 0xFu; }
#define XB_SPIN(cond, bar) do { unsigned _sp = 0; while (cond) { __builtin_amdgcn_s_sleep(1); \
    if ((++_sp & 255u) == 0u) { if (xb_ld(&(bar)[XB_TMO])) break; if (_sp > XB_SPIN_CAP) { atomicAdd(&(bar)[XB_TMO], 1u); break; } } } } while (0)

struct XcdBarrier {
    unsigned* bar; unsigned x;
    volatile LAS unsigned* st;
};

__device__ __forceinline__ XcdBarrier xcd_barrier_post(unsigned* bar, volatile LAS unsigned* st, int tid) {
    XcdBarrier b; b.bar = bar; b.x = xb_xcc_id(); b.st = st;
    if (tid == 0) (void)xb_add(&bar[XB_XCNT(b.x)], 1u);
    return b;
}
__device__ __forceinline__ void xcd_barrier_complete(unsigned* bar, unsigned x, unsigned& nloc, unsigned& nx) {
    const unsigned G = gridDim.x * gridDim.y * gridDim.z;
    unsigned sum, cnt, mine, sp = 0u;
    for (;;) {
        sum = 0u; cnt = 0u; mine = 0u;
#pragma unroll
        for (unsigned j = 0; j < 16; ++j) { const unsigned c = xb_ld(&bar[XB_XCNT(j)]); sum += c; cnt += (c > 0u) ? 1u : 0u; mine = (j == x) ? c : mine; }
        if (sum == G) break;
        __builtin_amdgcn_s_sleep(1);
        if ((++sp & 255u) == 0u) { if (xb_ld(&bar[XB_TMO])) break; if (sp > XB_SPIN_CAP) { atomicAdd(&bar[XB_TMO], 1u); break; } }
    }
    nloc = mine > 0u ? mine : 1u; nx = cnt > 0u ? cnt : 1u;
}

__device__ __forceinline__ void xcd_barrier(const XcdBarrier& b, int tid) {
    asm volatile("s_waitcnt vmcnt(0)" ::: "memory");
    __syncthreads();
    if (tid == 0) {
        unsigned* bar = b.bar;
        __builtin_amdgcn_s_waitcnt(0);
        unsigned nloc = b.st[0], nx = b.st[1];
        if (nloc == 0u) { xcd_barrier_complete(bar, b.x, nloc, nx); b.st[0] = nloc; b.st[1] = nx; }
        const unsigned old = xb_add(&bar[XB_XSUB(b.x)], 1u);
        const unsigned gen = old / nloc;
        if (old + 1u == (gen + 1u) * nloc) {
            __builtin_amdgcn_fence(__ATOMIC_RELEASE, "agent");
            asm volatile("s_waitcnt vmcnt(0)" ::: "memory");
            const unsigned og = xb_add(&bar[XB_TOP], 1u);
            const unsigned tg = og / nx;
            if (og + 1u == (tg + 1u) * nx) xb_add(&bar[XB_TOPGEN], 1u);
            else XB_SPIN(xb_ld(&bar[XB_TOPGEN]) == tg, bar);
            __builtin_amdgcn_fence(__ATOMIC_ACQUIRE, "agent");
            xb_add(&bar[XB_XGEN(b.x)], 1u);
            asm volatile("s_waitcnt vmcnt(0)" ::: "memory");
        } else {
            XB_SPIN(xb_ld(&bar[XB_XGEN(b.x)]) == gen, bar);
            __builtin_amdgcn_fence(__ATOMIC_ACQUIRE, "agent");
            asm volatile("s_waitcnt vmcnt(0)" ::: "memory");
        }
    }
    __syncthreads();
}

#ifndef PROBE_ITEM
#define PROBE_ITEM 0
#endif
#ifndef PROBE_STAT
#define PROBE_STAT 0
#endif
constexpr int CW_PROBE = 3700;
struct OneUnit { Unit u; __device__ bool next(int i, Unit& o) const { if (i) return false; o = u; return true; } };
constexpr int MX_DFTL = 64, MX_LRUL = 64, MX_ATTL = 256, MX_LRUC = 256, MX_ATTC = 128, MX_DFTC = 32;
constexpr int MX_N = MX_DFTL + MX_LRUL + MX_ATTL + MX_LRUC + MX_ATTC + MX_DFTC;
constexpr int CW_QUEUE = 3520;
__device__ __forceinline__ void mixer_phase(ArgsP args_in, const Ctx& C_in, int l_in) {
    for (;;) {
        ArgsP args = args_in; asm volatile("" : "+s"(args));
        int tid_ = C_in.tid; asm volatile("" : "+v"(tid_));
        int l = l_in; asm volatile("" : "+s"(l));
        Ctx C; C.out = args->out; C.ws = args->ws; C.lds = C_in.lds; C.tid = tid_; C.lane = tid_ & 63; C.wave = __builtin_amdgcn_readfirstlane(tid_ >> 6); C.bid = C_in.bid; C.G = C_in.G;
        volatile LAS int* qslot = (volatile LAS int*)(C.lds + 131072 + 64);
        unsigned* qhead = (unsigned*)(C.ws + WS_CTL) + CW_QUEUE + 64 * l;
        __syncthreads();
        if (C.tid == 0) qslot[0] = (int)__hip_atomic_fetch_add(qhead, 1u, __ATOMIC_RELAXED, __HIP_MEMORY_SCOPE_AGENT);
        __syncthreads();
        int idx = __builtin_amdgcn_readfirstlane(qslot[0]);
        if (idx >= MX_N) break;
        const unsigned long long pt0 = (PROBE_ITEM != 0) ? __builtin_amdgcn_s_memrealtime() : 0ull; int ptype = 0;
        if (idx < MX_DFTL) { const int z = idx >> 4, pm = (idx >> 1) & 7, pn = idx & 1;
            OneUnit S; S.u.pm = pm; S.u.pn = pn; S.u.z = z; S.u.A = (const bf16_t*)(C.ws + WS_DFTL) + (size_t)pm * 256 * LS; S.u.B = (const bf16_t*)act_ptr(C, A_XFT) + (size_t)16 * 512 * LC + ((size_t)z * 512 + pn * 256) * LS;
            EpiDft E{(bf16_t*)act_ptr(C, A_Z), LS, MP + z * LS}; GEMM(C, S, E, LS, LS, LS); ptype = 1; }
        else { idx -= MX_DFTL;
        if (idx < MX_LRUL) { lru_item(args, C, l, idx); ptype = 2; } else { idx -= MX_LRUL;
        if (idx < MX_ATTL) { attn_unit(args, C, l, idx); ptype = 3; } else { idx -= MX_ATTL;
        if (idx < MX_LRUC) { lru_item(args, C, l, 64 + idx); ptype = 4; } else { idx -= MX_LRUC;
        if (idx < MX_ATTC) { attn_unit(args, C, l, 256 + idx); ptype = 5; } else { idx -= MX_ATTC;
        { const int z = idx >> 1, pn = idx & 1; ptype = 6;
            OneUnit S; S.u.pm = 0; S.u.pn = pn; S.u.z = z; S.u.A = (const bf16_t*)(C.ws + WS_DFTC); S.u.B = (const bf16_t*)act_ptr(C, A_XFT) + ((size_t)z * 512 + pn * 256) * LC;
            EpiDft E{(bf16_t*)act_ptr(C, A_Z), LC, z * LC}; GEMM(C, S, E, LC, LC, LC); } } } } } }
        if (PROBE_ITEM != 0 && ptype == PROBE_ITEM && C.tid == 0) { const unsigned dt = (unsigned)(__builtin_amdgcn_s_memrealtime() - pt0); unsigned* pw = (unsigned*)(C.ws + WS_CTL) + CW_PROBE;
            if (PROBE_STAT == 0) atomicMax(pw, dt); else atomicAdd(pw, dt); }
    }
}

constexpr int N_PHASES = 19;
#define FRESH_CTX ArgsP args = args0; asm volatile("" : "+s"(args)); Ctx C; { unsigned z_ = 0u; asm volatile("" : "+s"(z_)); int tid_ = wave0 * 64 + (int)__builtin_amdgcn_mbcnt_hi(~0u, __builtin_amdgcn_mbcnt_lo(~0u, z_)); asm volatile("" : "+v"(tid_)); \
    int bid_ = blockIdx.x; asm volatile("" : "+s"(bid_)); C.out = args->out; C.ws = args->ws; C.lds = lds; C.tid = tid_; C.lane = tid_ & 63; C.wave = __builtin_amdgcn_readfirstlane(tid_ >> 6); C.bid = bid_; C.G = gridDim.x; }
__device__ __forceinline__ void run_phase(ArgsP args0, LAS unsigned char* lds, const int wave0, int ph) {
    if (ph == 0) { FRESH_CTX; p0_prologue(args, C); return; }
    if (ph == 1) { FRESH_CTX; p0b_phase(args, C); return; }
    if (ph == N_PHASES - 1) { FRESH_CTX; finalnorm_phase(args, C); return; }
    const int l = (ph - 2) >> 3, s = (ph - 2) & 7;
    if (s == 0 || s == 6) { FRESH_CTX; const int sub = s ? 2 : 0; StaticOrder S; S.init(M, 2 * DFF, C.G, C.bid, (const bf16_t*)act_ptr(C, A_XN), D, (const bf16_t*)wl_ptr(C, l, s ? WL_GU2 : WL_GU1), D);
        EpiGU E{(bf16_t*)act_ptr(C, A_G), ssq_ptr(C, l * 3 + sub), sw_ptr(C, l, sub, 0)}; GEMM(C, S, E, D, D, D);
        constexpr int T_D1 = 2 * I_G, T_GU2 = T_D1 + I_D, T_D2 = T_GU2 + 2 * I_G, T_IN = T_D2 + I_D, T_A = T_IN + I_IN + I_BG, TB = TR_PER_LAYER;
        if (l == 0 && s == 0) { bg_transposes(args, C, T_D1, T_D2); bg_transposes(args, C, T_IN, TB); bg_wf2(args, C, 0, (C.G > 64) ? 32 : 0); }
        if (l == 0 && s == 6) { bg_transposes(args, C, T_D2, T_IN); bg_transposes(args, C, TB, TB + T_D1); bg_transposes(args, C, TB + T_GU2, TB + T_D2); bg_transposes(args, C, TB + T_IN, TB + T_A);
            const int skip = (C.G > 64) ? 32 : 0;
            if (C.bid >= skip) { LAS float* SC = (LAS float*)C.lds; const float* c_in = args->in[2]; const float* cctx = args->in[6];
                __syncthreads();
                { float cv[10];
#pragma unroll
                  for (int j = 0; j < 8; ++j) cv[j] = c_in[C.tid + j * NTHREADS];
#pragma unroll
                  for (int j = 8; j < 10; ++j) cv[j] = cctx[C.tid + (j - 8) * NTHREADS];
                  __builtin_amdgcn_sched_barrier(0);
#pragma unroll
                  for (int j = 0; j < 10; ++j) SC[C.tid + j * NTHREADS] = siluf_(cv[j]); }
                __syncthreads();
                for (int it = 144 + (C.bid - skip); it < 288; it += C.G - skip) mod_item(args, C, it, SC, (LAS float*)(C.lds + 32768), SC, false); } }
        if (l == 1 && s == 0) { bg_transposes(args, C, TB + T_D1, TB + T_GU2); bg_transposes(args, C, TB + T_A, 2 * TB); bg_sw_rows(C, 1, 5632, 5632 + 5376 + 5632, (C.G > 64) ? 32 : 0); bg_wf2(args, C, 1, (C.G > 64) ? 32 : 0); }
        if (l == 1 && s == 6) bg_transposes(args, C, TB + T_D2, TB + T_IN); }
    else if (s == 1 || s == 7) { FRESH_CTX; const bool t192 = (C.G == 256); const float* MODB = (const float*)(C.ws + OFF_MOD); const int sub = (s == 1) ? 0 : 2; const bool first = (l == 0 && s == 1);
        int ln = l, subn = 1; if (s == 7) { ln = (l == 0) ? 1 : -1; subn = 0; }
        const int sidx = (ln < 0) ? 6 : ln * 3 + subn;
        const bf16_t* Ad = (const bf16_t*)act_ptr(C, A_G); const bf16_t* Bd = (const bf16_t*)wl_ptr(C, l, s == 1 ? WL_D1 : WL_D2);
        const float* xi0 = first ? args->in[0] : C.out; const float* xi1 = first ? args->in[1] : C.out + (size_t)MP * D; const float* nwn = (ln < 0) ? args->in[10] : args->in[9] + (size_t)(ln * 3 + subn) * D;
        if (t192) { Tile192Order S{Ad, Bd, DFF, DFF, C.bid}; EpiRes192 E{C.out, xi0, xi1, MODB, (bf16_t*)act_ptr(C, A_XN), nwn, ssq_ptr(C, sidx), (unsigned*)(C.ws + WS_CTL) + CW_FIN, l, sub, ln, subn, 0.5f}; GEMM192(C, S, E, DFF, DFF, DFF); }
        else { StaticOrder S; S.init(M, D, C.G, C.bid, Ad, DFF, Bd, DFF); EpiRes E{C.out, xi0, xi1, MODB, (bf16_t*)act_ptr(C, A_XN), nwn, ssq_ptr(C, sidx), l, sub, ln, subn, 0.5f}; GEMM(C, S, E, DFF, DFF, DFF); }
        if (first) bg_sw_rows(C, 0, 5632, 5632 + 5376 + 5632, 0);
        if (l == 0 && s == 7) bg_sw_rows(C, 1, 0, 5632, 0); }
    else if (s == 2) { FRESH_CTX; StaticOrder S; S.init(M, NIN, C.G, C.bid, (const bf16_t*)act_ptr(C, A_XN), D, (const bf16_t*)wl_ptr(C, l, WL_IN), D);
        LAS float* ropel = (LAS float*)(C.lds + 131072 + 1024);
        { float rv[4];
#pragma unroll
          for (int j = 0; j < 4; ++j) rv[j] = ((const float*)(C.ws + OFF_ROPE))[C.tid + j * NTHREADS];
          __builtin_amdgcn_sched_barrier(0);
#pragma unroll
          for (int j = 0; j < 4; ++j) ropel[C.tid + j * NTHREADS] = rv[j]; }
        __syncthreads();
        EpiIn E{(bf16_t*)act_ptr(C, A_Q), (bf16_t*)act_ptr(C, A_K), (bf16_t*)act_ptr(C, A_VT), (bf16_t*)act_ptr(C, A_GY), (bf16_t*)act_ptr(C, A_XFT), (bf16_t*)act_ptr(C, A_G),
                (float*)act_ptr(C, A_XR), C.out, args->in[19] + (size_t)l * 3072, ropel, l, ssq_ptr(C, l * 3 + 1), sw_ptr(C, l, 1, 0)};
        GEMM(C, S, E, D, D, D); }
    else if (s == 3) { FRESH_CTX; mixer_phase(args, C, l); }
    else if (s == 4) { FRESH_CTX; const bool t192 = (C.G == 256);
        bf16_t* MG = (bf16_t*)act_ptr(C, A_XR); const bf16_t* G = (const bf16_t*)act_ptr(C, A_G);
        const bf16_t* A0 = (const bf16_t*)act_ptr(C, A_Q); const bf16_t* A1 = (const bf16_t*)act_ptr(C, A_XN); const bf16_t* A2 = (const bf16_t*)act_ptr(C, A_Z);
        const bf16_t* B0 = (const bf16_t*)wl_ptr(C, l, WL_A); const bf16_t* B1 = (const bf16_t*)wl_ptr(C, l, WL_L2); const bf16_t* B2 = (const bf16_t*)wl_ptr(C, l, WL_F2);
        if (t192) {
            BranchOrder192 S{A0, A1, A2, B0, B1, B2, C.bid, C.G}; EpiBranchSeg192 E{MG, G};
            pg8::gemm_phase_seg<3>(C.lds, fresh_tid(C), S, E);
        } else {
            { StaticOrder S; S.init(M, D, C.G, C.bid, A0, 512, B0, 512); EpiBranch<0> E{MG, G, 0}; GEMM(C, S, E, 512, 512, 512); }
            { StaticOrder S; S.init(M, D, C.G, C.bid, A1, D, B1, D); EpiBranch<1> E{MG, G, 1}; GEMM(C, S, E, D, D, D); }
            { StaticOrder S; S.init(M, D, C.G, C.bid, A2, D, B2, D); EpiBranch<1> E{MG, G, 2}; GEMM(C, S, E, D, D, D); } } }
    else if (s == 5) { FRESH_CTX; const bool t192 = (C.G == 256); const float* MODB = (const float*)(C.ws + OFF_MOD); const bf16_t* Ao = (const bf16_t*)act_ptr(C, A_XR); const bf16_t* Bo = (const bf16_t*)wl_ptr(C, l, WL_O); const float* nwn = args->in[9] + (size_t)(l * 3 + 2) * D;
        if (t192) { Tile192Order S{Ao, Bo, D, D, C.bid}; EpiRes192 E{C.out, C.out, C.out + (size_t)MP * D, MODB, (bf16_t*)act_ptr(C, A_XN), nwn, ssq_ptr(C, l * 3 + 2), (unsigned*)(C.ws + WS_CTL) + CW_FIN, l, 1, l, 2, 1.0f}; GEMM192(C, S, E, D, D, D); }
        else { StaticOrder S; S.init(M, D, C.G, C.bid, Ao, D, Bo, D); EpiRes E{C.out, C.out, C.out + (size_t)MP * D, MODB, (bf16_t*)act_ptr(C, A_XN), nwn, ssq_ptr(C, l * 3 + 2), l, 1, l, 2, 1.0f}; GEMM(C, S, E, D, D, D); } }
}

__global__ void __launch_bounds__(NTHREADS, 2) fwd_kernel(Args args_byval) {
    extern __shared__ __attribute__((aligned(16))) unsigned char lds_raw[];
    ArgsP args0 = (ArgsP)__builtin_amdgcn_kernarg_segment_ptr();
    const int lo = args0->ph_lo, hi = args0->ph_hi;
    volatile LAS unsigned* bst = (volatile LAS unsigned*)((LAS unsigned char*)lds_raw + 131072);
    const int wave0 = __builtin_amdgcn_readfirstlane(threadIdx.x >> 6);
#define TID_NOW() ({ unsigned z_ = 0u; asm volatile("" : "+s"(z_)); wave0 * 64 + (int)__builtin_amdgcn_mbcnt_hi(~0u, __builtin_amdgcn_mbcnt_lo(~0u, z_)); })
    { const int t = TID_NOW(); if (t < 2) bst[t] = 0u; }
    __syncthreads();
    (void)xcd_barrier_post((unsigned*)(args0->ws + WS_CTL), bst, TID_NOW());
    volatile LAS unsigned long long* tacc = (volatile LAS unsigned long long*)((LAS unsigned char*)lds_raw + 131072 + 128);
    if (PROBE_MASK != 0u && blockIdx.x == PROBE_BLOCK && TID_NOW() == 0) { tacc[0] = __builtin_amdgcn_s_memrealtime(); tacc[1] = 0ull; tacc[2] = 0ull; tacc[5] = 0ull; }
    for (int ph = lo; ph < hi; ++ph) {
        run_phase(args0, (LAS unsigned char*)lds_raw, wave0, ph);
#if PROBE_SEL == 2
        if (PROBE_MASK != 0u && blockIdx.x == PROBE_BLOCK && TID_NOW() == 0) tacc[3] = __builtin_amdgcn_s_memrealtime();
#endif
        if (ph + 1 < hi) { ArgsP args = args0; asm volatile("" : "+s"(args)); XcdBarrier xb; xb.bar = (unsigned*)(args->ws + WS_CTL); xb.x = xb_xcc_id(); xb.st = bst; xcd_barrier(xb, TID_NOW()); }
#if PROBE_SEL == 0
        if (PROBE_MASK != 0u && blockIdx.x == PROBE_BLOCK && TID_NOW() == 0) { const unsigned long long now = __builtin_amdgcn_s_memrealtime(); if ((PROBE_MASK >> ph) & 1u) tacc[1] = tacc[1] + (now - tacc[0]); tacc[0] = now; }
#elif PROBE_SEL == 1 || PROBE_SEL == 3
        if (PROBE_MASK != 0u && blockIdx.x == PROBE_BLOCK && TID_NOW() == 0) { const unsigned long long cur2 = tacc[2]; if ((PROBE_MASK >> ph) & 1u) tacc[1] = tacc[1] + (PROBE_SEL == 1 ? 8ull : 2ull) * (cur2 - tacc[5]); tacc[5] = cur2; tacc[0] = __builtin_amdgcn_s_memrealtime(); }
#else
        if (PROBE_MASK != 0u && blockIdx.x == PROBE_BLOCK && TID_NOW() == 0) { const unsigned long long now = __builtin_amdgcn_s_memrealtime(); if ((PROBE_MASK >> ph) & 1u) tacc[1] = tacc[1] + 8ull * (now - tacc[3]); tacc[0] = now; }
#endif
    }
    if (PROBE_ITEM != 0 && blockIdx.x == 0 && TID_NOW() == 0) { const unsigned v = __hip_atomic_load((unsigned*)(args0->ws + WS_CTL) + CW_PROBE, __ATOMIC_RELAXED, __HIP_MEMORY_SCOPE_AGENT); const unsigned long long want = PROBE_STAT ? v / 256u : v, t0 = __builtin_amdgcn_s_memrealtime(); while (__builtin_amdgcn_s_memrealtime() - t0 < want) __builtin_amdgcn_s_sleep(8); }
    if (PROBE_MASK != 0u && blockIdx.x == PROBE_BLOCK && TID_NOW() == 0) { const unsigned long long t0 = tacc[0], want = tacc[1]; while (__builtin_amdgcn_s_memrealtime() - t0 < want) __builtin_amdgcn_s_sleep(8); }
#undef TID_NOW
}

extern "C" void kernel_launch(void* const* d_in, const int* in_sizes, int n_in, void* d_out, int out_size, void* d_ws, size_t ws_size, hipStream_t stream) {
    if (n_in != 32 || ws_size < WS_END) { fprintf(stderr, "kernel_launch: n_in %d ws %zu (need %zu)\n", n_in, ws_size, (size_t)WS_END); return; }
    static int grid = 0;
    if (grid == 0) {
        int dev = 0, cus = 0, per_cu = 0;
        if (hipGetDevice(&dev) != hipSuccess || hipDeviceGetAttribute(&cus, hipDeviceAttributeMultiprocessorCount, dev) != hipSuccess) { fprintf(stderr, "kernel_launch: device query failed\n"); grid = -1; return; }
        if (hipFuncSetAttribute((const void*)fwd_kernel, hipFuncAttributeMaxDynamicSharedMemorySize, LDS_BYTES) != hipSuccess) { fprintf(stderr, "hipFuncSetAttribute failed\n"); grid = -1; return; }
        if (hipOccupancyMaxActiveBlocksPerMultiprocessor(&per_cu, (const void*)fwd_kernel, NTHREADS, LDS_BYTES) != hipSuccess || per_cu < 1) { fprintf(stderr, "kernel_launch: occupancy query says %d blocks per CU\n", per_cu); grid = -1; return; }
        if (per_cu > 1) per_cu = 1;
        grid = cus * per_cu;
    }
    if (grid < 0) return;
    Args a{};
    for (int i = 0; i < 32; ++i) a.in[i] = (const float*)d_in[i];
    a.out = (float*)d_out; a.ws = (unsigned char*)d_ws;
    a.ph_lo = 0; a.ph_hi = (grid == 256) ? N_PHASES - 1 : N_PHASES;
    if (hipMemsetAsync((char*)d_ws + WS_CTL, 0, CTL_ZERO_BYTES, stream) != hipSuccess) { fprintf(stderr, "hipMemsetAsync failed\n"); return; }
    void* kargs[] = {&a};
    hipError_t e = hipLaunchCooperativeKernel((const void*)fwd_kernel, dim3(grid), dim3(NTHREADS), kargs, LDS_BYTES, stream);
    if (e != hipSuccess) fprintf(stderr, "cooperative launch failed: %s (grid %d)\n", hipGetErrorString(e), grid);
}
```
